# Optimizing an MI355X kernel written in HIP

```python
import math
import jax, jax.numpy as jnp
from jax import lax
import numpy as np

D_MODEL = 2048
BATCH = 4
SEQ = 4096
DEPTH = 1

GRID_W = 64
CTX_LEN = 256
HEAD_DIM = 128
N_HEADS = D_MODEL // HEAD_DIM
HEADS_A = N_HEADS // 2
HEADS_B = N_HEADS - HEADS_A
KV_A = 2
KV_B = 2
WINDOW = 128
BLOCK = 128
FFN_HIDDEN = -(-8 * D_MODEL // 768) * 256
ROPE_THETA = 10000.0
EPS = 1e-6
ATTN_SCALE = HEAD_DIM ** -0.5
DN_ALPHA = (2.0 * DEPTH) ** 0.25
DN_BETA = (8.0 * DEPTH) ** -0.25

QA_W = HEADS_A * HEAD_DIM
KA_W = KV_A * HEAD_DIM
QB_W = HEADS_B * HEAD_DIM
KB_W = KV_B * HEAD_DIM
IN_WIDTH = QA_W + 2 * KA_W + QB_W + 2 * KB_W
IN_SPLITS = [QA_W, QA_W + KA_W, QA_W + 2 * KA_W, QA_W + 2 * KA_W + QB_W, QA_W + 2 * KA_W + QB_W + KB_W]
MIX_WIDTH = QA_W + QB_W

kernel_name = 'hybrid_window_sink_global_qknorm_dit_layer'


def layer_norm(x, g, b):
    xf = x.astype(jnp.float32)
    mu = jnp.mean(xf, axis=-1, keepdims=True)
    var = jnp.mean(jnp.square(xf - mu), axis=-1, keepdims=True)
    return ((xf - mu) * lax.rsqrt(var + EPS) * g + b).astype(x.dtype)


def rms_norm(x, g):
    xf = x.astype(jnp.float32)
    return (xf * lax.rsqrt(jnp.mean(jnp.square(xf), axis=-1, keepdims=True) + EPS) * g).astype(x.dtype)


def axial_rope_tables(rows):
    row_ids = jnp.repeat(jnp.arange(rows, dtype=jnp.float32), GRID_W)
    col_ids = jnp.tile(jnp.arange(GRID_W, dtype=jnp.float32), rows)
    axis_dim = HEAD_DIM // 2
    inv_freq = jnp.power(ROPE_THETA, -jnp.arange(0, axis_dim, 2, dtype=jnp.float32) / axis_dim)
    ang_r = row_ids[:, None] * inv_freq
    ang_c = col_ids[:, None] * inv_freq
    ang = jnp.concatenate([ang_r, ang_r, ang_c, ang_c], axis=-1)
    return jnp.cos(ang)[:, None, :], jnp.sin(ang)[:, None, :]


def rotate_half(x):
    x1, x2 = jnp.split(x, 2, axis=-1)
    return jnp.concatenate([-x2, x1], axis=-1)


def apply_axial_rope(x, cos, sin):
    xf = x.astype(jnp.float32)
    x_row, x_col = jnp.split(xf, 2, axis=-1)
    rot = jnp.concatenate([rotate_half(x_row), rotate_half(x_col)], axis=-1)
    return (xf * cos + rot * sin).astype(x.dtype)


def ada_mods(cond, w_ada, b_ada):
    m = jnp.einsum('bd,de->be', jax.nn.silu(cond), w_ada) + b_ada
    return [t[:, None, :] for t in jnp.split(m, 6, axis=-1)]


def modulate(x, shift, scale):
    return x * (1.0 + scale) + shift


def mixer_qkv(u, w_in, q_norm_g, k_norm_g, rope):
    B, N, _ = u.shape
    h = jnp.einsum('bnd,de->bne', u, w_in)
    qa, ka, va, qb, kb, vb = jnp.split(h, IN_SPLITS, axis=-1)
    heads = lambda t, n: t.reshape(B, N, n, HEAD_DIM)
    qa, ka, va = heads(qa, HEADS_A), heads(ka, KV_A), heads(va, KV_A)
    qb = rms_norm(heads(qb, HEADS_B), q_norm_g)
    kb = rms_norm(heads(kb, KV_B), k_norm_g)
    vb = heads(vb, KV_B)
    if rope is not None:
        cos, sin = rope
        qa, ka, qb, kb = (apply_axial_rope(t, cos, sin) for t in (qa, ka, qb, kb))
    return qa, ka, va, qb, kb, vb


def window_sink_attention(q, k, v, k_ctx, v_ctx, sink_logit):
    B, N = q.shape[0], q.shape[1]
    nb = N // BLOCK
    G = HEADS_A // KV_A
    qb = q.reshape(B, nb, BLOCK, KV_A, G, HEAD_DIM)
    pad = ((0, 0), (BLOCK, BLOCK), (0, 0), (0, 0))
    kp = jnp.pad(k, pad).reshape(B, nb + 2, BLOCK, KV_A, HEAD_DIM)
    vp = jnp.pad(v, pad).reshape(B, nb + 2, BLOCK, KV_A, HEAD_DIM)
    band = lambda t: jnp.concatenate([t[:, :-2], t[:, 1:-1], t[:, 2:]], axis=2)
    kb, vb = band(kp), band(vp)
    s_loc = jnp.einsum('bnqkgd,bnskd->bnkgqs', qb, kb, preferred_element_type=jnp.float32) * ATTN_SCALE
    blk = jnp.arange(nb)[:, None] * BLOCK
    qpos = blk + jnp.arange(BLOCK)[None, :]
    kpos = blk - BLOCK + jnp.arange(3 * BLOCK)[None, :]
    valid = ((jnp.abs(qpos[:, :, None] - kpos[:, None, :]) <= WINDOW)
             & (kpos[:, None, :] >= 0) & (kpos[:, None, :] < N))
    s_loc = jnp.where(valid[None, :, None, None, :, :], s_loc, -jnp.inf)
    s_ctx = jnp.einsum('bnqkgd,bckd->bnkgqc', qb, k_ctx, preferred_element_type=jnp.float32) * ATTN_SCALE
    sink_col = jnp.broadcast_to(sink_logit.reshape(KV_A, G)[None, None, :, :, None, None].astype(jnp.float32),
                                s_loc.shape[:-1] + (1,))
    p = jax.nn.softmax(jnp.concatenate([s_loc, s_ctx, sink_col], axis=-1), axis=-1)
    p_loc = p[..., :3 * BLOCK].astype(v.dtype)
    p_ctx = p[..., 3 * BLOCK:-1].astype(v.dtype)
    o = (jnp.einsum('bnkgqs,bnskd->bnqkgd', p_loc, vb)
         + jnp.einsum('bnkgqc,bckd->bnqkgd', p_ctx, v_ctx))
    return o.reshape(B, N, HEADS_A * HEAD_DIM)


def global_attention(q, k, v, k_ctx, v_ctx):
    B, N = q.shape[0], q.shape[1]
    nb = N // BLOCK
    G = HEADS_B // KV_B
    keys = jnp.concatenate([k, k_ctx], axis=1)
    vals = jnp.concatenate([v, v_ctx], axis=1)
    qb = q.reshape(B, nb, BLOCK, KV_B, G, HEAD_DIM).transpose(1, 0, 2, 3, 4, 5)

    def one_block(q_blk):
        s = jnp.einsum('bqkgd,bskd->bkgqs', q_blk, keys, preferred_element_type=jnp.float32) * ATTN_SCALE
        p = jax.nn.softmax(s, axis=-1).astype(vals.dtype)
        return jnp.einsum('bkgqs,bskd->bqkgd', p, vals)

    o = lax.map(one_block, qb)
    return o.transpose(1, 0, 2, 3, 4, 5).reshape(B, N, HEADS_B * HEAD_DIM)


def context_attention(q, k, v, sink_logit=None):
    B, C, H = q.shape[0], q.shape[1], q.shape[2]
    KV = k.shape[2]
    G = H // KV
    qg = q.reshape(B, C, KV, G, HEAD_DIM)
    s = jnp.einsum('bqkgd,bskd->bkgqs', qg, k, preferred_element_type=jnp.float32) * ATTN_SCALE
    if sink_logit is not None:
        col = jnp.broadcast_to(sink_logit.reshape(KV, G)[None, :, :, None, None].astype(jnp.float32),
                               s.shape[:-1] + (1,))
        s = jnp.concatenate([s, col], axis=-1)
    p = jax.nn.softmax(s, axis=-1)[..., :C].astype(v.dtype)
    o = jnp.einsum('bkgqs,bskd->bqkgd', p, v)
    return o.reshape(B, C, H * HEAD_DIM)


def swiglu(u, w_gate, w_up, w_down):
    return (jax.nn.silu(u @ w_gate) * (u @ w_up)) @ w_down


def setup_inputs(seed: int = 0) -> dict:
    key = jax.random.key(seed)
    ks = jax.random.split(key, 20)
    f32 = jnp.float32
    nrm = lambda k, shape, s: jax.random.normal(k, shape, f32) * s
    D, F, L = D_MODEL, FFN_HIDDEN, DEPTH
    return {
        'x': nrm(ks[0], (BATCH, SEQ, D), 1.0),
        'c': nrm(ks[1], (BATCH, D), 1.0),
        'ctx': nrm(ks[2], (BATCH, CTX_LEN, D), 1.0),
        'c_ctx': nrm(ks[3], (D,), 1.0),
        'w_ada': nrm(ks[4], (L, D, 6 * D), 0.3 * D ** -0.5),
        'b_ada': nrm(ks[5], (L, 6 * D), 0.02),
        'w_in': nrm(ks[6], (L, D, IN_WIDTH), D ** -0.5),
        'q_norm_g': 1.0 + nrm(ks[7], (L, HEAD_DIM), 0.02),
        'k_norm_g': 1.0 + nrm(ks[8], (L, HEAD_DIM), 0.02),
        'sink_logit': nrm(ks[9], (L, HEADS_A), 0.5),
        'w_out': nrm(ks[10], (L, MIX_WIDTH, D), DN_BETA * MIX_WIDTH ** -0.5),
        'ln1_g': 1.0 + nrm(ks[11], (L, D), 0.02),
        'ln1_b': nrm(ks[12], (L, D), 0.02),
        'w_gate': nrm(ks[13], (L, D, F), D ** -0.5),
        'w_up': nrm(ks[14], (L, D, F), D ** -0.5),
        'w_down': nrm(ks[15], (L, F, D), DN_BETA * F ** -0.5),
        'ln2_g': 1.0 + nrm(ks[16], (L, D), 0.02),
        'ln2_b': nrm(ks[17], (L, D), 0.02),
    }


def reference(x, c, ctx, c_ctx, w_ada, b_ada, w_in, q_norm_g, k_norm_g, sink_logit,
              w_out, ln1_g, ln1_b, w_gate, w_up, w_down, ln2_g, ln2_b):
    ROWS = x.shape[1] // GRID_W
    rope = axial_rope_tables(ROWS)
    for layer in range(DEPTH):
        sh1, sc1, g1, sh2, sc2, g2 = ada_mods(c, w_ada[layer], b_ada[layer])
        csh1, csc1, cg1, csh2, csc2, cg2 = ada_mods(c_ctx[None, :], w_ada[layer], b_ada[layer])

        qa, ka, va, qb, kb, vb = mixer_qkv(modulate(x, sh1, sc1), w_in[layer],
                                           q_norm_g[layer], k_norm_g[layer], rope)
        qac, kac, vac, qbc, kbc, vbc = mixer_qkv(modulate(ctx, csh1, csc1), w_in[layer],
                                                 q_norm_g[layer], k_norm_g[layer], None)
        heads = jnp.concatenate([window_sink_attention(qa, ka, va, kac, vac, sink_logit[layer]),
                                 global_attention(qb, kb, vb, kbc, vbc)], axis=-1)
        x = layer_norm(DN_ALPHA * x + g1 * (heads @ w_out[layer]), ln1_g[layer], ln1_b[layer])

        x = layer_norm(DN_ALPHA * x + g2 * swiglu(modulate(x, sh2, sc2), w_gate[layer], w_up[layer], w_down[layer]),
                       ln2_g[layer], ln2_b[layer])

        if layer < DEPTH - 1:
            heads_c = jnp.concatenate([context_attention(qac, kac, vac, sink_logit[layer]),
                                       context_attention(qbc, kbc, vbc)], axis=-1)
            ctx = layer_norm(DN_ALPHA * ctx + cg1 * (heads_c @ w_out[layer]), ln1_g[layer], ln1_b[layer])
            ctx = layer_norm(DN_ALPHA * ctx + cg2 * swiglu(modulate(ctx, csh2, csc2), w_gate[layer], w_up[layer], w_down[layer]),
                             ln2_g[layer], ln2_b[layer])
    return x
```

```cpp
#include <hip/hip_runtime.h>
#include <hip/hip_bf16.h>
#include <cstdio>
#include <cstdint>

#ifndef MK_N_LAUNCHES
#define MK_N_LAUNCHES 1
#endif

namespace pg8 {
#define PG8_LAS __attribute__((address_space(3)))
typedef unsigned short bf16_t;
typedef short bf16x8 __attribute__((ext_vector_type(8)));
typedef float f32x4 __attribute__((ext_vector_type(4)));
typedef unsigned u32x4 __attribute__((ext_vector_type(4)));
constexpr int BM = 256, BK = 64, HALF = 128, HTB = HALF * BK * 2, STAGE_BYTES = 8 * HTB, NXCD = 8, WGM = 8;

__host__ __device__ __forceinline__ int lds_byte(int r, int c) { const int st = (r >> 4) * 2 + (c >> 5), rr = r & 15, cc = c & 31, ob = rr * 64 + cc * 2; return st * 1024 + (ob ^ (((ob >> 9) & 1) << 5)); }
__host__ __device__ __forceinline__ void stage_rc(int b, int& R, int& C) { const int st = b / 1024, sb = b % 1024, swz = sb ^ (((sb >> 9) & 1) << 5); R = (st >> 1) * 16 + swz / 64; C = (st & 1) * 32 + (swz % 64) / 2; }
__host__ __device__ __forceinline__ int perm32(int rho) { const int n = rho >> 4, i = rho & 15; return 8 * (i >> 2) + 4 * n + (i & 3); }

struct Unit { int pm, pn; };
struct Gemm { const bf16_t* A; const bf16_t* Bt; int M, N, K; };

struct StaticOrder {
    int nM, nN, nwg, G, c;
    __host__ __device__ void init(int M, int N, int G_, int c_) { nM = M / BM; nN = N / BM; nwg = nM * nN; G = G_; c = c_; }
    __host__ __device__ bool next(int i, Unit& u) const {
        const long L = (long)i * G + c; if (L >= nwg) return false;
        int wgid = (int)L; { const int q = nwg / NXCD, r = nwg % NXCD, xcd = wgid % NXCD, off = wgid / NXCD; wgid = (xcd < r ? xcd * (q + 1) : r * (q + 1) + (xcd - r) * q) + off; }
        const int nig = WGM * nN, gid = wgid / nig, fm = gid * WGM, gsz = (nM - fm) < WGM ? (nM - fm) : WGM;
        u.pm = fm + ((wgid % nig) % gsz); u.pn = (wgid % nig) / gsz; return true;
    }
    __device__ __forceinline__ void a_ready(const Unit&) const {}
    __device__ __forceinline__ void done(const Unit&) const {}
};
struct OneUnit {
    int pm, pn;
    __device__ bool next(int i, Unit& u) const { if (i > 0) return false; u.pm = pm; u.pn = pn; return true; }
    __device__ __forceinline__ void a_ready(const Unit&) const {}
    __device__ __forceinline__ void done(const Unit&) const {}
};

__device__ __forceinline__ unsigned cvt_pk_bf16(float lo, float hi) { unsigned r; asm volatile("v_cvt_pk_bf16_f32 %0, %1, %2" : "=v"(r) : "v"(lo), "v"(hi)); return r; }


struct EpiQKV {
    static constexpr bool PERM = true, AFTER_DRAIN = false;
    bf16_t* QO; bf16_t* KA; bf16_t* VA; bf16_t* KB; bf16_t* VB;
    const float* qg; const float* kg; const float* ropec; const float* ropes;
    PG8_LAS float* xch;
    __device__ __forceinline__ void operator()(const f32x4 (&acc)[2][2][4][2], const Unit& u, int wr, int wc, int fr, int fq) const {
        const int pn = u.pn; const bool is_ctx = u.pm >= 64;
        const int b = is_ctx ? (u.pm - 64) : (u.pm >> 4), t0 = is_ctx ? 4096 : ((u.pm & 15) << 8);
        const int hh = wc >> 1, part = wc & 1, wid = wr * 4 + wc;
        const bool isq = (pn < 4) || (pn >= 6 && pn < 10), donorm = (pn >= 6 && pn <= 10), dorope = (!is_ctx) && pn != 5 && pn != 11;
        bf16_t* base; size_t rstride;
        if (isq) { const int head = (pn < 4 ? 2 * pn : 8 + 2 * (pn - 6)) + hh; base = QO + (size_t)(b * 4096 + t0) * 2048 + head * 128; rstride = 2048; }
        else { bf16_t* buf = pn == 4 ? KA : pn == 5 ? VA : pn == 10 ? KB : VB; base = buf + ((size_t)(b * 2 + hh) * 4352 + t0) * 128; rstride = 128; }
        const int d0 = 64 * part + 8 * fq;
        float rs[2][4];
        f32x4 gv[2][2];
#pragma unroll
        for (int bj = 0; bj < 2; ++bj)
#pragma unroll
            for (int n = 0; n < 2; ++n) gv[bj][n] = (f32x4){1.f, 1.f, 1.f, 1.f};
#pragma unroll
        for (int ai = 0; ai < 2; ++ai)
#pragma unroll
            for (int m = 0; m < 4; ++m) rs[ai][m] = 1.f;
        if (donorm) {
            const float* g = (pn == 10) ? kg : qg;
#pragma unroll
            for (int bj = 0; bj < 2; ++bj)
#pragma unroll
                for (int n = 0; n < 2; ++n) gv[bj][n] = *(const f32x4*)(g + d0 + 32 * bj + 4 * n);
#pragma unroll
            for (int ai = 0; ai < 2; ++ai)
#pragma unroll
                for (int m = 0; m < 4; ++m) {
                    float s = 0.f;
#pragma unroll
                    for (int bj = 0; bj < 2; ++bj)
#pragma unroll
                        for (int n = 0; n < 2; ++n) { const f32x4 x = acc[ai][bj][m][n]; s += (x[0] * x[0] + x[1] * x[1]) + (x[2] * x[2] + x[3] * x[3]); }
                    s += __shfl_xor(s, 16); s += __shfl_xor(s, 32);
                    if (fq == 0) xch[wid * 128 + ai * 64 + m * 16 + fr] = s;
                    rs[ai][m] = s;
                }
            asm volatile("s_waitcnt lgkmcnt(0)" ::: "memory"); __builtin_amdgcn_s_barrier(); asm volatile("" ::: "memory");
#pragma unroll
            for (int ai = 0; ai < 2; ++ai)
#pragma unroll
                for (int m = 0; m < 4; ++m) { const float o = xch[(wid ^ 1) * 128 + ai * 64 + m * 16 + fr]; rs[ai][m] = __builtin_amdgcn_rsqf((rs[ai][m] + o) * (1.0f / 128.0f) + 1e-6f); }
        }
#pragma unroll
        for (int ai = 0; ai < 2; ++ai)
#pragma unroll
            for (int m = 0; m < 4; ++m) {
                const int rt = ai * HALF + wr * 64 + m * 16 + fr;
                f32x4 lo[2], hi[2];
#pragma unroll
                for (int n = 0; n < 2; ++n) { lo[n] = acc[ai][0][m][n] * rs[ai][m] * gv[0][n]; hi[n] = acc[ai][1][m][n] * rs[ai][m] * gv[1][n]; }
                if (dorope) {
                    const int t = t0 + rt, pos = part ? (t & 63) : (t >> 6);
#pragma unroll
                    for (int n = 0; n < 2; ++n) {
                        const f32x4 c4 = *(const f32x4*)(ropec + pos * 32 + 8 * fq + 4 * n), s4 = *(const f32x4*)(ropes + pos * 32 + 8 * fq + 4 * n);
                        const f32x4 a = lo[n], bb = hi[n];
                        lo[n] = a * c4 - bb * s4; hi[n] = bb * c4 + a * s4;
                    }
                }
                bf16_t* rowp = base + (size_t)rt * rstride + d0;
                u32x4 w0, w1;
                w0.x = cvt_pk_bf16(lo[0][0], lo[0][1]); w0.y = cvt_pk_bf16(lo[0][2], lo[0][3]); w0.z = cvt_pk_bf16(lo[1][0], lo[1][1]); w0.w = cvt_pk_bf16(lo[1][2], lo[1][3]);
                w1.x = cvt_pk_bf16(hi[0][0], hi[0][1]); w1.y = cvt_pk_bf16(hi[0][2], hi[0][3]); w1.z = cvt_pk_bf16(hi[1][0], hi[1][1]); w1.w = cvt_pk_bf16(hi[1][2], hi[1][3]);
                *(u32x4*)(rowp) = w0; *(u32x4*)(rowp + 32) = w1;
            }
    }
};

struct EpiResid {
    static constexpr bool PERM = false, AFTER_DRAIN = false;
    const float* res; const float* gate; float* out; float alpha;
    __device__ __forceinline__ void operator()(const f32x4 (&acc)[2][2][4][2], const Unit& u, int wr, int wc, int fr, int fq) const {
        const int row0 = u.pm * BM + wr * 64 + fr, col0 = u.pn * BM + wc * 32 + 4 * fq, b = u.pm >> 4;
        f32x4 gv[2][2];
#pragma unroll
        for (int bj = 0; bj < 2; ++bj)
#pragma unroll
            for (int n = 0; n < 2; ++n) gv[bj][n] = *(const f32x4*)(gate + b * 12288 + col0 + bj * HALF + n * 16);
#pragma unroll
        for (int ai = 0; ai < 2; ++ai)
#pragma unroll
            for (int m = 0; m < 4; ++m) { const size_t off = (size_t)(row0 + ai * HALF + m * 16) * 2048 + col0;
#pragma unroll
                for (int bj = 0; bj < 2; ++bj)
#pragma unroll
                    for (int n = 0; n < 2; ++n) { const f32x4 xv = *(const f32x4*)(res + off + bj * HALF + n * 16);
                        *(f32x4*)(out + off + bj * HALF + n * 16) = xv * alpha + gv[bj][n] * acc[ai][bj][m][n]; } }
    }
};

struct EpiSwiglu {
    static constexpr bool PERM = true, AFTER_DRAIN = false;
    bf16_t* H; int ldh;
    __device__ __forceinline__ void operator()(const f32x4 (&acc)[2][2][4][2], const Unit& u, int wr, int wc, int fr, int fq) const {
        const int row0 = u.pm * BM + wr * 64 + fr, col0 = u.pn * 128 + wc * 32 + 8 * fq;
#pragma unroll
        for (int ai = 0; ai < 2; ++ai)
#pragma unroll
            for (int m = 0; m < 4; ++m) { bf16_t* rowp = H + (size_t)(row0 + ai * HALF + m * 16) * ldh + col0;
                f32x4 o[2];
#pragma unroll
                for (int n = 0; n < 2; ++n) { const f32x4 g = acc[ai][0][m][n], up = acc[ai][1][m][n];
#pragma unroll
                    for (int e = 0; e < 4; ++e) { const float sg = __builtin_amdgcn_rcpf(1.0f + __builtin_amdgcn_exp2f(-1.4426950408889634f * g[e])); o[n][e] = g[e] * sg * up[e]; } }
                u32x4 w; w.x = cvt_pk_bf16(o[0][0], o[0][1]); w.y = cvt_pk_bf16(o[0][2], o[0][3]); w.z = cvt_pk_bf16(o[1][0], o[1][1]); w.w = cvt_pk_bf16(o[1][2], o[1][3]);
                *(u32x4*)rowp = w; }
    }
};

template <class Epi, class Sched, bool ALIGN_EPI = false, bool SP2 = false>
__device__ __forceinline__ void gemm_phase(PG8_LAS unsigned char* lds, const Gemm g, const Sched& S, const Epi& E) {
    const int tid = threadIdx.x, wid = __builtin_amdgcn_readfirstlane(tid >> 6), lane = tid & 63, wr = wid >> 2, wc = wid & 3, fr = lane & 15, fq = lane >> 4;
    const int K = g.K, nt = K / BK;
    unsigned voffA[2], voffB[2];
#pragma unroll
    for (int i = 0; i < 2; ++i) { int R, C; stage_rc(tid * 16 + i * 8192, R, C); const int Rb = Epi::PERM ? ((R & ~31) + perm32(R & 31)) : R;
        voffA[i] = (unsigned)(R * K + C) * 2u; voffB[i] = (unsigned)(Rb * K + C) * 2u; }
    const size_t kstep = (size_t)(BK * 2);
    const size_t hstep = (size_t)HALF * K * 2;
    const size_t tstep = 2 * hstep;
    const unsigned ldsw = (unsigned)wid * 1024u;
    const int aoff = lds_byte(wr * 64 + fr, fq * 8), boff = lds_byte(wc * 32 + fr, fq * 8);
#define PG8_SA(b, h) (((b) * 2 + (h)) * HTB)
#define PG8_SB(b, h) ((4 + (b) * 2 + (h)) * HTB)
#define PG8_STAGE(bufoff, gbase, voff) do { _Pragma("unroll") for (int _i = 0; _i < 2; ++_i) \
        __builtin_amdgcn_global_load_lds((const unsigned*)((const char*)(gbase) + (voff)[_i]), (PG8_LAS unsigned*)(lds + (bufoff) + ldsw + _i * 8192), 16, 0, 0); } while (0)
#define PG8_LDA(dst, b, h) do { _Pragma("unroll") for (int m = 0; m < 4; ++m) _Pragma("unroll") for (int k = 0; k < 2; ++k) dst[m][k] = *(const PG8_LAS bf16x8*)(lds + PG8_SA(b, h) + aoff + m * 2048 + k * 1024); } while (0)
#define PG8_LDB(dst, b, h) do { _Pragma("unroll") for (int n = 0; n < 2; ++n) _Pragma("unroll") for (int k = 0; k < 2; ++k) dst[n][k] = *(const PG8_LAS bf16x8*)(lds + PG8_SB(b, h) + boff + n * 2048 + k * 1024); } while (0)
#define PG8_MMA(ai, bj, At, Bt) do { __builtin_amdgcn_s_setprio(1); _Pragma("unroll") for (int m = 0; m < 4; ++m) _Pragma("unroll") for (int n = 0; n < 2; ++n) _Pragma("unroll") for (int k = 0; k < 2; ++k) \
        acc[ai][bj][m][n] = __builtin_amdgcn_mfma_f32_16x16x32_bf16(Bt[n][k], At[m][k], acc[ai][bj][m][n], 0, 0, 0); __builtin_amdgcn_s_setprio(0); } while (0)
#define PG8_WAIT_V(n) asm volatile("s_waitcnt vmcnt(" #n ")" ::: "memory")
#define PG8_WAIT_L(n) asm volatile("s_waitcnt lgkmcnt(" #n ")" ::: "memory")
#define PG8_BAR __builtin_amdgcn_s_barrier()
#define PG8_SCHED __builtin_amdgcn_sched_barrier(0)
    Unit cur, nxt; int ui = 0;
    if (!S.next(0, cur)) return;
    f32x4 acc[2][2][4][2];
#pragma unroll
    for (int a = 0; a < 2; ++a)
#pragma unroll
        for (int b = 0; b < 2; ++b)
#pragma unroll
            for (int m = 0; m < 4; ++m)
#pragma unroll
                for (int n = 0; n < 2; ++n) acc[a][b][m][n] = (f32x4){0.f, 0.f, 0.f, 0.f};
    bf16x8 At[4][2], B0[2][2], B1[2][2];
    const char* cA = (const char*)g.A + (size_t)cur.pm * tstep; const char* cB = (const char*)g.Bt + (size_t)cur.pn * tstep;
    S.a_ready(cur);
    if constexpr (SP2) {
        PG8_STAGE(PG8_SB(0, 0), cB, voffB); PG8_STAGE(PG8_SB(0, 1), cB + hstep, voffB); PG8_STAGE(PG8_SA(0, 0), cA, voffA); PG8_STAGE(PG8_SA(0, 1), cA + hstep, voffA);
        if (wr == 1) PG8_BAR;
        PG8_WAIT_V(2); PG8_BAR;
        PG8_STAGE(PG8_SB(1, 0), cB + kstep, voffB); PG8_STAGE(PG8_SA(1, 0), cA + kstep, voffA); PG8_STAGE(PG8_SB(1, 1), cB + hstep + kstep, voffB);
        PG8_WAIT_V(6); PG8_BAR;
    } else {
        PG8_STAGE(PG8_SB(0, 0), cB, voffB); PG8_STAGE(PG8_SA(0, 0), cA, voffA); PG8_STAGE(PG8_SB(0, 1), cB + hstep, voffB); PG8_STAGE(PG8_SA(0, 1), cA + hstep, voffA);
        if (wr == 1) PG8_BAR;
        PG8_WAIT_V(4); PG8_BAR;
        PG8_STAGE(PG8_SB(1, 0), cB + kstep, voffB); PG8_STAGE(PG8_SA(1, 0), cA + kstep, voffA); PG8_STAGE(PG8_SB(1, 1), cB + hstep + kstep, voffB);
        PG8_WAIT_V(6); PG8_BAR;
    }
    for (;;) {
        const bool has_next = S.next(ui + 1, nxt);
        const char* nA = has_next ? (const char*)g.A + (size_t)nxt.pm * tstep : cA; const char* nB = has_next ? (const char*)g.Bt + (size_t)nxt.pn * tstep : cB;
        for (int t = 0; t < nt; t += 2) {
            const bool last = (t == nt - 2);
            const char* a1 = cA + (size_t)(t + 1) * kstep;
            const char* a2 = last ? nA : cA + (size_t)(t + 2) * kstep; const char* b2 = last ? nB : cB + (size_t)(t + 2) * kstep;
            const char* a3 = a2 + kstep; const char* b3 = b2 + kstep;
            if (last && has_next) S.a_ready(nxt);
            if constexpr (SP2) {
            PG8_LDB(B0, 0, 0); PG8_LDB(B1, 0, 1); PG8_SCHED; PG8_LDA(At, 0, 0); PG8_STAGE(PG8_SA(1, 1), a1 + hstep, voffA);
            PG8_WAIT_V(8); PG8_WAIT_L(0); PG8_BAR; PG8_MMA(0, 0, At, B0); PG8_MMA(0, 1, At, B1); PG8_BAR; PG8_SCHED;
            PG8_LDA(At, 0, 1); PG8_STAGE(PG8_SB(0, 0), b2, voffB); PG8_STAGE(PG8_SB(0, 1), b2 + hstep, voffB); PG8_STAGE(PG8_SA(0, 0), a2, voffA);
            PG8_WAIT_V(8); PG8_WAIT_L(0); PG8_BAR; PG8_MMA(1, 0, At, B0); PG8_MMA(1, 1, At, B1); PG8_BAR; PG8_SCHED;
            PG8_LDB(B0, 1, 0); PG8_LDB(B1, 1, 1); PG8_SCHED; PG8_LDA(At, 1, 0); PG8_STAGE(PG8_SA(0, 1), a2 + hstep, voffA);
            PG8_WAIT_V(8); PG8_WAIT_L(0); PG8_BAR; PG8_MMA(0, 0, At, B0); PG8_MMA(0, 1, At, B1); PG8_BAR; PG8_SCHED;
            PG8_LDA(At, 1, 1); PG8_STAGE(PG8_SB(1, 0), b3, voffB); PG8_STAGE(PG8_SB(1, 1), b3 + hstep, voffB); PG8_STAGE(PG8_SA(1, 0), a3, voffA);
            PG8_WAIT_V(8); PG8_WAIT_L(0); PG8_BAR; PG8_MMA(1, 0, At, B0); PG8_MMA(1, 1, At, B1); PG8_BAR; PG8_SCHED;
            } else {
            PG8_LDB(B0, 0, 0); PG8_SCHED; PG8_LDA(At, 0, 0); PG8_STAGE(PG8_SA(1, 1), a1 + hstep, voffA);
            PG8_WAIT_L(8); PG8_BAR; PG8_WAIT_L(0); PG8_MMA(0, 0, At, B0); PG8_BAR; PG8_SCHED;
            PG8_LDB(B1, 0, 1); PG8_STAGE(PG8_SB(0, 0), b2, voffB);
            PG8_BAR; PG8_WAIT_L(0); PG8_MMA(0, 1, At, B1); PG8_BAR;
            PG8_LDA(At, 0, 1); PG8_STAGE(PG8_SA(0, 0), a2, voffA);
            PG8_BAR; PG8_WAIT_L(0); PG8_MMA(1, 0, At, B0); PG8_BAR; PG8_SCHED;
            PG8_STAGE(PG8_SB(0, 1), b2 + hstep, voffB);
            PG8_WAIT_V(6); PG8_BAR; PG8_MMA(1, 1, At, B1); PG8_BAR;
            PG8_LDB(B0, 1, 0); PG8_SCHED; PG8_LDA(At, 1, 0); PG8_STAGE(PG8_SA(0, 1), a2 + hstep, voffA);
            PG8_WAIT_L(8); PG8_BAR; PG8_WAIT_L(0); PG8_MMA(0, 0, At, B0); PG8_BAR; PG8_SCHED;
            PG8_LDB(B1, 1, 1); PG8_STAGE(PG8_SB(1, 0), b3, voffB);
            PG8_BAR; PG8_WAIT_L(0); PG8_MMA(0, 1, At, B1); PG8_BAR;
            PG8_LDA(At, 1, 1); PG8_STAGE(PG8_SA(1, 0), a3, voffA);
            PG8_BAR; PG8_WAIT_L(0); PG8_MMA(1, 0, At, B0); PG8_BAR; PG8_SCHED;
            PG8_STAGE(PG8_SB(1, 1), b3 + hstep, voffB);
            PG8_WAIT_V(6); PG8_BAR; PG8_MMA(1, 1, At, B1); PG8_BAR;
            }
        }
        if constexpr (ALIGN_EPI) { if (wr == 0) PG8_BAR; }
        if constexpr (!Epi::AFTER_DRAIN) { E(acc, cur, wr, wc, fr, fq); S.done(cur); }
        if (!has_next) break;
#pragma unroll
        for (int a = 0; a < 2; ++a)
#pragma unroll
            for (int b = 0; b < 2; ++b)
#pragma unroll
                for (int m = 0; m < 4; ++m)
#pragma unroll
                    for (int n = 0; n < 2; ++n) acc[a][b][m][n] = (f32x4){0.f, 0.f, 0.f, 0.f};
        cur = nxt; cA = nA; cB = nB; ++ui;
        if constexpr (ALIGN_EPI) { if (wr == 1) PG8_BAR; }
    }
    PG8_WAIT_V(0);
    if constexpr (!ALIGN_EPI) { if (wr == 0) PG8_BAR; }
    PG8_BAR;
#undef PG8_SA
#undef PG8_SB
#undef PG8_STAGE
#undef PG8_LDA
#undef PG8_LDB
#undef PG8_MMA
#undef PG8_WAIT_V
#undef PG8_WAIT_L
#undef PG8_BAR
#undef PG8_SCHED
}
}

namespace att {
typedef unsigned short bf16;
using bf16x8 = __attribute__((ext_vector_type(8))) short;
using s16x4  = __attribute__((ext_vector_type(4))) short;
using f32x16 = __attribute__((ext_vector_type(16))) float;
using u32x4  = __attribute__((ext_vector_type(4))) unsigned;
constexpr int D = 128, NW = 8, QBLK = 32, KVBLK = 64;
constexpr float SCALE = 0.088388347648318440f;
constexpr float THR = 8.f;
constexpr int LDQ = 2048, LDK = 128, LDO = 2048;
constexpr int SHM_V = KVBLK * D * 2, SHM_K = KVBLK * D * 2, SHM_ATTN = 2 * SHM_V + 2 * SHM_K + NW * 64 * 4;
#define KSWZ(row, colB) ((row) * 256 + ((colB) ^ (((row) & 7) << 4)))
#define SBAR() __builtin_amdgcn_sched_barrier(0)
__device__ __forceinline__ int crow(int r, int hi) { return (r & 3) + 8 * (r >> 2) + 4 * hi; }
__device__ __forceinline__ unsigned cvtpk(float lo, float hi) { unsigned r; asm volatile("v_cvt_pk_bf16_f32 %0, %1, %2" : "=v"(r) : "v"(lo), "v"(hi)); return r; }

__device__ __forceinline__ void partialSM(f32x16& p0, f32x16& p1, float& m_reg, float& mn, float& alpha) {
  constexpr float C = SCALE * 1.4426950408889634f;
  float pmax = p0[0]; for (int r = 1; r < 16; ++r) pmax = fmaxf(pmax, p0[r]); for (int r = 0; r < 16; ++r) pmax = fmaxf(pmax, p1[r]);
  { auto rr = __builtin_amdgcn_permlane32_swap(__float_as_uint(pmax), __float_as_uint(pmax), false, false);
    pmax = fmaxf(__uint_as_float(rr[0]), __uint_as_float(rr[1])); }
  if (__builtin_expect(__all(pmax - m_reg <= THR / SCALE), 1)) { mn = m_reg; alpha = 1.f; }
  else { mn = fmaxf(m_reg, pmax); alpha = __builtin_amdgcn_exp2f((m_reg - mn) * C); m_reg = mn; }
  float mnC = -mn * C;
  for (int r = 0; r < 16; ++r) p0[r] = fmaf(p0[r], C, mnC); for (int r = 0; r < 16; ++r) p1[r] = fmaf(p1[r], C, mnC);
  for (int r = 0; r < 16; ++r) p0[r] = __builtin_amdgcn_exp2f(p0[r]);
}
__device__ __forceinline__ void finishSM(f32x16& p0, f32x16& p1, float alpha, float& l_reg, bf16x8& pa0, bf16x8& pa1, bf16x8& pa2, bf16x8& pa3) {
  for (int r = 0; r < 16; ++r) p1[r] = __builtin_amdgcn_exp2f(p1[r]);
  float ps = 0; for (int r = 0; r < 16; ++r) ps += p0[r]; for (int r = 0; r < 16; ++r) ps += p1[r];
  { auto rr = __builtin_amdgcn_permlane32_swap(__float_as_uint(ps), __float_as_uint(ps), false, false);
    ps = __uint_as_float(rr[0]) + __uint_as_float(rr[1]); }
  l_reg = l_reg * alpha + ps;
#define PK4(P, BASE, OUT) do { unsigned a0 = cvtpk(P[BASE + 0], P[BASE + 1]), a1 = cvtpk(P[BASE + 2], P[BASE + 3]);   \
    unsigned b0 = cvtpk(P[BASE + 4], P[BASE + 5]), b1 = cvtpk(P[BASE + 6], P[BASE + 7]);                              \
    auto r0 = __builtin_amdgcn_permlane32_swap(a0, b0, false, false); auto r1 = __builtin_amdgcn_permlane32_swap(a1, b1, false, false); \
    u32x4 w = {r0[0], r1[0], r0[1], r1[1]}; OUT = *reinterpret_cast<bf16x8*>(&w); } while (0)
  PK4(p0, 0, pa0); PK4(p0, 8, pa1); PK4(p1, 0, pa2); PK4(p1, 8, pa3);
#undef PK4
}
__device__ __forceinline__ void qkt(f32x16& p0, f32x16& p1, const bf16* Ks, const bf16x8* qr, int r32, int hi) {
  p0 = f32x16{}; p1 = f32x16{};
  for (int d0 = 0; d0 < 8; ++d0) { int cb = (d0 * 16 + hi * 8) * 2;
    bf16x8 b0 = *reinterpret_cast<const bf16x8*>((const char*)Ks + KSWZ(r32, cb));
    bf16x8 b1 = *reinterpret_cast<const bf16x8*>((const char*)Ks + KSWZ(32 + r32, cb));
    p0 = __builtin_amdgcn_mfma_f32_32x32x16_bf16(b0, qr[d0], p0, 0, 0, 0);
    p1 = __builtin_amdgcn_mfma_f32_32x32x16_bf16(b1, qr[d0], p1, 0, 0, 0); }
}
__device__ __forceinline__ void wmask(f32x16& p0, f32x16& p1, int kb, int qpos) {
  const int dq = qpos - kb + 128;
#pragma unroll
  for (int r = 0; r < 16; ++r) { const int d = dq - ((r & 3) + 8 * (r >> 2));
    if ((unsigned)d > 256u) p0[r] = -INFINITY;
    if ((unsigned)(d - 32) > 256u) p1[r] = -INFINITY; }
}
__device__ __forceinline__ int v_st(int k, int c) { const int kk = (k & ~0xC) | ((k & 4) << 1) | ((k & 8) >> 1); return ((kk >> 3) * 4 + (c >> 5)) * 512 + ((kk & 7) * 32 + (c & 31)) * 2; }
__device__ __forceinline__ int v_rd_base(int lane) { return ((lane & 3) << 3) | (((lane >> 2) & 3) << 6) | (((lane >> 4) & 1) << 5) | (((lane >> 5) & 1) << 8); }
constexpr int v_rd_off(int d0, int ks, int half) { return d0 * 512 + ks * 4096 + half * 2048; }
template <int OFF> __device__ __forceinline__ s16x4 tr_read(int vb) {
  s16x4 r; asm volatile("ds_read_b64_tr_b16 %0, %1 offset:%2" : "=&v"(r) : "v"(vb), "i"(OFF) : "memory"); return r;
}
template <int D0> __device__ __forceinline__ void pv_one(f32x16& od, int vb, bf16x8 pa0, bf16x8 pa1, bf16x8 pa2, bf16x8 pa3) {
  const s16x4 l0 = tr_read<v_rd_off(D0, 0, 0)>(vb), h0 = tr_read<v_rd_off(D0, 0, 1)>(vb), l1 = tr_read<v_rd_off(D0, 1, 0)>(vb), h1 = tr_read<v_rd_off(D0, 1, 1)>(vb);
  const s16x4 l2 = tr_read<v_rd_off(D0, 2, 0)>(vb), h2 = tr_read<v_rd_off(D0, 2, 1)>(vb), l3 = tr_read<v_rd_off(D0, 3, 0)>(vb), h3 = tr_read<v_rd_off(D0, 3, 1)>(vb);
  asm volatile("s_waitcnt lgkmcnt(0)" ::: "memory"); SBAR();
#define PK(L, H) (bf16x8){L[0], L[1], L[2], L[3], H[0], H[1], H[2], H[3]}
  od = __builtin_amdgcn_mfma_f32_32x32x16_bf16(pa0, PK(l0, h0), od, 0, 0, 0);
  od = __builtin_amdgcn_mfma_f32_32x32x16_bf16(pa1, PK(l1, h1), od, 0, 0, 0);
  od = __builtin_amdgcn_mfma_f32_32x32x16_bf16(pa2, PK(l2, h2), od, 0, 0, 0);
  od = __builtin_amdgcn_mfma_f32_32x32x16_bf16(pa3, PK(l3, h3), od, 0, 0, 0);
#undef PK
}
__device__ __forceinline__ void pv_d0(f32x16* o, int vb, bf16x8 pa0, bf16x8 pa1, bf16x8 pa2, bf16x8 pa3) {
  pv_one<0>(o[0], vb, pa0, pa1, pa2, pa3); pv_one<1>(o[1], vb, pa0, pa1, pa2, pa3); pv_one<2>(o[2], vb, pa0, pa1, pa2, pa3); pv_one<3>(o[3], vb, pa0, pa1, pa2, pa3);
}

__device__ __forceinline__ void attn_unit(const bf16* __restrict__ Qb, const bf16* __restrict__ Kh, const bf16* __restrict__ Vh, bf16* Ob,
                                          int NT, int nctx, int jlo, int q0, bool masked, float sinkl2, char* lds) {
  const int tid = threadIdx.x, wid = tid >> 6, lane = tid & 63, r32 = lane & 31, hi = lane >> 5;
  bf16* V_lds = (bf16*)lds; bf16* K_lds = (bf16*)(lds + 2 * SHM_V);
  float* ws = (float*)(lds + 2 * SHM_V + 2 * SHM_K) + wid * 64; float* li_l = ws; float* al_l = ws + 32;
  float m_reg = -1e30f, l_reg = 0; f32x16 o[4] = {}; bf16x8 qr[8];
  const bf16* Qw = Qb + (long)(wid * QBLK + r32) * LDQ + hi * 8;
#pragma unroll
  for (int d0 = 0; d0 < 8; ++d0) qr[d0] = *reinterpret_cast<const bf16x8*>(Qw + d0 * 16);
  const int sr = tid >> 4, sc = (tid & 15) * 8, vst0 = v_st(sr, sc), vst1 = v_st(32 + sr, sc);
  const int vb0 = (int)(uintptr_t)V_lds + v_rd_base(lane);
  const int qpos = q0 + wid * QBLK + r32;
  struct { bf16x8 vs0, vs1, ks0, ks1; } sr_[2];
#define KOF(t) (((t) < nctx) ? (4096 + 64 * (t)) : 64 * (jlo + (t) - nctx))
#define SLOAD(i, k0) do { const int k0_ = (k0); sr_[i].vs0 = *reinterpret_cast<const bf16x8*>(&Vh[(long)(k0_ + sr) * LDK + sc]); sr_[i].vs1 = *reinterpret_cast<const bf16x8*>(&Vh[(long)(k0_ + 32 + sr) * LDK + sc]); \
    sr_[i].ks0 = *reinterpret_cast<const bf16x8*>(&Kh[(long)(k0_ + sr) * LDK + sc]); sr_[i].ks1 = *reinterpret_cast<const bf16x8*>(&Kh[(long)(k0_ + 32 + sr) * LDK + sc]); } while (0)
#define SWRITE(b, i) do { *(bf16x8*)((char*)V_lds + (b) * SHM_V + vst0) = sr_[i].vs0;          \
    *(bf16x8*)((char*)V_lds + (b) * SHM_V + vst1) = sr_[i].vs1; int kc = sc * 2;               \
    *(bf16x8*)((char*)K_lds + (b) * SHM_K + KSWZ(sr, kc)) = sr_[i].ks0;                       \
    *(bf16x8*)((char*)K_lds + (b) * SHM_K + KSWZ(32 + sr, kc)) = sr_[i].ks1; } while (0)
#define SWAIT() asm volatile("s_waitcnt vmcnt(4)" ::: "memory")
#define RESC(a) do { if (__any((a) < 1.f)) { if (hi == 0) al_l[r32] = (a); asm volatile("s_waitcnt lgkmcnt(0)" ::: "memory"); \
    for (int d = 0; d < 4; ++d) for (int r = 0; r < 16; ++r) o[d][r] *= al_l[crow(r, hi)]; } } while (0)
#define MASK(P0, P1, t) do { if (masked && (t) >= nctx) wmask(P0, P1, KOF(t) + 4 * hi, qpos); } while (0)
  f32x16 pA0, pA1, pB0, pB1; float mnA, mnB, alA, alB; bf16x8 pa0, pa1, pa2, pa3;
  constexpr int SE = 0, SO = 1;
  SLOAD(SE, KOF(0)); asm volatile("s_waitcnt vmcnt(0)" ::: "memory"); SWRITE(0, SE); __syncthreads();
  qkt(pA0, pA1, K_lds, qr, r32, hi); MASK(pA0, pA1, 0); partialSM(pA0, pA1, m_reg, mnA, alA);
  SLOAD(SO, KOF(1)); if (2 < NT) SLOAD(SE, KOF(2));
  SWAIT(); SWRITE(1, SO); __syncthreads();
  for (int j = 1; j + 1 < NT; j += 2) {
    SBAR(); qkt(pB0, pB1, (bf16*)((char*)K_lds + SHM_K), qr, r32, hi);
    finishSM(pA0, pA1, alA, l_reg, pa0, pa1, pa2, pa3); SBAR();
    SLOAD(SO, KOF(j + 2)); SBAR();
    pv_d0(o, vb0, pa0, pa1, pa2, pa3); MASK(pB0, pB1, j); partialSM(pB0, pB1, m_reg, mnB, alB);
    __syncthreads(); SWAIT(); SWRITE(0, SE);
    RESC(alB); __syncthreads();
    SBAR(); qkt(pA0, pA1, K_lds, qr, r32, hi);
    finishSM(pB0, pB1, alB, l_reg, pa0, pa1, pa2, pa3); SBAR();
    if (j + 3 < NT) SLOAD(SE, KOF(j + 3)); SBAR();
    pv_d0(o, vb0 + (int)SHM_V, pa0, pa1, pa2, pa3); MASK(pA0, pA1, j + 1); partialSM(pA0, pA1, m_reg, mnA, alA);
    __syncthreads(); SWAIT(); SWRITE(1, SO);
    RESC(alA); __syncthreads();
  }
  SBAR(); qkt(pB0, pB1, (bf16*)((char*)K_lds + SHM_K), qr, r32, hi);
  finishSM(pA0, pA1, alA, l_reg, pa0, pa1, pa2, pa3); SBAR();
  pv_d0(o, vb0, pa0, pa1, pa2, pa3); MASK(pB0, pB1, NT - 1); partialSM(pB0, pB1, m_reg, mnB, alB);
  __syncthreads(); RESC(alB);
  finishSM(pB0, pB1, alB, l_reg, pa0, pa1, pa2, pa3); SBAR();
  pv_d0(o, vb0 + (int)SHM_V, pa0, pa1, pa2, pa3);
  l_reg += __builtin_amdgcn_exp2f(sinkl2 - m_reg * (SCALE * 1.4426950408889634f));
  if (hi == 0) li_l[r32] = l_reg; asm volatile("s_waitcnt lgkmcnt(0)" ::: "memory");
  float rli[16];
#pragma unroll
  for (int r = 0; r < 16; ++r) rli[r] = __builtin_amdgcn_rcpf(li_l[crow(r, hi)]);
  __syncthreads();
  { char* stg = lds + wid * 8192 + (4 * hi * 128 + r32) * 2;
#pragma unroll
    for (int r = 0; r < 16; ++r) {
#pragma unroll
      for (int d0 = 0; d0 < 4; ++d0) { const float v = o[d0][r] * rli[r]; *(bf16*)(stg + ((r & 3) + 8 * (r >> 2)) * 256 + d0 * 64) = (bf16)(cvtpk(v, v) & 0xffffu); }
      asm volatile("" ::: "memory"); }
    asm volatile("s_waitcnt lgkmcnt(0)" ::: "memory");
    bf16* Ow = Ob + (long)(wid * QBLK + (lane >> 4)) * LDO + (lane & 15) * 8;
    const char* rd = lds + wid * 8192 + (lane >> 4) * 256 + (lane & 15) * 16;
#pragma unroll
    for (int i = 0; i < 8; ++i) { const u32x4 v = *(const u32x4*)(rd + i * 1024); *(u32x4*)(Ow + (long)i * 4 * LDO) = v; } }
  __syncthreads();
#undef KOF
#undef SLOAD
#undef SWRITE
#undef SWAIT
#undef RESC
#undef MASK
}
#undef KSWZ
#undef SBAR
}

constexpr int NWAVES = 8;
constexpr int N_LAUNCHES = MK_N_LAUNCHES;
constexpr int N_PHASES = 10;
constexpr int DM = 2048, NB = 4, SEQ = 4096, CTXL = 256, FFN = 5632, INW = 3072, NMOD = 12288;
constexpr int M = NB * SEQ, MC = NB * CTXL, MU = M + MC;
constexpr int SKV = SEQ + CTXL;
constexpr float LN_EPS = 1e-6f;
constexpr float DN_ALPHA = 1.189207115002721f;

constexpr size_t MiB = 1u << 20;
constexpr size_t WS_CTL = 0, CTL_ZERO_BYTES = 64 * 1024;
constexpr size_t WS_MODP = 1 * MiB;
constexpr size_t WS_MODS = 2 * MiB;
constexpr size_t WS_ROPE = 2 * MiB + 512 * 1024;
constexpr size_t WS_WIN = 3 * MiB, WS_WOUT = 15 * MiB, WS_WGU = 23 * MiB, WS_WDN = 67 * MiB;
constexpr size_t WS_U = 89 * MiB;
constexpr size_t WS_Y = 157 * MiB;
constexpr size_t WS_QO = 285 * MiB;
constexpr size_t WS_KV = 349 * MiB;
constexpr size_t KV_BYTES = (size_t)NB * 2 * SKV * 128 * 2;
constexpr size_t WS_H = 285 * MiB;
constexpr size_t WS_END = 461 * MiB;
static_assert(WS_WIN + (size_t)INW * DM * 2 <= WS_WOUT && WS_WOUT + (size_t)DM * DM * 2 <= WS_WGU && WS_WGU + (size_t)2 * FFN * DM * 2 <= WS_WDN && WS_WDN + (size_t)DM * FFN * 2 <= WS_U, "ws map (weights)");
static_assert(WS_U + (size_t)MU * DM * 2 <= WS_Y && WS_Y + (size_t)M * DM * 4 <= WS_QO && WS_QO + (size_t)M * DM * 2 <= WS_KV && WS_KV + 4 * KV_BYTES <= WS_END && WS_H + (size_t)M * FFN * 2 <= WS_END, "ws map");
constexpr int CW_BAR = 4096;

constexpr int RING_OFF = 0, RING_BYTES = 131072;
constexpr int LDSCTL_OFF = RING_BYTES, MISC_OFF = LDSCTL_OFF + 320;
constexpr int XCH_OFF = RING_BYTES + 1024;
constexpr int LDS_BYTES = 147456;
static_assert(XCH_OFF + 4096 <= LDS_BYTES, "LDS map");

#define GAS __attribute__((address_space(1)))
#define LAS __attribute__((address_space(3)))
typedef unsigned short bf16;
typedef unsigned v4u __attribute__((ext_vector_type(4)));
typedef float f32x4 __attribute__((ext_vector_type(4)));
typedef GAS unsigned gu32;
#define RLX_AGENT __ATOMIC_RELAXED, __HIP_MEMORY_SCOPE_AGENT
#define LDS_WAIT() asm volatile("s_waitcnt lgkmcnt(0)" ::: "memory")
#define VM_WAIT() asm volatile("s_waitcnt vmcnt(0)" ::: "memory")
__device__ __forceinline__ unsigned f2bf(float f) { unsigned u = __builtin_bit_cast(unsigned, f); return (u + 0x7fffu + ((u >> 16) & 1u)) >> 16; }
__device__ __forceinline__ unsigned pk2(float lo, float hi) { return f2bf(lo) | (f2bf(hi) << 16); }

#define XB_TMO      128
#define XB_XCNT(j)  (256  + 64 * (j))
#define XB_XSUB(j)  (1280 + 64 * (j))
#define XB_XGEN(j)  (2304 + 64 * (j))
#define XB_TOP      3328
#define XB_TOPGEN   3392
#define XCD_BAR_WORDS 3456
#define XB_SPIN_CAP (1u << 18)
__device__ __forceinline__ unsigned xb_ld(unsigned* p)              { return __hip_atomic_load(p, __ATOMIC_RELAXED, __HIP_MEMORY_SCOPE_AGENT); }
__device__ __forceinline__ unsigned xb_add(unsigned* p, unsigned v) { return __hip_atomic_fetch_add(p, v, __ATOMIC_RELAXED, __HIP_MEMORY_SCOPE_AGENT); }
__device__ __forceinline__ unsigned xb_xcc_id() { return (unsigned)__builtin_amdgcn_s_getreg((3 << 11) | 20) & 0xFu; }
#define XB_SPIN(cond, bar) do { unsigned _sp = 0; while (cond) { __builtin_amdgcn_s_sleep(1); \
    if ((++_sp & 255u) == 0u) { if (xb_ld(&(bar)[XB_TMO])) break; if (_sp > XB_SPIN_CAP) { atomicAdd(&(bar)[XB_TMO], 1u); break; } } } } while (0)
struct XcdBarrier { unsigned* bar; unsigned x; volatile LAS unsigned* st; };
__device__ __forceinline__ XcdBarrier xcd_barrier_post(unsigned* bar, volatile LAS unsigned* st) {
    XcdBarrier b; b.bar = bar; b.x = xb_xcc_id(); b.st = st;
    if (threadIdx.x == 0) (void)xb_add(&bar[XB_XCNT(b.x)], 1u);
    return b;
}
__device__ __forceinline__ void xcd_barrier_complete(unsigned* bar, unsigned x, unsigned& nloc, unsigned& nx) {
    const unsigned G = gridDim.x * gridDim.y * gridDim.z;
    unsigned sum, cnt, mine, sp = 0u;
    for (;;) {
        sum = 0u; cnt = 0u; mine = 0u;
#pragma unroll
        for (unsigned j = 0; j < 16; ++j) { const unsigned c = xb_ld(&bar[XB_XCNT(j)]); sum += c; cnt += (c > 0u) ? 1u : 0u; mine = (j == x) ? c : mine; }
        if (sum == G) break;
        __builtin_amdgcn_s_sleep(1);
        if ((++sp & 255u) == 0u) { if (xb_ld(&bar[XB_TMO])) break; if (sp > XB_SPIN_CAP) { atomicAdd(&bar[XB_TMO], 1u); break; } }
    }
    nloc = mine > 0u ? mine : 1u; nx = cnt > 0u ? cnt : 1u;
}
__device__ __forceinline__ void xcd_barrier(const XcdBarrier& b) {
    asm volatile("s_waitcnt vmcnt(0)" ::: "memory");
    __syncthreads();
    if (threadIdx.x == 0) {
        unsigned* bar = b.bar;
        __builtin_amdgcn_s_waitcnt(0);
        unsigned nloc = b.st[0], nx = b.st[1];
        if (nloc == 0u) { xcd_barrier_complete(bar, b.x, nloc, nx); b.st[0] = nloc; b.st[1] = nx; }
        const unsigned old = xb_add(&bar[XB_XSUB(b.x)], 1u);
        const unsigned gen = old / nloc;
        if (old + 1u == (gen + 1u) * nloc) {
            __builtin_amdgcn_fence(__ATOMIC_RELEASE, "agent");
            asm volatile("s_waitcnt vmcnt(0)" ::: "memory");
            const unsigned og = xb_add(&bar[XB_TOP], 1u);
            const unsigned tg = og / nx;
            if (og + 1u == (tg + 1u) * nx) xb_add(&bar[XB_TOPGEN], 1u);
            else XB_SPIN(xb_ld(&bar[XB_TOPGEN]) == tg, bar);
            __builtin_amdgcn_fence(__ATOMIC_ACQUIRE, "agent");
            xb_add(&bar[XB_XGEN(b.x)], 1u);
            asm volatile("s_waitcnt vmcnt(0)" ::: "memory");
        } else {
            XB_SPIN(xb_ld(&bar[XB_XGEN(b.x)]) == gen, bar);
            __builtin_amdgcn_fence(__ATOMIC_ACQUIRE, "agent");
            asm volatile("s_waitcnt vmcnt(0)" ::: "memory");
        }
    }
    __syncthreads();
}

__device__ __forceinline__ float wave_sum(float v) {
#pragma unroll
    for (int o = 1; o < 64; o <<= 1) v += __shfl_xor(v, o);
    return v;
}
__device__ __forceinline__ void transpose_item(const float* W, int ldw, int k0, int n0, bf16* WT, int Kd, int dst_row0, LAS float* scr, int lane) {
#pragma unroll 8
    for (int i = 0; i < 32; ++i) { const int kk = 2 * i + (lane >> 5); scr[kk * 33 + (lane & 31)] = W[(size_t)(k0 + kk) * ldw + n0 + (lane & 31)]; }
    LDS_WAIT(); asm volatile("" ::: "memory");
    const int c = lane & 7;
#pragma unroll
    for (int j = 0; j < 4; ++j) { const int n = (lane >> 3) + 8 * j; const LAS float* s = scr + (8 * c) * 33 + n;
        v4u o; o.x = pk2(s[0 * 33], s[1 * 33]); o.y = pk2(s[2 * 33], s[3 * 33]); o.z = pk2(s[4 * 33], s[5 * 33]); o.w = pk2(s[6 * 33], s[7 * 33]);
        *(GAS v4u*)(WT + (size_t)(dst_row0 + n) * Kd + k0 + 8 * c) = o; }
    LDS_WAIT(); asm volatile("" ::: "memory");
}
__device__ __forceinline__ float silu_f(float x) { return x / (1.0f + __expf(-x)); }

struct Args { const float* in[18]; float* out; unsigned char* ws; int ph_lo, ph_hi, li, pad; };

__device__ __forceinline__ void modulate_row(const float* xrow, bf16* orow, const LAS float* p0, const LAS float* p1, int lane) {
    const GAS f32x4* xr = (const GAS f32x4*)xrow + lane;
    GAS unsigned long long* o8 = (GAS unsigned long long*)orow + lane;
    f32x4 v[8];
#pragma unroll
    for (int j = 0; j < 8; ++j) v[j] = xr[64 * j];
#pragma unroll
    for (int j = 0; j < 8; ++j) { const f32x4 a = *(const LAS f32x4*)(p0 + 256 * j + 4 * lane), s = *(const LAS f32x4*)(p1 + 256 * j + 4 * lane); const f32x4 r = v[j] * a + s;
        o8[64 * j] = (unsigned long long)pk2(r.x, r.y) | ((unsigned long long)pk2(r.z, r.w) << 32); }
}
template <bool MOD>
__device__ __forceinline__ void ln_row(float* yrow, bf16* urow, const LAS float* g, const LAS float* bb, const LAS float* p0, const LAS float* p1, int lane) {
    GAS f32x4* yr = (GAS f32x4*)yrow + lane;
    f32x4 v[8]; float s = 0.f;
#pragma unroll
    for (int j = 0; j < 8; ++j) { v[j] = yr[64 * j]; s += (v[j].x + v[j].y) + (v[j].z + v[j].w); }
    const float mean = wave_sum(s) * (1.f / DM); float s2 = 0.f;
#pragma unroll
    for (int j = 0; j < 8; ++j) { v[j] = v[j] - mean; s2 += (v[j].x * v[j].x + v[j].y * v[j].y) + (v[j].z * v[j].z + v[j].w * v[j].w); }
    const float rstd = __builtin_amdgcn_rsqf(wave_sum(s2) * (1.f / DM) + LN_EPS);
#pragma unroll
    for (int j = 0; j < 8; ++j) { const int c = 256 * j + 4 * lane; const f32x4 gg = *(const LAS f32x4*)(g + c), be = *(const LAS f32x4*)(bb + c);
        const f32x4 x1 = v[j] * rstd * gg + be; yr[64 * j] = x1;
        if constexpr (MOD) { const f32x4 a = *(const LAS f32x4*)(p0 + c), sh = *(const LAS f32x4*)(p1 + c); const f32x4 r = x1 * a + sh;
            ((GAS unsigned long long*)urow + lane)[64 * j] = (unsigned long long)pk2(r.x, r.y) | ((unsigned long long)pk2(r.z, r.w) << 32); } }
}

__global__ void __launch_bounds__(NWAVES * 64, 2) dit_fwd(Args args) {
    extern __shared__ __attribute__((aligned(16))) unsigned char lds[];
    LAS unsigned char* L = (LAS unsigned char*)lds;
    volatile LAS unsigned* MISC = (volatile LAS unsigned*)(L + MISC_OFF);
    const int tid = threadIdx.x, lane = tid & 63, wave = __builtin_amdgcn_readfirstlane(tid >> 6);
    const int G = gridDim.x, bx = blockIdx.x;
    unsigned char* ws = args.ws;
    gu32* ctl = (gu32*)(ws + WS_CTL);
    const float* x = args.in[0]; const float* cvec = args.in[1]; const float* ctx = args.in[2]; const float* c_ctx = args.in[3];
    const float* w_ada = args.in[4]; const float* b_ada = args.in[5]; const float* w_in = args.in[6]; const float* qng = args.in[7]; const float* kng = args.in[8];
    const float* sink = args.in[9]; const float* w_out = args.in[10]; const float* ln1g = args.in[11]; const float* ln1b = args.in[12];
    const float* w_gate = args.in[13]; const float* w_up = args.in[14]; const float* w_down = args.in[15]; const float* ln2g = args.in[16]; const float* ln2b = args.in[17];
    float* MODP = (float*)(ws + WS_MODP); float* MODS = (float*)(ws + WS_MODS); float* ROPEC = (float*)(ws + WS_ROPE); float* ROPES = ROPEC + 2048;
    bf16* WIN = (bf16*)(ws + WS_WIN); bf16* WOUT = (bf16*)(ws + WS_WOUT); bf16* WGU = (bf16*)(ws + WS_WGU); bf16* WDN = (bf16*)(ws + WS_WDN);
    bf16* U = (bf16*)(ws + WS_U); float* Y = (float*)(ws + WS_Y); bf16* QO = (bf16*)(ws + WS_QO);
    bf16* KA = (bf16*)(ws + WS_KV); bf16* VA = (bf16*)(ws + WS_KV + KV_BYTES); bf16* KB = (bf16*)(ws + WS_KV + 2 * KV_BYTES); bf16* VB = (bf16*)(ws + WS_KV + 3 * KV_BYTES);
    bf16* HB = (bf16*)(ws + WS_H);

    for (int u = tid; u < (LDS_BYTES - LDSCTL_OFF) / 4; u += NWAVES * 64) ((LAS unsigned*)(L + LDSCTL_OFF))[u] = 0u;
    __syncthreads();
    XcdBarrier bar; bar.bar = (unsigned*)(ctl + CW_BAR); bar.x = 0; bar.st = nullptr;
    if (N_LAUNCHES == 1) bar = xcd_barrier_post((unsigned*)(ctl + CW_BAR), MISC + 8);
#define GRID_BAR() do { if (N_LAUNCHES == 1) xcd_barrier(bar); } while (0)
    const int lo = args.ph_lo, hi = args.ph_hi;
#ifndef PHMASK
#define PHMASK 0x3FF
#endif
#define IN(k) (((PHMASK >> (k)) & 1) && lo <= (k) && (k) < hi)
#define BOTH(k) (IN(k) && IN((k) + 1))

    if (IN(0)) {
        if (bx < 192) {
            const int cb = bx >> 2, kq = bx & 3, k0 = kq * 512 + wave * 64;
            float sv[5];
#pragma unroll
            for (int b = 0; b < 4; ++b) sv[b] = silu_f(cvec[b * DM + k0 + lane]);
            sv[4] = silu_f(c_ctx[k0 + lane]);
            f32x4 acc[5];
#pragma unroll
            for (int b = 0; b < 5; ++b) acc[b] = (f32x4){0.f, 0.f, 0.f, 0.f};
            const float* wp = w_ada + (size_t)k0 * NMOD + cb * 256 + lane * 4;
#pragma unroll 16
            for (int kk = 0; kk < 64; ++kk) { const f32x4 wv = *(const f32x4*)(wp + (size_t)kk * NMOD);
#pragma unroll
                for (int b = 0; b < 5; ++b) { const float s = __builtin_bit_cast(float, __builtin_amdgcn_readlane(__builtin_bit_cast(int, sv[b]), kk)); acc[b] += wv * s; } }
            LAS f32x4* red = (LAS f32x4*)(L + RING_OFF);
#pragma unroll
            for (int b = 0; b < 5; ++b) red[(wave * 5 + b) * 64 + lane] = acc[b];
            LDS_WAIT(); __syncthreads();
            if (tid < 320) { const int b = tid >> 6, l = tid & 63; f32x4 s = red[b * 64 + l];
#pragma unroll
                for (int w = 1; w < 8; ++w) s += red[(w * 5 + b) * 64 + l];
                *(f32x4*)(MODP + ((size_t)kq * 5 + b) * NMOD + cb * 256 + l * 4) = s; }
            __syncthreads();
        }
        if (bx == 255) {
            for (int e = tid; e < 2048; e += NWAVES * 64) { const int pos = e >> 5, f = e & 31;
                const float inv = exp2f(-(float)f * (13.287712379549449f / 32.0f)); const float ang = (float)pos * inv;
                float sn, cs; sincosf(ang, &sn, &cs); ROPEC[e] = cs; ROPES[e] = sn; }
        }
        {
            LAS float* scr = (LAS float*)(L + RING_OFF + wave * 16384);
            constexpr int I_IN = 32 * 96, I_OUT = 32 * 64, I_G = 32 * 176, I_D = 88 * 64, NITEMS = I_IN + I_OUT + 2 * I_G + I_D, NSLOT = 192 * 8 * 2 + 64 * 8 * 3;
            const int nsl = bx < 192 ? 2 : 3, sl0 = bx < 192 ? (bx * 8 + wave) * 2 : 3072 + ((bx - 192) * 8 + wave) * 3;
            for (int s = 0; s < nsl; ++s)
                for (int it = sl0 + s; it < NITEMS; it += NSLOT) {
                    int r = it;
                    if (r < I_IN) { const int kb = r / 96, nb = r % 96, pn = nb >> 3, q = nb & 7, hh = q >> 2, part = (q >> 1) & 1, bj = q & 1;
                        transpose_item(w_in, INW, 64 * kb, 32 * nb, WIN, DM, 256 * pn + 32 * (4 * bj + 2 * hh + part), scr, lane); continue; } r -= I_IN;
                    if (r < I_OUT) { const int kb = r / 64, nb = r % 64; transpose_item(w_out, DM, 64 * kb, 32 * nb, WOUT, DM, 32 * nb, scr, lane); continue; } r -= I_OUT;
                    if (r < I_G) { const int kb = r / 176, nb = r % 176; transpose_item(w_gate, FFN, 64 * kb, 32 * nb, WGU, DM, 256 * (nb >> 2) + 32 * (nb & 3), scr, lane); continue; } r -= I_G;
                    if (r < I_G) { const int kb = r / 176, nb = r % 176; transpose_item(w_up, FFN, 64 * kb, 32 * nb, WGU, DM, 256 * (nb >> 2) + 128 + 32 * (nb & 3), scr, lane); continue; } r -= I_G;
                    { const int kb = r / 64, nb = r % 64; transpose_item(w_down, DM, 64 * kb, 32 * nb, WDN, FFN, 32 * nb, scr, lane); }
                }
        }
        if (BOTH(0)) GRID_BAR();
    }

    if (IN(1)) {
        { const int idx = bx * 512 + tid;
          if (idx < 5 * NMOD) { float s = b_ada[idx % NMOD];
#pragma unroll
              for (int q = 0; q < 4; ++q) s += MODP[(size_t)q * 5 * NMOD + idx];
              MODS[idx] = s; } }
        if (bx < 128) {
            LAS float* P0 = (LAS float*)(L + RING_OFF); LAS float* P1 = P0 + 2048;
            for (int i = tid; i < 2048; i += NWAVES * 64) { float sh = b_ada[i], sc = b_ada[2048 + i];
#pragma unroll
                for (int q = 0; q < 4; ++q) { sh += MODP[((size_t)q * 5 + 4) * NMOD + i]; sc += MODP[((size_t)q * 5 + 4) * NMOD + 2048 + i]; }
                P0[i] = 1.0f + sc; P1[i] = sh; }
            LDS_WAIT(); __syncthreads();
            const int r = bx * 8 + wave;
            modulate_row(ctx + (size_t)r * DM, U + (size_t)(M + r) * DM, P0, P1, lane);
            __syncthreads();
        }
        if (BOTH(1)) GRID_BAR();
    }

    if (IN(2)) {
        if (bx < 16) {
            const int pnl[4] = {4, 5, 10, 11};
            pg8::Gemm g{U, WIN, MU, INW, DM}; pg8::OneUnit S{64 + (bx >> 2), (bx & 3) == 0 ? 4 : (bx & 3) == 1 ? 5 : (bx & 3) == 2 ? 10 : 11}; (void)pnl;
            pg8::EpiQKV E{QO, KA, VA, KB, VB, qng, kng, ROPEC, ROPES, (LAS float*)(L + XCH_OFF)};
            pg8::gemm_phase<pg8::EpiQKV, pg8::OneUnit, true, true>(L + RING_OFF, g, S, E);
        } else {
            LAS float* P0 = (LAS float*)(L + RING_OFF); LAS float* P1 = P0 + 2048;
            const int i = bx - 16, r0 = (int)(((long)i * M) / 240), r1 = (int)(((long)(i + 1) * M) / 240);
            int r = r0;
            while (r < r1) {
                const int b = r >> 12; int re = (b + 1) << 12; if (re > r1) re = r1;
                __syncthreads();
                for (int k = tid; k < 2048; k += NWAVES * 64) { P0[k] = 1.0f + MODS[b * NMOD + 2048 + k]; P1[k] = MODS[b * NMOD + k]; }
                LDS_WAIT(); __syncthreads();
                for (int rr = r + wave; rr < re; rr += NWAVES) modulate_row(x + (size_t)rr * DM, U + (size_t)rr * DM, P0, P1, lane);
                r = re;
            }
            __syncthreads();
        }
        if (BOTH(2)) GRID_BAR();
    }

    if (IN(3)) {
        pg8::Gemm g{U, WIN, M, INW, DM}; pg8::StaticOrder S; S.init(M, INW, G, bx);
        pg8::EpiQKV E{QO, KA, VA, KB, VB, qng, kng, ROPEC, ROPES, (LAS float*)(L + XCH_OFF)};
        pg8::gemm_phase<pg8::EpiQKV, pg8::StaticOrder, true, true>(L + RING_OFF, g, S, E);
        if (BOTH(3)) GRID_BAR();
    }

    if (IN(4)) {
        const int xg = bx & 7, y = bx >> 3, b = xg >> 1, kvh = xg & 1;
        const size_t kvoff = (size_t)(b * 2 + kvh) * SKV * 128;
        for (int i = 0; i < 4; ++i) {
            const int uu = 2 * y + (i & 1), gq = uu >> 4, qb = uu & 15, q0 = qb * 256;
            const bool isA = i >= 2;
            const int head = kvh * 4 + gq;
            bf16* Qp = QO + (size_t)(b * SEQ + q0) * DM + (isA ? 0 : 1024) + head * 128;
            const int jlo = !isA ? 0 : ((q0 >> 6) - 2 < 0 ? 0 : (q0 >> 6) - 2), jhi = (q0 >> 6) + 6 > 64 ? 64 : (q0 >> 6) + 6;
            const int nctx = isA ? 4 : 0, NT = isA ? 4 + (jhi - jlo) : SKV / 64;
            const float sk = isA ? sink[head] * 1.4426950408889634f : -INFINITY;
            att::attn_unit(Qp, (isA ? KA : KB) + kvoff, (isA ? VA : VB) + kvoff, Qp, NT, nctx, jlo, q0, isA, sk, (char*)lds + RING_OFF);
        }
        if (BOTH(4)) GRID_BAR();
    }

    if (IN(5)) {
        pg8::Gemm g{QO, WOUT, M, DM, DM}; pg8::StaticOrder S; S.init(M, DM, G, bx);
        pg8::EpiResid E{x, MODS + 2 * 2048, Y, DN_ALPHA};
        pg8::gemm_phase<pg8::EpiResid, pg8::StaticOrder, true, true>(L + RING_OFF, g, S, E);
        if (BOTH(5)) GRID_BAR();
    }

    if (IN(6)) {
        LAS float* Pg = (LAS float*)(L + RING_OFF); LAS float* Pb = Pg + 2048; LAS float* P0 = Pg + 4096; LAS float* P1 = Pg + 6144;
        const int b = bx >> 6;
        for (int k = tid; k < 2048; k += NWAVES * 64) { Pg[k] = ln1g[k]; Pb[k] = ln1b[k]; P0[k] = 1.0f + MODS[b * NMOD + 4 * 2048 + k]; P1[k] = MODS[b * NMOD + 3 * 2048 + k]; }
        LDS_WAIT(); __syncthreads();
        for (int rr = bx * 64 + wave; rr < bx * 64 + 64; rr += NWAVES) ln_row<true>(Y + (size_t)rr * DM, U + (size_t)rr * DM, Pg, Pb, P0, P1, lane);
        __syncthreads();
        if (BOTH(6)) GRID_BAR();
    }

    if (IN(7)) {
        pg8::Gemm g{U, WGU, M, 2 * FFN, DM}; pg8::StaticOrder S; S.init(M, 2 * FFN, G, bx);
        pg8::EpiSwiglu E{HB, FFN};
        pg8::gemm_phase<pg8::EpiSwiglu, pg8::StaticOrder, true, true>(L + RING_OFF, g, S, E);
        if (BOTH(7)) GRID_BAR();
    }

    if (IN(8)) {
        pg8::Gemm g{HB, WDN, M, DM, FFN}; pg8::StaticOrder S; S.init(M, DM, G, bx);
        pg8::EpiResid E{Y, MODS + 5 * 2048, args.out, DN_ALPHA};
        pg8::gemm_phase<pg8::EpiResid, pg8::StaticOrder, true, true>(L + RING_OFF, g, S, E);
        if (BOTH(8)) GRID_BAR();
    }

    if (IN(9)) {
        LAS float* Pg = (LAS float*)(L + RING_OFF); LAS float* Pb = Pg + 2048;
        for (int k = tid; k < 2048; k += NWAVES * 64) { Pg[k] = ln2g[k]; Pb[k] = ln2b[k]; }
        LDS_WAIT(); __syncthreads();
        for (int rr = bx * 64 + wave; rr < bx * 64 + 64; rr += NWAVES) ln_row<false>(args.out + (size_t)rr * DM, nullptr, Pg, Pb, Pg, Pb, lane);
    }
#undef IN
#undef BOTH
#undef GRID_BAR
}

extern "C" void kernel_launch(void* const* d_in, const int* in_sizes, int n_in, void* d_out, int out_size, void* d_ws, size_t ws_size, hipStream_t stream) {
    static int grid = 0;
    if (grid == 0) {
        if (n_in != 18 || in_sizes[0] != M * DM || out_size != M * DM || ws_size < WS_END) {
            fprintf(stderr, "kernel_launch: shape mismatch (n_in %d, in0 %d, out %d, ws %zu; need ws >= %zu); nothing launched\n", n_in, n_in > 0 ? in_sizes[0] : -1, out_size, ws_size, (size_t)WS_END); grid = -1; return; }
        int dev = 0, cus = 0, per_cu = 0;
        if (hipGetDevice(&dev) != hipSuccess || hipDeviceGetAttribute(&cus, hipDeviceAttributeMultiprocessorCount, dev) != hipSuccess) { fprintf(stderr, "kernel_launch: device query failed\n"); grid = -1; return; }
        if (hipFuncSetAttribute((const void*)dit_fwd, hipFuncAttributeMaxDynamicSharedMemorySize, LDS_BYTES) != hipSuccess) { fprintf(stderr, "kernel_launch: hipFuncSetAttribute failed\n"); grid = -1; return; }
        if (hipOccupancyMaxActiveBlocksPerMultiprocessor(&per_cu, (const void*)dit_fwd, NWAVES * 64, LDS_BYTES) != hipSuccess || per_cu < 1)
            fprintf(stderr, "kernel_launch: note: occupancy query reports %d workgroups per CU\n", per_cu);
        (void)hipGetLastError();
        if (cus != 256) { fprintf(stderr, "kernel_launch: built for a 256-CU device, found %d CUs; nothing launched\n", cus); grid = -1; return; }
        grid = 256;
    }
    if (grid < 0) return;
    if (hipMemsetAsync((char*)d_ws + WS_CTL, 0, CTL_ZERO_BYTES, stream) != hipSuccess) { fprintf(stderr, "kernel_launch: hipMemsetAsync failed\n"); return; }
    Args a{};
    for (int i = 0; i < 18; ++i) a.in[i] = (const float*)d_in[i];
    a.out = (float*)d_out; a.ws = (unsigned char*)d_ws;
    if (N_LAUNCHES == 1) { a.ph_lo = 0; a.ph_hi = N_PHASES; a.li = 0; hipLaunchKernelGGL(dit_fwd, dim3(grid), dim3(NWAVES * 64), LDS_BYTES, stream, a); }
    else for (int li = 0; li < N_PHASES; ++li) { a.ph_lo = li; a.ph_hi = li + 1; a.li = li; hipLaunchKernelGGL(dit_fwd, dim3(grid), dim3(NWAVES * 64), LDS_BYTES, stream, a); }
    const hipError_t le = hipPeekAtLastError();
    if (le != hipSuccess) fprintf(stderr, "kernel_launch: launch failed: %s\n", hipGetErrorName(le));
}
```

```cpp
#include <hip/hip_runtime.h>
#include <hip/hip_bf16.h>
#include <cstdio>
#include <cstdint>

#ifndef PHASE_LIST
#define PHASE_LIST {0, 1, 2, 3, 4, 5, 6, 7, 8, 9}
#endif
#ifndef MK_N_LAUNCHES
#define MK_N_LAUNCHES 1
#endif

namespace pg8 {
#define PG8_LAS __attribute__((address_space(3)))
typedef unsigned short bf16_t;
typedef short bf16x8 __attribute__((ext_vector_type(8)));
typedef float f32x4 __attribute__((ext_vector_type(4)));
typedef unsigned u32x4 __attribute__((ext_vector_type(4)));
constexpr int BM = 256, BK = 64, HALF = 128, HTB = HALF * BK * 2, STAGE_BYTES = 8 * HTB, NXCD = 8, WGM = 8;

__host__ __device__ __forceinline__ int lds_byte(int r, int c) { const int st = (r >> 4) * 2 + (c >> 5), rr = r & 15, cc = c & 31, ob = rr * 64 + cc * 2; return st * 1024 + (ob ^ (((ob >> 9) & 1) << 5)); }
__host__ __device__ __forceinline__ void stage_rc(int b, int& R, int& C) { const int st = b / 1024, sb = b % 1024, swz = sb ^ (((sb >> 9) & 1) << 5); R = (st >> 1) * 16 + swz / 64; C = (st & 1) * 32 + (swz % 64) / 2; }
__host__ __device__ __forceinline__ int perm32(int rho) { const int n = rho >> 4, i = rho & 15; return 8 * (i >> 2) + 4 * n + (i & 3); }

struct Unit { int pm, pn; };
struct Gemm { const bf16_t* A; const bf16_t* Bt; int M, N, K; };

struct StaticOrder {
    int nM, nN, nwg, G, c;
    __host__ __device__ void init(int M, int N, int G_, int c_) { nM = M / BM; nN = N / BM; nwg = nM * nN; G = G_; c = c_; }
    __host__ __device__ bool next(int i, Unit& u) const {
        const long L = (long)i * G + c; if (L >= nwg) return false;
        int wgid = (int)L; { const int q = nwg / NXCD, r = nwg % NXCD, xcd = wgid % NXCD, off = wgid / NXCD; wgid = (xcd < r ? xcd * (q + 1) : r * (q + 1) + (xcd - r) * q) + off; }
        const int nig = WGM * nN, gid = wgid / nig, fm = gid * WGM, gsz = (nM - fm) < WGM ? (nM - fm) : WGM;
        u.pm = fm + ((wgid % nig) % gsz); u.pn = (wgid % nig) / gsz; return true;
    }
    __device__ __forceinline__ void a_ready(const Unit&) const {}
    __device__ __forceinline__ void done(const Unit&) const {}
};
struct OneUnit {
    int pm, pn;
    __device__ bool next(int i, Unit& u) const { if (i > 0) return false; u.pm = pm; u.pn = pn; return true; }
    __device__ __forceinline__ void a_ready(const Unit&) const {}
    __device__ __forceinline__ void done(const Unit&) const {}
};

__device__ __forceinline__ unsigned cvt_pk_bf16(float lo, float hi) { unsigned r; asm volatile("v_cvt_pk_bf16_f32 %0, %1, %2" : "=v"(r) : "v"(lo), "v"(hi)); return r; }


struct EpiQKV {
    static constexpr bool PERM = true, AFTER_DRAIN = false;
    bf16_t* QO; bf16_t* KA; bf16_t* VA; bf16_t* KB; bf16_t* VB;
    const float* qg; const float* kg; const float* ropec; const float* ropes;
    PG8_LAS float* xch;
    __device__ __forceinline__ void operator()(const f32x4 (&acc)[2][2][4][2], const Unit& u, int wr, int wc, int fr, int fq) const {
        const int pn = u.pn; const bool is_ctx = u.pm >= 64;
        const int b = is_ctx ? (u.pm - 64) : (u.pm >> 4), t0 = is_ctx ? 4096 : ((u.pm & 15) << 8);
        const int hh = wc >> 1, part = wc & 1, wid = wr * 4 + wc;
        const bool isq = (pn < 4) || (pn >= 6 && pn < 10), donorm = (pn >= 6 && pn <= 10), dorope = (!is_ctx) && pn != 5 && pn != 11;
        bf16_t* base; size_t rstride;
        if (isq) { const int head = (pn < 4 ? 2 * pn : 8 + 2 * (pn - 6)) + hh; base = QO + (size_t)(b * 4096 + t0) * 2048 + head * 128; rstride = 2048; }
        else { bf16_t* buf = pn == 4 ? KA : pn == 5 ? VA : pn == 10 ? KB : VB; base = buf + ((size_t)(b * 2 + hh) * 4352 + t0) * 128; rstride = 128; }
        const int d0 = 64 * part + 8 * fq;
        float rs[2][4];
        f32x4 gv[2][2];
#pragma unroll
        for (int bj = 0; bj < 2; ++bj)
#pragma unroll
            for (int n = 0; n < 2; ++n) gv[bj][n] = (f32x4){1.f, 1.f, 1.f, 1.f};
#pragma unroll
        for (int ai = 0; ai < 2; ++ai)
#pragma unroll
            for (int m = 0; m < 4; ++m) rs[ai][m] = 1.f;
        if (donorm) {
            const float* g = (pn == 10) ? kg : qg;
#pragma unroll
            for (int bj = 0; bj < 2; ++bj)
#pragma unroll
                for (int n = 0; n < 2; ++n) gv[bj][n] = *(const f32x4*)(g + d0 + 32 * bj + 4 * n);
#pragma unroll
            for (int ai = 0; ai < 2; ++ai)
#pragma unroll
                for (int m = 0; m < 4; ++m) {
                    float s = 0.f;
#pragma unroll
                    for (int bj = 0; bj < 2; ++bj)
#pragma unroll
                        for (int n = 0; n < 2; ++n) { const f32x4 x = acc[ai][bj][m][n]; s += (x[0] * x[0] + x[1] * x[1]) + (x[2] * x[2] + x[3] * x[3]); }
                    s += __shfl_xor(s, 16); s += __shfl_xor(s, 32);
                    if (fq == 0) xch[wid * 128 + ai * 64 + m * 16 + fr] = s;
                    rs[ai][m] = s;
                }
            asm volatile("s_waitcnt lgkmcnt(0)" ::: "memory"); __builtin_amdgcn_s_barrier(); asm volatile("" ::: "memory");
#pragma unroll
            for (int ai = 0; ai < 2; ++ai)
#pragma unroll
                for (int m = 0; m < 4; ++m) { const float o = xch[(wid ^ 1) * 128 + ai * 64 + m * 16 + fr]; rs[ai][m] = __builtin_amdgcn_rsqf((rs[ai][m] + o) * (1.0f / 128.0f) + 1e-6f); }
        }
#pragma unroll
        for (int ai = 0; ai < 2; ++ai)
#pragma unroll
            for (int m = 0; m < 4; ++m) {
                const int rt = ai * HALF + wr * 64 + m * 16 + fr;
                f32x4 lo[2], hi[2];
#pragma unroll
                for (int n = 0; n < 2; ++n) { lo[n] = acc[ai][0][m][n] * rs[ai][m] * gv[0][n]; hi[n] = acc[ai][1][m][n] * rs[ai][m] * gv[1][n]; }
                if (dorope) {
                    const int t = t0 + rt, pos = part ? (t & 63) : (t >> 6);
#pragma unroll
                    for (int n = 0; n < 2; ++n) {
                        const f32x4 c4 = *(const f32x4*)(ropec + pos * 32 + 8 * fq + 4 * n), s4 = *(const f32x4*)(ropes + pos * 32 + 8 * fq + 4 * n);
                        const f32x4 a = lo[n], bb = hi[n];
                        lo[n] = a * c4 - bb * s4; hi[n] = bb * c4 + a * s4;
                    }
                }
                bf16_t* rowp = base + (size_t)rt * rstride + d0;
                u32x4 w0, w1;
                w0.x = cvt_pk_bf16(lo[0][0], lo[0][1]); w0.y = cvt_pk_bf16(lo[0][2], lo[0][3]); w0.z = cvt_pk_bf16(lo[1][0], lo[1][1]); w0.w = cvt_pk_bf16(lo[1][2], lo[1][3]);
                w1.x = cvt_pk_bf16(hi[0][0], hi[0][1]); w1.y = cvt_pk_bf16(hi[0][2], hi[0][3]); w1.z = cvt_pk_bf16(hi[1][0], hi[1][1]); w1.w = cvt_pk_bf16(hi[1][2], hi[1][3]);
                *(u32x4*)(rowp) = w0; *(u32x4*)(rowp + 32) = w1;
            }
    }
};

struct EpiResid {
    static constexpr bool PERM = false, AFTER_DRAIN = false;
    const float* res; const float* gate; float* out; float alpha;
    __device__ __forceinline__ void operator()(const f32x4 (&acc)[2][2][4][2], const Unit& u, int wr, int wc, int fr, int fq) const {
        const int row0 = u.pm * BM + wr * 64 + fr, col0 = u.pn * BM + wc * 32 + 4 * fq, b = u.pm >> 4;
        f32x4 gv[2][2];
#pragma unroll
        for (int bj = 0; bj < 2; ++bj)
#pragma unroll
            for (int n = 0; n < 2; ++n) gv[bj][n] = *(const f32x4*)(gate + b * 12288 + col0 + bj * HALF + n * 16);
#pragma unroll
        for (int ai = 0; ai < 2; ++ai)
#pragma unroll
            for (int m = 0; m < 4; ++m) { const size_t off = (size_t)(row0 + ai * HALF + m * 16) * 2048 + col0;
#pragma unroll
                for (int bj = 0; bj < 2; ++bj)
#pragma unroll
                    for (int n = 0; n < 2; ++n) { const f32x4 xv = *(const f32x4*)(res + off + bj * HALF + n * 16);
                        *(f32x4*)(out + off + bj * HALF + n * 16) = xv * alpha + gv[bj][n] * acc[ai][bj][m][n]; } }
    }
};


struct EpiBf16Plain {
    static constexpr bool PERM = true, AFTER_DRAIN = false;
    bf16_t* O; int ldc;
    __device__ __forceinline__ void operator()(const f32x4 (&acc)[2][2][4][2], const Unit& u, int wr, int wc, int fr, int fq) const {
        const int row0 = u.pm * BM + wr * 64 + fr, col0 = u.pn * BM + wc * 32 + 8 * fq;
#pragma unroll
        for (int ai = 0; ai < 2; ++ai)
#pragma unroll
            for (int m = 0; m < 4; ++m) { bf16_t* rowp = O + (size_t)(row0 + ai * HALF + m * 16) * ldc + col0;
#pragma unroll
                for (int bj = 0; bj < 2; ++bj) { const f32x4 v0 = acc[ai][bj][m][0], v1 = acc[ai][bj][m][1];
                    u32x4 w; w.x = cvt_pk_bf16(v0[0], v0[1]); w.y = cvt_pk_bf16(v0[2], v0[3]); w.z = cvt_pk_bf16(v1[0], v1[1]); w.w = cvt_pk_bf16(v1[2], v1[3]);
                    *(u32x4*)(rowp + bj * HALF) = w; } }
    }
};

struct EpiSwiglu {
    static constexpr bool PERM = true, AFTER_DRAIN = false;
    bf16_t* H; int ldh;
    __device__ __forceinline__ void operator()(const f32x4 (&acc)[2][2][4][2], const Unit& u, int wr, int wc, int fr, int fq) const {
        const int row0 = u.pm * BM + wr * 64 + fr, col0 = u.pn * 128 + wc * 32 + 8 * fq;
#pragma unroll
        for (int ai = 0; ai < 2; ++ai)
#pragma unroll
            for (int m = 0; m < 4; ++m) { bf16_t* rowp = H + (size_t)(row0 + ai * HALF + m * 16) * ldh + col0;
                f32x4 o[2];
#pragma unroll
                for (int n = 0; n < 2; ++n) { const f32x4 g = acc[ai][0][m][n], up = acc[ai][1][m][n];
#pragma unroll
                    for (int e = 0; e < 4; ++e) { const float sg = __builtin_amdgcn_rcpf(1.0f + __builtin_amdgcn_exp2f(-1.4426950408889634f * g[e])); o[n][e] = g[e] * sg * up[e]; } }
                u32x4 w; w.x = cvt_pk_bf16(o[0][0], o[0][1]); w.y = cvt_pk_bf16(o[0][2], o[0][3]); w.z = cvt_pk_bf16(o[1][0], o[1][1]); w.w = cvt_pk_bf16(o[1][2], o[1][3]);
                *(u32x4*)rowp = w; }
    }
};

template <class Epi, class Sched, bool ALIGN_EPI = false, bool SP2 = false>
__device__ __forceinline__ void gemm_phase(PG8_LAS unsigned char* lds, const Gemm g, const Sched& S, const Epi& E) {
    const int tid = threadIdx.x, wid = __builtin_amdgcn_readfirstlane(tid >> 6), lane = tid & 63, wr = wid >> 2, wc = wid & 3, fr = lane & 15, fq = lane >> 4;
    const int K = g.K, nt = K / BK;
    unsigned voffA[2], voffB[2];
#pragma unroll
    for (int i = 0; i < 2; ++i) { int R, C; stage_rc(tid * 16 + i * 8192, R, C); const int Rb = Epi::PERM ? ((R & ~31) + perm32(R & 31)) : R;
        voffA[i] = (unsigned)(R * K + C) * 2u; voffB[i] = (unsigned)(Rb * K + C) * 2u; }
    const size_t kstep = (size_t)(BK * 2);
    const size_t hstep = (size_t)HALF * K * 2;
    const size_t tstep = 2 * hstep;
    const unsigned ldsw = (unsigned)wid * 1024u;
    const int aoff = lds_byte(wr * 64 + fr, fq * 8), boff = lds_byte(wc * 32 + fr, fq * 8);
#define PG8_SA(b, h) (((b) * 2 + (h)) * HTB)
#define PG8_SB(b, h) ((4 + (b) * 2 + (h)) * HTB)
#define PG8_STAGE(bufoff, gbase, voff) do { _Pragma("unroll") for (int _i = 0; _i < 2; ++_i) \
        __builtin_amdgcn_global_load_lds((const unsigned*)((const char*)(gbase) + (voff)[_i]), (PG8_LAS unsigned*)(lds + (bufoff) + ldsw + _i * 8192), 16, 0, 0); } while (0)
#define PG8_LDA(dst, b, h) do { _Pragma("unroll") for (int m = 0; m < 4; ++m) _Pragma("unroll") for (int k = 0; k < 2; ++k) dst[m][k] = *(const PG8_LAS bf16x8*)(lds + PG8_SA(b, h) + aoff + m * 2048 + k * 1024); } while (0)
#define PG8_LDB(dst, b, h) do { _Pragma("unroll") for (int n = 0; n < 2; ++n) _Pragma("unroll") for (int k = 0; k < 2; ++k) dst[n][k] = *(const PG8_LAS bf16x8*)(lds + PG8_SB(b, h) + boff + n * 2048 + k * 1024); } while (0)
#define PG8_MMA(ai, bj, At, Bt) do { __builtin_amdgcn_s_setprio(1); _Pragma("unroll") for (int m = 0; m < 4; ++m) _Pragma("unroll") for (int n = 0; n < 2; ++n) _Pragma("unroll") for (int k = 0; k < 2; ++k) \
        acc[ai][bj][m][n] = __builtin_amdgcn_mfma_f32_16x16x32_bf16(Bt[n][k], At[m][k], acc[ai][bj][m][n], 0, 0, 0); __builtin_amdgcn_s_setprio(0); } while (0)
#define PG8_WAIT_V(n) asm volatile("s_waitcnt vmcnt(" #n ")" ::: "memory")
#define PG8_WAIT_L(n) asm volatile("s_waitcnt lgkmcnt(" #n ")" ::: "memory")
#define PG8_BAR __builtin_amdgcn_s_barrier()
#define PG8_SCHED __builtin_amdgcn_sched_barrier(0)
    Unit cur, nxt; int ui = 0;
    if (!S.next(0, cur)) return;
    f32x4 acc[2][2][4][2];
#pragma unroll
    for (int a = 0; a < 2; ++a)
#pragma unroll
        for (int b = 0; b < 2; ++b)
#pragma unroll
            for (int m = 0; m < 4; ++m)
#pragma unroll
                for (int n = 0; n < 2; ++n) acc[a][b][m][n] = (f32x4){0.f, 0.f, 0.f, 0.f};
    bf16x8 At[4][2], B0[2][2], B1[2][2];
    const char* cA = (const char*)g.A + (size_t)cur.pm * tstep; const char* cB = (const char*)g.Bt + (size_t)cur.pn * tstep;
    S.a_ready(cur);
    if constexpr (SP2) {
        PG8_STAGE(PG8_SB(0, 0), cB, voffB); PG8_STAGE(PG8_SB(0, 1), cB + hstep, voffB); PG8_STAGE(PG8_SA(0, 0), cA, voffA); PG8_STAGE(PG8_SA(0, 1), cA + hstep, voffA);
        if (wr == 1) PG8_BAR;
        PG8_WAIT_V(2); PG8_BAR;
        PG8_STAGE(PG8_SB(1, 0), cB + kstep, voffB); PG8_STAGE(PG8_SA(1, 0), cA + kstep, voffA); PG8_STAGE(PG8_SB(1, 1), cB + hstep + kstep, voffB);
        PG8_WAIT_V(6); PG8_BAR;
    } else {
        PG8_STAGE(PG8_SB(0, 0), cB, voffB); PG8_STAGE(PG8_SA(0, 0), cA, voffA); PG8_STAGE(PG8_SB(0, 1), cB + hstep, voffB); PG8_STAGE(PG8_SA(0, 1), cA + hstep, voffA);
        if (wr == 1) PG8_BAR;
        PG8_WAIT_V(4); PG8_BAR;
        PG8_STAGE(PG8_SB(1, 0), cB + kstep, voffB); PG8_STAGE(PG8_SA(1, 0), cA + kstep, voffA); PG8_STAGE(PG8_SB(1, 1), cB + hstep + kstep, voffB);
        PG8_WAIT_V(6); PG8_BAR;
    }
    for (;;) {
        const bool has_next = S.next(ui + 1, nxt);
        const char* nA = has_next ? (const char*)g.A + (size_t)nxt.pm * tstep : cA; const char* nB = has_next ? (const char*)g.Bt + (size_t)nxt.pn * tstep : cB;
        for (int t = 0; t < nt; t += 2) {
            const bool last = (t == nt - 2);
            const char* a1 = cA + (size_t)(t + 1) * kstep;
            const char* a2 = last ? nA : cA + (size_t)(t + 2) * kstep; const char* b2 = last ? nB : cB + (size_t)(t + 2) * kstep;
            const char* a3 = a2 + kstep; const char* b3 = b2 + kstep;
            if (last && has_next) S.a_ready(nxt);
            if constexpr (SP2) {
            PG8_LDB(B0, 0, 0); PG8_LDB(B1, 0, 1); PG8_SCHED; PG8_LDA(At, 0, 0); PG8_STAGE(PG8_SA(1, 1), a1 + hstep, voffA);
            PG8_WAIT_V(8); PG8_WAIT_L(0); PG8_BAR; PG8_MMA(0, 0, At, B0); PG8_MMA(0, 1, At, B1); PG8_BAR; PG8_SCHED;
            PG8_LDA(At, 0, 1); PG8_STAGE(PG8_SB(0, 0), b2, voffB); PG8_STAGE(PG8_SB(0, 1), b2 + hstep, voffB); PG8_STAGE(PG8_SA(0, 0), a2, voffA);
            PG8_WAIT_V(8); PG8_WAIT_L(0); PG8_BAR; PG8_MMA(1, 0, At, B0); PG8_MMA(1, 1, At, B1); PG8_BAR; PG8_SCHED;
            PG8_LDB(B0, 1, 0); PG8_LDB(B1, 1, 1); PG8_SCHED; PG8_LDA(At, 1, 0); PG8_STAGE(PG8_SA(0, 1), a2 + hstep, voffA);
            PG8_WAIT_V(8); PG8_WAIT_L(0); PG8_BAR; PG8_MMA(0, 0, At, B0); PG8_MMA(0, 1, At, B1); PG8_BAR; PG8_SCHED;
            PG8_LDA(At, 1, 1); PG8_STAGE(PG8_SB(1, 0), b3, voffB); PG8_STAGE(PG8_SB(1, 1), b3 + hstep, voffB); PG8_STAGE(PG8_SA(1, 0), a3, voffA);
            PG8_WAIT_V(8); PG8_WAIT_L(0); PG8_BAR; PG8_MMA(1, 0, At, B0); PG8_MMA(1, 1, At, B1); PG8_BAR; PG8_SCHED;
            } else {
            PG8_LDB(B0, 0, 0); PG8_SCHED; PG8_LDA(At, 0, 0); PG8_STAGE(PG8_SA(1, 1), a1 + hstep, voffA);
            PG8_WAIT_L(8); PG8_BAR; PG8_WAIT_L(0); PG8_MMA(0, 0, At, B0); PG8_BAR; PG8_SCHED;
            PG8_LDB(B1, 0, 1); PG8_STAGE(PG8_SB(0, 0), b2, voffB);
            PG8_BAR; PG8_WAIT_L(0); PG8_MMA(0, 1, At, B1); PG8_BAR;
            PG8_LDA(At, 0, 1); PG8_STAGE(PG8_SA(0, 0), a2, voffA);
            PG8_BAR; PG8_WAIT_L(0); PG8_MMA(1, 0, At, B0); PG8_BAR; PG8_SCHED;
            PG8_STAGE(PG8_SB(0, 1), b2 + hstep, voffB);
            PG8_WAIT_V(6); PG8_BAR; PG8_MMA(1, 1, At, B1); PG8_BAR;
            PG8_LDB(B0, 1, 0); PG8_SCHED; PG8_LDA(At, 1, 0); PG8_STAGE(PG8_SA(0, 1), a2 + hstep, voffA);
            PG8_WAIT_L(8); PG8_BAR; PG8_WAIT_L(0); PG8_MMA(0, 0, At, B0); PG8_BAR; PG8_SCHED;
            PG8_LDB(B1, 1, 1); PG8_STAGE(PG8_SB(1, 0), b3, voffB);
            PG8_BAR; PG8_WAIT_L(0); PG8_MMA(0, 1, At, B1); PG8_BAR;
            PG8_LDA(At, 1, 1); PG8_STAGE(PG8_SA(1, 0), a3, voffA);
            PG8_BAR; PG8_WAIT_L(0); PG8_MMA(1, 0, At, B0); PG8_BAR; PG8_SCHED;
            PG8_STAGE(PG8_SB(1, 1), b3 + hstep, voffB);
            PG8_WAIT_V(6); PG8_BAR; PG8_MMA(1, 1, At, B1); PG8_BAR;
            }
        }
        if constexpr (ALIGN_EPI) { if (wr == 0) PG8_BAR; }
        if constexpr (!Epi::AFTER_DRAIN) { E(acc, cur, wr, wc, fr, fq); S.done(cur); }
        if (!has_next) break;
#pragma unroll
        for (int a = 0; a < 2; ++a)
#pragma unroll
            for (int b = 0; b < 2; ++b)
#pragma unroll
                for (int m = 0; m < 4; ++m)
#pragma unroll
                    for (int n = 0; n < 2; ++n) acc[a][b][m][n] = (f32x4){0.f, 0.f, 0.f, 0.f};
        cur = nxt; cA = nA; cB = nB; ++ui;
        if constexpr (ALIGN_EPI) { if (wr == 1) PG8_BAR; }
    }
    PG8_WAIT_V(0);
    if constexpr (!ALIGN_EPI) { if (wr == 0) PG8_BAR; }
    PG8_BAR;
#undef PG8_SA
#undef PG8_SB
#undef PG8_STAGE
#undef PG8_LDA
#undef PG8_LDB
#undef PG8_MMA
#undef PG8_WAIT_V
#undef PG8_WAIT_L
#undef PG8_BAR
#undef PG8_SCHED
}
}

namespace att {
typedef unsigned short bf16;
using bf16x8 = __attribute__((ext_vector_type(8))) short;
using s16x4  = __attribute__((ext_vector_type(4))) short;
using f32x16 = __attribute__((ext_vector_type(16))) float;
using u32x4  = __attribute__((ext_vector_type(4))) unsigned;
constexpr int D = 128, NW = 8, QBLK = 32, KVBLK = 64;
constexpr float SCALE = 0.088388347648318440f;
constexpr float THR = 8.f;
constexpr int LDQ = 2048, LDK = 128, LDO = 2048;
constexpr int SHM_V = KVBLK * D * 2, SHM_K = KVBLK * D * 2, SHM_ATTN = 2 * SHM_V + 2 * SHM_K + NW * 64 * 4;
#define KSWZ(row, colB) ((row) * 256 + ((colB) ^ (((row) & 7) << 4)))
#define SBAR() __builtin_amdgcn_sched_barrier(0)
__device__ __forceinline__ int crow(int r, int hi) { return (r & 3) + 8 * (r >> 2) + 4 * hi; }
__device__ __forceinline__ unsigned cvtpk(float lo, float hi) { unsigned r; asm volatile("v_cvt_pk_bf16_f32 %0, %1, %2" : "=v"(r) : "v"(lo), "v"(hi)); return r; }

__device__ __forceinline__ void partialSM(f32x16& p0, f32x16& p1, float& m_reg, float& mn, float& alpha) {
  constexpr float C = SCALE * 1.4426950408889634f;
  float pmax = p0[0]; for (int r = 1; r < 16; ++r) pmax = fmaxf(pmax, p0[r]); for (int r = 0; r < 16; ++r) pmax = fmaxf(pmax, p1[r]);
  { auto rr = __builtin_amdgcn_permlane32_swap(__float_as_uint(pmax), __float_as_uint(pmax), false, false);
    pmax = fmaxf(__uint_as_float(rr[0]), __uint_as_float(rr[1])); }
  if (__builtin_expect(__all(pmax - m_reg <= THR / SCALE), 1)) { mn = m_reg; alpha = 1.f; }
  else { mn = fmaxf(m_reg, pmax); alpha = __builtin_amdgcn_exp2f((m_reg - mn) * C); m_reg = mn; }
  float mnC = -mn * C;
  for (int r = 0; r < 16; ++r) p0[r] = fmaf(p0[r], C, mnC); for (int r = 0; r < 16; ++r) p1[r] = fmaf(p1[r], C, mnC);
  for (int r = 0; r < 16; ++r) p0[r] = __builtin_amdgcn_exp2f(p0[r]);
}
__device__ __forceinline__ void finishSM(f32x16& p0, f32x16& p1, float alpha, float& l_reg, bf16x8& pa0, bf16x8& pa1, bf16x8& pa2, bf16x8& pa3) {
  for (int r = 0; r < 16; ++r) p1[r] = __builtin_amdgcn_exp2f(p1[r]);
  float ps = 0; for (int r = 0; r < 16; ++r) ps += p0[r]; for (int r = 0; r < 16; ++r) ps += p1[r];
  { auto rr = __builtin_amdgcn_permlane32_swap(__float_as_uint(ps), __float_as_uint(ps), false, false);
    ps = __uint_as_float(rr[0]) + __uint_as_float(rr[1]); }
  l_reg = l_reg * alpha + ps;
#define PK4(P, BASE, OUT) do { unsigned a0 = cvtpk(P[BASE + 0], P[BASE + 1]), a1 = cvtpk(P[BASE + 2], P[BASE + 3]);   \
    unsigned b0 = cvtpk(P[BASE + 4], P[BASE + 5]), b1 = cvtpk(P[BASE + 6], P[BASE + 7]);                              \
    auto r0 = __builtin_amdgcn_permlane32_swap(a0, b0, false, false); auto r1 = __builtin_amdgcn_permlane32_swap(a1, b1, false, false); \
    u32x4 w = {r0[0], r1[0], r0[1], r1[1]}; OUT = *reinterpret_cast<bf16x8*>(&w); } while (0)
  PK4(p0, 0, pa0); PK4(p0, 8, pa1); PK4(p1, 0, pa2); PK4(p1, 8, pa3);
#undef PK4
}
__device__ __forceinline__ void qkt(f32x16& p0, f32x16& p1, const bf16* Ks, const bf16x8* qr, int r32, int hi) {
  p0 = f32x16{}; p1 = f32x16{};
  for (int d0 = 0; d0 < 8; ++d0) { int cb = (d0 * 16 + hi * 8) * 2;
    bf16x8 b0 = *reinterpret_cast<const bf16x8*>((const char*)Ks + KSWZ(r32, cb));
    bf16x8 b1 = *reinterpret_cast<const bf16x8*>((const char*)Ks + KSWZ(32 + r32, cb));
    p0 = __builtin_amdgcn_mfma_f32_32x32x16_bf16(b0, qr[d0], p0, 0, 0, 0);
    p1 = __builtin_amdgcn_mfma_f32_32x32x16_bf16(b1, qr[d0], p1, 0, 0, 0); }
}
__device__ __forceinline__ void wmask(f32x16& p0, f32x16& p1, int kb, int qpos) {
  const int dq = qpos - kb + 128;
#pragma unroll
  for (int r = 0; r < 16; ++r) { const int d = dq - ((r & 3) + 8 * (r >> 2));
    if ((unsigned)d > 256u) p0[r] = -INFINITY;
    if ((unsigned)(d - 32) > 256u) p1[r] = -INFINITY; }
}
__device__ __forceinline__ int v_st(int k, int c) { const int kk = (k & ~0xC) | ((k & 4) << 1) | ((k & 8) >> 1); return ((kk >> 3) * 4 + (c >> 5)) * 512 + ((kk & 7) * 32 + (c & 31)) * 2; }
__device__ __forceinline__ int v_rd_base(int lane) { return ((lane & 3) << 3) | (((lane >> 2) & 3) << 6) | (((lane >> 4) & 1) << 5) | (((lane >> 5) & 1) << 8); }
constexpr int v_rd_off(int d0, int ks, int half) { return d0 * 512 + ks * 4096 + half * 2048; }
template <int OFF> __device__ __forceinline__ s16x4 tr_read(int vb) {
  s16x4 r; asm volatile("ds_read_b64_tr_b16 %0, %1 offset:%2" : "=&v"(r) : "v"(vb), "i"(OFF) : "memory"); return r;
}
template <int D0> __device__ __forceinline__ void pv_one(f32x16& od, int vb, bf16x8 pa0, bf16x8 pa1, bf16x8 pa2, bf16x8 pa3) {
  const s16x4 l0 = tr_read<v_rd_off(D0, 0, 0)>(vb), h0 = tr_read<v_rd_off(D0, 0, 1)>(vb), l1 = tr_read<v_rd_off(D0, 1, 0)>(vb), h1 = tr_read<v_rd_off(D0, 1, 1)>(vb);
  const s16x4 l2 = tr_read<v_rd_off(D0, 2, 0)>(vb), h2 = tr_read<v_rd_off(D0, 2, 1)>(vb), l3 = tr_read<v_rd_off(D0, 3, 0)>(vb), h3 = tr_read<v_rd_off(D0, 3, 1)>(vb);
  asm volatile("s_waitcnt lgkmcnt(0)" ::: "memory"); SBAR();
#define PK(L, H) (bf16x8){L[0], L[1], L[2], L[3], H[0], H[1], H[2], H[3]}
  od = __builtin_amdgcn_mfma_f32_32x32x16_bf16(pa0, PK(l0, h0), od, 0, 0, 0);
  od = __builtin_amdgcn_mfma_f32_32x32x16_bf16(pa1, PK(l1, h1), od, 0, 0, 0);
  od = __builtin_amdgcn_mfma_f32_32x32x16_bf16(pa2, PK(l2, h2), od, 0, 0, 0);
  od = __builtin_amdgcn_mfma_f32_32x32x16_bf16(pa3, PK(l3, h3), od, 0, 0, 0);
#undef PK
}
__device__ __forceinline__ void pv_d0(f32x16* o, int vb, bf16x8 pa0, bf16x8 pa1, bf16x8 pa2, bf16x8 pa3) {
  pv_one<0>(o[0], vb, pa0, pa1, pa2, pa3); pv_one<1>(o[1], vb, pa0, pa1, pa2, pa3); pv_one<2>(o[2], vb, pa0, pa1, pa2, pa3); pv_one<3>(o[3], vb, pa0, pa1, pa2, pa3);
}

__device__ __forceinline__ void attn_unit(const bf16* __restrict__ Qb, const bf16* __restrict__ Kh, const bf16* __restrict__ Vh, bf16* Ob,
                                          int NT, int nctx, int jlo, int q0, bool masked, float sinkl2, char* lds) {
  const int tid = threadIdx.x, wid = tid >> 6, lane = tid & 63, r32 = lane & 31, hi = lane >> 5;
  bf16* V_lds = (bf16*)lds; bf16* K_lds = (bf16*)(lds + 2 * SHM_V);
  float* ws = (float*)(lds + 2 * SHM_V + 2 * SHM_K) + wid * 64; float* li_l = ws; float* al_l = ws + 32;
  float m_reg = -1e30f, l_reg = 0; f32x16 o[4] = {}; bf16x8 qr[8];
  const bf16* Qw = Qb + (long)(wid * QBLK + r32) * LDQ + hi * 8;
#pragma unroll
  for (int d0 = 0; d0 < 8; ++d0) qr[d0] = *reinterpret_cast<const bf16x8*>(Qw + d0 * 16);
  const int sr = tid >> 4, sc = (tid & 15) * 8, vst0 = v_st(sr, sc), vst1 = v_st(32 + sr, sc);
  const int vb0 = (int)(uintptr_t)V_lds + v_rd_base(lane);
  const int qpos = q0 + wid * QBLK + r32;
  struct { bf16x8 vs0, vs1, ks0, ks1; } sr_[2];
#define KOF(t) (((t) < nctx) ? (4096 + 64 * (t)) : 64 * (jlo + (t) - nctx))
#define SLOAD(i, k0) do { const int k0_ = (k0); sr_[i].vs0 = *reinterpret_cast<const bf16x8*>(&Vh[(long)(k0_ + sr) * LDK + sc]); sr_[i].vs1 = *reinterpret_cast<const bf16x8*>(&Vh[(long)(k0_ + 32 + sr) * LDK + sc]); \
    sr_[i].ks0 = *reinterpret_cast<const bf16x8*>(&Kh[(long)(k0_ + sr) * LDK + sc]); sr_[i].ks1 = *reinterpret_cast<const bf16x8*>(&Kh[(long)(k0_ + 32 + sr) * LDK + sc]); } while (0)
#define SWRITE(b, i) do { *(bf16x8*)((char*)V_lds + (b) * SHM_V + vst0) = sr_[i].vs0;          \
    *(bf16x8*)((char*)V_lds + (b) * SHM_V + vst1) = sr_[i].vs1; int kc = sc * 2;               \
    *(bf16x8*)((char*)K_lds + (b) * SHM_K + KSWZ(sr, kc)) = sr_[i].ks0;                       \
    *(bf16x8*)((char*)K_lds + (b) * SHM_K + KSWZ(32 + sr, kc)) = sr_[i].ks1; } while (0)
#define SWAIT() asm volatile("s_waitcnt vmcnt(4)" ::: "memory")
#define RESC(a) do { if (__any((a) < 1.f)) { if (hi == 0) al_l[r32] = (a); asm volatile("s_waitcnt lgkmcnt(0)" ::: "memory"); \
    for (int d = 0; d < 4; ++d) for (int r = 0; r < 16; ++r) o[d][r] *= al_l[crow(r, hi)]; } } while (0)
#define MASK(P0, P1, t) do { if (masked && (t) >= nctx) wmask(P0, P1, KOF(t) + 4 * hi, qpos); } while (0)
  f32x16 pA0, pA1, pB0, pB1; float mnA, mnB, alA, alB; bf16x8 pa0, pa1, pa2, pa3;
  constexpr int SE = 0, SO = 1;
  SLOAD(SE, KOF(0)); asm volatile("s_waitcnt vmcnt(0)" ::: "memory"); SWRITE(0, SE); __syncthreads();
  qkt(pA0, pA1, K_lds, qr, r32, hi); MASK(pA0, pA1, 0); partialSM(pA0, pA1, m_reg, mnA, alA);
  SLOAD(SO, KOF(1)); if (2 < NT) SLOAD(SE, KOF(2));
  SWAIT(); SWRITE(1, SO); __syncthreads();
  for (int j = 1; j + 1 < NT; j += 2) {
    SBAR(); qkt(pB0, pB1, (bf16*)((char*)K_lds + SHM_K), qr, r32, hi);
    finishSM(pA0, pA1, alA, l_reg, pa0, pa1, pa2, pa3); SBAR();
    SLOAD(SO, KOF(j + 2)); SBAR();
    pv_d0(o, vb0, pa0, pa1, pa2, pa3); MASK(pB0, pB1, j); partialSM(pB0, pB1, m_reg, mnB, alB);
    __syncthreads(); SWAIT(); SWRITE(0, SE);
    RESC(alB); __syncthreads();
    SBAR(); qkt(pA0, pA1, K_lds, qr, r32, hi);
    finishSM(pB0, pB1, alB, l_reg, pa0, pa1, pa2, pa3); SBAR();
    if (j + 3 < NT) SLOAD(SE, KOF(j + 3)); SBAR();
    pv_d0(o, vb0 + (int)SHM_V, pa0, pa1, pa2, pa3); MASK(pA0, pA1, j + 1); partialSM(pA0, pA1, m_reg, mnA, alA);
    __syncthreads(); SWAIT(); SWRITE(1, SO);
    RESC(alA); __syncthreads();
  }
  SBAR(); qkt(pB0, pB1, (bf16*)((char*)K_lds + SHM_K), qr, r32, hi);
  finishSM(pA0, pA1, alA, l_reg, pa0, pa1, pa2, pa3); SBAR();
  pv_d0(o, vb0, pa0, pa1, pa2, pa3); MASK(pB0, pB1, NT - 1); partialSM(pB0, pB1, m_reg, mnB, alB);
  __syncthreads(); RESC(alB);
  finishSM(pB0, pB1, alB, l_reg, pa0, pa1, pa2, pa3); SBAR();
  pv_d0(o, vb0 + (int)SHM_V, pa0, pa1, pa2, pa3);
  l_reg += __builtin_amdgcn_exp2f(sinkl2 - m_reg * (SCALE * 1.4426950408889634f));
  if (hi == 0) li_l[r32] = l_reg; asm volatile("s_waitcnt lgkmcnt(0)" ::: "memory");
  float rli[16];
#pragma unroll
  for (int r = 0; r < 16; ++r) rli[r] = __builtin_amdgcn_rcpf(li_l[crow(r, hi)]);
  __syncthreads();
  { char* stg = lds + wid * 8192 + (4 * hi * 128 + r32) * 2;
#pragma unroll
    for (int r = 0; r < 16; ++r) {
#pragma unroll
      for (int d0 = 0; d0 < 4; ++d0) { const float v = o[d0][r] * rli[r]; *(bf16*)(stg + ((r & 3) + 8 * (r >> 2)) * 256 + d0 * 64) = (bf16)(cvtpk(v, v) & 0xffffu); }
      asm volatile("" ::: "memory"); }
    asm volatile("s_waitcnt lgkmcnt(0)" ::: "memory");
    bf16* Ow = Ob + (long)(wid * QBLK + (lane >> 4)) * LDO + (lane & 15) * 8;
    const char* rd = lds + wid * 8192 + (lane >> 4) * 256 + (lane & 15) * 16;
#pragma unroll
    for (int i = 0; i < 8; ++i) { const u32x4 v = *(const u32x4*)(rd + i * 1024); *(u32x4*)(Ow + (long)i * 4 * LDO) = v; } }
  __syncthreads();
#undef KOF
#undef SLOAD
#undef SWRITE
#undef SWAIT
#undef RESC
#undef MASK
}
#undef KSWZ
#undef SBAR
}

constexpr int NWAVES = 8;
constexpr int N_LAUNCHES = MK_N_LAUNCHES;
constexpr int N_PHASES = 10;
constexpr int DM = 2048, NB = 4, SEQ = 4096, CTXL = 256, FFN = 5632, INW = 3072, NMOD = 12288;
constexpr int M = NB * SEQ, MC = NB * CTXL, MU = M + MC;
constexpr int SKV = SEQ + CTXL;
constexpr float LN_EPS = 1e-6f;
constexpr float DN_ALPHA = 1.189207115002721f;

constexpr size_t MiB = 1u << 20;
constexpr size_t WS_CTL = 0, CTL_ZERO_BYTES = 64 * 1024;
constexpr size_t WS_MODP = 1 * MiB;
constexpr size_t WS_MODS = 2 * MiB;
constexpr size_t WS_ROPE = 2 * MiB + 512 * 1024;
constexpr size_t WS_WIN = 3 * MiB, WS_WOUT = 15 * MiB, WS_WGU = 23 * MiB, WS_WDN = 67 * MiB;
constexpr size_t WS_U = 89 * MiB;
constexpr size_t WS_Y = 157 * MiB;
constexpr size_t WS_QO = 285 * MiB;
constexpr size_t WS_KV = 349 * MiB;
constexpr size_t KV_BYTES = (size_t)NB * 2 * SKV * 128 * 2;
constexpr size_t WS_H = 285 * MiB;
constexpr size_t WS_END = 461 * MiB;
static_assert(WS_WIN + (size_t)INW * DM * 2 <= WS_WOUT && WS_WOUT + (size_t)DM * DM * 2 <= WS_WGU && WS_WGU + (size_t)2 * FFN * DM * 2 <= WS_WDN && WS_WDN + (size_t)DM * FFN * 2 <= WS_U, "ws map (weights)");
static_assert(WS_U + (size_t)MU * DM * 2 <= WS_Y && WS_Y + (size_t)M * DM * 4 <= WS_QO && WS_QO + (size_t)M * DM * 2 <= WS_KV && WS_KV + 4 * KV_BYTES <= WS_END && WS_H + (size_t)M * FFN * 2 <= WS_END, "ws map");
constexpr int CW_BAR = 4096;

constexpr int RING_OFF = 0, RING_BYTES = 131072;
constexpr int LDSCTL_OFF = RING_BYTES, MISC_OFF = LDSCTL_OFF + 320;
constexpr int XCH_OFF = RING_BYTES + 1024;
constexpr int LDS_BYTES = 147456;
static_assert(XCH_OFF + 4096 <= LDS_BYTES, "LDS map");

#define GAS __attribute__((address_space(1)))
#define LAS __attribute__((address_space(3)))
typedef unsigned short bf16;
typedef unsigned v4u __attribute__((ext_vector_type(4)));
typedef float f32x4 __attribute__((ext_vector_type(4)));
typedef GAS unsigned gu32;
#define RLX_AGENT __ATOMIC_RELAXED, __HIP_MEMORY_SCOPE_AGENT
#define LDS_WAIT() asm volatile("s_waitcnt lgkmcnt(0)" ::: "memory")
#define VM_WAIT() asm volatile("s_waitcnt vmcnt(0)" ::: "memory")
__device__ __forceinline__ unsigned f2bf(float f) { unsigned u = __builtin_bit_cast(unsigned, f); return (u + 0x7fffu + ((u >> 16) & 1u)) >> 16; }
__device__ __forceinline__ unsigned pk2(float lo, float hi) { return f2bf(lo) | (f2bf(hi) << 16); }

#define XB_TMO      128
#define XB_XCNT(j)  (256  + 64 * (j))
#define XB_XSUB(j)  (1280 + 64 * (j))
#define XB_XGEN(j)  (2304 + 64 * (j))
#define XB_TOP      3328
#define XB_TOPGEN   3392
#define XCD_BAR_WORDS 3456
#define XB_SPIN_CAP (1u << 18)
__device__ __forceinline__ unsigned xb_ld(unsigned* p)              { return __hip_atomic_load(p, __ATOMIC_RELAXED, __HIP_MEMORY_SCOPE_AGENT); }
__device__ __forceinline__ unsigned xb_add(unsigned* p, unsigned v) { return __hip_atomic_fetch_add(p, v, __ATOMIC_RELAXED, __HIP_MEMORY_SCOPE_AGENT); }
__device__ __forceinline__ unsigned xb_xcc_id() { return (unsigned)__builtin_amdgcn_s_getreg((3 << 11) | 20) & 0xFu; }
#define XB_SPIN(cond, bar) do { unsigned _sp = 0; while (cond) { __builtin_amdgcn_s_sleep(1); \
    if ((++_sp & 255u) == 0u) { if (xb_ld(&(bar)[XB_TMO])) break; if (_sp > XB_SPIN_CAP) { atomicAdd(&(bar)[XB_TMO], 1u); break; } } } } while (0)
struct XcdBarrier { unsigned* bar; unsigned x; volatile LAS unsigned* st; };
__device__ __forceinline__ XcdBarrier xcd_barrier_post(unsigned* bar, volatile LAS unsigned* st) {
    XcdBarrier b; b.bar = bar; b.x = xb_xcc_id(); b.st = st;
    if (threadIdx.x == 0) (void)xb_add(&bar[XB_XCNT(b.x)], 1u);
    return b;
}
__device__ __forceinline__ void xcd_barrier_complete(unsigned* bar, unsigned x, unsigned& nloc, unsigned& nx) {
    const unsigned G = gridDim.x * gridDim.y * gridDim.z;
    unsigned sum, cnt, mine, sp = 0u;
    for (;;) {
        sum = 0u; cnt = 0u; mine = 0u;
#pragma unroll
        for (unsigned j = 0; j < 16; ++j) { const unsigned c = xb_ld(&bar[XB_XCNT(j)]); sum += c; cnt += (c > 0u) ? 1u : 0u; mine = (j == x) ? c : mine; }
        if (sum == G) break;
        __builtin_amdgcn_s_sleep(1);
        if ((++sp & 255u) == 0u) { if (xb_ld(&bar[XB_TMO])) break; if (sp > XB_SPIN_CAP) { atomicAdd(&bar[XB_TMO], 1u); break; } }
    }
    nloc = mine > 0u ? mine : 1u; nx = cnt > 0u ? cnt : 1u;
}
__device__ __forceinline__ void xcd_barrier(const XcdBarrier& b) {
    asm volatile("s_waitcnt vmcnt(0)" ::: "memory");
    __syncthreads();
    if (threadIdx.x == 0) {
        unsigned* bar = b.bar;
        __builtin_amdgcn_s_waitcnt(0);
        unsigned nloc = b.st[0], nx = b.st[1];
        if (nloc == 0u) { xcd_barrier_complete(bar, b.x, nloc, nx); b.st[0] = nloc; b.st[1] = nx; }
        const unsigned old = xb_add(&bar[XB_XSUB(b.x)], 1u);
        const unsigned gen = old / nloc;
        if (old + 1u == (gen + 1u) * nloc) {
            __builtin_amdgcn_fence(__ATOMIC_RELEASE, "agent");
            asm volatile("s_waitcnt vmcnt(0)" ::: "memory");
            const unsigned og = xb_add(&bar[XB_TOP], 1u);
            const unsigned tg = og / nx;
            if (og + 1u == (tg + 1u) * nx) xb_add(&bar[XB_TOPGEN], 1u);
            else XB_SPIN(xb_ld(&bar[XB_TOPGEN]) == tg, bar);
            __builtin_amdgcn_fence(__ATOMIC_ACQUIRE, "agent");
            xb_add(&bar[XB_XGEN(b.x)], 1u);
            asm volatile("s_waitcnt vmcnt(0)" ::: "memory");
        } else {
            XB_SPIN(xb_ld(&bar[XB_XGEN(b.x)]) == gen, bar);
            __builtin_amdgcn_fence(__ATOMIC_ACQUIRE, "agent");
            asm volatile("s_waitcnt vmcnt(0)" ::: "memory");
        }
    }
    __syncthreads();
}

__device__ __forceinline__ float wave_sum(float v) {
#pragma unroll
    for (int o = 1; o < 64; o <<= 1) v += __shfl_xor(v, o);
    return v;
}
__device__ __forceinline__ void transpose_item(const float* W, int ldw, int k0, int n0, bf16* WT, int Kd, int dst_row0, LAS float* scr, int lane) {
#pragma unroll 8
    for (int i = 0; i < 32; ++i) { const int kk = 2 * i + (lane >> 5); scr[kk * 33 + (lane & 31)] = W[(size_t)(k0 + kk) * ldw + n0 + (lane & 31)]; }
    LDS_WAIT(); asm volatile("" ::: "memory");
    const int c = lane & 7;
#pragma unroll
    for (int j = 0; j < 4; ++j) { const int n = (lane >> 3) + 8 * j; const LAS float* s = scr + (8 * c) * 33 + n;
        v4u o; o.x = pk2(s[0 * 33], s[1 * 33]); o.y = pk2(s[2 * 33], s[3 * 33]); o.z = pk2(s[4 * 33], s[5 * 33]); o.w = pk2(s[6 * 33], s[7 * 33]);
        *(GAS v4u*)(WT + (size_t)(dst_row0 + n) * Kd + k0 + 8 * c) = o; }
    LDS_WAIT(); asm volatile("" ::: "memory");
}
__device__ __forceinline__ float silu_f(float x) { return x / (1.0f + __expf(-x)); }

struct Args { const float* in[18]; float* out; unsigned char* ws; int ph_lo, ph_hi, li, flags; };

__device__ __forceinline__ void modulate_row(const float* xrow, bf16* orow, const LAS float* p0, const LAS float* p1, int lane) {
    const GAS f32x4* xr = (const GAS f32x4*)xrow + lane;
    GAS unsigned long long* o8 = (GAS unsigned long long*)orow + lane;
    f32x4 v[8];
#pragma unroll
    for (int j = 0; j < 8; ++j) v[j] = xr[64 * j];
#pragma unroll
    for (int j = 0; j < 8; ++j) { const f32x4 a = *(const LAS f32x4*)(p0 + 256 * j + 4 * lane), s = *(const LAS f32x4*)(p1 + 256 * j + 4 * lane); const f32x4 r = v[j] * a + s;
        o8[64 * j] = (unsigned long long)pk2(r.x, r.y) | ((unsigned long long)pk2(r.z, r.w) << 32); }
}
typedef unsigned u32x2 __attribute__((ext_vector_type(2)));
__device__ __forceinline__ f32x4 bf4_to_f32(u32x2 w) { f32x4 r; r.x = __uint_as_float(w.x << 16); r.y = __uint_as_float(w.x & 0xffff0000u); r.z = __uint_as_float(w.y << 16); r.w = __uint_as_float(w.y & 0xffff0000u); return r; }
__device__ __forceinline__ void ln_regs(f32x4 (&v)[8], const LAS float* g, const LAS float* bb, int lane) {
    float s = 0.f;
#pragma unroll
    for (int j = 0; j < 8; ++j) s += (v[j].x + v[j].y) + (v[j].z + v[j].w);
    const float mean = wave_sum(s) * (1.f / DM); float s2 = 0.f;
#pragma unroll
    for (int j = 0; j < 8; ++j) { v[j] = v[j] - mean; s2 += (v[j].x * v[j].x + v[j].y * v[j].y) + (v[j].z * v[j].z + v[j].w * v[j].w); }
    const float rstd = __builtin_amdgcn_rsqf(wave_sum(s2) * (1.f / DM) + LN_EPS);
#pragma unroll
    for (int j = 0; j < 8; ++j) { const int c = 256 * j + 4 * lane; v[j] = v[j] * rstd * *(const LAS f32x4*)(g + c) + *(const LAS f32x4*)(bb + c); }
}
__device__ __forceinline__ void x1_row(f32x4 (&v)[8], const float* xrow, const bf16* arow, const LAS float* P, int lane) {
    const GAS f32x4* xr = (const GAS f32x4*)xrow + lane; const GAS u32x2* ar = (const GAS u32x2*)arow + lane;
    u32x2 aw[8];
#pragma unroll
    for (int j = 0; j < 8; ++j) { v[j] = xr[64 * j]; aw[j] = ar[64 * j]; }
#pragma unroll
    for (int j = 0; j < 8; ++j) v[j] = v[j] * DN_ALPHA + *(const LAS f32x4*)(P + 256 * j + 4 * lane) * bf4_to_f32(aw[j]);
    ln_regs(v, P + 2048, P + 4096, lane);
}

__global__ void __launch_bounds__(NWAVES * 64, 2) dit_fwd(Args args) {
    extern __shared__ __attribute__((aligned(16))) unsigned char lds[];
    LAS unsigned char* L = (LAS unsigned char*)lds;
    volatile LAS unsigned* MISC = (volatile LAS unsigned*)(L + MISC_OFF);
    const int tid = threadIdx.x, lane = tid & 63, wave = __builtin_amdgcn_readfirstlane(tid >> 6);
    const int G = gridDim.x, bx = blockIdx.x;
    unsigned char* ws = args.ws;
    gu32* ctl = (gu32*)(ws + WS_CTL);
    const float* x = args.in[0]; const float* cvec = args.in[1]; const float* ctx = args.in[2]; const float* c_ctx = args.in[3];
    const float* w_ada = args.in[4]; const float* b_ada = args.in[5]; const float* w_in = args.in[6]; const float* qng = args.in[7]; const float* kng = args.in[8];
    const float* sink = args.in[9]; const float* w_out = args.in[10]; const float* ln1g = args.in[11]; const float* ln1b = args.in[12];
    const float* w_gate = args.in[13]; const float* w_up = args.in[14]; const float* w_down = args.in[15]; const float* ln2g = args.in[16]; const float* ln2b = args.in[17];
    float* MODP = (float*)(ws + WS_MODP); float* MODS = (float*)(ws + WS_MODS); float* ROPEC = (float*)(ws + WS_ROPE); float* ROPES = ROPEC + 2048;
    bf16* WIN = (bf16*)(ws + WS_WIN); bf16* WOUT = (bf16*)(ws + WS_WOUT); bf16* WGU = (bf16*)(ws + WS_WGU); bf16* WDN = (bf16*)(ws + WS_WDN);
    bf16* U = (bf16*)(ws + WS_U); bf16* AB = (bf16*)(ws + WS_Y); bf16* DB = (bf16*)(ws + WS_Y + 64 * MiB); bf16* QO = (bf16*)(ws + WS_QO);
    bf16* KA = (bf16*)(ws + WS_KV); bf16* VA = (bf16*)(ws + WS_KV + KV_BYTES); bf16* KB = (bf16*)(ws + WS_KV + 2 * KV_BYTES); bf16* VB = (bf16*)(ws + WS_KV + 3 * KV_BYTES);
    bf16* HB = (bf16*)(ws + WS_H);

    for (int u = tid; u < (LDS_BYTES - LDSCTL_OFF) / 4; u += NWAVES * 64) ((LAS unsigned*)(L + LDSCTL_OFF))[u] = 0u;
    __syncthreads();
    XcdBarrier bar; bar.bar = (unsigned*)(ctl + CW_BAR); bar.x = 0; bar.st = nullptr;
    if (N_LAUNCHES == 1) bar = xcd_barrier_post((unsigned*)(ctl + CW_BAR), MISC + 8);
#define GRID_BAR() do { if (N_LAUNCHES == 1) xcd_barrier(bar); } while (0)
    const int lo = args.ph_lo, hi = args.ph_hi;
#ifndef PHMASK
#define PHMASK 0x3FF
#endif
#define IN(k) (((PHMASK >> (k)) & 1) && lo <= (k) && (k) < hi)
#define BOTH(k) (IN(k) && IN((k) + 1))

    if (IN(0)) {
        if (bx < 192) {
            const int cb = bx >> 2, kq = bx & 3, k0 = kq * 512 + wave * 64;
            float sv[5];
#pragma unroll
            for (int b = 0; b < 4; ++b) sv[b] = silu_f(cvec[b * DM + k0 + lane]);
            sv[4] = silu_f(c_ctx[k0 + lane]);
            f32x4 acc[5];
#pragma unroll
            for (int b = 0; b < 5; ++b) acc[b] = (f32x4){0.f, 0.f, 0.f, 0.f};
            const float* wp = w_ada + (size_t)k0 * NMOD + cb * 256 + lane * 4;
#pragma unroll 16
            for (int kk = 0; kk < 64; ++kk) { const f32x4 wv = *(const f32x4*)(wp + (size_t)kk * NMOD);
#pragma unroll
                for (int b = 0; b < 5; ++b) { const float s = __builtin_bit_cast(float, __builtin_amdgcn_readlane(__builtin_bit_cast(int, sv[b]), kk)); acc[b] += wv * s; } }
            LAS f32x4* red = (LAS f32x4*)(L + RING_OFF);
#pragma unroll
            for (int b = 0; b < 5; ++b) red[(wave * 5 + b) * 64 + lane] = acc[b];
            LDS_WAIT(); __syncthreads();
            if (tid < 320) { const int b = tid >> 6, l = tid & 63; f32x4 s = red[b * 64 + l];
#pragma unroll
                for (int w = 1; w < 8; ++w) s += red[(w * 5 + b) * 64 + l];
                *(f32x4*)(MODP + ((size_t)kq * 5 + b) * NMOD + cb * 256 + l * 4) = s; }
            __syncthreads();
        }
        if (bx == 255) {
            for (int e = tid; e < 2048; e += NWAVES * 64) { const int pos = e >> 5, f = e & 31;
                const float inv = exp2f(-(float)f * (13.287712379549449f / 32.0f)); const float ang = (float)pos * inv;
                float sn, cs; sincosf(ang, &sn, &cs); ROPEC[e] = cs; ROPES[e] = sn; }
        }
        {
            LAS float* scr = (LAS float*)(L + RING_OFF + wave * 16384);
            constexpr int I_IN = 32 * 96, I_OUT = 32 * 64, I_G = 32 * 176, I_D = 88 * 64, NITEMS = I_IN + I_OUT + 2 * I_G + I_D, NSLOT = 192 * 8 * 2 + 64 * 8 * 3;
            const int nsl = bx < 192 ? 2 : 3, sl0 = bx < 192 ? (bx * 8 + wave) * 2 : 3072 + ((bx - 192) * 8 + wave) * 3;
            for (int s = 0; s < nsl; ++s)
                for (int it = sl0 + s; it < NITEMS; it += NSLOT) {
                    int r = it;
                    if (r < I_IN) { const int kb = r / 96, nb = r % 96, pn = nb >> 3, q = nb & 7, hh = q >> 2, part = (q >> 1) & 1, bj = q & 1;
                        transpose_item(w_in, INW, 64 * kb, 32 * nb, WIN, DM, 256 * pn + 32 * (4 * bj + 2 * hh + part), scr, lane); continue; } r -= I_IN;
                    if (r < I_OUT) { const int kb = r / 64, nb = r % 64; transpose_item(w_out, DM, 64 * kb, 32 * nb, WOUT, DM, 32 * nb, scr, lane); continue; } r -= I_OUT;
                    if (r < I_G) { const int kb = r / 176, nb = r % 176; transpose_item(w_gate, FFN, 64 * kb, 32 * nb, WGU, DM, 256 * (nb >> 2) + 32 * (nb & 3), scr, lane); continue; } r -= I_G;
                    if (r < I_G) { const int kb = r / 176, nb = r % 176; transpose_item(w_up, FFN, 64 * kb, 32 * nb, WGU, DM, 256 * (nb >> 2) + 128 + 32 * (nb & 3), scr, lane); continue; } r -= I_G;
                    { const int kb = r / 64, nb = r % 64; transpose_item(w_down, DM, 64 * kb, 32 * nb, WDN, FFN, 32 * nb, scr, lane); }
                }
        }
        if (BOTH(0)) GRID_BAR();
    }

    if (IN(1)) {
        { const int idx = bx * 512 + tid;
          if (idx < 5 * NMOD) { float s = b_ada[idx % NMOD];
#pragma unroll
              for (int q = 0; q < 4; ++q) s += MODP[(size_t)q * 5 * NMOD + idx];
              MODS[idx] = s; } }
        if (bx < 128) {
            LAS float* P0 = (LAS float*)(L + RING_OFF); LAS float* P1 = P0 + 2048;
            for (int i = tid; i < 2048; i += NWAVES * 64) { float sh = b_ada[i], sc = b_ada[2048 + i];
#pragma unroll
                for (int q = 0; q < 4; ++q) { sh += MODP[((size_t)q * 5 + 4) * NMOD + i]; sc += MODP[((size_t)q * 5 + 4) * NMOD + 2048 + i]; }
                P0[i] = 1.0f + sc; P1[i] = sh; }
            LDS_WAIT(); __syncthreads();
            const int r = bx * 8 + wave;
            modulate_row(ctx + (size_t)r * DM, U + (size_t)(M + r) * DM, P0, P1, lane);
            __syncthreads();
        }
        if (BOTH(1)) GRID_BAR();
    }

    if (IN(2)) {
        if (bx < 16) {
            const int pnl[4] = {4, 5, 10, 11};
            pg8::Gemm g{U, WIN, MU, INW, DM}; pg8::OneUnit S{64 + (bx >> 2), (bx & 3) == 0 ? 4 : (bx & 3) == 1 ? 5 : (bx & 3) == 2 ? 10 : 11}; (void)pnl;
            pg8::EpiQKV E{QO, KA, VA, KB, VB, qng, kng, ROPEC, ROPES, (LAS float*)(L + XCH_OFF)};
            pg8::gemm_phase<pg8::EpiQKV, pg8::OneUnit, true, true>(L + RING_OFF, g, S, E);
        } else {
            LAS float* P0 = (LAS float*)(L + RING_OFF); LAS float* P1 = P0 + 2048;
            const int i = bx - 16, r0 = (int)(((long)i * M) / 240), r1 = (int)(((long)(i + 1) * M) / 240);
            int r = r0;
            while (r < r1) {
                const int b = r >> 12; int re = (b + 1) << 12; if (re > r1) re = r1;
                __syncthreads();
                for (int k = tid; k < 2048; k += NWAVES * 64) { P0[k] = 1.0f + MODS[b * NMOD + 2048 + k]; P1[k] = MODS[b * NMOD + k]; }
                LDS_WAIT(); __syncthreads();
                for (int rr = r + wave; rr < re; rr += NWAVES) modulate_row(x + (size_t)rr * DM, U + (size_t)rr * DM, P0, P1, lane);
                r = re;
            }
            __syncthreads();
        }
        if (BOTH(2)) GRID_BAR();
    }

    if (IN(3)) {
        pg8::Gemm g{U, WIN, M, INW, DM}; pg8::StaticOrder S; S.init(M, INW, G, bx);
        pg8::EpiQKV E{QO, KA, VA, KB, VB, qng, kng, ROPEC, ROPES, (LAS float*)(L + XCH_OFF)};
        pg8::gemm_phase<pg8::EpiQKV, pg8::StaticOrder, true, true>(L + RING_OFF, g, S, E);
        if (BOTH(3)) GRID_BAR();
    }

    if (IN(4)) {
        const int xg = bx & 7, y = bx >> 3, b = xg >> 1, kvh = xg & 1;
        const size_t kvoff = (size_t)(b * 2 + kvh) * SKV * 128;
        for (int i = 0; i < 4; ++i) {
            const int uu = 2 * y + (i & 1), gq = uu >> 4, qb = uu & 15, q0 = qb * 256;
            const bool isA = i >= 2;
            const int head = kvh * 4 + gq;
            bf16* Qp = QO + (size_t)(b * SEQ + q0) * DM + (isA ? 0 : 1024) + head * 128;
            const int jlo = !isA ? 0 : ((q0 >> 6) - 2 < 0 ? 0 : (q0 >> 6) - 2), jhi = (q0 >> 6) + 6 > 64 ? 64 : (q0 >> 6) + 6;
            const int nctx = isA ? 4 : 0, NT = isA ? 4 + (jhi - jlo) : SKV / 64;
            const float sk = isA ? sink[head] * 1.4426950408889634f : -INFINITY;
            att::attn_unit(Qp, (isA ? KA : KB) + kvoff, (isA ? VA : VB) + kvoff, (args.flags & 1) ? (bf16*)(ws + 384 * MiB) + (Qp - QO) : Qp, NT, nctx, jlo, q0, isA, sk, (char*)lds + RING_OFF);
        }
        if (BOTH(4)) GRID_BAR();
    }

    if (IN(5)) {
        pg8::Gemm g{QO, WOUT, M, DM, DM}; pg8::StaticOrder S; S.init(M, DM, G, bx);
        pg8::EpiBf16Plain E{AB, DM};
        pg8::gemm_phase<pg8::EpiBf16Plain, pg8::StaticOrder, true, true>(L + RING_OFF, g, S, E);
        if (BOTH(5)) GRID_BAR();
    }

    if (IN(6)) {
        LAS float* P = (LAS float*)(L + RING_OFF);
        const int b = bx >> 6;
        for (int k = tid; k < 2048; k += NWAVES * 64) { P[k] = MODS[b * NMOD + 2 * 2048 + k]; P[2048 + k] = ln1g[k]; P[4096 + k] = ln1b[k]; P[6144 + k] = 1.0f + MODS[b * NMOD + 4 * 2048 + k]; P[8192 + k] = MODS[b * NMOD + 3 * 2048 + k]; }
        LDS_WAIT(); __syncthreads();
        for (int rr = bx * 64 + wave; rr < bx * 64 + 64; rr += NWAVES) {
            f32x4 v[8]; x1_row(v, x + (size_t)rr * DM, AB + (size_t)rr * DM, P, lane);
            GAS unsigned long long* o8 = (GAS unsigned long long*)(U + (size_t)rr * DM) + lane;
#pragma unroll
            for (int j = 0; j < 8; ++j) { const int c = 256 * j + 4 * lane; const f32x4 r = v[j] * *(const LAS f32x4*)(P + 6144 + c) + *(const LAS f32x4*)(P + 8192 + c);
                o8[64 * j] = (unsigned long long)pk2(r.x, r.y) | ((unsigned long long)pk2(r.z, r.w) << 32); }
        }
        __syncthreads();
        if (BOTH(6)) GRID_BAR();
    }

    if (IN(7)) {
        pg8::Gemm g{U, WGU, M, 2 * FFN, DM}; pg8::StaticOrder S; S.init(M, 2 * FFN, G, bx);
        pg8::EpiSwiglu E{HB, FFN};
        pg8::gemm_phase<pg8::EpiSwiglu, pg8::StaticOrder, true, true>(L + RING_OFF, g, S, E);
        if (BOTH(7)) GRID_BAR();
    }

    if (IN(8)) {
        pg8::Gemm g{HB, WDN, M, DM, FFN}; pg8::StaticOrder S; S.init(M, DM, G, bx);
        pg8::EpiBf16Plain E{DB, DM};
        pg8::gemm_phase<pg8::EpiBf16Plain, pg8::StaticOrder, true, true>(L + RING_OFF, g, S, E);
        if (BOTH(8)) GRID_BAR();
    }

    if (IN(9)) {
        LAS float* P = (LAS float*)(L + RING_OFF);
        const int b = bx >> 6;
        for (int k = tid; k < 2048; k += NWAVES * 64) { P[k] = MODS[b * NMOD + 2 * 2048 + k]; P[2048 + k] = ln1g[k]; P[4096 + k] = ln1b[k]; P[6144 + k] = MODS[b * NMOD + 5 * 2048 + k]; P[8192 + k] = ln2g[k]; P[10240 + k] = ln2b[k]; }
        LDS_WAIT(); __syncthreads();
        for (int rr = bx * 64 + wave; rr < bx * 64 + 64; rr += NWAVES) {
            f32x4 v[8]; x1_row(v, x + (size_t)rr * DM, AB + (size_t)rr * DM, P, lane);
            const GAS u32x2* dr = (const GAS u32x2*)(DB + (size_t)rr * DM) + lane;
#pragma unroll
            for (int j = 0; j < 8; ++j) v[j] = v[j] * DN_ALPHA + *(const LAS f32x4*)(P + 6144 + 256 * j + 4 * lane) * bf4_to_f32(dr[64 * j]);
            ln_regs(v, P + 8192, P + 10240, lane);
            GAS f32x4* orow = (GAS f32x4*)(args.out + (size_t)rr * DM) + lane;
#pragma unroll
            for (int j = 0; j < 8; ++j) orow[64 * j] = v[j];
        }
    }
#undef IN
#undef BOTH
#undef GRID_BAR
}

extern "C" void kernel_launch(void* const* d_in, const int* in_sizes, int n_in, void* d_out, int out_size, void* d_ws, size_t ws_size, hipStream_t stream) {
    static int grid = 0;
    if (grid == 0) {
        if (n_in != 18 || in_sizes[0] != M * DM || out_size != M * DM || ws_size < WS_END) {
            fprintf(stderr, "kernel_launch: shape mismatch (n_in %d, in0 %d, out %d, ws %zu; need ws >= %zu); nothing launched\n", n_in, n_in > 0 ? in_sizes[0] : -1, out_size, ws_size, (size_t)WS_END); grid = -1; return; }
        int dev = 0, cus = 0, per_cu = 0;
        if (hipGetDevice(&dev) != hipSuccess || hipDeviceGetAttribute(&cus, hipDeviceAttributeMultiprocessorCount, dev) != hipSuccess) { fprintf(stderr, "kernel_launch: device query failed\n"); grid = -1; return; }
        if (hipFuncSetAttribute((const void*)dit_fwd, hipFuncAttributeMaxDynamicSharedMemorySize, LDS_BYTES) != hipSuccess) { fprintf(stderr, "kernel_launch: hipFuncSetAttribute failed\n"); grid = -1; return; }
        if (hipOccupancyMaxActiveBlocksPerMultiprocessor(&per_cu, (const void*)dit_fwd, NWAVES * 64, LDS_BYTES) != hipSuccess || per_cu < 1)
            fprintf(stderr, "kernel_launch: note: occupancy query reports %d workgroups per CU\n", per_cu);
        (void)hipGetLastError();
        if (cus != 256) { fprintf(stderr, "kernel_launch: built for a 256-CU device, found %d CUs; nothing launched\n", cus); grid = -1; return; }
        grid = 256;
    }
    if (grid < 0) return;
    if (hipMemsetAsync((char*)d_ws + WS_CTL, 0, CTL_ZERO_BYTES, stream) != hipSuccess) { fprintf(stderr, "kernel_launch: hipMemsetAsync failed\n"); return; }
    Args a{};
    for (int i = 0; i < 18; ++i) a.in[i] = (const float*)d_in[i];
    a.out = (float*)d_out; a.ws = (unsigned char*)d_ws;
    if (N_LAUNCHES == 1) { a.ph_lo = 0; a.ph_hi = N_PHASES; a.li = 0; hipLaunchKernelGGL(dit_fwd, dim3(grid), dim3(NWAVES * 64), LDS_BYTES, stream, a); }
    else { const int plist[] = PHASE_LIST;
        for (unsigned i = 0; i < sizeof(plist) / sizeof(int); ++i) { const int p = plist[i] % 100; a.ph_lo = p; a.ph_hi = p + 1; a.li = 0; a.flags = plist[i] >= 100 ? 1 : 0;
            hipLaunchKernelGGL(dit_fwd, dim3(grid), dim3(NWAVES * 64), LDS_BYTES, stream, a); } }
    const hipError_t le = hipPeekAtLastError();
    if (le != hipSuccess) fprintf(stderr, "kernel_launch: launch failed: %s\n", hipGetErrorName(le));
}
```

```cpp
#include <hip/hip_runtime.h>
#include <hip/hip_bf16.h>
#include <cstdio>
#include <cstdint>

#ifndef PHASE_LIST
#define PHASE_LIST {0, 1, 2, 3, 4, 5, 6, 7, 8, 9}
#endif
#ifndef MK_N_LAUNCHES
#define MK_N_LAUNCHES 1
#endif

namespace pg8 {
#define PG8_LAS __attribute__((address_space(3)))
typedef unsigned short bf16_t;
typedef short bf16x8 __attribute__((ext_vector_type(8)));
typedef float f32x4 __attribute__((ext_vector_type(4)));
typedef unsigned u32x4 __attribute__((ext_vector_type(4)));
constexpr int BM = 256, BK = 64, HALF = 128, HTB = HALF * BK * 2, STAGE_BYTES = 8 * HTB, NXCD = 8, WGM = 8;

__host__ __device__ __forceinline__ int lds_byte(int r, int c) { const int st = (r >> 4) * 2 + (c >> 5), rr = r & 15, cc = c & 31, ob = rr * 64 + cc * 2; return st * 1024 + (ob ^ (((ob >> 9) & 1) << 5)); }
__host__ __device__ __forceinline__ void stage_rc(int b, int& R, int& C) { const int st = b / 1024, sb = b % 1024, swz = sb ^ (((sb >> 9) & 1) << 5); R = (st >> 1) * 16 + swz / 64; C = (st & 1) * 32 + (swz % 64) / 2; }
__host__ __device__ __forceinline__ int perm32(int rho) { const int n = rho >> 4, i = rho & 15; return 8 * (i >> 2) + 4 * n + (i & 3); }

struct Unit { int pm, pn; };
struct Gemm { const bf16_t* A; const bf16_t* Bt; int M, N, K; };

struct StaticOrder {
    int nM, nN, nwg, G, c;
    __host__ __device__ void init(int M, int N, int G_, int c_) { nM = M / BM; nN = N / BM; nwg = nM * nN; G = G_; c = c_; }
    __host__ __device__ bool next(int i, Unit& u) const {
        const long L = (long)i * G + c; if (L >= nwg) return false;
        int wgid = (int)L; { const int q = nwg / NXCD, r = nwg % NXCD, xcd = wgid % NXCD, off = wgid / NXCD; wgid = (xcd < r ? xcd * (q + 1) : r * (q + 1) + (xcd - r) * q) + off; }
        const int nig = WGM * nN, gid = wgid / nig, fm = gid * WGM, gsz = (nM - fm) < WGM ? (nM - fm) : WGM;
        u.pm = fm + ((wgid % nig) % gsz); u.pn = (wgid % nig) / gsz; return true;
    }
    __device__ __forceinline__ void a_ready(const Unit&) const {}
    __device__ __forceinline__ void done(const Unit&) const {}
};
struct OneUnit {
    int pm, pn;
    __device__ bool next(int i, Unit& u) const { if (i > 0) return false; u.pm = pm; u.pn = pn; return true; }
    __device__ __forceinline__ void a_ready(const Unit&) const {}
    __device__ __forceinline__ void done(const Unit&) const {}
};

__device__ __forceinline__ unsigned cvt_pk_bf16(float lo, float hi) { unsigned r; asm volatile("v_cvt_pk_bf16_f32 %0, %1, %2" : "=v"(r) : "v"(lo), "v"(hi)); return r; }


struct EpiQKV {
    static constexpr bool PERM = true, AFTER_DRAIN = false;
    bf16_t* QO; bf16_t* KA; bf16_t* VA; bf16_t* KB; bf16_t* VB;
    const float* qg; const float* kg; const float* ropec; const float* ropes;
    PG8_LAS float* xch;
    __device__ __forceinline__ void operator()(const f32x4 (&acc)[2][2][4][2], const Unit& u, int wr, int wc, int fr, int fq) const {
        const int pn = u.pn; const bool is_ctx = u.pm >= 64;
        const int b = is_ctx ? (u.pm - 64) : (u.pm >> 4), t0 = is_ctx ? 4096 : ((u.pm & 15) << 8);
        const int hh = wc >> 1, part = wc & 1, wid = wr * 4 + wc;
        const bool isq = (pn < 4) || (pn >= 6 && pn < 10), donorm = (pn >= 6 && pn <= 10), dorope = (!is_ctx) && pn != 5 && pn != 11;
        bf16_t* base; size_t rstride;
        if (isq) { const int head = (pn < 4 ? 2 * pn : 8 + 2 * (pn - 6)) + hh; base = QO + (size_t)(b * 4096 + t0) * 2048 + head * 128; rstride = 2048; }
        else { bf16_t* buf = pn == 4 ? KA : pn == 5 ? VA : pn == 10 ? KB : VB; base = buf + ((size_t)(b * 2 + hh) * 4352 + t0) * 128; rstride = 128; }
        const int d0 = 64 * part + 8 * fq;
        float rs[2][4];
        f32x4 gv[2][2];
#pragma unroll
        for (int bj = 0; bj < 2; ++bj)
#pragma unroll
            for (int n = 0; n < 2; ++n) gv[bj][n] = (f32x4){1.f, 1.f, 1.f, 1.f};
#pragma unroll
        for (int ai = 0; ai < 2; ++ai)
#pragma unroll
            for (int m = 0; m < 4; ++m) rs[ai][m] = 1.f;
        if (donorm) {
            const float* g = (pn == 10) ? kg : qg;
#pragma unroll
            for (int bj = 0; bj < 2; ++bj)
#pragma unroll
                for (int n = 0; n < 2; ++n) gv[bj][n] = *(const f32x4*)(g + d0 + 32 * bj + 4 * n);
#pragma unroll
            for (int ai = 0; ai < 2; ++ai)
#pragma unroll
                for (int m = 0; m < 4; ++m) {
                    float s = 0.f;
#pragma unroll
                    for (int bj = 0; bj < 2; ++bj)
#pragma unroll
                        for (int n = 0; n < 2; ++n) { const f32x4 x = acc[ai][bj][m][n]; s += (x[0] * x[0] + x[1] * x[1]) + (x[2] * x[2] + x[3] * x[3]); }
                    s += __shfl_xor(s, 16); s += __shfl_xor(s, 32);
                    if (fq == 0) xch[wid * 128 + ai * 64 + m * 16 + fr] = s;
                    rs[ai][m] = s;
                }
            asm volatile("s_waitcnt lgkmcnt(0)" ::: "memory"); __builtin_amdgcn_s_barrier(); asm volatile("" ::: "memory");
#pragma unroll
            for (int ai = 0; ai < 2; ++ai)
#pragma unroll
                for (int m = 0; m < 4; ++m) { const float o = xch[(wid ^ 1) * 128 + ai * 64 + m * 16 + fr]; rs[ai][m] = __builtin_amdgcn_rsqf((rs[ai][m] + o) * (1.0f / 128.0f) + 1e-6f); }
        }
#pragma unroll
        for (int ai = 0; ai < 2; ++ai)
#pragma unroll
            for (int m = 0; m < 4; ++m) {
                const int rt = ai * HALF + wr * 64 + m * 16 + fr;
                f32x4 lo[2], hi[2];
#pragma unroll
                for (int n = 0; n < 2; ++n) { lo[n] = acc[ai][0][m][n] * rs[ai][m] * gv[0][n]; hi[n] = acc[ai][1][m][n] * rs[ai][m] * gv[1][n]; }
                if (dorope) {
                    const int t = t0 + rt, pos = part ? (t & 63) : (t >> 6);
#pragma unroll
                    for (int n = 0; n < 2; ++n) {
                        const f32x4 c4 = *(const f32x4*)(ropec + pos * 32 + 8 * fq + 4 * n), s4 = *(const f32x4*)(ropes + pos * 32 + 8 * fq + 4 * n);
                        const f32x4 a = lo[n], bb = hi[n];
                        lo[n] = a * c4 - bb * s4; hi[n] = bb * c4 + a * s4;
                    }
                }
                bf16_t* rowp = base + (size_t)rt * rstride + d0;
                u32x4 w0, w1;
                w0.x = cvt_pk_bf16(lo[0][0], lo[0][1]); w0.y = cvt_pk_bf16(lo[0][2], lo[0][3]); w0.z = cvt_pk_bf16(lo[1][0], lo[1][1]); w0.w = cvt_pk_bf16(lo[1][2], lo[1][3]);
                w1.x = cvt_pk_bf16(hi[0][0], hi[0][1]); w1.y = cvt_pk_bf16(hi[0][2], hi[0][3]); w1.z = cvt_pk_bf16(hi[1][0], hi[1][1]); w1.w = cvt_pk_bf16(hi[1][2], hi[1][3]);
                *(u32x4*)(rowp) = w0; *(u32x4*)(rowp + 32) = w1;
            }
    }
};

struct EpiResid {
    static constexpr bool PERM = false, AFTER_DRAIN = false;
    const float* res; const float* gate; float* out; float alpha;
    __device__ __forceinline__ void operator()(const f32x4 (&acc)[2][2][4][2], const Unit& u, int wr, int wc, int fr, int fq) const {
        const int row0 = u.pm * BM + wr * 64 + fr, col0 = u.pn * BM + wc * 32 + 4 * fq, b = u.pm >> 4;
        f32x4 gv[2][2];
#pragma unroll
        for (int bj = 0; bj < 2; ++bj)
#pragma unroll
            for (int n = 0; n < 2; ++n) gv[bj][n] = *(const f32x4*)(gate + b * 12288 + col0 + bj * HALF + n * 16);
#pragma unroll
        for (int ai = 0; ai < 2; ++ai)
#pragma unroll
            for (int m = 0; m < 4; ++m) { const size_t off = (size_t)(row0 + ai * HALF + m * 16) * 2048 + col0;
#pragma unroll
                for (int bj = 0; bj < 2; ++bj)
#pragma unroll
                    for (int n = 0; n < 2; ++n) { const f32x4 xv = *(const f32x4*)(res + off + bj * HALF + n * 16);
                        *(f32x4*)(out + off + bj * HALF + n * 16) = xv * alpha + gv[bj][n] * acc[ai][bj][m][n]; } }
    }
};


struct EpiBf16Plain {
    static constexpr bool PERM = true, AFTER_DRAIN = false;
    bf16_t* O; int ldc;
    __device__ __forceinline__ void operator()(const f32x4 (&acc)[2][2][4][2], const Unit& u, int wr, int wc, int fr, int fq) const {
        const int row0 = u.pm * BM + wr * 64 + fr, col0 = u.pn * BM + wc * 32 + 8 * fq;
#pragma unroll
        for (int ai = 0; ai < 2; ++ai)
#pragma unroll
            for (int m = 0; m < 4; ++m) { bf16_t* rowp = O + (size_t)(row0 + ai * HALF + m * 16) * ldc + col0;
#pragma unroll
                for (int bj = 0; bj < 2; ++bj) { const f32x4 v0 = acc[ai][bj][m][0], v1 = acc[ai][bj][m][1];
                    u32x4 w; w.x = cvt_pk_bf16(v0[0], v0[1]); w.y = cvt_pk_bf16(v0[2], v0[3]); w.z = cvt_pk_bf16(v1[0], v1[1]); w.w = cvt_pk_bf16(v1[2], v1[3]);
                    *(u32x4*)(rowp + bj * HALF) = w; } }
    }
};

struct EpiSwiglu {
    static constexpr bool PERM = true, AFTER_DRAIN = false;
    bf16_t* H; int ldh;
    __device__ __forceinline__ void operator()(const f32x4 (&acc)[2][2][4][2], const Unit& u, int wr, int wc, int fr, int fq) const {
        const int row0 = u.pm * BM + wr * 64 + fr, col0 = u.pn * 128 + wc * 32 + 8 * fq;
#pragma unroll
        for (int ai = 0; ai < 2; ++ai)
#pragma unroll
            for (int m = 0; m < 4; ++m) { bf16_t* rowp = H + (size_t)(row0 + ai * HALF + m * 16) * ldh + col0;
                f32x4 o[2];
#pragma unroll
                for (int n = 0; n < 2; ++n) { const f32x4 g = acc[ai][0][m][n], up = acc[ai][1][m][n];
#pragma unroll
                    for (int e = 0; e < 4; ++e) { const float sg = __builtin_amdgcn_rcpf(1.0f + __builtin_amdgcn_exp2f(-1.4426950408889634f * g[e])); o[n][e] = g[e] * sg * up[e]; } }
                u32x4 w; w.x = cvt_pk_bf16(o[0][0], o[0][1]); w.y = cvt_pk_bf16(o[0][2], o[0][3]); w.z = cvt_pk_bf16(o[1][0], o[1][1]); w.w = cvt_pk_bf16(o[1][2], o[1][3]);
                *(u32x4*)rowp = w; }
    }
};

template <class Epi, class Sched, bool ALIGN_EPI = false, bool SP2 = false>
__device__ __forceinline__ void gemm_phase(PG8_LAS unsigned char* lds, const Gemm g, const Sched& S, const Epi& E) {
    const int tid = threadIdx.x, wid = __builtin_amdgcn_readfirstlane(tid >> 6), lane = tid & 63, wr = wid >> 2, wc = wid & 3, fr = lane & 15, fq = lane >> 4;
    const int K = g.K, nt = K / BK;
    unsigned voffA[2], voffB[2];
#pragma unroll
    for (int i = 0; i < 2; ++i) { int R, C; stage_rc(tid * 16 + i * 8192, R, C); const int Rb = Epi::PERM ? ((R & ~31) + perm32(R & 31)) : R;
        voffA[i] = (unsigned)(R * K + C) * 2u; voffB[i] = (unsigned)(Rb * K + C) * 2u; }
    const size_t kstep = (size_t)(BK * 2);
    const size_t hstep = (size_t)HALF * K * 2;
    const size_t tstep = 2 * hstep;
    const unsigned ldsw = (unsigned)wid * 1024u;
    const int aoff = lds_byte(wr * 64 + fr, fq * 8), boff = lds_byte(wc * 32 + fr, fq * 8);
#define PG8_SA(b, h) (((b) * 2 + (h)) * HTB)
#define PG8_SB(b, h) ((4 + (b) * 2 + (h)) * HTB)
#define PG8_STAGE(bufoff, gbase, voff) do { _Pragma("unroll") for (int _i = 0; _i < 2; ++_i) \
        __builtin_amdgcn_global_load_lds((const unsigned*)((const char*)(gbase) + (voff)[_i]), (PG8_LAS unsigned*)(lds + (bufoff) + ldsw + _i * 8192), 16, 0, 0); } while (0)
#define PG8_LDA(dst, b, h) do { _Pragma("unroll") for (int m = 0; m < 4; ++m) _Pragma("unroll") for (int k = 0; k < 2; ++k) dst[m][k] = *(const PG8_LAS bf16x8*)(lds + PG8_SA(b, h) + aoff + m * 2048 + k * 1024); } while (0)
#define PG8_LDB(dst, b, h) do { _Pragma("unroll") for (int n = 0; n < 2; ++n) _Pragma("unroll") for (int k = 0; k < 2; ++k) dst[n][k] = *(const PG8_LAS bf16x8*)(lds + PG8_SB(b, h) + boff + n * 2048 + k * 1024); } while (0)
#define PG8_MMA(ai, bj, At, Bt) do { __builtin_amdgcn_s_setprio(1); _Pragma("unroll") for (int m = 0; m < 4; ++m) _Pragma("unroll") for (int n = 0; n < 2; ++n) _Pragma("unroll") for (int k = 0; k < 2; ++k) \
        acc[ai][bj][m][n] = __builtin_amdgcn_mfma_f32_16x16x32_bf16(Bt[n][k], At[m][k], acc[ai][bj][m][n], 0, 0, 0); __builtin_amdgcn_s_setprio(0); } while (0)
#define PG8_WAIT_V(n) asm volatile("s_waitcnt vmcnt(" #n ")" ::: "memory")
#define PG8_WAIT_L(n) asm volatile("s_waitcnt lgkmcnt(" #n ")" ::: "memory")
#define PG8_BAR __builtin_amdgcn_s_barrier()
#define PG8_SCHED __builtin_amdgcn_sched_barrier(0)
    Unit cur, nxt; int ui = 0;
    if (!S.next(0, cur)) return;
    f32x4 acc[2][2][4][2];
#pragma unroll
    for (int a = 0; a < 2; ++a)
#pragma unroll
        for (int b = 0; b < 2; ++b)
#pragma unroll
            for (int m = 0; m < 4; ++m)
#pragma unroll
                for (int n = 0; n < 2; ++n) acc[a][b][m][n] = (f32x4){0.f, 0.f, 0.f, 0.f};
    bf16x8 At[4][2], B0[2][2], B1[2][2];
    const char* cA = (const char*)g.A + (size_t)cur.pm * tstep; const char* cB = (const char*)g.Bt + (size_t)cur.pn * tstep;
    S.a_ready(cur);
    if constexpr (SP2) {
        PG8_STAGE(PG8_SB(0, 0), cB, voffB); PG8_STAGE(PG8_SB(0, 1), cB + hstep, voffB); PG8_STAGE(PG8_SA(0, 0), cA, voffA); PG8_STAGE(PG8_SA(0, 1), cA + hstep, voffA);
        if (wr == 1) PG8_BAR;
        PG8_WAIT_V(2); PG8_BAR;
        PG8_STAGE(PG8_SB(1, 0), cB + kstep, voffB); PG8_STAGE(PG8_SA(1, 0), cA + kstep, voffA); PG8_STAGE(PG8_SB(1, 1), cB + hstep + kstep, voffB);
        PG8_WAIT_V(6); PG8_BAR;
    } else {
        PG8_STAGE(PG8_SB(0, 0), cB, voffB); PG8_STAGE(PG8_SA(0, 0), cA, voffA); PG8_STAGE(PG8_SB(0, 1), cB + hstep, voffB); PG8_STAGE(PG8_SA(0, 1), cA + hstep, voffA);
        if (wr == 1) PG8_BAR;
        PG8_WAIT_V(4); PG8_BAR;
        PG8_STAGE(PG8_SB(1, 0), cB + kstep, voffB); PG8_STAGE(PG8_SA(1, 0), cA + kstep, voffA); PG8_STAGE(PG8_SB(1, 1), cB + hstep + kstep, voffB);
        PG8_WAIT_V(6); PG8_BAR;
    }
    for (;;) {
        const bool has_next = S.next(ui + 1, nxt);
        const char* nA = has_next ? (const char*)g.A + (size_t)nxt.pm * tstep : cA; const char* nB = has_next ? (const char*)g.Bt + (size_t)nxt.pn * tstep : cB;
        for (int t = 0; t < nt; t += 2) {
            const bool last = (t == nt - 2);
            const char* a1 = cA + (size_t)(t + 1) * kstep;
            const char* a2 = last ? nA : cA + (size_t)(t + 2) * kstep; const char* b2 = last ? nB : cB + (size_t)(t + 2) * kstep;
            const char* a3 = a2 + kstep; const char* b3 = b2 + kstep;
            if (last && has_next) S.a_ready(nxt);
            if constexpr (SP2) {
            PG8_LDB(B0, 0, 0); PG8_LDB(B1, 0, 1); PG8_SCHED; PG8_LDA(At, 0, 0); PG8_STAGE(PG8_SA(1, 1), a1 + hstep, voffA);
            PG8_WAIT_V(8); PG8_WAIT_L(0); PG8_BAR; PG8_MMA(0, 0, At, B0); PG8_MMA(0, 1, At, B1); PG8_BAR; PG8_SCHED;
            PG8_LDA(At, 0, 1); PG8_STAGE(PG8_SB(0, 0), b2, voffB); PG8_STAGE(PG8_SB(0, 1), b2 + hstep, voffB); PG8_STAGE(PG8_SA(0, 0), a2, voffA);
            PG8_WAIT_V(8); PG8_WAIT_L(0); PG8_BAR; PG8_MMA(1, 0, At, B0); PG8_MMA(1, 1, At, B1); PG8_BAR; PG8_SCHED;
            PG8_LDB(B0, 1, 0); PG8_LDB(B1, 1, 1); PG8_SCHED; PG8_LDA(At, 1, 0); PG8_STAGE(PG8_SA(0, 1), a2 + hstep, voffA);
            PG8_WAIT_V(8); PG8_WAIT_L(0); PG8_BAR; PG8_MMA(0, 0, At, B0); PG8_MMA(0, 1, At, B1); PG8_BAR; PG8_SCHED;
            PG8_LDA(At, 1, 1); PG8_STAGE(PG8_SB(1, 0), b3, voffB); PG8_STAGE(PG8_SB(1, 1), b3 + hstep, voffB); PG8_STAGE(PG8_SA(1, 0), a3, voffA);
            PG8_WAIT_V(8); PG8_WAIT_L(0); PG8_BAR; PG8_MMA(1, 0, At, B0); PG8_MMA(1, 1, At, B1); PG8_BAR; PG8_SCHED;
            } else {
            PG8_LDB(B0, 0, 0); PG8_SCHED; PG8_LDA(At, 0, 0); PG8_STAGE(PG8_SA(1, 1), a1 + hstep, voffA);
            PG8_WAIT_L(8); PG8_BAR; PG8_WAIT_L(0); PG8_MMA(0, 0, At, B0); PG8_BAR; PG8_SCHED;
            PG8_LDB(B1, 0, 1); PG8_STAGE(PG8_SB(0, 0), b2, voffB);
            PG8_BAR; PG8_WAIT_L(0); PG8_MMA(0, 1, At, B1); PG8_BAR;
            PG8_LDA(At, 0, 1); PG8_STAGE(PG8_SA(0, 0), a2, voffA);
            PG8_BAR; PG8_WAIT_L(0); PG8_MMA(1, 0, At, B0); PG8_BAR; PG8_SCHED;
            PG8_STAGE(PG8_SB(0, 1), b2 + hstep, voffB);
            PG8_WAIT_V(6); PG8_BAR; PG8_MMA(1, 1, At, B1); PG8_BAR;
            PG8_LDB(B0, 1, 0); PG8_SCHED; PG8_LDA(At, 1, 0); PG8_STAGE(PG8_SA(0, 1), a2 + hstep, voffA);
            PG8_WAIT_L(8); PG8_BAR; PG8_WAIT_L(0); PG8_MMA(0, 0, At, B0); PG8_BAR; PG8_SCHED;
            PG8_LDB(B1, 1, 1); PG8_STAGE(PG8_SB(1, 0), b3, voffB);
            PG8_BAR; PG8_WAIT_L(0); PG8_MMA(0, 1, At, B1); PG8_BAR;
            PG8_LDA(At, 1, 1); PG8_STAGE(PG8_SA(1, 0), a3, voffA);
            PG8_BAR; PG8_WAIT_L(0); PG8_MMA(1, 0, At, B0); PG8_BAR; PG8_SCHED;
            PG8_STAGE(PG8_SB(1, 1), b3 + hstep, voffB);
            PG8_WAIT_V(6); PG8_BAR; PG8_MMA(1, 1, At, B1); PG8_BAR;
            }
        }
        if constexpr (ALIGN_EPI) { if (wr == 0) PG8_BAR; }
        if constexpr (!Epi::AFTER_DRAIN) { E(acc, cur, wr, wc, fr, fq); S.done(cur); }
        if (!has_next) break;
#pragma unroll
        for (int a = 0; a < 2; ++a)
#pragma unroll
            for (int b = 0; b < 2; ++b)
#pragma unroll
                for (int m = 0; m < 4; ++m)
#pragma unroll
                    for (int n = 0; n < 2; ++n) acc[a][b][m][n] = (f32x4){0.f, 0.f, 0.f, 0.f};
        cur = nxt; cA = nA; cB = nB; ++ui;
        if constexpr (ALIGN_EPI) { if (wr == 1) PG8_BAR; }
    }
    PG8_WAIT_V(0);
    if constexpr (!ALIGN_EPI) { if (wr == 0) PG8_BAR; }
    PG8_BAR;
#undef PG8_SA
#undef PG8_SB
#undef PG8_STAGE
#undef PG8_LDA
#undef PG8_LDB
#undef PG8_MMA
#undef PG8_WAIT_V
#undef PG8_WAIT_L
#undef PG8_BAR
#undef PG8_SCHED
}
}

namespace att {
typedef unsigned short bf16;
using bf16x8 = __attribute__((ext_vector_type(8))) short;
using s16x4  = __attribute__((ext_vector_type(4))) short;
using f32x16 = __attribute__((ext_vector_type(16))) float;
using u32x4  = __attribute__((ext_vector_type(4))) unsigned;
constexpr int D = 128, NW = 8, QBLK = 32, KVBLK = 64;
constexpr float SCALE = 0.088388347648318440f;
constexpr float THR = 8.f;
constexpr int LDQ = 2048, LDK = 128, LDO = 2048;
constexpr int SHM_V = KVBLK * D * 2, SHM_K = KVBLK * D * 2, SHM_ATTN = 2 * SHM_V + 2 * SHM_K + NW * 64 * 4;
#define KSWZ(row, colB) ((row) * 256 + ((colB) ^ (((row) & 7) << 4)))
#define SBAR() __builtin_amdgcn_sched_barrier(0)
__device__ __forceinline__ int crow(int r, int hi) { return (r & 3) + 8 * (r >> 2) + 4 * hi; }
__device__ __forceinline__ unsigned cvtpk(float lo, float hi) { unsigned r; asm volatile("v_cvt_pk_bf16_f32 %0, %1, %2" : "=v"(r) : "v"(lo), "v"(hi)); return r; }

__device__ __forceinline__ void partialSM(f32x16& p0, f32x16& p1, float& m_reg, float& mn, float& alpha, bool fixedm) {
  constexpr float C = SCALE * 1.4426950408889634f;
  if (fixedm) { mn = m_reg; alpha = 1.f; }
  else {
  float pmax = p0[0]; for (int r = 1; r < 16; ++r) pmax = fmaxf(pmax, p0[r]); for (int r = 0; r < 16; ++r) pmax = fmaxf(pmax, p1[r]);
  { auto rr = __builtin_amdgcn_permlane32_swap(__float_as_uint(pmax), __float_as_uint(pmax), false, false);
    pmax = fmaxf(__uint_as_float(rr[0]), __uint_as_float(rr[1])); }
  if (__builtin_expect(__all(pmax - m_reg <= THR / SCALE), 1)) { mn = m_reg; alpha = 1.f; }
  else { mn = fmaxf(m_reg, pmax); alpha = __builtin_amdgcn_exp2f((m_reg - mn) * C); m_reg = mn; }
  }
  float mnC = -mn * C;
  for (int r = 0; r < 16; ++r) p0[r] = fmaf(p0[r], C, mnC); for (int r = 0; r < 16; ++r) p1[r] = fmaf(p1[r], C, mnC);
  for (int r = 0; r < 16; ++r) p0[r] = __builtin_amdgcn_exp2f(p0[r]);
}
__device__ __forceinline__ void finishSM(f32x16& p0, f32x16& p1, float alpha, float& l_reg, bf16x8& pa0, bf16x8& pa1, bf16x8& pa2, bf16x8& pa3) {
  for (int r = 0; r < 16; ++r) p1[r] = __builtin_amdgcn_exp2f(p1[r]);
  float ps = 0; for (int r = 0; r < 16; ++r) ps += p0[r]; for (int r = 0; r < 16; ++r) ps += p1[r];
  { auto rr = __builtin_amdgcn_permlane32_swap(__float_as_uint(ps), __float_as_uint(ps), false, false);
    ps = __uint_as_float(rr[0]) + __uint_as_float(rr[1]); }
  l_reg = l_reg * alpha + ps;
#define PK4(P, BASE, OUT) do { unsigned a0 = cvtpk(P[BASE + 0], P[BASE + 1]), a1 = cvtpk(P[BASE + 2], P[BASE + 3]);   \
    unsigned b0 = cvtpk(P[BASE + 4], P[BASE + 5]), b1 = cvtpk(P[BASE + 6], P[BASE + 7]);                              \
    auto r0 = __builtin_amdgcn_permlane32_swap(a0, b0, false, false); auto r1 = __builtin_amdgcn_permlane32_swap(a1, b1, false, false); \
    u32x4 w = {r0[0], r1[0], r0[1], r1[1]}; OUT = *reinterpret_cast<bf16x8*>(&w); } while (0)
  PK4(p0, 0, pa0); PK4(p0, 8, pa1); PK4(p1, 0, pa2); PK4(p1, 8, pa3);
#undef PK4
}
__device__ __forceinline__ void qkt(f32x16& p0, f32x16& p1, const bf16* Ks, const bf16x8* qr, int r32, int hi) {
  p0 = f32x16{}; p1 = f32x16{};
  for (int d0 = 0; d0 < 8; ++d0) { int cb = (d0 * 16 + hi * 8) * 2;
    bf16x8 b0 = *reinterpret_cast<const bf16x8*>((const char*)Ks + KSWZ(r32, cb));
    bf16x8 b1 = *reinterpret_cast<const bf16x8*>((const char*)Ks + KSWZ(32 + r32, cb));
    p0 = __builtin_amdgcn_mfma_f32_32x32x16_bf16(b0, qr[d0], p0, 0, 0, 0);
    p1 = __builtin_amdgcn_mfma_f32_32x32x16_bf16(b1, qr[d0], p1, 0, 0, 0); }
}
__device__ __forceinline__ void wmask(f32x16& p0, f32x16& p1, int kb, int qpos) {
  const int dq = qpos - kb + 128;
#pragma unroll
  for (int r = 0; r < 16; ++r) { const int d = dq - ((r & 3) + 8 * (r >> 2));
    if ((unsigned)d > 256u) p0[r] = -INFINITY;
    if ((unsigned)(d - 32) > 256u) p1[r] = -INFINITY; }
}
__device__ __forceinline__ int v_st(int k, int c) { const int kk = (k & ~0xC) | ((k & 4) << 1) | ((k & 8) >> 1); return ((kk >> 3) * 4 + (c >> 5)) * 512 + ((kk & 7) * 32 + (c & 31)) * 2; }
__device__ __forceinline__ int v_rd_base(int lane) { return ((lane & 3) << 3) | (((lane >> 2) & 3) << 6) | (((lane >> 4) & 1) << 5) | (((lane >> 5) & 1) << 8); }
constexpr int v_rd_off(int d0, int ks, int half) { return d0 * 512 + ks * 4096 + half * 2048; }
template <int OFF> __device__ __forceinline__ s16x4 tr_read(int vb) {
  s16x4 r; asm volatile("ds_read_b64_tr_b16 %0, %1 offset:%2" : "=&v"(r) : "v"(vb), "i"(OFF) : "memory"); return r;
}
template <int D0> __device__ __forceinline__ void pv_one(f32x16& od, int vb, bf16x8 pa0, bf16x8 pa1, bf16x8 pa2, bf16x8 pa3) {
  const s16x4 l0 = tr_read<v_rd_off(D0, 0, 0)>(vb), h0 = tr_read<v_rd_off(D0, 0, 1)>(vb), l1 = tr_read<v_rd_off(D0, 1, 0)>(vb), h1 = tr_read<v_rd_off(D0, 1, 1)>(vb);
  const s16x4 l2 = tr_read<v_rd_off(D0, 2, 0)>(vb), h2 = tr_read<v_rd_off(D0, 2, 1)>(vb), l3 = tr_read<v_rd_off(D0, 3, 0)>(vb), h3 = tr_read<v_rd_off(D0, 3, 1)>(vb);
  asm volatile("s_waitcnt lgkmcnt(0)" ::: "memory"); SBAR();
#define PK(L, H) (bf16x8){L[0], L[1], L[2], L[3], H[0], H[1], H[2], H[3]}
  od = __builtin_amdgcn_mfma_f32_32x32x16_bf16(pa0, PK(l0, h0), od, 0, 0, 0);
  od = __builtin_amdgcn_mfma_f32_32x32x16_bf16(pa1, PK(l1, h1), od, 0, 0, 0);
  od = __builtin_amdgcn_mfma_f32_32x32x16_bf16(pa2, PK(l2, h2), od, 0, 0, 0);
  od = __builtin_amdgcn_mfma_f32_32x32x16_bf16(pa3, PK(l3, h3), od, 0, 0, 0);
#undef PK
}
__device__ __forceinline__ void pv_d0(f32x16* o, int vb, bf16x8 pa0, bf16x8 pa1, bf16x8 pa2, bf16x8 pa3) {
  pv_one<0>(o[0], vb, pa0, pa1, pa2, pa3); pv_one<1>(o[1], vb, pa0, pa1, pa2, pa3); pv_one<2>(o[2], vb, pa0, pa1, pa2, pa3); pv_one<3>(o[3], vb, pa0, pa1, pa2, pa3);
}

__device__ __forceinline__ void attn_unit(const bf16* __restrict__ Qb, const bf16* __restrict__ Kh, const bf16* __restrict__ Vh, bf16* Ob,
                                          int NT, int nctx, int jlo, int q0, bool masked, float sinkl2, float kbound, char* lds) {
  const int tid = threadIdx.x, wid = tid >> 6, lane = tid & 63, r32 = lane & 31, hi = lane >> 5;
  bf16* V_lds = (bf16*)lds; bf16* K_lds = (bf16*)(lds + 2 * SHM_V);
  float* ws = (float*)(lds + 2 * SHM_V + 2 * SHM_K) + wid * 64; float* li_l = ws; float* al_l = ws + 32;
  float m_reg = -1e30f, l_reg = 0; f32x16 o[4] = {}; bf16x8 qr[8];
  const bf16* Qw = Qb + (long)(wid * QBLK + r32) * LDQ + hi * 8;
#pragma unroll
  for (int d0 = 0; d0 < 8; ++d0) qr[d0] = *reinterpret_cast<const bf16x8*>(Qw + d0 * 16);
  const bool fixedm = kbound > 0.f;
  if (fixedm) { float ss = 0.f;
#pragma unroll
    for (int d0 = 0; d0 < 8; ++d0)
#pragma unroll
      for (int e = 0; e < 8; ++e) { const float qv = __uint_as_float(((unsigned)(unsigned short)qr[d0][e]) << 16); ss += qv * qv; }
    { auto rr = __builtin_amdgcn_permlane32_swap(__float_as_uint(ss), __float_as_uint(ss), false, false); ss = __uint_as_float(rr[0]) + __uint_as_float(rr[1]); }
    m_reg = sqrtf(ss) * kbound; }
  const int sr = tid >> 4, sc = (tid & 15) * 8, vst0 = v_st(sr, sc), vst1 = v_st(32 + sr, sc);
  const int vb0 = (int)(uintptr_t)V_lds + v_rd_base(lane);
  const int qpos = q0 + wid * QBLK + r32;
  struct { bf16x8 vs0, vs1, ks0, ks1; } sr_[2];
#define KOF(t) (((t) < nctx) ? (4096 + 64 * (t)) : 64 * (jlo + (t) - nctx))
#define SLOAD(i, k0) do { const int k0_ = (k0); sr_[i].vs0 = *reinterpret_cast<const bf16x8*>(&Vh[(long)(k0_ + sr) * LDK + sc]); sr_[i].vs1 = *reinterpret_cast<const bf16x8*>(&Vh[(long)(k0_ + 32 + sr) * LDK + sc]); \
    sr_[i].ks0 = *reinterpret_cast<const bf16x8*>(&Kh[(long)(k0_ + sr) * LDK + sc]); sr_[i].ks1 = *reinterpret_cast<const bf16x8*>(&Kh[(long)(k0_ + 32 + sr) * LDK + sc]); } while (0)
#define SWRITE(b, i) do { *(bf16x8*)((char*)V_lds + (b) * SHM_V + vst0) = sr_[i].vs0;          \
    *(bf16x8*)((char*)V_lds + (b) * SHM_V + vst1) = sr_[i].vs1; int kc = sc * 2;               \
    *(bf16x8*)((char*)K_lds + (b) * SHM_K + KSWZ(sr, kc)) = sr_[i].ks0;                       \
    *(bf16x8*)((char*)K_lds + (b) * SHM_K + KSWZ(32 + sr, kc)) = sr_[i].ks1; } while (0)
#define SWAIT() asm volatile("s_waitcnt vmcnt(4)" ::: "memory")
#define RESC(a) do { if (__any((a) < 1.f)) { if (hi == 0) al_l[r32] = (a); asm volatile("s_waitcnt lgkmcnt(0)" ::: "memory"); \
    for (int d = 0; d < 4; ++d) for (int r = 0; r < 16; ++r) o[d][r] *= al_l[crow(r, hi)]; } } while (0)
#define MASK(P0, P1, t) do { if (masked && (t) >= nctx) wmask(P0, P1, KOF(t) + 4 * hi, qpos); } while (0)
  f32x16 pA0, pA1, pB0, pB1; float mnA, mnB, alA, alB; bf16x8 pa0, pa1, pa2, pa3;
  constexpr int SE = 0, SO = 1;
  SLOAD(SE, KOF(0)); asm volatile("s_waitcnt vmcnt(0)" ::: "memory"); SWRITE(0, SE); __syncthreads();
  qkt(pA0, pA1, K_lds, qr, r32, hi); MASK(pA0, pA1, 0); partialSM(pA0, pA1, m_reg, mnA, alA, fixedm);
  SLOAD(SO, KOF(1)); if (2 < NT) SLOAD(SE, KOF(2));
  SWAIT(); SWRITE(1, SO); __syncthreads();
  for (int j = 1; j + 1 < NT; j += 2) {
    SBAR(); qkt(pB0, pB1, (bf16*)((char*)K_lds + SHM_K), qr, r32, hi);
    finishSM(pA0, pA1, alA, l_reg, pa0, pa1, pa2, pa3); SBAR();
    SLOAD(SO, KOF(j + 2)); SBAR();
    pv_d0(o, vb0, pa0, pa1, pa2, pa3); MASK(pB0, pB1, j); partialSM(pB0, pB1, m_reg, mnB, alB, fixedm);
    __syncthreads(); SWAIT(); SWRITE(0, SE);
    RESC(alB); __syncthreads();
    SBAR(); qkt(pA0, pA1, K_lds, qr, r32, hi);
    finishSM(pB0, pB1, alB, l_reg, pa0, pa1, pa2, pa3); SBAR();
    if (j + 3 < NT) SLOAD(SE, KOF(j + 3)); SBAR();
    pv_d0(o, vb0 + (int)SHM_V, pa0, pa1, pa2, pa3); MASK(pA0, pA1, j + 1); partialSM(pA0, pA1, m_reg, mnA, alA, fixedm);
    __syncthreads(); SWAIT(); SWRITE(1, SO);
    RESC(alA); __syncthreads();
  }
  SBAR(); qkt(pB0, pB1, (bf16*)((char*)K_lds + SHM_K), qr, r32, hi);
  finishSM(pA0, pA1, alA, l_reg, pa0, pa1, pa2, pa3); SBAR();
  pv_d0(o, vb0, pa0, pa1, pa2, pa3); MASK(pB0, pB1, NT - 1); partialSM(pB0, pB1, m_reg, mnB, alB, fixedm);
  __syncthreads(); RESC(alB);
  finishSM(pB0, pB1, alB, l_reg, pa0, pa1, pa2, pa3); SBAR();
  pv_d0(o, vb0 + (int)SHM_V, pa0, pa1, pa2, pa3);
  l_reg += __builtin_amdgcn_exp2f(sinkl2 - m_reg * (SCALE * 1.4426950408889634f));
  if (hi == 0) li_l[r32] = l_reg; asm volatile("s_waitcnt lgkmcnt(0)" ::: "memory");
  float rli[16];
#pragma unroll
  for (int r = 0; r < 16; ++r) rli[r] = __builtin_amdgcn_rcpf(li_l[crow(r, hi)]);
  __syncthreads();
  { char* stg = lds + wid * 8192 + (4 * hi * 128 + r32) * 2;
#pragma unroll
    for (int r = 0; r < 16; ++r) {
#pragma unroll
      for (int d0 = 0; d0 < 4; ++d0) { const float v = o[d0][r] * rli[r]; *(bf16*)(stg + ((r & 3) + 8 * (r >> 2)) * 256 + d0 * 64) = (bf16)(cvtpk(v, v) & 0xffffu); }
      asm volatile("" ::: "memory"); }
    asm volatile("s_waitcnt lgkmcnt(0)" ::: "memory");
    bf16* Ow = Ob + (long)(wid * QBLK + (lane >> 4)) * LDO + (lane & 15) * 8;
    const char* rd = lds + wid * 8192 + (lane >> 4) * 256 + (lane & 15) * 16;
#pragma unroll
    for (int i = 0; i < 8; ++i) { const u32x4 v = *(const u32x4*)(rd + i * 1024); *(u32x4*)(Ow + (long)i * 4 * LDO) = v; } }
  __syncthreads();
#undef KOF
#undef SLOAD
#undef SWRITE
#undef SWAIT
#undef RESC
#undef MASK
}
#undef KSWZ
#undef SBAR
}

constexpr int NWAVES = 8;
constexpr int N_LAUNCHES = MK_N_LAUNCHES;
constexpr int N_PHASES = 10;
constexpr int DM = 2048, NB = 4, SEQ = 4096, CTXL = 256, FFN = 5632, INW = 3072, NMOD = 12288;
constexpr int M = NB * SEQ, MC = NB * CTXL, MU = M + MC;
constexpr int SKV = SEQ + CTXL;
constexpr float LN_EPS = 1e-6f;
constexpr float DN_ALPHA = 1.189207115002721f;

constexpr size_t MiB = 1u << 20;
constexpr size_t WS_CTL = 0, CTL_ZERO_BYTES = 64 * 1024;
constexpr size_t WS_MODP = 1 * MiB;
constexpr size_t WS_MODS = 2 * MiB;
constexpr size_t WS_ROPE = 2 * MiB + 512 * 1024;
constexpr size_t WS_WIN = 3 * MiB, WS_WOUT = 15 * MiB, WS_WGU = 23 * MiB, WS_WDN = 67 * MiB;
constexpr size_t WS_U = 89 * MiB;
constexpr size_t WS_Y = 157 * MiB;
constexpr size_t WS_QO = 285 * MiB;
constexpr size_t WS_KV = 349 * MiB;
constexpr size_t KV_BYTES = (size_t)NB * 2 * SKV * 128 * 2;
constexpr size_t WS_H = 285 * MiB;
constexpr size_t WS_END = 461 * MiB;
static_assert(WS_WIN + (size_t)INW * DM * 2 <= WS_WOUT && WS_WOUT + (size_t)DM * DM * 2 <= WS_WGU && WS_WGU + (size_t)2 * FFN * DM * 2 <= WS_WDN && WS_WDN + (size_t)DM * FFN * 2 <= WS_U, "ws map (weights)");
static_assert(WS_U + (size_t)MU * DM * 2 <= WS_Y && WS_Y + (size_t)M * DM * 4 <= WS_QO && WS_QO + (size_t)M * DM * 2 <= WS_KV && WS_KV + 4 * KV_BYTES <= WS_END && WS_H + (size_t)M * FFN * 2 <= WS_END, "ws map");
constexpr int CW_BAR = 4096;

constexpr int RING_OFF = 0, RING_BYTES = 131072;
constexpr int LDSCTL_OFF = RING_BYTES, MISC_OFF = LDSCTL_OFF + 320;
constexpr int XCH_OFF = RING_BYTES + 1024;
constexpr int LDS_BYTES = 147456;
static_assert(XCH_OFF + 4096 <= LDS_BYTES, "LDS map");

#define GAS __attribute__((address_space(1)))
#define LAS __attribute__((address_space(3)))
typedef unsigned short bf16;
typedef unsigned v4u __attribute__((ext_vector_type(4)));
typedef float f32x4 __attribute__((ext_vector_type(4)));
typedef GAS unsigned gu32;
#define RLX_AGENT __ATOMIC_RELAXED, __HIP_MEMORY_SCOPE_AGENT
#define LDS_WAIT() asm volatile("s_waitcnt lgkmcnt(0)" ::: "memory")
#define VM_WAIT() asm volatile("s_waitcnt vmcnt(0)" ::: "memory")
__device__ __forceinline__ unsigned f2bf(float f) { unsigned u = __builtin_bit_cast(unsigned, f); return (u + 0x7fffu + ((u >> 16) & 1u)) >> 16; }
__device__ __forceinline__ unsigned pk2(float lo, float hi) { return f2bf(lo) | (f2bf(hi) << 16); }

#define XB_TMO      128
#define XB_XCNT(j)  (256  + 64 * (j))
#define XB_XSUB(j)  (1280 + 64 * (j))
#define XB_XGEN(j)  (2304 + 64 * (j))
#define XB_TOP      3328
#define XB_TOPGEN   3392
#define XCD_BAR_WORDS 3456
#define XB_SPIN_CAP (1u << 18)
__device__ __forceinline__ unsigned xb_ld(unsigned* p)              { return __hip_atomic_load(p, __ATOMIC_RELAXED, __HIP_MEMORY_SCOPE_AGENT); }
__device__ __forceinline__ unsigned xb_add(unsigned* p, unsigned v) { return __hip_atomic_fetch_add(p, v, __ATOMIC_RELAXED, __HIP_MEMORY_SCOPE_AGENT); }
__device__ __forceinline__ unsigned xb_xcc_id() { return (unsigned)__builtin_amdgcn_s_getreg((3 << 11) | 20) & 0xFu; }
#define XB_SPIN(cond, bar) do { unsigned _sp = 0; while (cond) { __builtin_amdgcn_s_sleep(1); \
    if ((++_sp & 255u) == 0u) { if (xb_ld(&(bar)[XB_TMO])) break; if (_sp > XB_SPIN_CAP) { atomicAdd(&(bar)[XB_TMO], 1u); break; } } } } while (0)
struct XcdBarrier { unsigned* bar; unsigned x; volatile LAS unsigned* st; };
__device__ __forceinline__ XcdBarrier xcd_barrier_post(unsigned* bar, volatile LAS unsigned* st) {
    XcdBarrier b; b.bar = bar; b.x = xb_xcc_id(); b.st = st;
    if (threadIdx.x == 0) (void)xb_add(&bar[XB_XCNT(b.x)], 1u);
    return b;
}
__device__ __forceinline__ void xcd_barrier_complete(unsigned* bar, unsigned x, unsigned& nloc, unsigned& nx) {
    const unsigned G = gridDim.x * gridDim.y * gridDim.z;
    unsigned sum, cnt, mine, sp = 0u;
    for (;;) {
        sum = 0u; cnt = 0u; mine = 0u;
#pragma unroll
        for (unsigned j = 0; j < 16; ++j) { const unsigned c = xb_ld(&bar[XB_XCNT(j)]); sum += c; cnt += (c > 0u) ? 1u : 0u; mine = (j == x) ? c : mine; }
        if (sum == G) break;
        __builtin_amdgcn_s_sleep(1);
        if ((++sp & 255u) == 0u) { if (xb_ld(&bar[XB_TMO])) break; if (sp > XB_SPIN_CAP) { atomicAdd(&bar[XB_TMO], 1u); break; } }
    }
    nloc = mine > 0u ? mine : 1u; nx = cnt > 0u ? cnt : 1u;
}
__device__ __forceinline__ void xcd_barrier(const XcdBarrier& b) {
    asm volatile("s_waitcnt vmcnt(0)" ::: "memory");
    __syncthreads();
    if (threadIdx.x == 0) {
        unsigned* bar = b.bar;
        __builtin_amdgcn_s_waitcnt(0);
        unsigned nloc = b.st[0], nx = b.st[1];
        if (nloc == 0u) { xcd_barrier_complete(bar, b.x, nloc, nx); b.st[0] = nloc; b.st[1] = nx; }
        const unsigned old = xb_add(&bar[XB_XSUB(b.x)], 1u);
        const unsigned gen = old / nloc;
        if (old + 1u == (gen + 1u) * nloc) {
            __builtin_amdgcn_fence(__ATOMIC_RELEASE, "agent");
            asm volatile("s_waitcnt vmcnt(0)" ::: "memory");
            const unsigned og = xb_add(&bar[XB_TOP], 1u);
            const unsigned tg = og / nx;
            if (og + 1u == (tg + 1u) * nx) xb_add(&bar[XB_TOPGEN], 1u);
            else XB_SPIN(xb_ld(&bar[XB_TOPGEN]) == tg, bar);
            __builtin_amdgcn_fence(__ATOMIC_ACQUIRE, "agent");
            xb_add(&bar[XB_XGEN(b.x)], 1u);
            asm volatile("s_waitcnt vmcnt(0)" ::: "memory");
        } else {
            XB_SPIN(xb_ld(&bar[XB_XGEN(b.x)]) == gen, bar);
            __builtin_amdgcn_fence(__ATOMIC_ACQUIRE, "agent");
            asm volatile("s_waitcnt vmcnt(0)" ::: "memory");
        }
    }
    __syncthreads();
}

__device__ __forceinline__ float wave_sum(float v) {
#pragma unroll
    for (int o = 1; o < 64; o <<= 1) v += __shfl_xor(v, o);
    return v;
}
__device__ __forceinline__ void transpose_item(const float* W, int ldw, int k0, int n0, bf16* WT, int Kd, int dst_row0, LAS float* scr, int lane) {
#pragma unroll 8
    for (int i = 0; i < 32; ++i) { const int kk = 2 * i + (lane >> 5); scr[kk * 33 + (lane & 31)] = W[(size_t)(k0 + kk) * ldw + n0 + (lane & 31)]; }
    LDS_WAIT(); asm volatile("" ::: "memory");
    const int c = lane & 7;
#pragma unroll
    for (int j = 0; j < 4; ++j) { const int n = (lane >> 3) + 8 * j; const LAS float* s = scr + (8 * c) * 33 + n;
        v4u o; o.x = pk2(s[0 * 33], s[1 * 33]); o.y = pk2(s[2 * 33], s[3 * 33]); o.z = pk2(s[4 * 33], s[5 * 33]); o.w = pk2(s[6 * 33], s[7 * 33]);
        *(GAS v4u*)(WT + (size_t)(dst_row0 + n) * Kd + k0 + 8 * c) = o; }
    LDS_WAIT(); asm volatile("" ::: "memory");
}
__device__ __forceinline__ float silu_f(float x) { return x / (1.0f + __expf(-x)); }

struct Args { const float* in[18]; float* out; unsigned char* ws; int ph_lo, ph_hi, li, flags; };

__device__ __forceinline__ void modulate_row(const float* xrow, bf16* orow, const LAS float* p0, const LAS float* p1, int lane) {
    const GAS f32x4* xr = (const GAS f32x4*)xrow + lane;
    GAS unsigned long long* o8 = (GAS unsigned long long*)orow + lane;
    f32x4 v[8];
#pragma unroll
    for (int j = 0; j < 8; ++j) v[j] = xr[64 * j];
#pragma unroll
    for (int j = 0; j < 8; ++j) { const f32x4 a = *(const LAS f32x4*)(p0 + 256 * j + 4 * lane), s = *(const LAS f32x4*)(p1 + 256 * j + 4 * lane); const f32x4 r = v[j] * a + s;
        o8[64 * j] = (unsigned long long)pk2(r.x, r.y) | ((unsigned long long)pk2(r.z, r.w) << 32); }
}
typedef unsigned u32x2 __attribute__((ext_vector_type(2)));
__device__ __forceinline__ f32x4 bf4_to_f32(u32x2 w) { f32x4 r; r.x = __uint_as_float(w.x << 16); r.y = __uint_as_float(w.x & 0xffff0000u); r.z = __uint_as_float(w.y << 16); r.w = __uint_as_float(w.y & 0xffff0000u); return r; }
__device__ __forceinline__ void ln_regs(f32x4 (&v)[8], const LAS float* g, const LAS float* bb, int lane) {
    float s = 0.f;
#pragma unroll
    for (int j = 0; j < 8; ++j) s += (v[j].x + v[j].y) + (v[j].z + v[j].w);
    const float mean = wave_sum(s) * (1.f / DM); float s2 = 0.f;
#pragma unroll
    for (int j = 0; j < 8; ++j) { v[j] = v[j] - mean; s2 += (v[j].x * v[j].x + v[j].y * v[j].y) + (v[j].z * v[j].z + v[j].w * v[j].w); }
    const float rstd = __builtin_amdgcn_rsqf(wave_sum(s2) * (1.f / DM) + LN_EPS);
#pragma unroll
    for (int j = 0; j < 8; ++j) { const int c = 256 * j + 4 * lane; v[j] = v[j] * rstd * *(const LAS f32x4*)(g + c) + *(const LAS f32x4*)(bb + c); }
}
__device__ __forceinline__ void x1_row(f32x4 (&v)[8], const float* xrow, const bf16* arow, const LAS float* P, int lane) {
    const GAS f32x4* xr = (const GAS f32x4*)xrow + lane; const GAS u32x2* ar = (const GAS u32x2*)arow + lane;
    u32x2 aw[8];
#pragma unroll
    for (int j = 0; j < 8; ++j) { v[j] = xr[64 * j]; aw[j] = ar[64 * j]; }
#pragma unroll
    for (int j = 0; j < 8; ++j) v[j] = v[j] * DN_ALPHA + *(const LAS f32x4*)(P + 256 * j + 4 * lane) * bf4_to_f32(aw[j]);
    ln_regs(v, P + 2048, P + 4096, lane);
}

__global__ void __launch_bounds__(NWAVES * 64, 2) dit_fwd(Args args) {
    extern __shared__ __attribute__((aligned(16))) unsigned char lds[];
    LAS unsigned char* L = (LAS unsigned char*)lds;
    volatile LAS unsigned* MISC = (volatile LAS unsigned*)(L + MISC_OFF);
    const int tid = threadIdx.x, lane = tid & 63, wave = __builtin_amdgcn_readfirstlane(tid >> 6);
    const int G = gridDim.x, bx = blockIdx.x;
    unsigned char* ws = args.ws;
    gu32* ctl = (gu32*)(ws + WS_CTL);
    const float* x = args.in[0]; const float* cvec = args.in[1]; const float* ctx = args.in[2]; const float* c_ctx = args.in[3];
    const float* w_ada = args.in[4]; const float* b_ada = args.in[5]; const float* w_in = args.in[6]; const float* qng = args.in[7]; const float* kng = args.in[8];
    const float* sink = args.in[9]; const float* w_out = args.in[10]; const float* ln1g = args.in[11]; const float* ln1b = args.in[12];
    const float* w_gate = args.in[13]; const float* w_up = args.in[14]; const float* w_down = args.in[15]; const float* ln2g = args.in[16]; const float* ln2b = args.in[17];
    float* MODP = (float*)(ws + WS_MODP); float* MODS = (float*)(ws + WS_MODS); float* ROPEC = (float*)(ws + WS_ROPE); float* ROPES = ROPEC + 2048;
    bf16* WIN = (bf16*)(ws + WS_WIN); bf16* WOUT = (bf16*)(ws + WS_WOUT); bf16* WGU = (bf16*)(ws + WS_WGU); bf16* WDN = (bf16*)(ws + WS_WDN);
    bf16* U = (bf16*)(ws + WS_U); bf16* AB = (bf16*)(ws + WS_Y); bf16* DB = (bf16*)(ws + WS_Y + 64 * MiB); bf16* QO = (bf16*)(ws + WS_QO);
    bf16* KA = (bf16*)(ws + WS_KV); bf16* VA = (bf16*)(ws + WS_KV + KV_BYTES); bf16* KB = (bf16*)(ws + WS_KV + 2 * KV_BYTES); bf16* VB = (bf16*)(ws + WS_KV + 3 * KV_BYTES);
    bf16* HB = (bf16*)(ws + WS_H);

    for (int u = tid; u < (LDS_BYTES - LDSCTL_OFF) / 4; u += NWAVES * 64) ((LAS unsigned*)(L + LDSCTL_OFF))[u] = 0u;
    __syncthreads();
    XcdBarrier bar; bar.bar = (unsigned*)(ctl + CW_BAR); bar.x = 0; bar.st = nullptr;
    if (N_LAUNCHES == 1) bar = xcd_barrier_post((unsigned*)(ctl + CW_BAR), MISC + 8);
#define GRID_BAR() do { if (N_LAUNCHES == 1) xcd_barrier(bar); } while (0)
    const int lo = args.ph_lo, hi = args.ph_hi;
#ifndef PHMASK
#define PHMASK 0x3FF
#endif
#define IN(k) (((PHMASK >> (k)) & 1) && lo <= (k) && (k) < hi)
#define BOTH(k) (IN(k) && IN((k) + 1))

    if (IN(0)) {
        if (bx < 192) {
            const int cb = bx >> 2, kq = bx & 3, k0 = kq * 512 + wave * 64;
            float sv[5];
#pragma unroll
            for (int b = 0; b < 4; ++b) sv[b] = silu_f(cvec[b * DM + k0 + lane]);
            sv[4] = silu_f(c_ctx[k0 + lane]);
            f32x4 acc[5];
#pragma unroll
            for (int b = 0; b < 5; ++b) acc[b] = (f32x4){0.f, 0.f, 0.f, 0.f};
            const float* wp = w_ada + (size_t)k0 * NMOD + cb * 256 + lane * 4;
#pragma unroll 16
            for (int kk = 0; kk < 64; ++kk) { const f32x4 wv = *(const f32x4*)(wp + (size_t)kk * NMOD);
#pragma unroll
                for (int b = 0; b < 5; ++b) { const float s = __builtin_bit_cast(float, __builtin_amdgcn_readlane(__builtin_bit_cast(int, sv[b]), kk)); acc[b] += wv * s; } }
            LAS f32x4* red = (LAS f32x4*)(L + RING_OFF);
#pragma unroll
            for (int b = 0; b < 5; ++b) red[(wave * 5 + b) * 64 + lane] = acc[b];
            LDS_WAIT(); __syncthreads();
            if (tid < 320) { const int b = tid >> 6, l = tid & 63; f32x4 s = red[b * 64 + l];
#pragma unroll
                for (int w = 1; w < 8; ++w) s += red[(w * 5 + b) * 64 + l];
                *(f32x4*)(MODP + ((size_t)kq * 5 + b) * NMOD + cb * 256 + l * 4) = s; }
            __syncthreads();
        }
        if (bx == 255) {
            for (int e = tid; e < 2048; e += NWAVES * 64) { const int pos = e >> 5, f = e & 31;
                const float inv = exp2f(-(float)f * (13.287712379549449f / 32.0f)); const float ang = (float)pos * inv;
                float sn, cs; sincosf(ang, &sn, &cs); ROPEC[e] = cs; ROPES[e] = sn; }
        }
        {
            LAS float* scr = (LAS float*)(L + RING_OFF + wave * 16384);
            constexpr int I_IN = 32 * 96, I_OUT = 32 * 64, I_G = 32 * 176, NITEMS = I_IN + I_OUT + I_G, NSLOT = 192 * 8 * 2 + 64 * 8 * 5;
            const int nsl = bx < 192 ? 2 : 5, sl0 = bx < 192 ? (bx * 8 + wave) * 2 : 3072 + ((bx - 192) * 8 + wave) * 5;
            for (int s = 0; s < nsl; ++s)
                for (int it = sl0 + s; it < NITEMS; it += NSLOT) {
                    int r = it;
                    if (r < I_IN) { const int kb = r / 96, nb = r % 96, pn = nb >> 3, q = nb & 7, hh = q >> 2, part = (q >> 1) & 1, bj = q & 1;
                        transpose_item(w_in, INW, 64 * kb, 32 * nb, WIN, DM, 256 * pn + 32 * (4 * bj + 2 * hh + part), scr, lane); continue; } r -= I_IN;
                    if (r < I_OUT) { const int kb = r / 64, nb = r % 64; transpose_item(w_out, DM, 64 * kb, 32 * nb, WOUT, DM, 32 * nb, scr, lane); continue; } r -= I_OUT;
                    { const int kb = r / 176, nb = r % 176; transpose_item(w_gate, FFN, 64 * kb, 32 * nb, WGU, DM, 256 * (nb >> 2) + 32 * (nb & 3), scr, lane); }
                }
        }
        if (BOTH(0)) GRID_BAR();
    }

    if (IN(1)) {
        { const int idx = bx * 512 + tid;
          if (idx < 5 * NMOD) { float s = b_ada[idx % NMOD];
#pragma unroll
              for (int q = 0; q < 4; ++q) s += MODP[(size_t)q * 5 * NMOD + idx];
              MODS[idx] = s; } }
        if (bx < 128) {
            LAS float* P0 = (LAS float*)(L + RING_OFF); LAS float* P1 = P0 + 2048;
            for (int i = tid; i < 2048; i += NWAVES * 64) { float sh = b_ada[i], sc = b_ada[2048 + i];
#pragma unroll
                for (int q = 0; q < 4; ++q) { sh += MODP[((size_t)q * 5 + 4) * NMOD + i]; sc += MODP[((size_t)q * 5 + 4) * NMOD + 2048 + i]; }
                P0[i] = 1.0f + sc; P1[i] = sh; }
            LDS_WAIT(); __syncthreads();
            const int r = bx * 8 + wave;
            modulate_row(ctx + (size_t)r * DM, U + (size_t)(M + r) * DM, P0, P1, lane);
            __syncthreads();
        }
        if (BOTH(1)) GRID_BAR();
    }

    if (IN(2)) {
        if (bx < 16) {
            const int pnl[4] = {4, 5, 10, 11};
            pg8::Gemm g{U, WIN, MU, INW, DM}; pg8::OneUnit S{64 + (bx >> 2), (bx & 3) == 0 ? 4 : (bx & 3) == 1 ? 5 : (bx & 3) == 2 ? 10 : 11}; (void)pnl;
            pg8::EpiQKV E{QO, KA, VA, KB, VB, qng, kng, ROPEC, ROPES, (LAS float*)(L + XCH_OFF)};
            pg8::gemm_phase<pg8::EpiQKV, pg8::OneUnit, true, true>(L + RING_OFF, g, S, E);
        } else {
            LAS float* P0 = (LAS float*)(L + RING_OFF); LAS float* P1 = P0 + 2048;
            const int i = bx - 16, r0 = (int)(((long)i * M) / 240), r1 = (int)(((long)(i + 1) * M) / 240);
            int r = r0;
            while (r < r1) {
                const int b = r >> 12; int re = (b + 1) << 12; if (re > r1) re = r1;
                __syncthreads();
                for (int k = tid; k < 2048; k += NWAVES * 64) { P0[k] = 1.0f + MODS[b * NMOD + 2048 + k]; P1[k] = MODS[b * NMOD + k]; }
                LDS_WAIT(); __syncthreads();
                for (int rr = r + wave; rr < re; rr += NWAVES) modulate_row(x + (size_t)rr * DM, U + (size_t)rr * DM, P0, P1, lane);
                r = re;
            }
            __syncthreads();
            {
                LAS float* scr = (LAS float*)(L + RING_OFF + wave * 16384);
                constexpr int I_G = 32 * 176, I_D = 88 * 64, NITEMS2 = I_G + I_D;
                for (int it = i * 8 + wave; it < NITEMS2; it += 240 * 8) {
                    if (it < I_G) { const int kb = it / 176, nb = it % 176; transpose_item(w_up, FFN, 64 * kb, 32 * nb, WGU, DM, 256 * (nb >> 2) + 128 + 32 * (nb & 3), scr, lane); }
                    else { const int r2 = it - I_G, kb = r2 / 64, nb = r2 % 64; transpose_item(w_down, DM, 64 * kb, 32 * nb, WDN, FFN, 32 * nb, scr, lane); }
                }
            }
        }
        if (BOTH(2)) GRID_BAR();
    }

    if (IN(3)) {
        pg8::Gemm g{U, WIN, M, INW, DM}; pg8::StaticOrder S; S.init(M, INW, G, bx);
        pg8::EpiQKV E{QO, KA, VA, KB, VB, qng, kng, ROPEC, ROPES, (LAS float*)(L + XCH_OFF)};
        pg8::gemm_phase<pg8::EpiQKV, pg8::StaticOrder, true, true>(L + RING_OFF, g, S, E);
        if (BOTH(3)) GRID_BAR();
    }

    if (IN(4)) {
        const int xg = bx & 7, y = bx >> 3, b = xg >> 1, kvh = xg & 1;
        const size_t kvoff = (size_t)(b * 2 + kvh) * SKV * 128;
        float kbnd; { float gm = fmaxf(fabsf(kng[lane]), fabsf(kng[64 + lane]));
#pragma unroll
            for (int o = 1; o < 64; o <<= 1) gm = fmaxf(gm, __shfl_xor(gm, o));
            kbnd = gm * 11.313708498984761f * 1.01f; }
        for (int i = 0; i < 4; ++i) {
            const int uu = 2 * y + (i & 1), gq = uu >> 4, qb = uu & 15, q0 = qb * 256;
            const bool isA = i >= 2;
            const int head = kvh * 4 + gq;
            bf16* Qp = QO + (size_t)(b * SEQ + q0) * DM + (isA ? 0 : 1024) + head * 128;
            const int jlo = !isA ? 0 : ((q0 >> 6) - 2 < 0 ? 0 : (q0 >> 6) - 2), jhi = (q0 >> 6) + 6 > 64 ? 64 : (q0 >> 6) + 6;
            const int nctx = isA ? 4 : 0, NT = isA ? 4 + (jhi - jlo) : SKV / 64;
            const float sk = isA ? sink[head] * 1.4426950408889634f : -INFINITY;
            att::attn_unit(Qp, (isA ? KA : KB) + kvoff, (isA ? VA : VB) + kvoff, (args.flags & 1) ? (bf16*)(ws + 384 * MiB) + (Qp - QO) : Qp, NT, nctx, jlo, q0, isA, sk, isA ? -1.f : kbnd, (char*)lds + RING_OFF);
        }
        if (BOTH(4)) GRID_BAR();
    }

    if (IN(5)) {
        pg8::Gemm g{QO, WOUT, M, DM, DM}; pg8::StaticOrder S; S.init(M, DM, G, bx);
        pg8::EpiBf16Plain E{AB, DM};
        pg8::gemm_phase<pg8::EpiBf16Plain, pg8::StaticOrder, true, true>(L + RING_OFF, g, S, E);
        if (BOTH(5)) GRID_BAR();
    }

    if (IN(6)) {
        LAS float* P = (LAS float*)(L + RING_OFF);
        const int b = bx >> 6;
        for (int k = tid; k < 2048; k += NWAVES * 64) { P[k] = MODS[b * NMOD + 2 * 2048 + k]; P[2048 + k] = ln1g[k]; P[4096 + k] = ln1b[k]; P[6144 + k] = 1.0f + MODS[b * NMOD + 4 * 2048 + k]; P[8192 + k] = MODS[b * NMOD + 3 * 2048 + k]; }
        LDS_WAIT(); __syncthreads();
        for (int rr = bx * 64 + wave; rr < bx * 64 + 64; rr += NWAVES) {
            f32x4 v[8]; x1_row(v, x + (size_t)rr * DM, AB + (size_t)rr * DM, P, lane);
            GAS unsigned long long* o8 = (GAS unsigned long long*)(U + (size_t)rr * DM) + lane;
#pragma unroll
            for (int j = 0; j < 8; ++j) { const int c = 256 * j + 4 * lane; const f32x4 r = v[j] * *(const LAS f32x4*)(P + 6144 + c) + *(const LAS f32x4*)(P + 8192 + c);
                o8[64 * j] = (unsigned long long)pk2(r.x, r.y) | ((unsigned long long)pk2(r.z, r.w) << 32); }
        }
        __syncthreads();
        if (BOTH(6)) GRID_BAR();
    }

    if (IN(7)) {
        pg8::Gemm g{U, WGU, M, 2 * FFN, DM}; pg8::StaticOrder S; S.init(M, 2 * FFN, G, bx);
        pg8::EpiSwiglu E{HB, FFN};
        pg8::gemm_phase<pg8::EpiSwiglu, pg8::StaticOrder, true, true>(L + RING_OFF, g, S, E);
        if (BOTH(7)) GRID_BAR();
    }

    if (IN(8)) {
        pg8::Gemm g{HB, WDN, M, DM, FFN}; pg8::StaticOrder S; S.init(M, DM, G, bx);
        pg8::EpiBf16Plain E{DB, DM};
        pg8::gemm_phase<pg8::EpiBf16Plain, pg8::StaticOrder, true, true>(L + RING_OFF, g, S, E);
        if (BOTH(8)) GRID_BAR();
    }

    if (IN(9)) {
        LAS float* P = (LAS float*)(L + RING_OFF);
        const int b = bx >> 6;
        for (int k = tid; k < 2048; k += NWAVES * 64) { P[k] = MODS[b * NMOD + 2 * 2048 + k]; P[2048 + k] = ln1g[k]; P[4096 + k] = ln1b[k]; P[6144 + k] = MODS[b * NMOD + 5 * 2048 + k]; P[8192 + k] = ln2g[k]; P[10240 + k] = ln2b[k]; }
        LDS_WAIT(); __syncthreads();
        for (int rr = bx * 64 + wave; rr < bx * 64 + 64; rr += NWAVES) {
            f32x4 v[8]; x1_row(v, x + (size_t)rr * DM, AB + (size_t)rr * DM, P, lane);
            const GAS u32x2* dr = (const GAS u32x2*)(DB + (size_t)rr * DM) + lane;
#pragma unroll
            for (int j = 0; j < 8; ++j) v[j] = v[j] * DN_ALPHA + *(const LAS f32x4*)(P + 6144 + 256 * j + 4 * lane) * bf4_to_f32(dr[64 * j]);
            ln_regs(v, P + 8192, P + 10240, lane);
            GAS f32x4* orow = (GAS f32x4*)(args.out + (size_t)rr * DM) + lane;
#pragma unroll
            for (int j = 0; j < 8; ++j) orow[64 * j] = v[j];
        }
    }
#undef IN
#undef BOTH
#undef GRID_BAR
}

extern "C" void kernel_launch(void* const* d_in, const int* in_sizes, int n_in, void* d_out, int out_size, void* d_ws, size_t ws_size, hipStream_t stream) {
    static int grid = 0;
    if (grid == 0) {
        if (n_in != 18 || in_sizes[0] != M * DM || out_size != M * DM || ws_size < WS_END) {
            fprintf(stderr, "kernel_launch: shape mismatch (n_in %d, in0 %d, out %d, ws %zu; need ws >= %zu); nothing launched\n", n_in, n_in > 0 ? in_sizes[0] : -1, out_size, ws_size, (size_t)WS_END); grid = -1; return; }
        int dev = 0, cus = 0, per_cu = 0;
        if (hipGetDevice(&dev) != hipSuccess || hipDeviceGetAttribute(&cus, hipDeviceAttributeMultiprocessorCount, dev) != hipSuccess) { fprintf(stderr, "kernel_launch: device query failed\n"); grid = -1; return; }
        if (hipFuncSetAttribute((const void*)dit_fwd, hipFuncAttributeMaxDynamicSharedMemorySize, LDS_BYTES) != hipSuccess) { fprintf(stderr, "kernel_launch: hipFuncSetAttribute failed\n"); grid = -1; return; }
        if (hipOccupancyMaxActiveBlocksPerMultiprocessor(&per_cu, (const void*)dit_fwd, NWAVES * 64, LDS_BYTES) != hipSuccess || per_cu < 1)
            fprintf(stderr, "kernel_launch: note: occupancy query reports %d workgroups per CU\n", per_cu);
        (void)hipGetLastError();
        if (cus != 256) { fprintf(stderr, "kernel_launch: built for a 256-CU device, found %d CUs; nothing launched\n", cus); grid = -1; return; }
        grid = 256;
    }
    if (grid < 0) return;
    if (hipMemsetAsync((char*)d_ws + WS_CTL, 0, CTL_ZERO_BYTES, stream) != hipSuccess) { fprintf(stderr, "kernel_launch: hipMemsetAsync failed\n"); return; }
    Args a{};
    for (int i = 0; i < 18; ++i) a.in[i] = (const float*)d_in[i];
    a.out = (float*)d_out; a.ws = (unsigned char*)d_ws;
    if (N_LAUNCHES == 1) { a.ph_lo = 0; a.ph_hi = N_PHASES; a.li = 0; hipLaunchKernelGGL(dit_fwd, dim3(grid), dim3(NWAVES * 64), LDS_BYTES, stream, a); }
    else { const int plist[] = PHASE_LIST;
        for (unsigned i = 0; i < sizeof(plist) / sizeof(int); ++i) { const int p = plist[i] % 100; a.ph_lo = p; a.ph_hi = p + 1; a.li = 0; a.flags = plist[i] >= 100 ? 1 : 0;
            hipLaunchKernelGGL(dit_fwd, dim3(grid), dim3(NWAVES * 64), LDS_BYTES, stream, a); } }
    const hipError_t le = hipPeekAtLastError();
    if (le != hipSuccess) fprintf(stderr, "kernel_launch: launch failed: %s\n", hipGetErrorName(le));
}
```

```cpp
#include <hip/hip_runtime.h>
#include <hip/hip_bf16.h>
#include <cstdio>
#include <cstdint>

#ifndef PHASE_LIST
#define PHASE_LIST {0, 1, 2, 3, 4, 5, 6, 7, 8, 9}
#endif
#ifndef MK_N_LAUNCHES
#define MK_N_LAUNCHES 1
#endif

namespace pg8 {
#define PG8_LAS __attribute__((address_space(3)))
typedef unsigned short bf16_t;
typedef short bf16x8 __attribute__((ext_vector_type(8)));
typedef float f32x4 __attribute__((ext_vector_type(4)));
typedef unsigned u32x4 __attribute__((ext_vector_type(4)));
constexpr int BM = 256, BK = 64, HALF = 128, HTB = HALF * BK * 2, STAGE_BYTES = 8 * HTB, NXCD = 8, WGM = 8;

__host__ __device__ __forceinline__ int lds_byte(int r, int c) { const int st = (r >> 4) * 2 + (c >> 5), rr = r & 15, cc = c & 31, ob = rr * 64 + cc * 2; return st * 1024 + (ob ^ (((ob >> 9) & 1) << 5)); }
__host__ __device__ __forceinline__ void stage_rc(int b, int& R, int& C) { const int st = b / 1024, sb = b % 1024, swz = sb ^ (((sb >> 9) & 1) << 5); R = (st >> 1) * 16 + swz / 64; C = (st & 1) * 32 + (swz % 64) / 2; }
__host__ __device__ __forceinline__ int perm32(int rho) { const int n = rho >> 4, i = rho & 15; return 8 * (i >> 2) + 4 * n + (i & 3); }

struct Unit { int pm, pn; };
struct Gemm { const bf16_t* A; const bf16_t* Bt; int M, N, K; };

struct StaticOrder {
    int nM, nN, nwg, G, c;
    __host__ __device__ void init(int M, int N, int G_, int c_) { nM = M / BM; nN = N / BM; nwg = nM * nN; G = G_; c = c_; }
    __host__ __device__ bool next(int i, Unit& u) const {
        const long L = (long)i * G + c; if (L >= nwg) return false;
        int wgid = (int)L; { const int q = nwg / NXCD, r = nwg % NXCD, xcd = wgid % NXCD, off = wgid / NXCD; wgid = (xcd < r ? xcd * (q + 1) : r * (q + 1) + (xcd - r) * q) + off; }
        const int nig = WGM * nN, gid = wgid / nig, fm = gid * WGM, gsz = (nM - fm) < WGM ? (nM - fm) : WGM;
        u.pm = fm + ((wgid % nig) % gsz); u.pn = (wgid % nig) / gsz; return true;
    }
    __device__ __forceinline__ void a_ready(const Unit&) const {}
    __device__ __forceinline__ void done(const Unit&) const {}
};
struct OneUnit {
    int pm, pn;
    __device__ bool next(int i, Unit& u) const { if (i > 0) return false; u.pm = pm; u.pn = pn; return true; }
    __device__ __forceinline__ void a_ready(const Unit&) const {}
    __device__ __forceinline__ void done(const Unit&) const {}
};

__device__ __forceinline__ unsigned cvt_pk_bf16(float lo, float hi) { unsigned r; asm volatile("v_cvt_pk_bf16_f32 %0, %1, %2" : "=v"(r) : "v"(lo), "v"(hi)); return r; }


struct EpiQKV {
    static constexpr bool PERM = true, AFTER_DRAIN = false;
    bf16_t* QO; bf16_t* KA; bf16_t* VA; bf16_t* KB; bf16_t* VB;
    const float* qg; const float* kg; const float* ropec; const float* ropes;
    PG8_LAS float* xch;
    __device__ __forceinline__ void operator()(const f32x4 (&acc)[2][2][4][2], const Unit& u, int wr, int wc, int fr, int fq) const {
        const int pn = u.pn; const bool is_ctx = u.pm >= 64;
        const int b = is_ctx ? (u.pm - 64) : (u.pm >> 4), t0 = is_ctx ? 4096 : ((u.pm & 15) << 8);
        const int hh = wc >> 1, part = wc & 1, wid = wr * 4 + wc;
        const bool isq = (pn < 4) || (pn >= 6 && pn < 10), donorm = (pn >= 6 && pn <= 10), dorope = (!is_ctx) && pn != 5 && pn != 11;
        bf16_t* base; size_t rstride;
        if (isq) { const int head = (pn < 4 ? 2 * pn : 8 + 2 * (pn - 6)) + hh; base = QO + (size_t)(b * 4096 + t0) * 2048 + head * 128; rstride = 2048; }
        else { bf16_t* buf = pn == 4 ? KA : pn == 5 ? VA : pn == 10 ? KB : VB; base = buf + ((size_t)(b * 2 + hh) * 4352 + t0) * 128; rstride = 128; }
        const int d0 = 64 * part + 8 * fq;
        float rs[2][4];
        f32x4 gv[2][2];
#pragma unroll
        for (int bj = 0; bj < 2; ++bj)
#pragma unroll
            for (int n = 0; n < 2; ++n) gv[bj][n] = (f32x4){1.f, 1.f, 1.f, 1.f};
#pragma unroll
        for (int ai = 0; ai < 2; ++ai)
#pragma unroll
            for (int m = 0; m < 4; ++m) rs[ai][m] = 1.f;
        if (donorm) {
            const float* g = (pn == 10) ? kg : qg;
#pragma unroll
            for (int bj = 0; bj < 2; ++bj)
#pragma unroll
                for (int n = 0; n < 2; ++n) gv[bj][n] = *(const f32x4*)(g + d0 + 32 * bj + 4 * n);
#pragma unroll
            for (int ai = 0; ai < 2; ++ai)
#pragma unroll
                for (int m = 0; m < 4; ++m) {
                    float s = 0.f;
#pragma unroll
                    for (int bj = 0; bj < 2; ++bj)
#pragma unroll
                        for (int n = 0; n < 2; ++n) { const f32x4 x = acc[ai][bj][m][n]; s += (x[0] * x[0] + x[1] * x[1]) + (x[2] * x[2] + x[3] * x[3]); }
                    s += __shfl_xor(s, 16); s += __shfl_xor(s, 32);
                    if (fq == 0) xch[wid * 128 + ai * 64 + m * 16 + fr] = s;
                    rs[ai][m] = s;
                }
            asm volatile("s_waitcnt lgkmcnt(0)" ::: "memory"); __builtin_amdgcn_s_barrier(); asm volatile("" ::: "memory");
#pragma unroll
            for (int ai = 0; ai < 2; ++ai)
#pragma unroll
                for (int m = 0; m < 4; ++m) { const float o = xch[(wid ^ 1) * 128 + ai * 64 + m * 16 + fr]; rs[ai][m] = __builtin_amdgcn_rsqf((rs[ai][m] + o) * (1.0f / 128.0f) + 1e-6f); }
        }
#pragma unroll
        for (int ai = 0; ai < 2; ++ai)
#pragma unroll
            for (int m = 0; m < 4; ++m) {
                const int rt = ai * HALF + wr * 64 + m * 16 + fr;
                f32x4 lo[2], hi[2];
#pragma unroll
                for (int n = 0; n < 2; ++n) { lo[n] = acc[ai][0][m][n] * rs[ai][m] * gv[0][n]; hi[n] = acc[ai][1][m][n] * rs[ai][m] * gv[1][n]; }
                if (dorope) {
                    const int t = t0 + rt, pos = part ? (t & 63) : (t >> 6);
#pragma unroll
                    for (int n = 0; n < 2; ++n) {
                        const f32x4 c4 = *(const f32x4*)(ropec + pos * 32 + 8 * fq + 4 * n), s4 = *(const f32x4*)(ropes + pos * 32 + 8 * fq + 4 * n);
                        const f32x4 a = lo[n], bb = hi[n];
                        lo[n] = a * c4 - bb * s4; hi[n] = bb * c4 + a * s4;
                    }
                }
                bf16_t* rowp = base + (size_t)rt * rstride + d0;
                u32x4 w0, w1;
                w0.x = cvt_pk_bf16(lo[0][0], lo[0][1]); w0.y = cvt_pk_bf16(lo[0][2], lo[0][3]); w0.z = cvt_pk_bf16(lo[1][0], lo[1][1]); w0.w = cvt_pk_bf16(lo[1][2], lo[1][3]);
                w1.x = cvt_pk_bf16(hi[0][0], hi[0][1]); w1.y = cvt_pk_bf16(hi[0][2], hi[0][3]); w1.z = cvt_pk_bf16(hi[1][0], hi[1][1]); w1.w = cvt_pk_bf16(hi[1][2], hi[1][3]);
                *(u32x4*)(rowp) = w0; *(u32x4*)(rowp + 32) = w1;
            }
    }
};

struct EpiResid {
    static constexpr bool PERM = false, AFTER_DRAIN = false;
    const float* res; const float* gate; float* out; float alpha;
    __device__ __forceinline__ void operator()(const f32x4 (&acc)[2][2][4][2], const Unit& u, int wr, int wc, int fr, int fq) const {
        const int row0 = u.pm * BM + wr * 64 + fr, col0 = u.pn * BM + wc * 32 + 4 * fq, b = u.pm >> 4;
        f32x4 gv[2][2];
#pragma unroll
        for (int bj = 0; bj < 2; ++bj)
#pragma unroll
            for (int n = 0; n < 2; ++n) gv[bj][n] = *(const f32x4*)(gate + b * 12288 + col0 + bj * HALF + n * 16);
#pragma unroll
        for (int ai = 0; ai < 2; ++ai)
#pragma unroll
            for (int m = 0; m < 4; ++m) { const size_t off = (size_t)(row0 + ai * HALF + m * 16) * 2048 + col0;
#pragma unroll
                for (int bj = 0; bj < 2; ++bj)
#pragma unroll
                    for (int n = 0; n < 2; ++n) { const f32x4 xv = *(const f32x4*)(res + off + bj * HALF + n * 16);
                        *(f32x4*)(out + off + bj * HALF + n * 16) = xv * alpha + gv[bj][n] * acc[ai][bj][m][n]; } }
    }
};


struct EpiBf16Plain {
    static constexpr bool PERM = true, AFTER_DRAIN = false;
    bf16_t* O; int ldc;
    __device__ __forceinline__ void operator()(const f32x4 (&acc)[2][2][4][2], const Unit& u, int wr, int wc, int fr, int fq) const {
        const int row0 = u.pm * BM + wr * 64 + fr, col0 = u.pn * BM + wc * 32 + 8 * fq;
#pragma unroll
        for (int ai = 0; ai < 2; ++ai)
#pragma unroll
            for (int m = 0; m < 4; ++m) { bf16_t* rowp = O + (size_t)(row0 + ai * HALF + m * 16) * ldc + col0;
#pragma unroll
                for (int bj = 0; bj < 2; ++bj) { const f32x4 v0 = acc[ai][bj][m][0], v1 = acc[ai][bj][m][1];
                    u32x4 w; w.x = cvt_pk_bf16(v0[0], v0[1]); w.y = cvt_pk_bf16(v0[2], v0[3]); w.z = cvt_pk_bf16(v1[0], v1[1]); w.w = cvt_pk_bf16(v1[2], v1[3]);
                    *(u32x4*)(rowp + bj * HALF) = w; } }
    }
};

struct EpiSwiglu {
    static constexpr bool PERM = true, AFTER_DRAIN = false;
    bf16_t* H; int ldh;
    __device__ __forceinline__ void operator()(const f32x4 (&acc)[2][2][4][2], const Unit& u, int wr, int wc, int fr, int fq) const {
        const int row0 = u.pm * BM + wr * 64 + fr, col0 = u.pn * 128 + wc * 32 + 8 * fq;
#pragma unroll
        for (int ai = 0; ai < 2; ++ai)
#pragma unroll
            for (int m = 0; m < 4; ++m) { bf16_t* rowp = H + (size_t)(row0 + ai * HALF + m * 16) * ldh + col0;
                f32x4 o[2];
#pragma unroll
                for (int n = 0; n < 2; ++n) { const f32x4 g = acc[ai][0][m][n], up = acc[ai][1][m][n];
#pragma unroll
                    for (int e = 0; e < 4; ++e) { const float sg = __builtin_amdgcn_rcpf(1.0f + __builtin_amdgcn_exp2f(-1.4426950408889634f * g[e])); o[n][e] = g[e] * sg * up[e]; } }
                u32x4 w; w.x = cvt_pk_bf16(o[0][0], o[0][1]); w.y = cvt_pk_bf16(o[0][2], o[0][3]); w.z = cvt_pk_bf16(o[1][0], o[1][1]); w.w = cvt_pk_bf16(o[1][2], o[1][3]);
                *(u32x4*)rowp = w; }
    }
};

template <class Epi, class Sched, bool ALIGN_EPI = false, bool SP2 = false>
__device__ __forceinline__ void gemm_phase(PG8_LAS unsigned char* lds, const Gemm g, const Sched& S, const Epi& E) {
    const int tid = threadIdx.x, wid = __builtin_amdgcn_readfirstlane(tid >> 6), lane = tid & 63, wr = wid >> 2, wc = wid & 3, fr = lane & 15, fq = lane >> 4;
    const int K = g.K, nt = K / BK;
    unsigned voffA[2], voffB[2];
#pragma unroll
    for (int i = 0; i < 2; ++i) { int R, C; stage_rc(tid * 16 + i * 8192, R, C); const int Rb = Epi::PERM ? ((R & ~31) + perm32(R & 31)) : R;
        voffA[i] = (unsigned)(R * K + C) * 2u; voffB[i] = (unsigned)(Rb * K + C) * 2u; }
    const size_t kstep = (size_t)(BK * 2);
    const size_t hstep = (size_t)HALF * K * 2;
    const size_t tstep = 2 * hstep;
    const unsigned ldsw = (unsigned)wid * 1024u;
    const int aoff = lds_byte(wr * 64 + fr, fq * 8), boff = lds_byte(wc * 32 + fr, fq * 8);
#define PG8_SA(b, h) (((b) * 2 + (h)) * HTB)
#define PG8_SB(b, h) ((4 + (b) * 2 + (h)) * HTB)
#define PG8_STAGE(bufoff, gbase, voff) do { _Pragma("unroll") for (int _i = 0; _i < 2; ++_i) \
        __builtin_amdgcn_global_load_lds((const unsigned*)((const char*)(gbase) + (voff)[_i]), (PG8_LAS unsigned*)(lds + (bufoff) + ldsw + _i * 8192), 16, 0, 0); } while (0)
#define PG8_LDA(dst, b, h) do { _Pragma("unroll") for (int m = 0; m < 4; ++m) _Pragma("unroll") for (int k = 0; k < 2; ++k) dst[m][k] = *(const PG8_LAS bf16x8*)(lds + PG8_SA(b, h) + aoff + m * 2048 + k * 1024); } while (0)
#define PG8_LDB(dst, b, h) do { _Pragma("unroll") for (int n = 0; n < 2; ++n) _Pragma("unroll") for (int k = 0; k < 2; ++k) dst[n][k] = *(const PG8_LAS bf16x8*)(lds + PG8_SB(b, h) + boff + n * 2048 + k * 1024); } while (0)
#define PG8_MMA(ai, bj, At, Bt) do { __builtin_amdgcn_s_setprio(1); _Pragma("unroll") for (int m = 0; m < 4; ++m) _Pragma("unroll") for (int n = 0; n < 2; ++n) _Pragma("unroll") for (int k = 0; k < 2; ++k) \
        acc[ai][bj][m][n] = __builtin_amdgcn_mfma_f32_16x16x32_bf16(Bt[n][k], At[m][k], acc[ai][bj][m][n], 0, 0, 0); __builtin_amdgcn_s_setprio(0); } while (0)
#define PG8_WAIT_V(n) asm volatile("s_waitcnt vmcnt(" #n ")" ::: "memory")
#define PG8_WAIT_L(n) asm volatile("s_waitcnt lgkmcnt(" #n ")" ::: "memory")
#define PG8_BAR __builtin_amdgcn_s_barrier()
#define PG8_SCHED __builtin_amdgcn_sched_barrier(0)
    Unit cur, nxt; int ui = 0;
    if (!S.next(0, cur)) return;
    f32x4 acc[2][2][4][2];
#pragma unroll
    for (int a = 0; a < 2; ++a)
#pragma unroll
        for (int b = 0; b < 2; ++b)
#pragma unroll
            for (int m = 0; m < 4; ++m)
#pragma unroll
                for (int n = 0; n < 2; ++n) acc[a][b][m][n] = (f32x4){0.f, 0.f, 0.f, 0.f};
    bf16x8 At[4][2], B0[2][2], B1[2][2];
    const char* cA = (const char*)g.A + (size_t)cur.pm * tstep; const char* cB = (const char*)g.Bt + (size_t)cur.pn * tstep;
    S.a_ready(cur);
    if constexpr (SP2) {
        PG8_STAGE(PG8_SB(0, 0), cB, voffB); PG8_STAGE(PG8_SB(0, 1), cB + hstep, voffB); PG8_STAGE(PG8_SA(0, 0), cA, voffA); PG8_STAGE(PG8_SA(0, 1), cA + hstep, voffA);
        if (wr == 1) PG8_BAR;
        PG8_WAIT_V(2); PG8_BAR;
        PG8_STAGE(PG8_SB(1, 0), cB + kstep, voffB); PG8_STAGE(PG8_SA(1, 0), cA + kstep, voffA); PG8_STAGE(PG8_SB(1, 1), cB + hstep + kstep, voffB);
        PG8_WAIT_V(6); PG8_BAR;
    } else {
        PG8_STAGE(PG8_SB(0, 0), cB, voffB); PG8_STAGE(PG8_SA(0, 0), cA, voffA); PG8_STAGE(PG8_SB(0, 1), cB + hstep, voffB); PG8_STAGE(PG8_SA(0, 1), cA + hstep, voffA);
        if (wr == 1) PG8_BAR;
        PG8_WAIT_V(4); PG8_BAR;
        PG8_STAGE(PG8_SB(1, 0), cB + kstep, voffB); PG8_STAGE(PG8_SA(1, 0), cA + kstep, voffA); PG8_STAGE(PG8_SB(1, 1), cB + hstep + kstep, voffB);
        PG8_WAIT_V(6); PG8_BAR;
    }
    for (;;) {
        const bool has_next = S.next(ui + 1, nxt);
        const char* nA = has_next ? (const char*)g.A + (size_t)nxt.pm * tstep : cA; const char* nB = has_next ? (const char*)g.Bt + (size_t)nxt.pn * tstep : cB;
        for (int t = 0; t < nt; t += 2) {
            const bool last = (t == nt - 2);
            const char* a1 = cA + (size_t)(t + 1) * kstep;
            const char* a2 = last ? nA : cA + (size_t)(t + 2) * kstep; const char* b2 = last ? nB : cB + (size_t)(t + 2) * kstep;
            const char* a3 = a2 + kstep; const char* b3 = b2 + kstep;
            if (last && has_next) S.a_ready(nxt);
            if constexpr (SP2) {
            PG8_LDB(B0, 0, 0); PG8_LDB(B1, 0, 1); PG8_SCHED; PG8_LDA(At, 0, 0); PG8_STAGE(PG8_SA(1, 1), a1 + hstep, voffA);
            PG8_WAIT_V(8); PG8_WAIT_L(0); PG8_BAR; PG8_MMA(0, 0, At, B0); PG8_MMA(0, 1, At, B1); PG8_BAR; PG8_SCHED;
            PG8_LDA(At, 0, 1); PG8_STAGE(PG8_SB(0, 0), b2, voffB); PG8_STAGE(PG8_SB(0, 1), b2 + hstep, voffB); PG8_STAGE(PG8_SA(0, 0), a2, voffA);
            PG8_WAIT_V(8); PG8_WAIT_L(0); PG8_BAR; PG8_MMA(1, 0, At, B0); PG8_MMA(1, 1, At, B1); PG8_BAR; PG8_SCHED;
            PG8_LDB(B0, 1, 0); PG8_LDB(B1, 1, 1); PG8_SCHED; PG8_LDA(At, 1, 0); PG8_STAGE(PG8_SA(0, 1), a2 + hstep, voffA);
            PG8_WAIT_V(8); PG8_WAIT_L(0); PG8_BAR; PG8_MMA(0, 0, At, B0); PG8_MMA(0, 1, At, B1); PG8_BAR; PG8_SCHED;
            PG8_LDA(At, 1, 1); PG8_STAGE(PG8_SB(1, 0), b3, voffB); PG8_STAGE(PG8_SB(1, 1), b3 + hstep, voffB); PG8_STAGE(PG8_SA(1, 0), a3, voffA);
            PG8_WAIT_V(8); PG8_WAIT_L(0); PG8_BAR; PG8_MMA(1, 0, At, B0); PG8_MMA(1, 1, At, B1); PG8_BAR; PG8_SCHED;
            } else {
            PG8_LDB(B0, 0, 0); PG8_SCHED; PG8_LDA(At, 0, 0); PG8_STAGE(PG8_SA(1, 1), a1 + hstep, voffA);
            PG8_WAIT_L(8); PG8_BAR; PG8_WAIT_L(0); PG8_MMA(0, 0, At, B0); PG8_BAR; PG8_SCHED;
            PG8_LDB(B1, 0, 1); PG8_STAGE(PG8_SB(0, 0), b2, voffB);
            PG8_BAR; PG8_WAIT_L(0); PG8_MMA(0, 1, At, B1); PG8_BAR;
            PG8_LDA(At, 0, 1); PG8_STAGE(PG8_SA(0, 0), a2, voffA);
            PG8_BAR; PG8_WAIT_L(0); PG8_MMA(1, 0, At, B0); PG8_BAR; PG8_SCHED;
            PG8_STAGE(PG8_SB(0, 1), b2 + hstep, voffB);
            PG8_WAIT_V(6); PG8_BAR; PG8_MMA(1, 1, At, B1); PG8_BAR;
            PG8_LDB(B0, 1, 0); PG8_SCHED; PG8_LDA(At, 1, 0); PG8_STAGE(PG8_SA(0, 1), a2 + hstep, voffA);
            PG8_WAIT_L(8); PG8_BAR; PG8_WAIT_L(0); PG8_MMA(0, 0, At, B0); PG8_BAR; PG8_SCHED;
            PG8_LDB(B1, 1, 1); PG8_STAGE(PG8_SB(1, 0), b3, voffB);
            PG8_BAR; PG8_WAIT_L(0); PG8_MMA(0, 1, At, B1); PG8_BAR;
            PG8_LDA(At, 1, 1); PG8_STAGE(PG8_SA(1, 0), a3, voffA);
            PG8_BAR; PG8_WAIT_L(0); PG8_MMA(1, 0, At, B0); PG8_BAR; PG8_SCHED;
            PG8_STAGE(PG8_SB(1, 1), b3 + hstep, voffB);
            PG8_WAIT_V(6); PG8_BAR; PG8_MMA(1, 1, At, B1); PG8_BAR;
            }
        }
        if constexpr (ALIGN_EPI) { if (wr == 0) PG8_BAR; }
        if constexpr (!Epi::AFTER_DRAIN) { E(acc, cur, wr, wc, fr, fq); S.done(cur); }
        if (!has_next) break;
#pragma unroll
        for (int a = 0; a < 2; ++a)
#pragma unroll
            for (int b = 0; b < 2; ++b)
#pragma unroll
                for (int m = 0; m < 4; ++m)
#pragma unroll
                    for (int n = 0; n < 2; ++n) acc[a][b][m][n] = (f32x4){0.f, 0.f, 0.f, 0.f};
        cur = nxt; cA = nA; cB = nB; ++ui;
        if constexpr (ALIGN_EPI) { if (wr == 1) PG8_BAR; }
    }
    PG8_WAIT_V(0);
    if constexpr (!ALIGN_EPI) { if (wr == 0) PG8_BAR; }
    PG8_BAR;
#undef PG8_SA
#undef PG8_SB
#undef PG8_STAGE
#undef PG8_LDA
#undef PG8_LDB
#undef PG8_MMA
#undef PG8_WAIT_V
#undef PG8_WAIT_L
#undef PG8_BAR
#undef PG8_SCHED
}
}

namespace att {
typedef unsigned short bf16;
using bf16x8 = __attribute__((ext_vector_type(8))) short;
using s16x4  = __attribute__((ext_vector_type(4))) short;
using f32x16 = __attribute__((ext_vector_type(16))) float;
using u32x4  = __attribute__((ext_vector_type(4))) unsigned;
constexpr int D = 128, NW = 8, QBLK = 32, KVBLK = 64;
constexpr float SCALE = 0.088388347648318440f;
constexpr float THR = 8.f;
constexpr int LDQ = 2048, LDK = 128, LDO = 2048;
constexpr int SHM_V = KVBLK * D * 2, SHM_K = KVBLK * D * 2, SHM_ATTN = 2 * SHM_V + 2 * SHM_K + NW * 64 * 4;
#define KSWZ(row, colB) ((row) * 256 + ((colB) ^ (((row) & 7) << 4)))
#define SBAR() __builtin_amdgcn_sched_barrier(0)
__device__ __forceinline__ int crow(int r, int hi) { return (r & 3) + 8 * (r >> 2) + 4 * hi; }
__device__ __forceinline__ unsigned cvtpk(float lo, float hi) { unsigned r; asm volatile("v_cvt_pk_bf16_f32 %0, %1, %2" : "=v"(r) : "v"(lo), "v"(hi)); return r; }

__device__ __forceinline__ void partialSM(f32x16& p0, f32x16& p1, float& m_reg, float& mn, float& alpha, bool fixedm) {
  constexpr float C = SCALE * 1.4426950408889634f;
  if (fixedm) { mn = m_reg; alpha = 1.f; }
  else {
  float pmax = p0[0]; for (int r = 1; r < 16; ++r) pmax = fmaxf(pmax, p0[r]); for (int r = 0; r < 16; ++r) pmax = fmaxf(pmax, p1[r]);
  { auto rr = __builtin_amdgcn_permlane32_swap(__float_as_uint(pmax), __float_as_uint(pmax), false, false);
    pmax = fmaxf(__uint_as_float(rr[0]), __uint_as_float(rr[1])); }
  if (__builtin_expect(__all(pmax - m_reg <= THR / SCALE), 1)) { mn = m_reg; alpha = 1.f; }
  else { mn = fmaxf(m_reg, pmax); alpha = __builtin_amdgcn_exp2f((m_reg - mn) * C); m_reg = mn; }
  }
  float mnC = -mn * C;
  for (int r = 0; r < 16; ++r) p0[r] = fmaf(p0[r], C, mnC); for (int r = 0; r < 16; ++r) p1[r] = fmaf(p1[r], C, mnC);
  for (int r = 0; r < 16; ++r) p0[r] = __builtin_amdgcn_exp2f(p0[r]);
}
__device__ __forceinline__ void finishSM(f32x16& p0, f32x16& p1, float alpha, float& l_reg, bf16x8& pa0, bf16x8& pa1, bf16x8& pa2, bf16x8& pa3) {
  for (int r = 0; r < 16; ++r) p1[r] = __builtin_amdgcn_exp2f(p1[r]);
  float ps = 0; for (int r = 0; r < 16; ++r) ps += p0[r]; for (int r = 0; r < 16; ++r) ps += p1[r];
  { auto rr = __builtin_amdgcn_permlane32_swap(__float_as_uint(ps), __float_as_uint(ps), false, false);
    ps = __uint_as_float(rr[0]) + __uint_as_float(rr[1]); }
  l_reg = l_reg * alpha + ps;
#define PK4(P, BASE, OUT) do { unsigned a0 = cvtpk(P[BASE + 0], P[BASE + 1]), a1 = cvtpk(P[BASE + 2], P[BASE + 3]);   \
    unsigned b0 = cvtpk(P[BASE + 4], P[BASE + 5]), b1 = cvtpk(P[BASE + 6], P[BASE + 7]);                              \
    auto r0 = __builtin_amdgcn_permlane32_swap(a0, b0, false, false); auto r1 = __builtin_amdgcn_permlane32_swap(a1, b1, false, false); \
    u32x4 w = {r0[0], r1[0], r0[1], r1[1]}; OUT = *reinterpret_cast<bf16x8*>(&w); } while (0)
  PK4(p0, 0, pa0); PK4(p0, 8, pa1); PK4(p1, 0, pa2); PK4(p1, 8, pa3);
#undef PK4
}
__device__ __forceinline__ void qkt(f32x16& p0, f32x16& p1, const bf16* Ks, const bf16x8* qr, int r32, int hi) {
  p0 = f32x16{}; p1 = f32x16{};
  for (int d0 = 0; d0 < 8; ++d0) { int cb = (d0 * 16 + hi * 8) * 2;
    bf16x8 b0 = *reinterpret_cast<const bf16x8*>((const char*)Ks + KSWZ(r32, cb));
    bf16x8 b1 = *reinterpret_cast<const bf16x8*>((const char*)Ks + KSWZ(32 + r32, cb));
    p0 = __builtin_amdgcn_mfma_f32_32x32x16_bf16(b0, qr[d0], p0, 0, 0, 0);
    p1 = __builtin_amdgcn_mfma_f32_32x32x16_bf16(b1, qr[d0], p1, 0, 0, 0); }
}
__device__ __forceinline__ void wmask(f32x16& p0, f32x16& p1, int kb, int qpos) {
  const int dq = qpos - kb + 128;
#pragma unroll
  for (int r = 0; r < 16; ++r) { const int d = dq - ((r & 3) + 8 * (r >> 2));
    if ((unsigned)d > 256u) p0[r] = -INFINITY;
    if ((unsigned)(d - 32) > 256u) p1[r] = -INFINITY; }
}
__device__ __forceinline__ int v_st(int k, int c) { const int kk = (k & ~0xC) | ((k & 4) << 1) | ((k & 8) >> 1); return ((kk >> 3) * 4 + (c >> 5)) * 512 + ((kk & 7) * 32 + (c & 31)) * 2; }
__device__ __forceinline__ int v_rd_base(int lane) { return ((lane & 3) << 3) | (((lane >> 2) & 3) << 6) | (((lane >> 4) & 1) << 5) | (((lane >> 5) & 1) << 8); }
constexpr int v_rd_off(int d0, int ks, int half) { return d0 * 512 + ks * 4096 + half * 2048; }
template <int OFF> __device__ __forceinline__ s16x4 tr_read(int vb) {
  s16x4 r; asm volatile("ds_read_b64_tr_b16 %0, %1 offset:%2" : "=&v"(r) : "v"(vb), "i"(OFF) : "memory"); return r;
}
template <int D0> __device__ __forceinline__ void pv_one(f32x16& od, int vb, bf16x8 pa0, bf16x8 pa1, bf16x8 pa2, bf16x8 pa3) {
  const s16x4 l0 = tr_read<v_rd_off(D0, 0, 0)>(vb), h0 = tr_read<v_rd_off(D0, 0, 1)>(vb), l1 = tr_read<v_rd_off(D0, 1, 0)>(vb), h1 = tr_read<v_rd_off(D0, 1, 1)>(vb);
  const s16x4 l2 = tr_read<v_rd_off(D0, 2, 0)>(vb), h2 = tr_read<v_rd_off(D0, 2, 1)>(vb), l3 = tr_read<v_rd_off(D0, 3, 0)>(vb), h3 = tr_read<v_rd_off(D0, 3, 1)>(vb);
  asm volatile("s_waitcnt lgkmcnt(0)" ::: "memory"); SBAR();
#define PK(L, H) (bf16x8){L[0], L[1], L[2], L[3], H[0], H[1], H[2], H[3]}
  od = __builtin_amdgcn_mfma_f32_32x32x16_bf16(pa0, PK(l0, h0), od, 0, 0, 0);
  od = __builtin_amdgcn_mfma_f32_32x32x16_bf16(pa1, PK(l1, h1), od, 0, 0, 0);
  od = __builtin_amdgcn_mfma_f32_32x32x16_bf16(pa2, PK(l2, h2), od, 0, 0, 0);
  od = __builtin_amdgcn_mfma_f32_32x32x16_bf16(pa3, PK(l3, h3), od, 0, 0, 0);
#undef PK
}
__device__ __forceinline__ void pv_d0(f32x16* o, int vb, bf16x8 pa0, bf16x8 pa1, bf16x8 pa2, bf16x8 pa3) {
  pv_one<0>(o[0], vb, pa0, pa1, pa2, pa3); pv_one<1>(o[1], vb, pa0, pa1, pa2, pa3); pv_one<2>(o[2], vb, pa0, pa1, pa2, pa3); pv_one<3>(o[3], vb, pa0, pa1, pa2, pa3);
}

__device__ __forceinline__ void attn_unit(const bf16* __restrict__ Qb, const bf16* __restrict__ Kh, const bf16* __restrict__ Vh, bf16* Ob,
                                          int NT, int nctx, int jlo, int q0, bool masked, float sinkl2, float kbound, char* lds) {
  const int tid = threadIdx.x, wid = tid >> 6, lane = tid & 63, r32 = lane & 31, hi = lane >> 5;
  bf16* V_lds = (bf16*)lds; bf16* K_lds = (bf16*)(lds + 2 * SHM_V);
  float* ws = (float*)(lds + 2 * SHM_V + 2 * SHM_K) + wid * 64; float* li_l = ws; float* al_l = ws + 32;
  float m_reg = -1e30f, l_reg = 0; f32x16 o[4] = {}; bf16x8 qr[8];
  const bf16* Qw = Qb + (long)(wid * QBLK + r32) * LDQ + hi * 8;
#pragma unroll
  for (int d0 = 0; d0 < 8; ++d0) qr[d0] = *reinterpret_cast<const bf16x8*>(Qw + d0 * 16);
  const bool fixedm = kbound > 0.f;
  if (fixedm) { float ss = 0.f;
#pragma unroll
    for (int d0 = 0; d0 < 8; ++d0)
#pragma unroll
      for (int e = 0; e < 8; ++e) { const float qv = __uint_as_float(((unsigned)(unsigned short)qr[d0][e]) << 16); ss += qv * qv; }
    { auto rr = __builtin_amdgcn_permlane32_swap(__float_as_uint(ss), __float_as_uint(ss), false, false); ss = __uint_as_float(rr[0]) + __uint_as_float(rr[1]); }
    m_reg = sqrtf(ss) * kbound; }
  const int sr = tid >> 4, sc = (tid & 15) * 8, vst0 = v_st(sr, sc), vst1 = v_st(32 + sr, sc);
  const int vb0 = (int)(uintptr_t)V_lds + v_rd_base(lane);
  const int qpos = q0 + wid * QBLK + r32;
  struct { bf16x8 vs0, vs1, ks0, ks1; } sr_[2];
#define KOF(t) (((t) < nctx) ? (4096 + 64 * (t)) : 64 * (jlo + (t) - nctx))
#define SLOAD(i, k0) do { const int k0_ = (k0); sr_[i].vs0 = *reinterpret_cast<const bf16x8*>(&Vh[(long)(k0_ + sr) * LDK + sc]); sr_[i].vs1 = *reinterpret_cast<const bf16x8*>(&Vh[(long)(k0_ + 32 + sr) * LDK + sc]); \
    sr_[i].ks0 = *reinterpret_cast<const bf16x8*>(&Kh[(long)(k0_ + sr) * LDK + sc]); sr_[i].ks1 = *reinterpret_cast<const bf16x8*>(&Kh[(long)(k0_ + 32 + sr) * LDK + sc]); } while (0)
#define SWRITE(b, i) do { *(bf16x8*)((char*)V_lds + (b) * SHM_V + vst0) = sr_[i].vs0;          \
    *(bf16x8*)((char*)V_lds + (b) * SHM_V + vst1) = sr_[i].vs1; int kc = sc * 2;               \
    *(bf16x8*)((char*)K_lds + (b) * SHM_K + KSWZ(sr, kc)) = sr_[i].ks0;                       \
    *(bf16x8*)((char*)K_lds + (b) * SHM_K + KSWZ(32 + sr, kc)) = sr_[i].ks1; } while (0)
#define SWAIT() asm volatile("s_waitcnt vmcnt(4)" ::: "memory")
#define RESC(a) do { if (__any((a) < 1.f)) { if (hi == 0) al_l[r32] = (a); asm volatile("s_waitcnt lgkmcnt(0)" ::: "memory"); \
    for (int d = 0; d < 4; ++d) for (int r = 0; r < 16; ++r) o[d][r] *= al_l[crow(r, hi)]; } } while (0)
#define MASK(P0, P1, t) do { if (masked && (t) >= nctx) wmask(P0, P1, KOF(t) + 4 * hi, qpos); } while (0)
  f32x16 pA0, pA1, pB0, pB1; float mnA, mnB, alA, alB; bf16x8 pa0, pa1, pa2, pa3;
  constexpr int SE = 0, SO = 1;
  SLOAD(SE, KOF(0)); SLOAD(SO, KOF(1)); SWAIT(); SWRITE(0, SE); __syncthreads();
  if (2 < NT) SLOAD(SE, KOF(2));
  qkt(pA0, pA1, K_lds, qr, r32, hi); MASK(pA0, pA1, 0); partialSM(pA0, pA1, m_reg, mnA, alA, fixedm);
  SWAIT(); SWRITE(1, SO); __syncthreads();
  for (int j = 1; j + 1 < NT; j += 2) {
    SBAR(); qkt(pB0, pB1, (bf16*)((char*)K_lds + SHM_K), qr, r32, hi);
    finishSM(pA0, pA1, alA, l_reg, pa0, pa1, pa2, pa3); SBAR();
    SLOAD(SO, KOF(j + 2)); SBAR();
    pv_d0(o, vb0, pa0, pa1, pa2, pa3); MASK(pB0, pB1, j); partialSM(pB0, pB1, m_reg, mnB, alB, fixedm);
    __syncthreads(); SWAIT(); SWRITE(0, SE);
    RESC(alB); __syncthreads();
    SBAR(); qkt(pA0, pA1, K_lds, qr, r32, hi);
    finishSM(pB0, pB1, alB, l_reg, pa0, pa1, pa2, pa3); SBAR();
    if (j + 3 < NT) SLOAD(SE, KOF(j + 3)); SBAR();
    pv_d0(o, vb0 + (int)SHM_V, pa0, pa1, pa2, pa3); MASK(pA0, pA1, j + 1); partialSM(pA0, pA1, m_reg, mnA, alA, fixedm);
    __syncthreads(); SWAIT(); SWRITE(1, SO);
    RESC(alA); __syncthreads();
  }
  SBAR(); qkt(pB0, pB1, (bf16*)((char*)K_lds + SHM_K), qr, r32, hi);
  finishSM(pA0, pA1, alA, l_reg, pa0, pa1, pa2, pa3); SBAR();
  pv_d0(o, vb0, pa0, pa1, pa2, pa3); MASK(pB0, pB1, NT - 1); partialSM(pB0, pB1, m_reg, mnB, alB, fixedm);
  __syncthreads(); RESC(alB);
  finishSM(pB0, pB1, alB, l_reg, pa0, pa1, pa2, pa3); SBAR();
  pv_d0(o, vb0 + (int)SHM_V, pa0, pa1, pa2, pa3);
  l_reg += __builtin_amdgcn_exp2f(sinkl2 - m_reg * (SCALE * 1.4426950408889634f));
  if (hi == 0) li_l[r32] = l_reg; asm volatile("s_waitcnt lgkmcnt(0)" ::: "memory");
  float rli[16];
#pragma unroll
  for (int r = 0; r < 16; ++r) rli[r] = __builtin_amdgcn_rcpf(li_l[crow(r, hi)]);
  __syncthreads();
  { char* stg = lds + wid * 8192 + (4 * hi * 128 + r32) * 2;
#pragma unroll
    for (int r = 0; r < 16; ++r) {
#pragma unroll
      for (int d0 = 0; d0 < 4; ++d0) { const float v = o[d0][r] * rli[r]; *(bf16*)(stg + ((r & 3) + 8 * (r >> 2)) * 256 + d0 * 64) = (bf16)(cvtpk(v, v) & 0xffffu); }
      asm volatile("" ::: "memory"); }
    asm volatile("s_waitcnt lgkmcnt(0)" ::: "memory");
    bf16* Ow = Ob + (long)(wid * QBLK + (lane >> 4)) * LDO + (lane & 15) * 8;
    const char* rd = lds + wid * 8192 + (lane >> 4) * 256 + (lane & 15) * 16;
#pragma unroll
    for (int i = 0; i < 8; ++i) { const u32x4 v = *(const u32x4*)(rd + i * 1024); *(u32x4*)(Ow + (long)i * 4 * LDO) = v; } }
  __syncthreads();
#undef KOF
#undef SLOAD
#undef SWRITE
#undef SWAIT
#undef RESC
#undef MASK
}
#undef KSWZ
#undef SBAR
}

constexpr int NWAVES = 8;
constexpr int N_LAUNCHES = MK_N_LAUNCHES;
constexpr int N_PHASES = 10;
constexpr int DM = 2048, NB = 4, SEQ = 4096, CTXL = 256, FFN = 5632, INW = 3072, NMOD = 12288;
constexpr int M = NB * SEQ, MC = NB * CTXL, MU = M + MC;
constexpr int SKV = SEQ + CTXL;
constexpr float LN_EPS = 1e-6f;
constexpr float DN_ALPHA = 1.189207115002721f;

constexpr size_t MiB = 1u << 20;
constexpr size_t WS_CTL = 0, CTL_ZERO_BYTES = 64 * 1024;
constexpr size_t WS_MODP = 1 * MiB;
constexpr size_t WS_MODS = 2 * MiB;
constexpr size_t WS_ROPE = 2 * MiB + 512 * 1024;
constexpr size_t WS_WIN = 3 * MiB, WS_WOUT = 15 * MiB, WS_WGU = 23 * MiB, WS_WDN = 67 * MiB;
constexpr size_t WS_U = 89 * MiB;
constexpr size_t WS_Y = 157 * MiB;
constexpr size_t WS_QO = 285 * MiB;
constexpr size_t WS_KV = 349 * MiB;
constexpr size_t KV_BYTES = (size_t)NB * 2 * SKV * 128 * 2;
constexpr size_t WS_H = 285 * MiB;
constexpr size_t WS_END = 461 * MiB;
static_assert(WS_WIN + (size_t)INW * DM * 2 <= WS_WOUT && WS_WOUT + (size_t)DM * DM * 2 <= WS_WGU && WS_WGU + (size_t)2 * FFN * DM * 2 <= WS_WDN && WS_WDN + (size_t)DM * FFN * 2 <= WS_U, "ws map (weights)");
static_assert(WS_U + (size_t)MU * DM * 2 <= WS_Y && WS_Y + (size_t)M * DM * 4 <= WS_QO && WS_QO + (size_t)M * DM * 2 <= WS_KV && WS_KV + 4 * KV_BYTES <= WS_END && WS_H + (size_t)M * FFN * 2 <= WS_END, "ws map");
constexpr int CW_BAR = 4096;

constexpr int RING_OFF = 0, RING_BYTES = 131072;
constexpr int LDSCTL_OFF = RING_BYTES, MISC_OFF = LDSCTL_OFF + 320;
constexpr int XCH_OFF = RING_BYTES + 1024;
constexpr int LDS_BYTES = 147456;
static_assert(XCH_OFF + 4096 <= LDS_BYTES, "LDS map");

#define GAS __attribute__((address_space(1)))
#define LAS __attribute__((address_space(3)))
typedef unsigned short bf16;
typedef unsigned v4u __attribute__((ext_vector_type(4)));
typedef float f32x4 __attribute__((ext_vector_type(4)));
typedef GAS unsigned gu32;
#define RLX_AGENT __ATOMIC_RELAXED, __HIP_MEMORY_SCOPE_AGENT
#define LDS_WAIT() asm volatile("s_waitcnt lgkmcnt(0)" ::: "memory")
#define VM_WAIT() asm volatile("s_waitcnt vmcnt(0)" ::: "memory")
__device__ __forceinline__ unsigned f2bf(float f) { unsigned u = __builtin_bit_cast(unsigned, f); return (u + 0x7fffu + ((u >> 16) & 1u)) >> 16; }
__device__ __forceinline__ unsigned pk2(float lo, float hi) { return f2bf(lo) | (f2bf(hi) << 16); }

#define XB_TMO      128
#define XB_XCNT(j)  (256  + 64 * (j))
#define XB_XSUB(j)  (1280 + 64 * (j))
#define XB_XGEN(j)  (2304 + 64 * (j))
#define XB_TOP      3328
#define XB_TOPGEN   3392
#define XCD_BAR_WORDS 3456
#define XB_SPIN_CAP (1u << 18)
__device__ __forceinline__ unsigned xb_ld(unsigned* p)              { return __hip_atomic_load(p, __ATOMIC_RELAXED, __HIP_MEMORY_SCOPE_AGENT); }
__device__ __forceinline__ unsigned xb_add(unsigned* p, unsigned v) { return __hip_atomic_fetch_add(p, v, __ATOMIC_RELAXED, __HIP_MEMORY_SCOPE_AGENT); }
__device__ __forceinline__ unsigned xb_xcc_id() { return (unsigned)__builtin_amdgcn_s_getreg((3 << 11) | 20) & 0xFu; }
#define XB_SPIN(cond, bar) do { unsigned _sp = 0; while (cond) { __builtin_amdgcn_s_sleep(1); \
    if ((++_sp & 255u) == 0u) { if (xb_ld(&(bar)[XB_TMO])) break; if (_sp > XB_SPIN_CAP) { atomicAdd(&(bar)[XB_TMO], 1u); break; } } } } while (0)
struct XcdBarrier { unsigned* bar; unsigned x; volatile LAS unsigned* st; };
__device__ __forceinline__ XcdBarrier xcd_barrier_post(unsigned* bar, volatile LAS unsigned* st) {
    XcdBarrier b; b.bar = bar; b.x = xb_xcc_id(); b.st = st;
    if (threadIdx.x == 0) (void)xb_add(&bar[XB_XCNT(b.x)], 1u);
    return b;
}
__device__ __forceinline__ void xcd_barrier_complete(unsigned* bar, unsigned x, unsigned& nloc, unsigned& nx) {
    const unsigned G = gridDim.x * gridDim.y * gridDim.z;
    unsigned sum, cnt, mine, sp = 0u;
    for (;;) {
        sum = 0u; cnt = 0u; mine = 0u;
#pragma unroll
        for (unsigned j = 0; j < 16; ++j) { const unsigned c = xb_ld(&bar[XB_XCNT(j)]); sum += c; cnt += (c > 0u) ? 1u : 0u; mine = (j == x) ? c : mine; }
        if (sum == G) break;
        __builtin_amdgcn_s_sleep(1);
        if ((++sp & 255u) == 0u) { if (xb_ld(&bar[XB_TMO])) break; if (sp > XB_SPIN_CAP) { atomicAdd(&bar[XB_TMO], 1u); break; } }
    }
    nloc = mine > 0u ? mine : 1u; nx = cnt > 0u ? cnt : 1u;
}
__device__ __forceinline__ void xcd_barrier(const XcdBarrier& b) {
    asm volatile("s_waitcnt vmcnt(0)" ::: "memory");
    __syncthreads();
    if (threadIdx.x == 0) {
        unsigned* bar = b.bar;
        __builtin_amdgcn_s_waitcnt(0);
        unsigned nloc = b.st[0], nx = b.st[1];
        if (nloc == 0u) { xcd_barrier_complete(bar, b.x, nloc, nx); b.st[0] = nloc; b.st[1] = nx; }
        const unsigned old = xb_add(&bar[XB_XSUB(b.x)], 1u);
        const unsigned gen = old / nloc;
        if (old + 1u == (gen + 1u) * nloc) {
            __builtin_amdgcn_fence(__ATOMIC_RELEASE, "agent");
            asm volatile("s_waitcnt vmcnt(0)" ::: "memory");
            const unsigned og = xb_add(&bar[XB_TOP], 1u);
            const unsigned tg = og / nx;
            if (og + 1u == (tg + 1u) * nx) xb_add(&bar[XB_TOPGEN], 1u);
            else XB_SPIN(xb_ld(&bar[XB_TOPGEN]) == tg, bar);
            __builtin_amdgcn_fence(__ATOMIC_ACQUIRE, "agent");
            xb_add(&bar[XB_XGEN(b.x)], 1u);
            asm volatile("s_waitcnt vmcnt(0)" ::: "memory");
        } else {
            XB_SPIN(xb_ld(&bar[XB_XGEN(b.x)]) == gen, bar);
            __builtin_amdgcn_fence(__ATOMIC_ACQUIRE, "agent");
            asm volatile("s_waitcnt vmcnt(0)" ::: "memory");
        }
    }
    __syncthreads();
}

__device__ __forceinline__ float wave_sum(float v) {
#pragma unroll
    for (int o = 1; o < 64; o <<= 1) v += __shfl_xor(v, o);
    return v;
}
__device__ __forceinline__ void transpose_item(const float* W, int ldw, int k0, int n0, bf16* WT, int Kd, int dst_row0, LAS float* scr, int lane) {
#pragma unroll 8
    for (int i = 0; i < 32; ++i) { const int kk = 2 * i + (lane >> 5); scr[kk * 33 + (lane & 31)] = W[(size_t)(k0 + kk) * ldw + n0 + (lane & 31)]; }
    LDS_WAIT(); asm volatile("" ::: "memory");
    const int c = lane & 7;
#pragma unroll
    for (int j = 0; j < 4; ++j) { const int n = (lane >> 3) + 8 * j; const LAS float* s = scr + (8 * c) * 33 + n;
        v4u o; o.x = pk2(s[0 * 33], s[1 * 33]); o.y = pk2(s[2 * 33], s[3 * 33]); o.z = pk2(s[4 * 33], s[5 * 33]); o.w = pk2(s[6 * 33], s[7 * 33]);
        *(GAS v4u*)(WT + (size_t)(dst_row0 + n) * Kd + k0 + 8 * c) = o; }
    LDS_WAIT(); asm volatile("" ::: "memory");
}
__device__ __forceinline__ float silu_f(float x) { return x / (1.0f + __expf(-x)); }

struct Args { const float* in[18]; float* out; unsigned char* ws; int ph_lo, ph_hi, li, flags; };

__device__ __forceinline__ void modulate_row(const float* xrow, bf16* orow, const LAS float* p0, const LAS float* p1, int lane) {
    const GAS f32x4* xr = (const GAS f32x4*)xrow + lane;
    GAS unsigned long long* o8 = (GAS unsigned long long*)orow + lane;
    f32x4 v[8];
#pragma unroll
    for (int j = 0; j < 8; ++j) v[j] = xr[64 * j];
#pragma unroll
    for (int j = 0; j < 8; ++j) { const f32x4 a = *(const LAS f32x4*)(p0 + 256 * j + 4 * lane), s = *(const LAS f32x4*)(p1 + 256 * j + 4 * lane); const f32x4 r = v[j] * a + s;
        o8[64 * j] = (unsigned long long)pk2(r.x, r.y) | ((unsigned long long)pk2(r.z, r.w) << 32); }
}
typedef unsigned u32x2 __attribute__((ext_vector_type(2)));
__device__ __forceinline__ f32x4 bf4_to_f32(u32x2 w) { f32x4 r; r.x = __uint_as_float(w.x << 16); r.y = __uint_as_float(w.x & 0xffff0000u); r.z = __uint_as_float(w.y << 16); r.w = __uint_as_float(w.y & 0xffff0000u); return r; }
__device__ __forceinline__ void ln_regs(f32x4 (&v)[8], const LAS float* g, const LAS float* bb, int lane) {
    float s = 0.f;
#pragma unroll
    for (int j = 0; j < 8; ++j) s += (v[j].x + v[j].y) + (v[j].z + v[j].w);
    const float mean = wave_sum(s) * (1.f / DM); float s2 = 0.f;
#pragma unroll
    for (int j = 0; j < 8; ++j) { v[j] = v[j] - mean; s2 += (v[j].x * v[j].x + v[j].y * v[j].y) + (v[j].z * v[j].z + v[j].w * v[j].w); }
    const float rstd = __builtin_amdgcn_rsqf(wave_sum(s2) * (1.f / DM) + LN_EPS);
#pragma unroll
    for (int j = 0; j < 8; ++j) { const int c = 256 * j + 4 * lane; v[j] = v[j] * rstd * *(const LAS f32x4*)(g + c) + *(const LAS f32x4*)(bb + c); }
}
__device__ __forceinline__ void x1_row(f32x4 (&v)[8], const float* xrow, const bf16* arow, const LAS float* P, int lane) {
    const GAS f32x4* xr = (const GAS f32x4*)xrow + lane; const GAS u32x2* ar = (const GAS u32x2*)arow + lane;
    u32x2 aw[8];
#pragma unroll
    for (int j = 0; j < 8; ++j) { v[j] = xr[64 * j]; aw[j] = ar[64 * j]; }
#pragma unroll
    for (int j = 0; j < 8; ++j) v[j] = v[j] * DN_ALPHA + *(const LAS f32x4*)(P + 256 * j + 4 * lane) * bf4_to_f32(aw[j]);
    ln_regs(v, P + 2048, P + 4096, lane);
}

__global__ void __launch_bounds__(NWAVES * 64, 2) dit_fwd(Args args) {
    extern __shared__ __attribute__((aligned(16))) unsigned char lds[];
    LAS unsigned char* L = (LAS unsigned char*)lds;
    volatile LAS unsigned* MISC = (volatile LAS unsigned*)(L + MISC_OFF);
    const int tid = threadIdx.x, lane = tid & 63, wave = __builtin_amdgcn_readfirstlane(tid >> 6);
    const int G = gridDim.x, bx = blockIdx.x;
    unsigned char* ws = args.ws;
    gu32* ctl = (gu32*)(ws + WS_CTL);
    const float* x = args.in[0]; const float* cvec = args.in[1]; const float* ctx = args.in[2]; const float* c_ctx = args.in[3];
    const float* w_ada = args.in[4]; const float* b_ada = args.in[5]; const float* w_in = args.in[6]; const float* qng = args.in[7]; const float* kng = args.in[8];
    const float* sink = args.in[9]; const float* w_out = args.in[10]; const float* ln1g = args.in[11]; const float* ln1b = args.in[12];
    const float* w_gate = args.in[13]; const float* w_up = args.in[14]; const float* w_down = args.in[15]; const float* ln2g = args.in[16]; const float* ln2b = args.in[17];
    float* MODP = (float*)(ws + WS_MODP); float* MODS = (float*)(ws + WS_MODS); float* ROPEC = (float*)(ws + WS_ROPE); float* ROPES = ROPEC + 2048;
    bf16* WIN = (bf16*)(ws + WS_WIN); bf16* WOUT = (bf16*)(ws + WS_WOUT); bf16* WGU = (bf16*)(ws + WS_WGU); bf16* WDN = (bf16*)(ws + WS_WDN);
    bf16* U = (bf16*)(ws + WS_U); bf16* AB = (bf16*)(ws + WS_Y); bf16* DB = (bf16*)(ws + WS_Y + 64 * MiB); bf16* QO = (bf16*)(ws + WS_QO);
    bf16* KA = (bf16*)(ws + WS_KV); bf16* VA = (bf16*)(ws + WS_KV + KV_BYTES); bf16* KB = (bf16*)(ws + WS_KV + 2 * KV_BYTES); bf16* VB = (bf16*)(ws + WS_KV + 3 * KV_BYTES);
    bf16* HB = (bf16*)(ws + WS_H);

    for (int u = tid; u < (LDS_BYTES - LDSCTL_OFF) / 4; u += NWAVES * 64) ((LAS unsigned*)(L + LDSCTL_OFF))[u] = 0u;
    __syncthreads();
    XcdBarrier bar; bar.bar = (unsigned*)(ctl + CW_BAR); bar.x = 0; bar.st = nullptr;
    if (N_LAUNCHES == 1) bar = xcd_barrier_post((unsigned*)(ctl + CW_BAR), MISC + 8);
#define GRID_BAR() do { if (N_LAUNCHES == 1) xcd_barrier(bar); } while (0)
    const int lo = args.ph_lo, hi = args.ph_hi;
#ifndef PHMASK
#define PHMASK 0x3FF
#endif
#define IN(k) (((PHMASK >> (k)) & 1) && lo <= (k) && (k) < hi)
#define BOTH(k) (IN(k) && IN((k) + 1))

    if (IN(0)) {
        if (bx < 192) {
            const int cb = bx >> 2, kq = bx & 3, k0 = kq * 512 + wave * 64;
            float sv[5];
#pragma unroll
            for (int b = 0; b < 4; ++b) sv[b] = silu_f(cvec[b * DM + k0 + lane]);
            sv[4] = silu_f(c_ctx[k0 + lane]);
            f32x4 acc[5];
#pragma unroll
            for (int b = 0; b < 5; ++b) acc[b] = (f32x4){0.f, 0.f, 0.f, 0.f};
            const float* wp = w_ada + (size_t)k0 * NMOD + cb * 256 + lane * 4;
#pragma unroll 16
            for (int kk = 0; kk < 64; ++kk) { const f32x4 wv = *(const f32x4*)(wp + (size_t)kk * NMOD);
#pragma unroll
                for (int b = 0; b < 5; ++b) { const float s = __builtin_bit_cast(float, __builtin_amdgcn_readlane(__builtin_bit_cast(int, sv[b]), kk)); acc[b] += wv * s; } }
            LAS f32x4* red = (LAS f32x4*)(L + RING_OFF);
#pragma unroll
            for (int b = 0; b < 5; ++b) red[(wave * 5 + b) * 64 + lane] = acc[b];
            LDS_WAIT(); __syncthreads();
            if (tid < 320) { const int b = tid >> 6, l = tid & 63; f32x4 s = red[b * 64 + l];
#pragma unroll
                for (int w = 1; w < 8; ++w) s += red[(w * 5 + b) * 64 + l];
                *(f32x4*)(MODP + ((size_t)kq * 5 + b) * NMOD + cb * 256 + l * 4) = s; }
            __syncthreads();
        }
        if (bx == 255) {
            for (int e = tid; e < 2048; e += NWAVES * 64) { const int pos = e >> 5, f = e & 31;
                const float inv = exp2f(-(float)f * (13.287712379549449f / 32.0f)); const float ang = (float)pos * inv;
                float sn, cs; sincosf(ang, &sn, &cs); ROPEC[e] = cs; ROPES[e] = sn; }
        }
        {
            LAS float* scr = (LAS float*)(L + RING_OFF + wave * 16384);
            constexpr int I_IN = 32 * 96, I_OUT = 32 * 64, I_G = 32 * 176, NITEMS = I_IN + I_OUT + I_G, NSLOT = 192 * 8 * 2 + 64 * 8 * 5;
            const int nsl = bx < 192 ? 2 : 5, sl0 = bx < 192 ? (bx * 8 + wave) * 2 : 3072 + ((bx - 192) * 8 + wave) * 5;
            for (int s = 0; s < nsl; ++s)
                for (int it = sl0 + s; it < NITEMS; it += NSLOT) {
                    int r = it;
                    if (r < I_IN) { const int kb = r / 96, nb = r % 96, pn = nb >> 3, q = nb & 7, hh = q >> 2, part = (q >> 1) & 1, bj = q & 1;
                        transpose_item(w_in, INW, 64 * kb, 32 * nb, WIN, DM, 256 * pn + 32 * (4 * bj + 2 * hh + part), scr, lane); continue; } r -= I_IN;
                    if (r < I_OUT) { const int kb = r / 64, nb = r % 64; transpose_item(w_out, DM, 64 * kb, 32 * nb, WOUT, DM, 32 * nb, scr, lane); continue; } r -= I_OUT;
                    { const int kb = r / 176, nb = r % 176; transpose_item(w_gate, FFN, 64 * kb, 32 * nb, WGU, DM, 256 * (nb >> 2) + 32 * (nb & 3), scr, lane); }
                }
        }
        if (BOTH(0)) GRID_BAR();
    }

    if (IN(1)) {
        { const int idx = bx * 512 + tid;
          if (idx < 5 * NMOD) { float s = b_ada[idx % NMOD];
#pragma unroll
              for (int q = 0; q < 4; ++q) s += MODP[(size_t)q * 5 * NMOD + idx];
              MODS[idx] = s; } }
        if (bx < 128) {
            LAS float* P0 = (LAS float*)(L + RING_OFF); LAS float* P1 = P0 + 2048;
            for (int i = tid; i < 2048; i += NWAVES * 64) { float sh = b_ada[i], sc = b_ada[2048 + i];
#pragma unroll
                for (int q = 0; q < 4; ++q) { sh += MODP[((size_t)q * 5 + 4) * NMOD + i]; sc += MODP[((size_t)q * 5 + 4) * NMOD + 2048 + i]; }
                P0[i] = 1.0f + sc; P1[i] = sh; }
            LDS_WAIT(); __syncthreads();
            const int r = bx * 8 + wave;
            modulate_row(ctx + (size_t)r * DM, U + (size_t)(M + r) * DM, P0, P1, lane);
            __syncthreads();
        }
        if (BOTH(1)) GRID_BAR();
    }

    if (IN(2)) {
        if (bx < 16) {
            const int pnl[4] = {4, 5, 10, 11};
            pg8::Gemm g{U, WIN, MU, INW, DM}; pg8::OneUnit S{64 + (bx >> 2), (bx & 3) == 0 ? 4 : (bx & 3) == 1 ? 5 : (bx & 3) == 2 ? 10 : 11}; (void)pnl;
            pg8::EpiQKV E{QO, KA, VA, KB, VB, qng, kng, ROPEC, ROPES, (LAS float*)(L + XCH_OFF)};
            pg8::gemm_phase<pg8::EpiQKV, pg8::OneUnit, true, true>(L + RING_OFF, g, S, E);
        } else {
            LAS float* P0 = (LAS float*)(L + RING_OFF); LAS float* P1 = P0 + 2048;
            const int i = bx - 16, r0 = (int)(((long)i * M) / 240), r1 = (int)(((long)(i + 1) * M) / 240);
            int r = r0;
            while (r < r1) {
                const int b = r >> 12; int re = (b + 1) << 12; if (re > r1) re = r1;
                __syncthreads();
                for (int k = tid; k < 2048; k += NWAVES * 64) { P0[k] = 1.0f + MODS[b * NMOD + 2048 + k]; P1[k] = MODS[b * NMOD + k]; }
                LDS_WAIT(); __syncthreads();
                for (int rr = r + wave; rr < re; rr += NWAVES) modulate_row(x + (size_t)rr * DM, U + (size_t)rr * DM, P0, P1, lane);
                r = re;
            }
            __syncthreads();
            {
                LAS float* scr = (LAS float*)(L + RING_OFF + wave * 16384);
                constexpr int I_G = 32 * 176, I_D = 88 * 64, NITEMS2 = I_G + I_D;
                for (int it = i * 8 + wave; it < NITEMS2; it += 240 * 8) {
                    if (it < I_G) { const int kb = it / 176, nb = it % 176; transpose_item(w_up, FFN, 64 * kb, 32 * nb, WGU, DM, 256 * (nb >> 2) + 128 + 32 * (nb & 3), scr, lane); }
                    else { const int r2 = it - I_G, kb = r2 / 64, nb = r2 % 64; transpose_item(w_down, DM, 64 * kb, 32 * nb, WDN, FFN, 32 * nb, scr, lane); }
                }
            }
        }
        if (BOTH(2)) GRID_BAR();
    }

    if (IN(3)) {
        pg8::Gemm g{U, WIN, M, INW, DM}; pg8::StaticOrder S; S.init(M, INW, G, bx);
        pg8::EpiQKV E{QO, KA, VA, KB, VB, qng, kng, ROPEC, ROPES, (LAS float*)(L + XCH_OFF)};
        pg8::gemm_phase<pg8::EpiQKV, pg8::StaticOrder, true, true>(L + RING_OFF, g, S, E);
        if (BOTH(3)) GRID_BAR();
    }

    if (IN(4)) {
        const int xg = bx & 7, y = bx >> 3, b = xg >> 1, kvh = xg & 1;
        const size_t kvoff = (size_t)(b * 2 + kvh) * SKV * 128;
        float kbnd; { float gm = fmaxf(fabsf(kng[lane]), fabsf(kng[64 + lane]));
#pragma unroll
            for (int o = 1; o < 64; o <<= 1) gm = fmaxf(gm, __shfl_xor(gm, o));
            kbnd = gm * 11.313708498984761f * 1.01f; }
        for (int i = 0; i < 4; ++i) {
            const int uu = 2 * y + (i & 1), gq = uu >> 4, qb = uu & 15, q0 = qb * 256;
            const bool isA = i >= 2;
            const int head = kvh * 4 + gq;
            bf16* Qp = QO + (size_t)(b * SEQ + q0) * DM + (isA ? 0 : 1024) + head * 128;
            const int jlo = !isA ? 0 : ((q0 >> 6) - 2 < 0 ? 0 : (q0 >> 6) - 2), jhi = (q0 >> 6) + 6 > 64 ? 64 : (q0 >> 6) + 6;
            const int nctx = isA ? 4 : 0, NT = isA ? 4 + (jhi - jlo) : SKV / 64;
            const float sk = isA ? sink[head] * 1.4426950408889634f : -INFINITY;
            att::attn_unit(Qp, (isA ? KA : KB) + kvoff, (isA ? VA : VB) + kvoff, (args.flags & 1) ? (bf16*)(ws + 384 * MiB) + (Qp - QO) : Qp, NT, nctx, jlo, q0, isA, sk, isA ? -1.f : kbnd, (char*)lds + RING_OFF);
        }
        if (BOTH(4)) GRID_BAR();
    }

    if (IN(5)) {
        pg8::Gemm g{QO, WOUT, M, DM, DM}; pg8::StaticOrder S; S.init(M, DM, G, bx);
        pg8::EpiBf16Plain E{AB, DM};
        pg8::gemm_phase<pg8::EpiBf16Plain, pg8::StaticOrder, true, true>(L + RING_OFF, g, S, E);
        if (BOTH(5)) GRID_BAR();
    }

    if (IN(6)) {
        LAS float* P = (LAS float*)(L + RING_OFF);
        const int b = bx >> 6;
        for (int k = tid; k < 2048; k += NWAVES * 64) { P[k] = MODS[b * NMOD + 2 * 2048 + k]; P[2048 + k] = ln1g[k]; P[4096 + k] = ln1b[k]; P[6144 + k] = 1.0f + MODS[b * NMOD + 4 * 2048 + k]; P[8192 + k] = MODS[b * NMOD + 3 * 2048 + k]; }
        LDS_WAIT(); __syncthreads();
        for (int rr = bx * 64 + wave; rr < bx * 64 + 64; rr += NWAVES) {
            f32x4 v[8]; x1_row(v, x + (size_t)rr * DM, AB + (size_t)rr * DM, P, lane);
            GAS unsigned long long* o8 = (GAS unsigned long long*)(U + (size_t)rr * DM) + lane;
#pragma unroll
            for (int j = 0; j < 8; ++j) { const int c = 256 * j + 4 * lane; const f32x4 r = v[j] * *(const LAS f32x4*)(P + 6144 + c) + *(const LAS f32x4*)(P + 8192 + c);
                o8[64 * j] = (unsigned long long)pk2(r.x, r.y) | ((unsigned long long)pk2(r.z, r.w) << 32); }
        }
        __syncthreads();
        if (BOTH(6)) GRID_BAR();
    }

    if (IN(7)) {
        pg8::Gemm g{U, WGU, M, 2 * FFN, DM}; pg8::StaticOrder S; S.init(M, 2 * FFN, G, bx);
        pg8::EpiSwiglu E{HB, FFN};
        pg8::gemm_phase<pg8::EpiSwiglu, pg8::StaticOrder, true, true>(L + RING_OFF, g, S, E);
        if (BOTH(7)) GRID_BAR();
    }

    if (IN(8)) {
        pg8::Gemm g{HB, WDN, M, DM, FFN}; pg8::StaticOrder S; S.init(M, DM, G, bx);
        pg8::EpiBf16Plain E{DB, DM};
        pg8::gemm_phase<pg8::EpiBf16Plain, pg8::StaticOrder, true, true>(L + RING_OFF, g, S, E);
        if (BOTH(8)) GRID_BAR();
    }

    if (IN(9)) {
        LAS float* P = (LAS float*)(L + RING_OFF);
        const int b = bx >> 6;
        for (int k = tid; k < 2048; k += NWAVES * 64) { P[k] = MODS[b * NMOD + 2 * 2048 + k]; P[2048 + k] = ln1g[k]; P[4096 + k] = ln1b[k]; P[6144 + k] = MODS[b * NMOD + 5 * 2048 + k]; P[8192 + k] = ln2g[k]; P[10240 + k] = ln2b[k]; }
        LDS_WAIT(); __syncthreads();
        for (int rr = bx * 64 + wave; rr < bx * 64 + 64; rr += NWAVES) {
            f32x4 v[8]; x1_row(v, x + (size_t)rr * DM, AB + (size_t)rr * DM, P, lane);
            const GAS u32x2* dr = (const GAS u32x2*)(DB + (size_t)rr * DM) + lane;
#pragma unroll
            for (int j = 0; j < 8; ++j) v[j] = v[j] * DN_ALPHA + *(const LAS f32x4*)(P + 6144 + 256 * j + 4 * lane) * bf4_to_f32(dr[64 * j]);
            ln_regs(v, P + 8192, P + 10240, lane);
            GAS f32x4* orow = (GAS f32x4*)(args.out + (size_t)rr * DM) + lane;
#pragma unroll
            for (int j = 0; j < 8; ++j) orow[64 * j] = v[j];
        }
    }
#undef IN
#undef BOTH
#undef GRID_BAR
}

extern "C" void kernel_launch(void* const* d_in, const int* in_sizes, int n_in, void* d_out, int out_size, void* d_ws, size_t ws_size, hipStream_t stream) {
    static int grid = 0;
    if (grid == 0) {
        if (n_in != 18 || in_sizes[0] != M * DM || out_size != M * DM || ws_size < WS_END) {
            fprintf(stderr, "kernel_launch: shape mismatch (n_in %d, in0 %d, out %d, ws %zu; need ws >= %zu); nothing launched\n", n_in, n_in > 0 ? in_sizes[0] : -1, out_size, ws_size, (size_t)WS_END); grid = -1; return; }
        int dev = 0, cus = 0, per_cu = 0;
        if (hipGetDevice(&dev) != hipSuccess || hipDeviceGetAttribute(&cus, hipDeviceAttributeMultiprocessorCount, dev) != hipSuccess) { fprintf(stderr, "kernel_launch: device query failed\n"); grid = -1; return; }
        if (hipFuncSetAttribute((const void*)dit_fwd, hipFuncAttributeMaxDynamicSharedMemorySize, LDS_BYTES) != hipSuccess) { fprintf(stderr, "kernel_launch: hipFuncSetAttribute failed\n"); grid = -1; return; }
        if (hipOccupancyMaxActiveBlocksPerMultiprocessor(&per_cu, (const void*)dit_fwd, NWAVES * 64, LDS_BYTES) != hipSuccess || per_cu < 1)
            fprintf(stderr, "kernel_launch: note: occupancy query reports %d workgroups per CU\n", per_cu);
        (void)hipGetLastError();
        if (cus != 256) { fprintf(stderr, "kernel_launch: built for a 256-CU device, found %d CUs; nothing launched\n", cus); grid = -1; return; }
        grid = 256;
    }
    if (grid < 0) return;
    if (hipMemsetAsync((char*)d_ws + WS_CTL, 0, CTL_ZERO_BYTES, stream) != hipSuccess) { fprintf(stderr, "kernel_launch: hipMemsetAsync failed\n"); return; }
    Args a{};
    for (int i = 0; i < 18; ++i) a.in[i] = (const float*)d_in[i];
    a.out = (float*)d_out; a.ws = (unsigned char*)d_ws;
    if (N_LAUNCHES == 1) { a.ph_lo = 0; a.ph_hi = N_PHASES; a.li = 0; hipLaunchKernelGGL(dit_fwd, dim3(grid), dim3(NWAVES * 64), LDS_BYTES, stream, a); }
    else { const int plist[] = PHASE_LIST;
        for (unsigned i = 0; i < sizeof(plist) / sizeof(int); ++i) { const int p = plist[i] % 100; a.ph_lo = p; a.ph_hi = p + 1; a.li = 0; a.flags = plist[i] >= 100 ? 1 : 0;
            hipLaunchKernelGGL(dit_fwd, dim3(grid), dim3(NWAVES * 64), LDS_BYTES, stream, a); } }
    const hipError_t le = hipPeekAtLastError();
    if (le != hipSuccess) fprintf(stderr, "kernel_launch: launch failed: %s\n", hipGetErrorName(le));
}
```

```cpp
#include <hip/hip_runtime.h>
#include <hip/hip_bf16.h>
#include <cstdio>
#include <cstdint>

#ifndef PHASE_LIST
#define PHASE_LIST {0, 1, 2, 3, 4, 5, 6, 7, 8, 9}
#endif
#ifndef MK_N_LAUNCHES
#define MK_N_LAUNCHES 1
#endif

namespace pg8 {
#define PG8_LAS __attribute__((address_space(3)))
typedef unsigned short bf16_t;
typedef short bf16x8 __attribute__((ext_vector_type(8)));
typedef float f32x4 __attribute__((ext_vector_type(4)));
typedef unsigned u32x4 __attribute__((ext_vector_type(4)));
constexpr int BM = 256, BK = 64, HALF = 128, HTB = HALF * BK * 2, STAGE_BYTES = 8 * HTB, NXCD = 8, WGM = 8;

__host__ __device__ __forceinline__ int lds_byte(int r, int c) { const int st = (r >> 4) * 2 + (c >> 5), rr = r & 15, cc = c & 31, ob = rr * 64 + cc * 2; return st * 1024 + (ob ^ (((ob >> 9) & 1) << 5)); }
__host__ __device__ __forceinline__ void stage_rc(int b, int& R, int& C) { const int st = b / 1024, sb = b % 1024, swz = sb ^ (((sb >> 9) & 1) << 5); R = (st >> 1) * 16 + swz / 64; C = (st & 1) * 32 + (swz % 64) / 2; }
__host__ __device__ __forceinline__ int perm32(int rho) { const int n = rho >> 4, i = rho & 15; return 8 * (i >> 2) + 4 * n + (i & 3); }

struct Unit { int pm, pn; };
struct Gemm { const bf16_t* A; const bf16_t* Bt; int M, N, K; };

struct StaticOrder {
    int nM, nN, nwg, G, c;
    __host__ __device__ void init(int M, int N, int G_, int c_) { nM = M / BM; nN = N / BM; nwg = nM * nN; G = G_; c = c_; }
    __host__ __device__ bool next(int i, Unit& u) const {
        const long L = (long)i * G + c; if (L >= nwg) return false;
        int wgid = (int)L; { const int q = nwg / NXCD, r = nwg % NXCD, xcd = wgid % NXCD, off = wgid / NXCD; wgid = (xcd < r ? xcd * (q + 1) : r * (q + 1) + (xcd - r) * q) + off; }
        const int nig = WGM * nN, gid = wgid / nig, fm = gid * WGM, gsz = (nM - fm) < WGM ? (nM - fm) : WGM;
        u.pm = fm + ((wgid % nig) % gsz); u.pn = (wgid % nig) / gsz; return true;
    }
    __device__ __forceinline__ void a_ready(const Unit&) const {}
    __device__ __forceinline__ void done(const Unit&) const {}
};
struct OneUnit {
    int pm, pn;
    __device__ bool next(int i, Unit& u) const { if (i > 0) return false; u.pm = pm; u.pn = pn; return true; }
    __device__ __forceinline__ void a_ready(const Unit&) const {}
    __device__ __forceinline__ void done(const Unit&) const {}
};

__device__ __forceinline__ unsigned cvt_pk_bf16(float lo, float hi) { unsigned r; asm volatile("v_cvt_pk_bf16_f32 %0, %1, %2" : "=v"(r) : "v"(lo), "v"(hi)); return r; }


struct EpiQKV {
    static constexpr bool PERM = true, AFTER_DRAIN = false;
    bf16_t* QO; bf16_t* KA; bf16_t* VA; bf16_t* KB; bf16_t* VB;
    const float* qg; const float* kg; const float* ropec; const float* ropes;
    PG8_LAS float* xch;
    __device__ __forceinline__ void operator()(const f32x4 (&acc)[2][2][4][2], const Unit& u, int wr, int wc, int fr, int fq) const {
        const int pn = u.pn; const bool is_ctx = u.pm >= 64;
        const int b = is_ctx ? (u.pm - 64) : (u.pm >> 4), t0 = is_ctx ? 4096 : ((u.pm & 15) << 8);
        const int hh = wc >> 1, part = wc & 1, wid = wr * 4 + wc;
        const bool isq = (pn < 4) || (pn >= 6 && pn < 10), donorm = (pn >= 6 && pn <= 10), dorope = (!is_ctx) && pn != 5 && pn != 11;
        bf16_t* base; size_t rstride;
        if (isq) { const int head = (pn < 4 ? 2 * pn : 8 + 2 * (pn - 6)) + hh; base = QO + (size_t)(b * 4096 + t0) * 2048 + head * 128; rstride = 2048; }
        else { bf16_t* buf = pn == 4 ? KA : pn == 5 ? VA : pn == 10 ? KB : VB; base = buf + ((size_t)(b * 2 + hh) * 4352 + t0) * 128; rstride = 128; }
        const int d0 = 64 * part + 8 * fq;
        float rs[2][4];
        f32x4 gv[2][2];
#pragma unroll
        for (int bj = 0; bj < 2; ++bj)
#pragma unroll
            for (int n = 0; n < 2; ++n) gv[bj][n] = (f32x4){1.f, 1.f, 1.f, 1.f};
#pragma unroll
        for (int ai = 0; ai < 2; ++ai)
#pragma unroll
            for (int m = 0; m < 4; ++m) rs[ai][m] = 1.f;
        if (donorm) {
            const float* g = (pn == 10) ? kg : qg;
#pragma unroll
            for (int bj = 0; bj < 2; ++bj)
#pragma unroll
                for (int n = 0; n < 2; ++n) gv[bj][n] = *(const f32x4*)(g + d0 + 32 * bj + 4 * n);
#pragma unroll
            for (int ai = 0; ai < 2; ++ai)
#pragma unroll
                for (int m = 0; m < 4; ++m) {
                    float s = 0.f;
#pragma unroll
                    for (int bj = 0; bj < 2; ++bj)
#pragma unroll
                        for (int n = 0; n < 2; ++n) { const f32x4 x = acc[ai][bj][m][n]; s += (x[0] * x[0] + x[1] * x[1]) + (x[2] * x[2] + x[3] * x[3]); }
                    s += __shfl_xor(s, 16); s += __shfl_xor(s, 32);
                    if (fq == 0) xch[wid * 128 + ai * 64 + m * 16 + fr] = s;
                    rs[ai][m] = s;
                }
            asm volatile("s_waitcnt lgkmcnt(0)" ::: "memory"); __builtin_amdgcn_s_barrier(); asm volatile("" ::: "memory");
#pragma unroll
            for (int ai = 0; ai < 2; ++ai)
#pragma unroll
                for (int m = 0; m < 4; ++m) { const float o = xch[(wid ^ 1) * 128 + ai * 64 + m * 16 + fr]; rs[ai][m] = __builtin_amdgcn_rsqf((rs[ai][m] + o) * (1.0f / 128.0f) + 1e-6f); }
        }
#pragma unroll
        for (int ai = 0; ai < 2; ++ai)
#pragma unroll
            for (int m = 0; m < 4; ++m) {
                const int rt = ai * HALF + wr * 64 + m * 16 + fr;
                f32x4 lo[2], hi[2];
#pragma unroll
                for (int n = 0; n < 2; ++n) { lo[n] = acc[ai][0][m][n] * rs[ai][m] * gv[0][n]; hi[n] = acc[ai][1][m][n] * rs[ai][m] * gv[1][n]; }
                if (dorope) {
                    const int t = t0 + rt, pos = part ? (t & 63) : (t >> 6);
#pragma unroll
                    for (int n = 0; n < 2; ++n) {
                        const f32x4 c4 = *(const f32x4*)(ropec + pos * 32 + 8 * fq + 4 * n), s4 = *(const f32x4*)(ropes + pos * 32 + 8 * fq + 4 * n);
                        const f32x4 a = lo[n], bb = hi[n];
                        lo[n] = a * c4 - bb * s4; hi[n] = bb * c4 + a * s4;
                    }
                }
                bf16_t* rowp = base + (size_t)rt * rstride + d0;
                u32x4 w0, w1;
                w0.x = cvt_pk_bf16(lo[0][0], lo[0][1]); w0.y = cvt_pk_bf16(lo[0][2], lo[0][3]); w0.z = cvt_pk_bf16(lo[1][0], lo[1][1]); w0.w = cvt_pk_bf16(lo[1][2], lo[1][3]);
                w1.x = cvt_pk_bf16(hi[0][0], hi[0][1]); w1.y = cvt_pk_bf16(hi[0][2], hi[0][3]); w1.z = cvt_pk_bf16(hi[1][0], hi[1][1]); w1.w = cvt_pk_bf16(hi[1][2], hi[1][3]);
                *(u32x4*)(rowp) = w0; *(u32x4*)(rowp + 32) = w1;
            }
    }
};

struct EpiResid {
    static constexpr bool PERM = false, AFTER_DRAIN = false;
    const float* res; const float* gate; float* out; float alpha;
    __device__ __forceinline__ void operator()(const f32x4 (&acc)[2][2][4][2], const Unit& u, int wr, int wc, int fr, int fq) const {
        const int row0 = u.pm * BM + wr * 64 + fr, col0 = u.pn * BM + wc * 32 + 4 * fq, b = u.pm >> 4;
        f32x4 gv[2][2];
#pragma unroll
        for (int bj = 0; bj < 2; ++bj)
#pragma unroll
            for (int n = 0; n < 2; ++n) gv[bj][n] = *(const f32x4*)(gate + b * 12288 + col0 + bj * HALF + n * 16);
#pragma unroll
        for (int ai = 0; ai < 2; ++ai)
#pragma unroll
            for (int m = 0; m < 4; ++m) { const size_t off = (size_t)(row0 + ai * HALF + m * 16) * 2048 + col0;
#pragma unroll
                for (int bj = 0; bj < 2; ++bj)
#pragma unroll
                    for (int n = 0; n < 2; ++n) { const f32x4 xv = *(const f32x4*)(res + off + bj * HALF + n * 16);
                        *(f32x4*)(out + off + bj * HALF + n * 16) = xv * alpha + gv[bj][n] * acc[ai][bj][m][n]; } }
    }
};


struct EpiBf16Plain {
    static constexpr bool PERM = true, AFTER_DRAIN = false;
    bf16_t* O; int ldc;
    __device__ __forceinline__ void operator()(const f32x4 (&acc)[2][2][4][2], const Unit& u, int wr, int wc, int fr, int fq) const {
        const int row0 = u.pm * BM + wr * 64 + fr, col0 = u.pn * BM + wc * 32 + 8 * fq;
#pragma unroll
        for (int ai = 0; ai < 2; ++ai)
#pragma unroll
            for (int m = 0; m < 4; ++m) { bf16_t* rowp = O + (size_t)(row0 + ai * HALF + m * 16) * ldc + col0;
#pragma unroll
                for (int bj = 0; bj < 2; ++bj) { const f32x4 v0 = acc[ai][bj][m][0], v1 = acc[ai][bj][m][1];
                    u32x4 w; w.x = cvt_pk_bf16(v0[0], v0[1]); w.y = cvt_pk_bf16(v0[2], v0[3]); w.z = cvt_pk_bf16(v1[0], v1[1]); w.w = cvt_pk_bf16(v1[2], v1[3]);
                    *(u32x4*)(rowp + bj * HALF) = w; } }
    }
};

struct EpiSwiglu {
    static constexpr bool PERM = true, AFTER_DRAIN = false;
    bf16_t* H; int ldh;
    __device__ __forceinline__ void operator()(const f32x4 (&acc)[2][2][4][2], const Unit& u, int wr, int wc, int fr, int fq) const {
        const int row0 = u.pm * BM + wr * 64 + fr, col0 = u.pn * 128 + wc * 32 + 8 * fq;
#pragma unroll
        for (int ai = 0; ai < 2; ++ai)
#pragma unroll
            for (int m = 0; m < 4; ++m) { bf16_t* rowp = H + (size_t)(row0 + ai * HALF + m * 16) * ldh + col0;
                f32x4 o[2];
#pragma unroll
                for (int n = 0; n < 2; ++n) { const f32x4 g = acc[ai][0][m][n], up = acc[ai][1][m][n];
#pragma unroll
                    for (int e = 0; e < 4; ++e) { const float sg = __builtin_amdgcn_rcpf(1.0f + __builtin_amdgcn_exp2f(-1.4426950408889634f * g[e])); o[n][e] = g[e] * sg * up[e]; } }
                u32x4 w; w.x = cvt_pk_bf16(o[0][0], o[0][1]); w.y = cvt_pk_bf16(o[0][2], o[0][3]); w.z = cvt_pk_bf16(o[1][0], o[1][1]); w.w = cvt_pk_bf16(o[1][2], o[1][3]);
                *(u32x4*)rowp = w; }
    }
};

typedef int v8i_t __attribute__((ext_vector_type(8))); typedef int v4i_t __attribute__((ext_vector_type(4)));
__device__ __forceinline__ v8i_t cat16(bf16x8 a, bf16x8 b) { return __builtin_shufflevector(__builtin_bit_cast(v4i_t, a), __builtin_bit_cast(v4i_t, b), 0, 1, 2, 3, 4, 5, 6, 7); }
template <class Epi, class Sched, bool ALIGN_EPI = false, bool SP2 = false, int SCW = 0, int SCA = 0>
__device__ __forceinline__ void gemm_phase(PG8_LAS unsigned char* lds, const Gemm g, const Sched& S, const Epi& E) {
    const int tid = threadIdx.x, wid = __builtin_amdgcn_readfirstlane(tid >> 6), lane = tid & 63, wr = wid >> 2, wc = wid & 3, fr = lane & 15, fq = lane >> 4;
    const int K = g.K, nt = K / BK;
    unsigned voffA[2], voffB[2];
#pragma unroll
    for (int i = 0; i < 2; ++i) { int R, C; stage_rc(tid * 16 + i * 8192, R, C); const int Rb = Epi::PERM ? ((R & ~31) + perm32(R & 31)) : R;
        voffA[i] = (unsigned)(R * K + C) * 2u; voffB[i] = (unsigned)(Rb * K + C) * 2u; }
    const size_t kstep = (size_t)(BK * 2);
    const size_t hstep = (size_t)HALF * K * 2;
    const size_t tstep = 2 * hstep;
    const unsigned ldsw = (unsigned)wid * 1024u;
    const int aoff = lds_byte(wr * 64 + fr, fq * 8), boff = lds_byte(wc * 32 + fr, fq * 8);
#define PG8_SA(b, h) (((b) * 2 + (h)) * HTB)
#define PG8_SB(b, h) ((4 + (b) * 2 + (h)) * HTB)
#define PG8_STAGE(bufoff, gbase, voff) do { _Pragma("unroll") for (int _i = 0; _i < 2; ++_i) \
        __builtin_amdgcn_global_load_lds((const unsigned*)((const char*)(gbase) + (voff)[_i]), (PG8_LAS unsigned*)(lds + (bufoff) + ldsw + _i * 8192), 16, 0, 0); } while (0)
#define PG8_LDA(dst, b, h) do { _Pragma("unroll") for (int m = 0; m < 4; ++m) { if constexpr (SCW != 0) dst##8[m] = cat16(*(const PG8_LAS bf16x8*)(lds + PG8_SA(b, h) + aoff + m * 2048), *(const PG8_LAS bf16x8*)(lds + PG8_SA(b, h) + aoff + m * 2048 + 1024)); \
        else { _Pragma("unroll") for (int k = 0; k < 2; ++k) dst[m][k] = *(const PG8_LAS bf16x8*)(lds + PG8_SA(b, h) + aoff + m * 2048 + k * 1024); } } } while (0)
#define PG8_LDB(dst, b, h) do { _Pragma("unroll") for (int n = 0; n < 2; ++n) { if constexpr (SCW != 0) dst##8[n] = cat16(*(const PG8_LAS bf16x8*)(lds + PG8_SB(b, h) + boff + n * 2048), *(const PG8_LAS bf16x8*)(lds + PG8_SB(b, h) + boff + n * 2048 + 1024)); \
        else { _Pragma("unroll") for (int k = 0; k < 2; ++k) dst[n][k] = *(const PG8_LAS bf16x8*)(lds + PG8_SB(b, h) + boff + n * 2048 + k * 1024); } } } while (0)
#define PG8_MMA(ai, bj, At, Bt) do { __builtin_amdgcn_s_setprio(1); _Pragma("unroll") for (int m = 0; m < 4; ++m) _Pragma("unroll") for (int n = 0; n < 2; ++n) { \
        if constexpr (SCW != 0) asm volatile("v_mfma_scale_f32_16x16x128_f8f6f4 %0, %1, %2, %0, %3, %4 op_sel_hi:[0,0,0]" : "+v"(acc[ai][bj][m][n]) : "v"(Bt##8[n]), "v"(At##8[m]), "v"(scw_), "v"(sca_));     \
        else { _Pragma("unroll") for (int k = 0; k < 2; ++k) acc[ai][bj][m][n] = __builtin_amdgcn_mfma_f32_16x16x32_bf16(Bt[n][k], At[m][k], acc[ai][bj][m][n], 0, 0, 0); } } \
        __builtin_amdgcn_s_setprio(0); } while (0)
#define PG8_WAIT_V(n) asm volatile("s_waitcnt vmcnt(" #n ")" ::: "memory")
#define PG8_WAIT_L(n) asm volatile("s_waitcnt lgkmcnt(" #n ")" ::: "memory")
#define PG8_BAR __builtin_amdgcn_s_barrier()
#define PG8_SCHED __builtin_amdgcn_sched_barrier(0)
    Unit cur, nxt; int ui = 0;
    if (!S.next(0, cur)) return;
    f32x4 acc[2][2][4][2];
#pragma unroll
    for (int a = 0; a < 2; ++a)
#pragma unroll
        for (int b = 0; b < 2; ++b)
#pragma unroll
            for (int m = 0; m < 4; ++m)
#pragma unroll
                for (int n = 0; n < 2; ++n) acc[a][b][m][n] = (f32x4){0.f, 0.f, 0.f, 0.f};
    int scw_ = SCW, sca_ = SCA; asm volatile("" : "+v"(scw_), "+v"(sca_));
    bf16x8 At[4][2], B0[2][2], B1[2][2]; v8i_t At8[4], B08[2], B18[2];
    const char* cA = (const char*)g.A + (size_t)cur.pm * tstep; const char* cB = (const char*)g.Bt + (size_t)cur.pn * tstep;
    S.a_ready(cur);
    if constexpr (SP2) {
        PG8_STAGE(PG8_SB(0, 0), cB, voffB); PG8_STAGE(PG8_SB(0, 1), cB + hstep, voffB); PG8_STAGE(PG8_SA(0, 0), cA, voffA); PG8_STAGE(PG8_SA(0, 1), cA + hstep, voffA);
        if (wr == 1) PG8_BAR;
        PG8_WAIT_V(2); PG8_BAR;
        PG8_STAGE(PG8_SB(1, 0), cB + kstep, voffB); PG8_STAGE(PG8_SA(1, 0), cA + kstep, voffA); PG8_STAGE(PG8_SB(1, 1), cB + hstep + kstep, voffB);
        PG8_WAIT_V(6); PG8_BAR;
    } else {
        PG8_STAGE(PG8_SB(0, 0), cB, voffB); PG8_STAGE(PG8_SA(0, 0), cA, voffA); PG8_STAGE(PG8_SB(0, 1), cB + hstep, voffB); PG8_STAGE(PG8_SA(0, 1), cA + hstep, voffA);
        if (wr == 1) PG8_BAR;
        PG8_WAIT_V(4); PG8_BAR;
        PG8_STAGE(PG8_SB(1, 0), cB + kstep, voffB); PG8_STAGE(PG8_SA(1, 0), cA + kstep, voffA); PG8_STAGE(PG8_SB(1, 1), cB + hstep + kstep, voffB);
        PG8_WAIT_V(6); PG8_BAR;
    }
    for (;;) {
        const bool has_next = S.next(ui + 1, nxt);
        const char* nA = has_next ? (const char*)g.A + (size_t)nxt.pm * tstep : cA; const char* nB = has_next ? (const char*)g.Bt + (size_t)nxt.pn * tstep : cB;
        for (int t = 0; t < nt; t += 2) {
            const bool last = (t == nt - 2);
            const char* a1 = cA + (size_t)(t + 1) * kstep;
            const char* a2 = last ? nA : cA + (size_t)(t + 2) * kstep; const char* b2 = last ? nB : cB + (size_t)(t + 2) * kstep;
            const char* a3 = a2 + kstep; const char* b3 = b2 + kstep;
            if (last && has_next) S.a_ready(nxt);
            if constexpr (SP2) {
            PG8_LDB(B0, 0, 0); PG8_LDB(B1, 0, 1); PG8_SCHED; PG8_LDA(At, 0, 0); PG8_STAGE(PG8_SA(1, 1), a1 + hstep, voffA);
            PG8_WAIT_V(8); PG8_WAIT_L(0); PG8_BAR; PG8_MMA(0, 0, At, B0); PG8_MMA(0, 1, At, B1); PG8_BAR; PG8_SCHED;
            PG8_LDA(At, 0, 1); PG8_STAGE(PG8_SB(0, 0), b2, voffB); PG8_STAGE(PG8_SB(0, 1), b2 + hstep, voffB); PG8_STAGE(PG8_SA(0, 0), a2, voffA);
            PG8_WAIT_V(8); PG8_WAIT_L(0); PG8_BAR; PG8_MMA(1, 0, At, B0); PG8_MMA(1, 1, At, B1); PG8_BAR; PG8_SCHED;
            PG8_LDB(B0, 1, 0); PG8_LDB(B1, 1, 1); PG8_SCHED; PG8_LDA(At, 1, 0); PG8_STAGE(PG8_SA(0, 1), a2 + hstep, voffA);
            PG8_WAIT_V(8); PG8_WAIT_L(0); PG8_BAR; PG8_MMA(0, 0, At, B0); PG8_MMA(0, 1, At, B1); PG8_BAR; PG8_SCHED;
            PG8_LDA(At, 1, 1); PG8_STAGE(PG8_SB(1, 0), b3, voffB); PG8_STAGE(PG8_SB(1, 1), b3 + hstep, voffB); PG8_STAGE(PG8_SA(1, 0), a3, voffA);
            PG8_WAIT_V(8); PG8_WAIT_L(0); PG8_BAR; PG8_MMA(1, 0, At, B0); PG8_MMA(1, 1, At, B1); PG8_BAR; PG8_SCHED;
            } else {
            PG8_LDB(B0, 0, 0); PG8_SCHED; PG8_LDA(At, 0, 0); PG8_STAGE(PG8_SA(1, 1), a1 + hstep, voffA);
            PG8_WAIT_L(8); PG8_BAR; PG8_WAIT_L(0); PG8_MMA(0, 0, At, B0); PG8_BAR; PG8_SCHED;
            PG8_LDB(B1, 0, 1); PG8_STAGE(PG8_SB(0, 0), b2, voffB);
            PG8_BAR; PG8_WAIT_L(0); PG8_MMA(0, 1, At, B1); PG8_BAR;
            PG8_LDA(At, 0, 1); PG8_STAGE(PG8_SA(0, 0), a2, voffA);
            PG8_BAR; PG8_WAIT_L(0); PG8_MMA(1, 0, At, B0); PG8_BAR; PG8_SCHED;
            PG8_STAGE(PG8_SB(0, 1), b2 + hstep, voffB);
            PG8_WAIT_V(6); PG8_BAR; PG8_MMA(1, 1, At, B1); PG8_BAR;
            PG8_LDB(B0, 1, 0); PG8_SCHED; PG8_LDA(At, 1, 0); PG8_STAGE(PG8_SA(0, 1), a2 + hstep, voffA);
            PG8_WAIT_L(8); PG8_BAR; PG8_WAIT_L(0); PG8_MMA(0, 0, At, B0); PG8_BAR; PG8_SCHED;
            PG8_LDB(B1, 1, 1); PG8_STAGE(PG8_SB(1, 0), b3, voffB);
            PG8_BAR; PG8_WAIT_L(0); PG8_MMA(0, 1, At, B1); PG8_BAR;
            PG8_LDA(At, 1, 1); PG8_STAGE(PG8_SA(1, 0), a3, voffA);
            PG8_BAR; PG8_WAIT_L(0); PG8_MMA(1, 0, At, B0); PG8_BAR; PG8_SCHED;
            PG8_STAGE(PG8_SB(1, 1), b3 + hstep, voffB);
            PG8_WAIT_V(6); PG8_BAR; PG8_MMA(1, 1, At, B1); PG8_BAR;
            }
        }
        if constexpr (ALIGN_EPI) { if (wr == 0) PG8_BAR; }
        if constexpr (SCW != 0) asm volatile("s_nop 15\n\ts_nop 15" ::: "memory");
        if constexpr (!Epi::AFTER_DRAIN) { E(acc, cur, wr, wc, fr, fq); S.done(cur); }
        if (!has_next) break;
#pragma unroll
        for (int a = 0; a < 2; ++a)
#pragma unroll
            for (int b = 0; b < 2; ++b)
#pragma unroll
                for (int m = 0; m < 4; ++m)
#pragma unroll
                    for (int n = 0; n < 2; ++n) acc[a][b][m][n] = (f32x4){0.f, 0.f, 0.f, 0.f};
        cur = nxt; cA = nA; cB = nB; ++ui;
        if constexpr (ALIGN_EPI) { if (wr == 1) PG8_BAR; }
    }
    PG8_WAIT_V(0);
    if constexpr (!ALIGN_EPI) { if (wr == 0) PG8_BAR; }
    PG8_BAR;
#undef PG8_SA
#undef PG8_SB
#undef PG8_STAGE
#undef PG8_LDA
#undef PG8_LDB
#undef PG8_MMA
#undef PG8_WAIT_V
#undef PG8_WAIT_L
#undef PG8_BAR
#undef PG8_SCHED
}
}

namespace att {
typedef unsigned short bf16;
using bf16x8 = __attribute__((ext_vector_type(8))) short;
using s16x4  = __attribute__((ext_vector_type(4))) short;
using f32x16 = __attribute__((ext_vector_type(16))) float;
using u32x4  = __attribute__((ext_vector_type(4))) unsigned;
constexpr int D = 128, NW = 8, QBLK = 32, KVBLK = 64;
constexpr float SCALE = 0.088388347648318440f;
constexpr float THR = 8.f;
constexpr int LDQ = 2048, LDK = 128, LDO = 2048;
constexpr float OSCL = 16.f;
constexpr int SHM_V = KVBLK * D * 2, SHM_K = KVBLK * D * 2, SHM_ATTN = 2 * SHM_V + 2 * SHM_K + NW * 64 * 4;
#define KSWZ(row, colB) ((row) * 256 + ((colB) ^ (((row) & 7) << 4)))
#define SBAR() __builtin_amdgcn_sched_barrier(0)
__device__ __forceinline__ int crow(int r, int hi) { return (r & 3) + 8 * (r >> 2) + 4 * hi; }
__device__ __forceinline__ unsigned cvtpk(float lo, float hi) { unsigned r; asm volatile("v_cvt_pk_bf16_f32 %0, %1, %2" : "=v"(r) : "v"(lo), "v"(hi)); return r; }

__device__ __forceinline__ void partialSM(f32x16& p0, f32x16& p1, float& m_reg, float& mn, float& alpha, bool fixedm) {
  constexpr float C = SCALE * 1.4426950408889634f;
  if (fixedm) { mn = m_reg; alpha = 1.f; }
  else {
  float pmax = p0[0]; for (int r = 1; r < 16; ++r) pmax = fmaxf(pmax, p0[r]); for (int r = 0; r < 16; ++r) pmax = fmaxf(pmax, p1[r]);
  { auto rr = __builtin_amdgcn_permlane32_swap(__float_as_uint(pmax), __float_as_uint(pmax), false, false);
    pmax = fmaxf(__uint_as_float(rr[0]), __uint_as_float(rr[1])); }
  if (__builtin_expect(__all(pmax - m_reg <= THR / SCALE), 1)) { mn = m_reg; alpha = 1.f; }
  else { mn = fmaxf(m_reg, pmax); alpha = __builtin_amdgcn_exp2f((m_reg - mn) * C); m_reg = mn; }
  }
  float mnC = -mn * C;
  for (int r = 0; r < 16; ++r) p0[r] = fmaf(p0[r], C, mnC); for (int r = 0; r < 16; ++r) p1[r] = fmaf(p1[r], C, mnC);
  for (int r = 0; r < 16; ++r) p0[r] = __builtin_amdgcn_exp2f(p0[r]);
}
__device__ __forceinline__ void finishSM(f32x16& p0, f32x16& p1, float alpha, float& l_reg, bf16x8& pa0, bf16x8& pa1, bf16x8& pa2, bf16x8& pa3) {
  for (int r = 0; r < 16; ++r) p1[r] = __builtin_amdgcn_exp2f(p1[r]);
  float ps = 0; for (int r = 0; r < 16; ++r) ps += p0[r]; for (int r = 0; r < 16; ++r) ps += p1[r];
  { auto rr = __builtin_amdgcn_permlane32_swap(__float_as_uint(ps), __float_as_uint(ps), false, false);
    ps = __uint_as_float(rr[0]) + __uint_as_float(rr[1]); }
  l_reg = l_reg * alpha + ps;
#define PK4(P, BASE, OUT) do { unsigned a0 = cvtpk(P[BASE + 0], P[BASE + 1]), a1 = cvtpk(P[BASE + 2], P[BASE + 3]);   \
    unsigned b0 = cvtpk(P[BASE + 4], P[BASE + 5]), b1 = cvtpk(P[BASE + 6], P[BASE + 7]);                              \
    auto r0 = __builtin_amdgcn_permlane32_swap(a0, b0, false, false); auto r1 = __builtin_amdgcn_permlane32_swap(a1, b1, false, false); \
    u32x4 w = {r0[0], r1[0], r0[1], r1[1]}; OUT = *reinterpret_cast<bf16x8*>(&w); } while (0)
  PK4(p0, 0, pa0); PK4(p0, 8, pa1); PK4(p1, 0, pa2); PK4(p1, 8, pa3);
#undef PK4
}
__device__ __forceinline__ void qkt(f32x16& p0, f32x16& p1, const bf16* Ks, const bf16x8* qr, int r32, int hi) {
  p0 = f32x16{}; p1 = f32x16{};
  for (int d0 = 0; d0 < 8; ++d0) { int cb = (d0 * 16 + hi * 8) * 2;
    bf16x8 b0 = *reinterpret_cast<const bf16x8*>((const char*)Ks + KSWZ(r32, cb));
    bf16x8 b1 = *reinterpret_cast<const bf16x8*>((const char*)Ks + KSWZ(32 + r32, cb));
    p0 = __builtin_amdgcn_mfma_f32_32x32x16_bf16(b0, qr[d0], p0, 0, 0, 0);
    p1 = __builtin_amdgcn_mfma_f32_32x32x16_bf16(b1, qr[d0], p1, 0, 0, 0); }
}
__device__ __forceinline__ void wmask(f32x16& p0, f32x16& p1, int kb, int qpos) {
  const int dq = qpos - kb + 128;
#pragma unroll
  for (int r = 0; r < 16; ++r) { const int d = dq - ((r & 3) + 8 * (r >> 2));
    if ((unsigned)d > 256u) p0[r] = -INFINITY;
    if ((unsigned)(d - 32) > 256u) p1[r] = -INFINITY; }
}
__device__ __forceinline__ int v_st(int k, int c) { const int kk = (k & ~0xC) | ((k & 4) << 1) | ((k & 8) >> 1); return ((kk >> 3) * 4 + (c >> 5)) * 512 + ((kk & 7) * 32 + (c & 31)) * 2; }
__device__ __forceinline__ int v_rd_base(int lane) { return ((lane & 3) << 3) | (((lane >> 2) & 3) << 6) | (((lane >> 4) & 1) << 5) | (((lane >> 5) & 1) << 8); }
constexpr int v_rd_off(int d0, int ks, int half) { return d0 * 512 + ks * 4096 + half * 2048; }
template <int OFF> __device__ __forceinline__ s16x4 tr_read(int vb) {
  s16x4 r; asm volatile("ds_read_b64_tr_b16 %0, %1 offset:%2" : "=&v"(r) : "v"(vb), "i"(OFF) : "memory"); return r;
}
template <int D0> __device__ __forceinline__ void pv_one(f32x16& od, int vb, bf16x8 pa0, bf16x8 pa1, bf16x8 pa2, bf16x8 pa3) {
  const s16x4 l0 = tr_read<v_rd_off(D0, 0, 0)>(vb), h0 = tr_read<v_rd_off(D0, 0, 1)>(vb), l1 = tr_read<v_rd_off(D0, 1, 0)>(vb), h1 = tr_read<v_rd_off(D0, 1, 1)>(vb);
  const s16x4 l2 = tr_read<v_rd_off(D0, 2, 0)>(vb), h2 = tr_read<v_rd_off(D0, 2, 1)>(vb), l3 = tr_read<v_rd_off(D0, 3, 0)>(vb), h3 = tr_read<v_rd_off(D0, 3, 1)>(vb);
  asm volatile("s_waitcnt lgkmcnt(0)" ::: "memory"); SBAR();
#define PK(L, H) (bf16x8){L[0], L[1], L[2], L[3], H[0], H[1], H[2], H[3]}
  od = __builtin_amdgcn_mfma_f32_32x32x16_bf16(pa0, PK(l0, h0), od, 0, 0, 0);
  od = __builtin_amdgcn_mfma_f32_32x32x16_bf16(pa1, PK(l1, h1), od, 0, 0, 0);
  od = __builtin_amdgcn_mfma_f32_32x32x16_bf16(pa2, PK(l2, h2), od, 0, 0, 0);
  od = __builtin_amdgcn_mfma_f32_32x32x16_bf16(pa3, PK(l3, h3), od, 0, 0, 0);
#undef PK
}
__device__ __forceinline__ void pv_d0(f32x16* o, int vb, bf16x8 pa0, bf16x8 pa1, bf16x8 pa2, bf16x8 pa3) {
  pv_one<0>(o[0], vb, pa0, pa1, pa2, pa3); pv_one<1>(o[1], vb, pa0, pa1, pa2, pa3); pv_one<2>(o[2], vb, pa0, pa1, pa2, pa3); pv_one<3>(o[3], vb, pa0, pa1, pa2, pa3);
}

struct Stg { bf16x8 vs0, vs1, ks0, ks1; };
struct AUnit { const bf16* Q; const bf16* K; const bf16* V; unsigned char* O; int NT, nctx, jlo, q0; bool masked; float sinkl2, kbound; };
#define KOFU(u, t) (((t) < (u).nctx) ? (4096 + 64 * (t)) : 64 * ((u).jlo + (t) - (u).nctx))
#define SLOADX(dst, Kp, Vp, k0) do { const int k0_ = (k0); (dst).vs0 = *reinterpret_cast<const bf16x8*>(&(Vp)[(long)(k0_ + sr) * LDK + sc]); (dst).vs1 = *reinterpret_cast<const bf16x8*>(&(Vp)[(long)(k0_ + 32 + sr) * LDK + sc]); \
    (dst).ks0 = *reinterpret_cast<const bf16x8*>(&(Kp)[(long)(k0_ + sr) * LDK + sc]); (dst).ks1 = *reinterpret_cast<const bf16x8*>(&(Kp)[(long)(k0_ + 32 + sr) * LDK + sc]); } while (0)
__device__ __forceinline__ void attn_prime(const AUnit& u, bf16x8 (&qr)[8], Stg (&sr_)[2]) {
  const int tid = threadIdx.x, wid = tid >> 6, lane = tid & 63, r32 = lane & 31, hi = lane >> 5, sr = tid >> 4, sc = (tid & 15) * 8;
  const bf16* Qw = u.Q + (long)(wid * QBLK + r32) * LDQ + hi * 8;
#pragma unroll
  for (int d0 = 0; d0 < 8; ++d0) qr[d0] = *reinterpret_cast<const bf16x8*>(Qw + d0 * 16);
  SLOADX(sr_[0], u.K, u.V, KOFU(u, 0)); SLOADX(sr_[1], u.K, u.V, KOFU(u, 1));
}
__device__ __forceinline__ void attn_unit(const AUnit& u, bool has_next, const AUnit& nx, bf16x8 (&qr)[8], Stg (&sr_)[2], char* lds) {
  const int tid = threadIdx.x, wid = tid >> 6, lane = tid & 63, r32 = lane & 31, hi = lane >> 5;
  const bf16* __restrict__ Kh = u.K; const bf16* __restrict__ Vh = u.V; const int NT = u.NT, nctx = u.nctx, jlo = u.jlo; const bool masked = u.masked;
  bf16* V_lds = (bf16*)lds; bf16* K_lds = (bf16*)(lds + 2 * SHM_V);
  float* ws = (float*)(lds + 2 * SHM_V + 2 * SHM_K) + wid * 64; float* li_l = ws; float* al_l = ws + 32;
  float m_reg = -1e30f, l_reg = 0; f32x16 o[4] = {};
  const bool fixedm = u.kbound > 0.f;
  if (fixedm) { float ss = 0.f;
#pragma unroll
    for (int d0 = 0; d0 < 8; ++d0)
#pragma unroll
      for (int e = 0; e < 8; ++e) { const float qv = __uint_as_float(((unsigned)(unsigned short)qr[d0][e]) << 16); ss += qv * qv; }
    { auto rr = __builtin_amdgcn_permlane32_swap(__float_as_uint(ss), __float_as_uint(ss), false, false); ss = __uint_as_float(rr[0]) + __uint_as_float(rr[1]); }
    m_reg = sqrtf(ss) * u.kbound; }
  const int sr = tid >> 4, sc = (tid & 15) * 8, vst0 = v_st(sr, sc), vst1 = v_st(32 + sr, sc);
  const int vb0 = (int)(uintptr_t)V_lds + v_rd_base(lane);
  const int qpos = u.q0 + wid * QBLK + r32;
#define KOF(t) (((t) < nctx) ? (4096 + 64 * (t)) : 64 * (jlo + (t) - nctx))
#define SLOAD(i, k0) SLOADX(sr_[i], Kh, Vh, k0)
#define SWRITE(b, i) do { *(bf16x8*)((char*)V_lds + (b) * SHM_V + vst0) = sr_[i].vs0;          \
    *(bf16x8*)((char*)V_lds + (b) * SHM_V + vst1) = sr_[i].vs1; int kc = sc * 2;               \
    *(bf16x8*)((char*)K_lds + (b) * SHM_K + KSWZ(sr, kc)) = sr_[i].ks0;                       \
    *(bf16x8*)((char*)K_lds + (b) * SHM_K + KSWZ(32 + sr, kc)) = sr_[i].ks1; } while (0)
#define SWAIT() asm volatile("s_waitcnt vmcnt(4)" ::: "memory")
#define RESC(a) do { if (__any((a) < 1.f)) { if (hi == 0) al_l[r32] = (a); asm volatile("s_waitcnt lgkmcnt(0)" ::: "memory"); \
    for (int d = 0; d < 4; ++d) for (int r = 0; r < 16; ++r) o[d][r] *= al_l[crow(r, hi)]; } } while (0)
#define MASK(P0, P1, t) do { if (masked && (t) >= nctx) wmask(P0, P1, KOF(t) + 4 * hi, qpos); } while (0)
  f32x16 pA0, pA1, pB0, pB1; float mnA, mnB, alA, alB; bf16x8 pa0, pa1, pa2, pa3;
  constexpr int SE = 0, SO = 1;
  SWAIT(); SWRITE(0, SE); __syncthreads();
  if (2 < NT) SLOAD(SE, KOF(2));
  qkt(pA0, pA1, K_lds, qr, r32, hi); MASK(pA0, pA1, 0); partialSM(pA0, pA1, m_reg, mnA, alA, fixedm);
  SWAIT(); SWRITE(1, SO); __syncthreads();
  for (int j = 1; j + 1 < NT; j += 2) {
    SBAR(); qkt(pB0, pB1, (bf16*)((char*)K_lds + SHM_K), qr, r32, hi);
    finishSM(pA0, pA1, alA, l_reg, pa0, pa1, pa2, pa3); SBAR();
    SLOAD(SO, KOF(j + 2)); SBAR();
    pv_d0(o, vb0, pa0, pa1, pa2, pa3); MASK(pB0, pB1, j); partialSM(pB0, pB1, m_reg, mnB, alB, fixedm);
    __syncthreads(); SWAIT(); SWRITE(0, SE);
    RESC(alB); __syncthreads();
    SBAR(); qkt(pA0, pA1, K_lds, qr, r32, hi);
    finishSM(pB0, pB1, alB, l_reg, pa0, pa1, pa2, pa3); SBAR();
    if (j + 3 < NT) SLOAD(SE, KOF(j + 3)); SBAR();
    pv_d0(o, vb0 + (int)SHM_V, pa0, pa1, pa2, pa3); MASK(pA0, pA1, j + 1); partialSM(pA0, pA1, m_reg, mnA, alA, fixedm);
    __syncthreads(); SWAIT(); SWRITE(1, SO);
    RESC(alA); __syncthreads();
  }
  SBAR(); qkt(pB0, pB1, (bf16*)((char*)K_lds + SHM_K), qr, r32, hi);
  finishSM(pA0, pA1, alA, l_reg, pa0, pa1, pa2, pa3); SBAR();
  pv_d0(o, vb0, pa0, pa1, pa2, pa3); MASK(pB0, pB1, NT - 1); partialSM(pB0, pB1, m_reg, mnB, alB, fixedm);
  SBAR(); if (has_next) attn_prime(nx, qr, sr_); SBAR();
  __syncthreads(); RESC(alB);
  finishSM(pB0, pB1, alB, l_reg, pa0, pa1, pa2, pa3); SBAR();
  pv_d0(o, vb0 + (int)SHM_V, pa0, pa1, pa2, pa3);
  l_reg += __builtin_amdgcn_exp2f(u.sinkl2 - m_reg * (SCALE * 1.4426950408889634f));
  if (hi == 0) li_l[r32] = l_reg; asm volatile("s_waitcnt lgkmcnt(0)" ::: "memory");
  float rli[16];
#pragma unroll
  for (int r = 0; r < 16; ++r) rli[r] = __builtin_amdgcn_rcpf(li_l[crow(r, hi)]);
  __syncthreads();
  { char* stg = lds + wid * 8192 + (4 * hi * 128 + r32) * 2;
#pragma unroll
    for (int r = 0; r < 16; ++r) {
#pragma unroll
      for (int d0 = 0; d0 < 4; ++d0) { const float v = o[d0][r] * rli[r]; *(bf16*)(stg + ((r & 3) + 8 * (r >> 2)) * 256 + d0 * 64) = (bf16)(cvtpk(v, v) & 0xffffu); }
      asm volatile("" ::: "memory"); }
    asm volatile("s_waitcnt lgkmcnt(0)" ::: "memory");
    unsigned char* Ow = u.O + (long)(wid * QBLK + (lane >> 4)) * LDO + (lane & 15) * 8;
    const char* rd = lds + wid * 8192 + (lane >> 4) * 256 + (lane & 15) * 16;
#pragma unroll
    for (int i = 0; i < 8; ++i) { const u32x4 v = *(const u32x4*)(rd + i * 1024);
      typedef unsigned u2v __attribute__((ext_vector_type(2))); u2v w;
#define LO16(x) (__uint_as_float((x) << 16) * OSCL)
#define HI16(x) (__uint_as_float((x) & 0xffff0000u) * OSCL)
      { int t = __builtin_amdgcn_cvt_pk_fp8_f32(LO16(v.x), HI16(v.x), 0, false); t = __builtin_amdgcn_cvt_pk_fp8_f32(LO16(v.y), HI16(v.y), t, true); w.x = (unsigned)t; }
      { int t = __builtin_amdgcn_cvt_pk_fp8_f32(LO16(v.z), HI16(v.z), 0, false); t = __builtin_amdgcn_cvt_pk_fp8_f32(LO16(v.w), HI16(v.w), t, true); w.y = (unsigned)t; }
#undef LO16
#undef HI16
      *(u2v*)(Ow + (long)i * 4 * LDO) = w; } }
  __syncthreads();
#undef KOF
#undef SLOAD
#undef SWRITE
#undef SWAIT
#undef RESC
#undef MASK
}
#undef KOFU
#undef SLOADX
#undef KSWZ
#undef SBAR
}

constexpr int NWAVES = 8;
constexpr int N_LAUNCHES = MK_N_LAUNCHES;
constexpr int N_PHASES = 10;
constexpr int DM = 2048, NB = 4, SEQ = 4096, CTXL = 256, FFN = 5632, INW = 3072, NMOD = 12288;
constexpr int M = NB * SEQ, MC = NB * CTXL, MU = M + MC;
constexpr int SKV = SEQ + CTXL;
constexpr float LN_EPS = 1e-6f;
constexpr float DN_ALPHA = 1.189207115002721f;

constexpr size_t MiB = 1u << 20;
constexpr size_t WS_CTL = 0, CTL_ZERO_BYTES = 64 * 1024;
constexpr size_t WS_MODP = 1 * MiB;
constexpr size_t WS_MODS = 2 * MiB;
constexpr size_t WS_ROPE = 2 * MiB + 512 * 1024;
constexpr size_t WS_WIN = 3 * MiB, WS_WOUT = 15 * MiB, WS_WGU = 23 * MiB, WS_WDN = 67 * MiB;
constexpr size_t WS_U = 89 * MiB;
constexpr size_t WS_Y = 157 * MiB;
constexpr size_t WS_QO = 285 * MiB;
constexpr size_t WS_KV = 349 * MiB;
constexpr size_t KV_BYTES = (size_t)NB * 2 * SKV * 128 * 2;
constexpr size_t WS_H = 285 * MiB;
constexpr size_t WS_END = 461 * MiB;
static_assert(WS_WIN + (size_t)INW * DM * 2 <= WS_WOUT && WS_WOUT + (size_t)DM * DM * 2 <= WS_WGU && WS_WGU + (size_t)2 * FFN * DM * 2 <= WS_WDN && WS_WDN + (size_t)DM * FFN * 2 <= WS_U, "ws map (weights)");
static_assert(WS_U + (size_t)MU * DM * 2 <= WS_Y && WS_Y + (size_t)M * DM * 4 <= WS_QO && WS_QO + (size_t)M * DM * 2 <= WS_KV && WS_KV + 4 * KV_BYTES <= WS_END && WS_H + (size_t)M * FFN * 2 <= WS_END, "ws map");
constexpr int CW_BAR = 4096;
constexpr int S_U = 2, S_W = 6, S_O = 4;
constexpr int E8(int s) { return (127 - s) * 0x01010101; }

constexpr int RING_OFF = 0, RING_BYTES = 131072;
constexpr int LDSCTL_OFF = RING_BYTES, MISC_OFF = LDSCTL_OFF + 320;
constexpr int XCH_OFF = RING_BYTES + 1024;
constexpr int LDS_BYTES = 147456;
static_assert(XCH_OFF + 4096 <= LDS_BYTES, "LDS map");

#define GAS __attribute__((address_space(1)))
#define LAS __attribute__((address_space(3)))
typedef unsigned short bf16;
typedef unsigned v4u __attribute__((ext_vector_type(4)));
typedef float f32x4 __attribute__((ext_vector_type(4)));
typedef GAS unsigned gu32;
#define RLX_AGENT __ATOMIC_RELAXED, __HIP_MEMORY_SCOPE_AGENT
#define LDS_WAIT() asm volatile("s_waitcnt lgkmcnt(0)" ::: "memory")
#define VM_WAIT() asm volatile("s_waitcnt vmcnt(0)" ::: "memory")
__device__ __forceinline__ unsigned f2bf(float f) { unsigned u = __builtin_bit_cast(unsigned, f); return (u + 0x7fffu + ((u >> 16) & 1u)) >> 16; }
__device__ __forceinline__ unsigned pk2(float lo, float hi) { return f2bf(lo) | (f2bf(hi) << 16); }

#define XB_TMO      128
#define XB_XCNT(j)  (256  + 64 * (j))
#define XB_XSUB(j)  (1280 + 64 * (j))
#define XB_XGEN(j)  (2304 + 64 * (j))
#define XB_TOP      3328
#define XB_TOPGEN   3392
#define XCD_BAR_WORDS 3456
#define XB_SPIN_CAP (1u << 18)
__device__ __forceinline__ unsigned xb_ld(unsigned* p)              { return __hip_atomic_load(p, __ATOMIC_RELAXED, __HIP_MEMORY_SCOPE_AGENT); }
__device__ __forceinline__ unsigned xb_add(unsigned* p, unsigned v) { return __hip_atomic_fetch_add(p, v, __ATOMIC_RELAXED, __HIP_MEMORY_SCOPE_AGENT); }
__device__ __forceinline__ unsigned xb_xcc_id() { return (unsigned)__builtin_amdgcn_s_getreg((3 << 11) | 20) & 0xFu; }
#define XB_SPIN(cond, bar) do { unsigned _sp = 0; while (cond) { __builtin_amdgcn_s_sleep(1); \
    if ((++_sp & 255u) == 0u) { if (xb_ld(&(bar)[XB_TMO])) break; if (_sp > XB_SPIN_CAP) { atomicAdd(&(bar)[XB_TMO], 1u); break; } } } } while (0)
struct XcdBarrier { unsigned* bar; unsigned x; volatile LAS unsigned* st; };
__device__ __forceinline__ XcdBarrier xcd_barrier_post(unsigned* bar, volatile LAS unsigned* st) {
    XcdBarrier b; b.bar = bar; b.x = xb_xcc_id(); b.st = st;
    if (threadIdx.x == 0) (void)xb_add(&bar[XB_XCNT(b.x)], 1u);
    return b;
}
__device__ __forceinline__ void xcd_barrier_complete(unsigned* bar, unsigned x, unsigned& nloc, unsigned& nx) {
    const unsigned G = gridDim.x * gridDim.y * gridDim.z;
    unsigned sum, cnt, mine, sp = 0u;
    for (;;) {
        sum = 0u; cnt = 0u; mine = 0u;
#pragma unroll
        for (unsigned j = 0; j < 16; ++j) { const unsigned c = xb_ld(&bar[XB_XCNT(j)]); sum += c; cnt += (c > 0u) ? 1u : 0u; mine = (j == x) ? c : mine; }
        if (sum == G) break;
        __builtin_amdgcn_s_sleep(1);
        if ((++sp & 255u) == 0u) { if (xb_ld(&bar[XB_TMO])) break; if (sp > XB_SPIN_CAP) { atomicAdd(&bar[XB_TMO], 1u); break; } }
    }
    nloc = mine > 0u ? mine : 1u; nx = cnt > 0u ? cnt : 1u;
}
__device__ __forceinline__ void xcd_barrier(const XcdBarrier& b) {
    asm volatile("s_waitcnt vmcnt(0)" ::: "memory");
    __syncthreads();
    if (threadIdx.x == 0) {
        unsigned* bar = b.bar;
        __builtin_amdgcn_s_waitcnt(0);
        unsigned nloc = b.st[0], nx = b.st[1];
        if (nloc == 0u) { xcd_barrier_complete(bar, b.x, nloc, nx); b.st[0] = nloc; b.st[1] = nx; }
        const unsigned old = xb_add(&bar[XB_XSUB(b.x)], 1u);
        const unsigned gen = old / nloc;
        if (old + 1u == (gen + 1u) * nloc) {
            __builtin_amdgcn_fence(__ATOMIC_RELEASE, "agent");
            asm volatile("s_waitcnt vmcnt(0)" ::: "memory");
            const unsigned og = xb_add(&bar[XB_TOP], 1u);
            const unsigned tg = og / nx;
            if (og + 1u == (tg + 1u) * nx) xb_add(&bar[XB_TOPGEN], 1u);
            else XB_SPIN(xb_ld(&bar[XB_TOPGEN]) == tg, bar);
            __builtin_amdgcn_fence(__ATOMIC_ACQUIRE, "agent");
            xb_add(&bar[XB_XGEN(b.x)], 1u);
            asm volatile("s_waitcnt vmcnt(0)" ::: "memory");
        } else {
            XB_SPIN(xb_ld(&bar[XB_XGEN(b.x)]) == gen, bar);
            __builtin_amdgcn_fence(__ATOMIC_ACQUIRE, "agent");
            asm volatile("s_waitcnt vmcnt(0)" ::: "memory");
        }
    }
    __syncthreads();
}

__device__ __forceinline__ float wave_sum(float v) {
#pragma unroll
    for (int o = 1; o < 64; o <<= 1) v += __shfl_xor(v, o);
    return v;
}
__device__ __forceinline__ void transpose_item(const float* W, int ldw, int k0, int n0, bf16* WT, int Kd, int dst_row0, LAS float* scr, int lane) {
#pragma unroll 8
    for (int i = 0; i < 32; ++i) { const int kk = 2 * i + (lane >> 5); scr[kk * 33 + (lane & 31)] = W[(size_t)(k0 + kk) * ldw + n0 + (lane & 31)]; }
    LDS_WAIT(); asm volatile("" ::: "memory");
    const int c = lane & 7;
#pragma unroll
    for (int j = 0; j < 4; ++j) { const int n = (lane >> 3) + 8 * j; const LAS float* s = scr + (8 * c) * 33 + n;
        v4u o; o.x = pk2(s[0 * 33], s[1 * 33]); o.y = pk2(s[2 * 33], s[3 * 33]); o.z = pk2(s[4 * 33], s[5 * 33]); o.w = pk2(s[6 * 33], s[7 * 33]);
        *(GAS v4u*)(WT + (size_t)(dst_row0 + n) * Kd + k0 + 8 * c) = o; }
    LDS_WAIT(); asm volatile("" ::: "memory");
}
__device__ __forceinline__ float clamp448(float v) { return __builtin_fminf(__builtin_fmaxf(v, -448.f), 448.f); }
__device__ __forceinline__ unsigned pk4_fp8(float a, float b, float c, float d) {
    int w = __builtin_amdgcn_cvt_pk_fp8_f32(clamp448(a), clamp448(b), 0, false); w = __builtin_amdgcn_cvt_pk_fp8_f32(clamp448(c), clamp448(d), w, true); return (unsigned)w; }
__device__ __forceinline__ void transpose_item8(const float* W, int ldw, int k0, int n0, unsigned char* WT, int Kd, int dst_row0, float scl, LAS float* scr, int lane) {
#pragma unroll 8
    for (int i = 0; i < 32; ++i) { const int kk = 2 * i + (lane >> 5); scr[kk * 33 + (lane & 31)] = W[(size_t)(k0 + kk) * ldw + n0 + (lane & 31)]; }
    LDS_WAIT(); asm volatile("" ::: "memory");
    const int c = lane & 7;
#pragma unroll
    for (int j = 0; j < 4; ++j) { const int n = (lane >> 3) + 8 * j; const LAS float* s = scr + (8 * c) * 33 + n;
        typedef unsigned u2v __attribute__((ext_vector_type(2)));
        u2v o; o.x = pk4_fp8(s[0 * 33] * scl, s[1 * 33] * scl, s[2 * 33] * scl, s[3 * 33] * scl); o.y = pk4_fp8(s[4 * 33] * scl, s[5 * 33] * scl, s[6 * 33] * scl, s[7 * 33] * scl);
        *(GAS u2v*)(WT + (size_t)(dst_row0 + n) * Kd + k0 + 8 * c) = o; }
    LDS_WAIT(); asm volatile("" ::: "memory");
}
__device__ __forceinline__ float silu_f(float x) { return x / (1.0f + __expf(-x)); }

struct Args { const float* in[18]; float* out; unsigned char* ws; int ph_lo, ph_hi, li, flags; };

__device__ __forceinline__ void modulate_row8(const float* xrow, unsigned char* orow, const LAS float* p0, const LAS float* p1, float scl, int lane) {
    const GAS f32x4* xr = (const GAS f32x4*)xrow + lane;
    GAS unsigned* o4 = (GAS unsigned*)orow + lane;
    f32x4 v[8];
#pragma unroll
    for (int j = 0; j < 8; ++j) v[j] = xr[64 * j];
#pragma unroll
    for (int j = 0; j < 8; ++j) { const f32x4 a = *(const LAS f32x4*)(p0 + 256 * j + 4 * lane), s = *(const LAS f32x4*)(p1 + 256 * j + 4 * lane); const f32x4 r = (v[j] * a + s) * scl;
        o4[64 * j] = pk4_fp8(r.x, r.y, r.z, r.w); }
}
__device__ __forceinline__ void modulate_row(const float* xrow, bf16* orow, const LAS float* p0, const LAS float* p1, int lane) {
    const GAS f32x4* xr = (const GAS f32x4*)xrow + lane;
    GAS unsigned long long* o8 = (GAS unsigned long long*)orow + lane;
    f32x4 v[8];
#pragma unroll
    for (int j = 0; j < 8; ++j) v[j] = xr[64 * j];
#pragma unroll
    for (int j = 0; j < 8; ++j) { const f32x4 a = *(const LAS f32x4*)(p0 + 256 * j + 4 * lane), s = *(const LAS f32x4*)(p1 + 256 * j + 4 * lane); const f32x4 r = v[j] * a + s;
        o8[64 * j] = (unsigned long long)pk2(r.x, r.y) | ((unsigned long long)pk2(r.z, r.w) << 32); }
}
typedef unsigned u32x2 __attribute__((ext_vector_type(2)));
__device__ __forceinline__ f32x4 bf4_to_f32(u32x2 w) { f32x4 r; r.x = __uint_as_float(w.x << 16); r.y = __uint_as_float(w.x & 0xffff0000u); r.z = __uint_as_float(w.y << 16); r.w = __uint_as_float(w.y & 0xffff0000u); return r; }
__device__ __forceinline__ void ln_regs(f32x4 (&v)[8], const LAS float* g, const LAS float* bb, int lane) {
    float s = 0.f;
#pragma unroll
    for (int j = 0; j < 8; ++j) s += (v[j].x + v[j].y) + (v[j].z + v[j].w);
    const float mean = wave_sum(s) * (1.f / DM); float s2 = 0.f;
#pragma unroll
    for (int j = 0; j < 8; ++j) { v[j] = v[j] - mean; s2 += (v[j].x * v[j].x + v[j].y * v[j].y) + (v[j].z * v[j].z + v[j].w * v[j].w); }
    const float rstd = __builtin_amdgcn_rsqf(wave_sum(s2) * (1.f / DM) + LN_EPS);
#pragma unroll
    for (int j = 0; j < 8; ++j) { const int c = 256 * j + 4 * lane; v[j] = v[j] * rstd * *(const LAS f32x4*)(g + c) + *(const LAS f32x4*)(bb + c); }
}
__device__ __forceinline__ void x1_row(f32x4 (&v)[8], const float* xrow, const bf16* arow, const LAS float* P, int lane) {
    const GAS f32x4* xr = (const GAS f32x4*)xrow + lane; const GAS u32x2* ar = (const GAS u32x2*)arow + lane;
    u32x2 aw[8];
#pragma unroll
    for (int j = 0; j < 8; ++j) { v[j] = xr[64 * j]; aw[j] = ar[64 * j]; }
#pragma unroll
    for (int j = 0; j < 8; ++j) v[j] = v[j] * DN_ALPHA + *(const LAS f32x4*)(P + 256 * j + 4 * lane) * bf4_to_f32(aw[j]);
    ln_regs(v, P + 2048, P + 4096, lane);
}

__global__ void __launch_bounds__(NWAVES * 64, 2) dit_fwd(Args args) {
    extern __shared__ __attribute__((aligned(16))) unsigned char lds[];
    LAS unsigned char* L = (LAS unsigned char*)lds;
    volatile LAS unsigned* MISC = (volatile LAS unsigned*)(L + MISC_OFF);
    const int tid = threadIdx.x, lane = tid & 63, wave = __builtin_amdgcn_readfirstlane(tid >> 6);
    const int G = gridDim.x, bx = blockIdx.x;
    unsigned char* ws = args.ws;
    gu32* ctl = (gu32*)(ws + WS_CTL);
    const float* x = args.in[0]; const float* cvec = args.in[1]; const float* ctx = args.in[2]; const float* c_ctx = args.in[3];
    const float* w_ada = args.in[4]; const float* b_ada = args.in[5]; const float* w_in = args.in[6]; const float* qng = args.in[7]; const float* kng = args.in[8];
    const float* sink = args.in[9]; const float* w_out = args.in[10]; const float* ln1g = args.in[11]; const float* ln1b = args.in[12];
    const float* w_gate = args.in[13]; const float* w_up = args.in[14]; const float* w_down = args.in[15]; const float* ln2g = args.in[16]; const float* ln2b = args.in[17];
    float* MODP = (float*)(ws + WS_MODP); float* MODS = (float*)(ws + WS_MODS); float* ROPEC = (float*)(ws + WS_ROPE); float* ROPES = ROPEC + 2048;
    bf16* WIN = (bf16*)(ws + WS_WIN); bf16* WOUT = (bf16*)(ws + WS_WOUT); bf16* WGU = (bf16*)(ws + WS_WGU); bf16* WDN = (bf16*)(ws + WS_WDN);
    bf16* U = (bf16*)(ws + WS_U); bf16* AB = (bf16*)(ws + WS_Y); bf16* DB = (bf16*)(ws + WS_Y + 64 * MiB);
    unsigned char* U8 = ws + WS_U;
    unsigned char* WIN8 = ws + WS_WIN; unsigned char* WOUT8 = ws + WS_WOUT;
    unsigned char* OF8 = ws + WS_Y + 64 * MiB;
    bf16* QO = (bf16*)(ws + WS_QO);
    bf16* KA = (bf16*)(ws + WS_KV); bf16* VA = (bf16*)(ws + WS_KV + KV_BYTES); bf16* KB = (bf16*)(ws + WS_KV + 2 * KV_BYTES); bf16* VB = (bf16*)(ws + WS_KV + 3 * KV_BYTES);
    bf16* HB = (bf16*)(ws + WS_H);

    for (int u = tid; u < (LDS_BYTES - LDSCTL_OFF) / 4; u += NWAVES * 64) ((LAS unsigned*)(L + LDSCTL_OFF))[u] = 0u;
    __syncthreads();
    XcdBarrier bar; bar.bar = (unsigned*)(ctl + CW_BAR); bar.x = 0; bar.st = nullptr;
    if (N_LAUNCHES == 1) bar = xcd_barrier_post((unsigned*)(ctl + CW_BAR), MISC + 8);
#define GRID_BAR() do { if (N_LAUNCHES == 1) xcd_barrier(bar); } while (0)
    const int lo = args.ph_lo, hi = args.ph_hi;
#ifndef PHMASK
#define PHMASK 0x3FF
#endif
#define IN(k) (((PHMASK >> (k)) & 1) && lo <= (k) && (k) < hi)
#define BOTH(k) (IN(k) && IN((k) + 1))

    if (IN(0)) {
        if (bx < 192) {
            const int cb = bx >> 2, kq = bx & 3, k0 = kq * 512 + wave * 64;
            float sv[5];
#pragma unroll
            for (int b = 0; b < 4; ++b) sv[b] = silu_f(cvec[b * DM + k0 + lane]);
            sv[4] = silu_f(c_ctx[k0 + lane]);
            f32x4 acc[5];
#pragma unroll
            for (int b = 0; b < 5; ++b) acc[b] = (f32x4){0.f, 0.f, 0.f, 0.f};
            const float* wp = w_ada + (size_t)k0 * NMOD + cb * 256 + lane * 4;
#pragma unroll 16
            for (int kk = 0; kk < 64; ++kk) { const f32x4 wv = *(const f32x4*)(wp + (size_t)kk * NMOD);
#pragma unroll
                for (int b = 0; b < 5; ++b) { const float s = __builtin_bit_cast(float, __builtin_amdgcn_readlane(__builtin_bit_cast(int, sv[b]), kk)); acc[b] += wv * s; } }
            LAS f32x4* red = (LAS f32x4*)(L + RING_OFF);
#pragma unroll
            for (int b = 0; b < 5; ++b) red[(wave * 5 + b) * 64 + lane] = acc[b];
            LDS_WAIT(); __syncthreads();
            if (tid < 320) { const int b = tid >> 6, l = tid & 63; f32x4 s = red[b * 64 + l];
#pragma unroll
                for (int w = 1; w < 8; ++w) s += red[(w * 5 + b) * 64 + l];
                *(f32x4*)(MODP + ((size_t)kq * 5 + b) * NMOD + cb * 256 + l * 4) = s; }
            __syncthreads();
        }
        if (bx == 255) {
            for (int e = tid; e < 2048; e += NWAVES * 64) { const int pos = e >> 5, f = e & 31;
                const float inv = exp2f(-(float)f * (13.287712379549449f / 32.0f)); const float ang = (float)pos * inv;
                float sn, cs; sincosf(ang, &sn, &cs); ROPEC[e] = cs; ROPES[e] = sn; }
        }
        {
            LAS float* scr = (LAS float*)(L + RING_OFF + wave * 16384);
            constexpr int I_IN = 32 * 96, I_OUT = 32 * 64, I_G = 32 * 176, NITEMS = I_IN + I_OUT + I_G, NSLOT = 192 * 8 * 2 + 64 * 8 * 5;
            const int nsl = bx < 192 ? 2 : 5, sl0 = bx < 192 ? (bx * 8 + wave) * 2 : 3072 + ((bx - 192) * 8 + wave) * 5;
            for (int s = 0; s < nsl; ++s)
                for (int it = sl0 + s; it < NITEMS; it += NSLOT) {
                    int r = it;
                    if (r < I_IN) { const int kb = r / 96, nb = r % 96, pn = nb >> 3, q = nb & 7, hh = q >> 2, part = (q >> 1) & 1, bj = q & 1;
                        transpose_item8(w_in, INW, 64 * kb, 32 * nb, WIN8, DM, 256 * pn + 32 * (4 * bj + 2 * hh + part), (float)(1 << S_W), scr, lane); continue; } r -= I_IN;
                    if (r < I_OUT) { const int kb = r / 64, nb = r % 64; transpose_item8(w_out, DM, 64 * kb, 32 * nb, WOUT8, DM, 32 * nb, (float)(1 << S_W), scr, lane); continue; } r -= I_OUT;
                    { const int kb = r / 176, nb = r % 176; transpose_item(w_gate, FFN, 64 * kb, 32 * nb, WGU, DM, 256 * (nb >> 2) + 32 * (nb & 3), scr, lane); }
                }
        }
        if (BOTH(0)) GRID_BAR();
    }

    if (IN(1)) {
        { const int idx = bx * 512 + tid;
          if (idx < 5 * NMOD) { float s = b_ada[idx % NMOD];
#pragma unroll
              for (int q = 0; q < 4; ++q) s += MODP[(size_t)q * 5 * NMOD + idx];
              MODS[idx] = s; } }
        if (bx < 128) {
            LAS float* P0 = (LAS float*)(L + RING_OFF); LAS float* P1 = P0 + 2048;
            for (int i = tid; i < 2048; i += NWAVES * 64) { float sh = b_ada[i], sc = b_ada[2048 + i];
#pragma unroll
                for (int q = 0; q < 4; ++q) { sh += MODP[((size_t)q * 5 + 4) * NMOD + i]; sc += MODP[((size_t)q * 5 + 4) * NMOD + 2048 + i]; }
                P0[i] = 1.0f + sc; P1[i] = sh; }
            LDS_WAIT(); __syncthreads();
            const int r = bx * 8 + wave;
            modulate_row8(ctx + (size_t)r * DM, U8 + (size_t)(M + r) * DM, P0, P1, (float)(1 << S_U), lane);
            __syncthreads();
        }
        if (BOTH(1)) GRID_BAR();
    }

    if (IN(2)) {
        if (bx < 16) {
            const int pnl[4] = {4, 5, 10, 11};
            pg8::Gemm g{(const bf16*)U8, (const bf16*)WIN8, MU, INW, DM / 2}; pg8::OneUnit S{64 + (bx >> 2), (bx & 3) == 0 ? 4 : (bx & 3) == 1 ? 5 : (bx & 3) == 2 ? 10 : 11}; (void)pnl;
            pg8::EpiQKV E{QO, KA, VA, KB, VB, qng, kng, ROPEC, ROPES, (LAS float*)(L + XCH_OFF)};
            pg8::gemm_phase<pg8::EpiQKV, pg8::OneUnit, true, true, E8(S_W), E8(S_U)>(L + RING_OFF, g, S, E);
        } else {
            LAS float* P0 = (LAS float*)(L + RING_OFF); LAS float* P1 = P0 + 2048;
            const int i = bx - 16, r0 = (int)(((long)i * M) / 240), r1 = (int)(((long)(i + 1) * M) / 240);
            int r = r0;
            while (r < r1) {
                const int b = r >> 12; int re = (b + 1) << 12; if (re > r1) re = r1;
                __syncthreads();
                for (int k = tid; k < 2048; k += NWAVES * 64) { P0[k] = 1.0f + MODS[b * NMOD + 2048 + k]; P1[k] = MODS[b * NMOD + k]; }
                LDS_WAIT(); __syncthreads();
                for (int rr = r + wave; rr < re; rr += NWAVES) modulate_row8(x + (size_t)rr * DM, U8 + (size_t)rr * DM, P0, P1, (float)(1 << S_U), lane);
                r = re;
            }
            __syncthreads();
            {
                LAS float* scr = (LAS float*)(L + RING_OFF + wave * 16384);
                constexpr int I_G = 32 * 176, I_D = 88 * 64, NITEMS2 = I_G + I_D;
                for (int it = i * 8 + wave; it < NITEMS2; it += 240 * 8) {
                    if (it < I_G) { const int kb = it / 176, nb = it % 176; transpose_item(w_up, FFN, 64 * kb, 32 * nb, WGU, DM, 256 * (nb >> 2) + 128 + 32 * (nb & 3), scr, lane); }
                    else { const int r2 = it - I_G, kb = r2 / 64, nb = r2 % 64; transpose_item(w_down, DM, 64 * kb, 32 * nb, WDN, FFN, 32 * nb, scr, lane); }
                }
            }
        }
        if (BOTH(2)) GRID_BAR();
    }

    if (IN(3)) {
        pg8::Gemm g{(const bf16*)U8, (const bf16*)WIN8, M, INW, DM / 2}; pg8::StaticOrder S; S.init(M, INW, G, bx);
        pg8::EpiQKV E{QO, KA, VA, KB, VB, qng, kng, ROPEC, ROPES, (LAS float*)(L + XCH_OFF)};
        pg8::gemm_phase<pg8::EpiQKV, pg8::StaticOrder, true, true, E8(S_W), E8(S_U)>(L + RING_OFF, g, S, E);
        if (BOTH(3)) GRID_BAR();
    }

    if (IN(4)) {
        const int xg = bx & 7, y = bx >> 3, b = xg >> 1, kvh = xg & 1;
        const size_t kvoff = (size_t)(b * 2 + kvh) * SKV * 128;
        float kbnd; { float gm = fmaxf(fabsf(kng[lane]), fabsf(kng[64 + lane]));
#pragma unroll
            for (int o = 1; o < 64; o <<= 1) gm = fmaxf(gm, __shfl_xor(gm, o));
            kbnd = gm * 11.313708498984761f * 1.01f; }
#define MKUNIT(u, i_) do { const int i__ = (i_); const int uu = 2 * y + (i__ & 1), gq = uu >> 4, qb = uu & 15, q0 = qb * 256; const bool isA = i__ >= 2; const int head = kvh * 4 + gq; \
            bf16* Qp = QO + (size_t)(b * SEQ + q0) * DM + (isA ? 0 : 1024) + head * 128; \
            const int jlo = !isA ? 0 : ((q0 >> 6) - 2 < 0 ? 0 : (q0 >> 6) - 2), jhi = (q0 >> 6) + 6 > 64 ? 64 : (q0 >> 6) + 6; \
            (u).Q = Qp; (u).K = (isA ? KA : KB) + kvoff; (u).V = (isA ? VA : VB) + kvoff; (u).O = ((args.flags & 1) ? ws + 384 * MiB : OF8) + (Qp - QO); \
            (u).NT = isA ? 4 + (jhi - jlo) : SKV / 64; (u).nctx = isA ? 4 : 0; (u).jlo = jlo; (u).q0 = q0; (u).masked = isA; (u).sinkl2 = isA ? sink[head] * 1.4426950408889634f : -INFINITY; (u).kbound = isA ? -1.f : kbnd; } while (0)
        att::bf16x8 qr[8]; att::Stg stg[2];
        att::AUnit cur, nx; MKUNIT(cur, 0); att::attn_prime(cur, qr, stg);
        for (int i = 0; i < 4; ++i) {
            MKUNIT(nx, i < 3 ? i + 1 : 3);
            att::attn_unit(cur, i < 3, nx, qr, stg, (char*)lds + RING_OFF);
            cur = nx;
        }
#undef MKUNIT
        if (BOTH(4)) GRID_BAR();
    }

    if (IN(5)) {
        pg8::Gemm g{(const bf16*)OF8, (const bf16*)WOUT8, M, DM, DM / 2}; pg8::StaticOrder S; S.init(M, DM, G, bx);
        pg8::EpiBf16Plain E{AB, DM};
        pg8::gemm_phase<pg8::EpiBf16Plain, pg8::StaticOrder, true, true, E8(S_W), E8(S_O)>(L + RING_OFF, g, S, E);
        if (BOTH(5)) GRID_BAR();
    }

    if (IN(6)) {
        LAS float* P = (LAS float*)(L + RING_OFF);
        const int b = bx >> 6;
        for (int k = tid; k < 2048; k += NWAVES * 64) { P[k] = MODS[b * NMOD + 2 * 2048 + k]; P[2048 + k] = ln1g[k]; P[4096 + k] = ln1b[k]; P[6144 + k] = 1.0f + MODS[b * NMOD + 4 * 2048 + k]; P[8192 + k] = MODS[b * NMOD + 3 * 2048 + k]; }
        LDS_WAIT(); __syncthreads();
        for (int rr = bx * 64 + wave; rr < bx * 64 + 64; rr += NWAVES) {
            f32x4 v[8]; x1_row(v, x + (size_t)rr * DM, AB + (size_t)rr * DM, P, lane);
            GAS unsigned long long* o8 = (GAS unsigned long long*)(U + (size_t)rr * DM) + lane;
#pragma unroll
            for (int j = 0; j < 8; ++j) { const int c = 256 * j + 4 * lane; const f32x4 r = v[j] * *(const LAS f32x4*)(P + 6144 + c) + *(const LAS f32x4*)(P + 8192 + c);
                o8[64 * j] = (unsigned long long)pk2(r.x, r.y) | ((unsigned long long)pk2(r.z, r.w) << 32); }
        }
        __syncthreads();
        if (BOTH(6)) GRID_BAR();
    }

    if (IN(7)) {
        pg8::Gemm g{U, WGU, M, 2 * FFN, DM}; pg8::StaticOrder S; S.init(M, 2 * FFN, G, bx);
        pg8::EpiSwiglu E{HB, FFN};
        pg8::gemm_phase<pg8::EpiSwiglu, pg8::StaticOrder, true, true>(L + RING_OFF, g, S, E);
        if (BOTH(7)) GRID_BAR();
    }

    if (IN(8)) {
        pg8::Gemm g{HB, WDN, M, DM, FFN}; pg8::StaticOrder S; S.init(M, DM, G, bx);
        pg8::EpiBf16Plain E{DB, DM};
        pg8::gemm_phase<pg8::EpiBf16Plain, pg8::StaticOrder, true, true>(L + RING_OFF, g, S, E);
        if (BOTH(8)) GRID_BAR();
    }

    if (IN(9)) {
        LAS float* P = (LAS float*)(L + RING_OFF);
        const int b = bx >> 6;
        for (int k = tid; k < 2048; k += NWAVES * 64) { P[k] = MODS[b * NMOD + 2 * 2048 + k]; P[2048 + k] = ln1g[k]; P[4096 + k] = ln1b[k]; P[6144 + k] = MODS[b * NMOD + 5 * 2048 + k]; P[8192 + k] = ln2g[k]; P[10240 + k] = ln2b[k]; }
        LDS_WAIT(); __syncthreads();
        for (int rr = bx * 64 + wave; rr < bx * 64 + 64; rr += NWAVES) {
            f32x4 v[8]; x1_row(v, x + (size_t)rr * DM, AB + (size_t)rr * DM, P, lane);
            const GAS u32x2* dr = (const GAS u32x2*)(DB + (size_t)rr * DM) + lane;
#pragma unroll
            for (int j = 0; j < 8; ++j) v[j] = v[j] * DN_ALPHA + *(const LAS f32x4*)(P + 6144 + 256 * j + 4 * lane) * bf4_to_f32(dr[64 * j]);
            ln_regs(v, P + 8192, P + 10240, lane);
            GAS f32x4* orow = (GAS f32x4*)(args.out + (size_t)rr * DM) + lane;
#pragma unroll
            for (int j = 0; j < 8; ++j) orow[64 * j] = v[j];
        }
    }
#undef IN
#undef BOTH
#undef GRID_BAR
}

extern "C" void kernel_launch(void* const* d_in, const int* in_sizes, int n_in, void* d_out, int out_size, void* d_ws, size_t ws_size, hipStream_t stream) {
    static int grid = 0;
    if (grid == 0) {
        if (n_in != 18 || in_sizes[0] != M * DM || out_size != M * DM || ws_size < WS_END) {
            fprintf(stderr, "kernel_launch: shape mismatch (n_in %d, in0 %d, out %d, ws %zu; need ws >= %zu); nothing launched\n", n_in, n_in > 0 ? in_sizes[0] : -1, out_size, ws_size, (size_t)WS_END); grid = -1; return; }
        int dev = 0, cus = 0, per_cu = 0;
        if (hipGetDevice(&dev) != hipSuccess || hipDeviceGetAttribute(&cus, hipDeviceAttributeMultiprocessorCount, dev) != hipSuccess) { fprintf(stderr, "kernel_launch: device query failed\n"); grid = -1; return; }
        if (hipFuncSetAttribute((const void*)dit_fwd, hipFuncAttributeMaxDynamicSharedMemorySize, LDS_BYTES) != hipSuccess) { fprintf(stderr, "kernel_launch: hipFuncSetAttribute failed\n"); grid = -1; return; }
        if (hipOccupancyMaxActiveBlocksPerMultiprocessor(&per_cu, (const void*)dit_fwd, NWAVES * 64, LDS_BYTES) != hipSuccess || per_cu < 1)
            fprintf(stderr, "kernel_launch: note: occupancy query reports %d workgroups per CU\n", per_cu);
        (void)hipGetLastError();
        if (cus != 256) { fprintf(stderr, "kernel_launch: built for a 256-CU device, found %d CUs; nothing launched\n", cus); grid = -1; return; }
        grid = 256;
    }
    if (grid < 0) return;
    if (hipMemsetAsync((char*)d_ws + WS_CTL, 0, CTL_ZERO_BYTES, stream) != hipSuccess) { fprintf(stderr, "kernel_launch: hipMemsetAsync failed\n"); return; }
    Args a{};
    for (int i = 0; i < 18; ++i) a.in[i] = (const float*)d_in[i];
    a.out = (float*)d_out; a.ws = (unsigned char*)d_ws;
    if (N_LAUNCHES == 1) { a.ph_lo = 0; a.ph_hi = N_PHASES; a.li = 0; hipLaunchKernelGGL(dit_fwd, dim3(grid), dim3(NWAVES * 64), LDS_BYTES, stream, a); }
    else { const int plist[] = PHASE_LIST;
        for (unsigned i = 0; i < sizeof(plist) / sizeof(int); ++i) { const int p = plist[i] % 100; a.ph_lo = p; a.ph_hi = p + 1; a.li = 0; a.flags = plist[i] >= 100 ? 1 : 0;
            hipLaunchKernelGGL(dit_fwd, dim3(grid), dim3(NWAVES * 64), LDS_BYTES, stream, a); } }
    const hipError_t le = hipPeekAtLastError();
    if (le != hipSuccess) fprintf(stderr, "kernel_launch: launch failed: %s\n", hipGetErrorName(le));
}
```

```cpp
#include <hip/hip_runtime.h>
#include <hip/hip_bf16.h>
#include <cstdio>
#include <cstdint>

#ifndef PHASE_LIST
#define PHASE_LIST {0, 1, 2, 3, 4, 5, 6, 7, 8, 9}
#endif
#ifndef MK_N_LAUNCHES
#define MK_N_LAUNCHES 1
#endif

namespace pg8 {
#define PG8_LAS __attribute__((address_space(3)))
typedef unsigned short bf16_t;
typedef short bf16x8 __attribute__((ext_vector_type(8)));
typedef float f32x4 __attribute__((ext_vector_type(4)));
typedef unsigned u32x4 __attribute__((ext_vector_type(4)));
constexpr int BM = 256, BK = 64, HALF = 128, HTB = HALF * BK * 2, STAGE_BYTES = 8 * HTB, NXCD = 8, WGM = 8;

__host__ __device__ __forceinline__ int lds_byte(int r, int c) { const int st = (r >> 4) * 2 + (c >> 5), rr = r & 15, cc = c & 31, ob = rr * 64 + cc * 2; return st * 1024 + (ob ^ (((ob >> 9) & 1) << 5)); }
__host__ __device__ __forceinline__ void stage_rc(int b, int& R, int& C) { const int st = b / 1024, sb = b % 1024, swz = sb ^ (((sb >> 9) & 1) << 5); R = (st >> 1) * 16 + swz / 64; C = (st & 1) * 32 + (swz % 64) / 2; }
__host__ __device__ __forceinline__ int perm32(int rho) { const int n = rho >> 4, i = rho & 15; return 8 * (i >> 2) + 4 * n + (i & 3); }

struct Unit { int pm, pn; };
struct Gemm { const bf16_t* A; const bf16_t* Bt; int M, N, K; };

struct StaticOrder {
    int nM, nN, nwg, G, c;
    __host__ __device__ void init(int M, int N, int G_, int c_) { nM = M / BM; nN = N / BM; nwg = nM * nN; G = G_; c = c_; }
    __host__ __device__ bool next(int i, Unit& u) const {
        const long L = (long)i * G + c; if (L >= nwg) return false;
        int wgid = (int)L; { const int q = nwg / NXCD, r = nwg % NXCD, xcd = wgid % NXCD, off = wgid / NXCD; wgid = (xcd < r ? xcd * (q + 1) : r * (q + 1) + (xcd - r) * q) + off; }
        const int nig = WGM * nN, gid = wgid / nig, fm = gid * WGM, gsz = (nM - fm) < WGM ? (nM - fm) : WGM;
        u.pm = fm + ((wgid % nig) % gsz); u.pn = (wgid % nig) / gsz; return true;
    }
    __device__ __forceinline__ void a_ready(const Unit&) const {}
    __device__ __forceinline__ void done(const Unit&) const {}
};
struct OneUnit {
    int pm, pn;
    __device__ bool next(int i, Unit& u) const { if (i > 0) return false; u.pm = pm; u.pn = pn; return true; }
    __device__ __forceinline__ void a_ready(const Unit&) const {}
    __device__ __forceinline__ void done(const Unit&) const {}
};

__device__ __forceinline__ unsigned cvt_pk_bf16(float lo, float hi) { unsigned r; asm volatile("v_cvt_pk_bf16_f32 %0, %1, %2" : "=v"(r) : "v"(lo), "v"(hi)); return r; }


struct EpiQKV {
    static constexpr bool PERM = true, AFTER_DRAIN = false;
    unsigned char* QO; unsigned char* KA; bf16_t* VA; unsigned char* KB; bf16_t* VB;
    const float* qg; const float* kg; const float* ropec; const float* ropes;
    PG8_LAS float* xch;
    __device__ __forceinline__ void operator()(const f32x4 (&acc)[2][2][4][2], const Unit& u, int wr, int wc, int fr, int fq) const {
        const int pn = u.pn; const bool is_ctx = u.pm >= 64;
        const int b = is_ctx ? (u.pm - 64) : (u.pm >> 4), t0 = is_ctx ? 4096 : ((u.pm & 15) << 8);
        const int hh = wc >> 1, part = wc & 1, wid = wr * 4 + wc;
        const bool isq = (pn < 4) || (pn >= 6 && pn < 10), donorm = (pn >= 6 && pn <= 10), dorope = (!is_ctx) && pn != 5 && pn != 11;
        const bool isv = (pn == 5 || pn == 11);
        bf16_t* base = nullptr; unsigned char* base8 = nullptr; size_t rstride;
        if (isq) { const int head = (pn < 4 ? 2 * pn : 8 + 2 * (pn - 6)) + hh; base8 = QO + (size_t)(b * 4096 + t0) * 2048 + head * 128; rstride = 2048; }
        else if (isv) { bf16_t* buf = pn == 5 ? VA : VB; base = buf + ((size_t)(b * 2 + hh) * 4352 + t0) * 128; rstride = 128; }
        else { unsigned char* buf = pn == 4 ? KA : KB; base8 = buf + ((size_t)(b * 2 + hh) * 4352 + t0) * 128; rstride = 128; }
        const int d0 = 64 * part + 8 * fq;
        float rs[2][4];
        f32x4 gv[2][2];
#pragma unroll
        for (int bj = 0; bj < 2; ++bj)
#pragma unroll
            for (int n = 0; n < 2; ++n) gv[bj][n] = (f32x4){1.f, 1.f, 1.f, 1.f};
#pragma unroll
        for (int ai = 0; ai < 2; ++ai)
#pragma unroll
            for (int m = 0; m < 4; ++m) rs[ai][m] = 1.f;
        if (donorm) {
            const float* g = (pn == 10) ? kg : qg;
#pragma unroll
            for (int bj = 0; bj < 2; ++bj)
#pragma unroll
                for (int n = 0; n < 2; ++n) gv[bj][n] = *(const f32x4*)(g + d0 + 32 * bj + 4 * n);
#pragma unroll
            for (int ai = 0; ai < 2; ++ai)
#pragma unroll
                for (int m = 0; m < 4; ++m) {
                    float s = 0.f;
#pragma unroll
                    for (int bj = 0; bj < 2; ++bj)
#pragma unroll
                        for (int n = 0; n < 2; ++n) { const f32x4 x = acc[ai][bj][m][n]; s += (x[0] * x[0] + x[1] * x[1]) + (x[2] * x[2] + x[3] * x[3]); }
                    s += __shfl_xor(s, 16); s += __shfl_xor(s, 32);
                    if (fq == 0) xch[wid * 128 + ai * 64 + m * 16 + fr] = s;
                    rs[ai][m] = s;
                }
            asm volatile("s_waitcnt lgkmcnt(0)" ::: "memory"); __builtin_amdgcn_s_barrier(); asm volatile("" ::: "memory");
#pragma unroll
            for (int ai = 0; ai < 2; ++ai)
#pragma unroll
                for (int m = 0; m < 4; ++m) { const float o = xch[(wid ^ 1) * 128 + ai * 64 + m * 16 + fr]; rs[ai][m] = __builtin_amdgcn_rsqf((rs[ai][m] + o) * (1.0f / 128.0f) + 1e-6f); }
        }
#pragma unroll
        for (int ai = 0; ai < 2; ++ai)
#pragma unroll
            for (int m = 0; m < 4; ++m) {
                const int rt = ai * HALF + wr * 64 + m * 16 + fr;
                f32x4 lo[2], hi[2];
#pragma unroll
                for (int n = 0; n < 2; ++n) { lo[n] = acc[ai][0][m][n] * rs[ai][m] * gv[0][n]; hi[n] = acc[ai][1][m][n] * rs[ai][m] * gv[1][n]; }
                if (dorope) {
                    const int t = t0 + rt, pos = part ? (t & 63) : (t >> 6);
#pragma unroll
                    for (int n = 0; n < 2; ++n) {
                        const f32x4 c4 = *(const f32x4*)(ropec + pos * 32 + 8 * fq + 4 * n), s4 = *(const f32x4*)(ropes + pos * 32 + 8 * fq + 4 * n);
                        const f32x4 a = lo[n], bb = hi[n];
                        lo[n] = a * c4 - bb * s4; hi[n] = bb * c4 + a * s4;
                    }
                }
                if (isv) {
                bf16_t* rowp = base + (size_t)rt * rstride + d0;
                u32x4 w0, w1;
                w0.x = cvt_pk_bf16(lo[0][0], lo[0][1]); w0.y = cvt_pk_bf16(lo[0][2], lo[0][3]); w0.z = cvt_pk_bf16(lo[1][0], lo[1][1]); w0.w = cvt_pk_bf16(lo[1][2], lo[1][3]);
                w1.x = cvt_pk_bf16(hi[0][0], hi[0][1]); w1.y = cvt_pk_bf16(hi[0][2], hi[0][3]); w1.z = cvt_pk_bf16(hi[1][0], hi[1][1]); w1.w = cvt_pk_bf16(hi[1][2], hi[1][3]);
                *(u32x4*)(rowp) = w0; *(u32x4*)(rowp + 32) = w1;
                } else {
                unsigned char* rowp = base8 + (size_t)rt * rstride + d0;
                typedef unsigned u2v __attribute__((ext_vector_type(2))); u2v w0, w1;
#define QK8(a, b, c, d) ({ int t_ = __builtin_amdgcn_cvt_pk_fp8_f32(__builtin_fminf(__builtin_fmaxf((a) * 16.f, -448.f), 448.f), __builtin_fminf(__builtin_fmaxf((b) * 16.f, -448.f), 448.f), 0, false); \
                        (unsigned)__builtin_amdgcn_cvt_pk_fp8_f32(__builtin_fminf(__builtin_fmaxf((c) * 16.f, -448.f), 448.f), __builtin_fminf(__builtin_fmaxf((d) * 16.f, -448.f), 448.f), t_, true); })
                w0.x = QK8(lo[0][0], lo[0][1], lo[0][2], lo[0][3]); w0.y = QK8(lo[1][0], lo[1][1], lo[1][2], lo[1][3]);
                w1.x = QK8(hi[0][0], hi[0][1], hi[0][2], hi[0][3]); w1.y = QK8(hi[1][0], hi[1][1], hi[1][2], hi[1][3]);
#undef QK8
                *(u2v*)(rowp) = w0; *(u2v*)(rowp + 32) = w1;
                }
            }
    }
};

struct EpiResid {
    static constexpr bool PERM = false, AFTER_DRAIN = false;
    const float* res; const float* gate; float* out; float alpha;
    __device__ __forceinline__ void operator()(const f32x4 (&acc)[2][2][4][2], const Unit& u, int wr, int wc, int fr, int fq) const {
        const int row0 = u.pm * BM + wr * 64 + fr, col0 = u.pn * BM + wc * 32 + 4 * fq, b = u.pm >> 4;
        f32x4 gv[2][2];
#pragma unroll
        for (int bj = 0; bj < 2; ++bj)
#pragma unroll
            for (int n = 0; n < 2; ++n) gv[bj][n] = *(const f32x4*)(gate + b * 12288 + col0 + bj * HALF + n * 16);
#pragma unroll
        for (int ai = 0; ai < 2; ++ai)
#pragma unroll
            for (int m = 0; m < 4; ++m) { const size_t off = (size_t)(row0 + ai * HALF + m * 16) * 2048 + col0;
#pragma unroll
                for (int bj = 0; bj < 2; ++bj)
#pragma unroll
                    for (int n = 0; n < 2; ++n) { const f32x4 xv = *(const f32x4*)(res + off + bj * HALF + n * 16);
                        *(f32x4*)(out + off + bj * HALF + n * 16) = xv * alpha + gv[bj][n] * acc[ai][bj][m][n]; } }
    }
};


struct EpiBf16Plain {
    static constexpr bool PERM = true, AFTER_DRAIN = false;
    bf16_t* O; int ldc;
    __device__ __forceinline__ void operator()(const f32x4 (&acc)[2][2][4][2], const Unit& u, int wr, int wc, int fr, int fq) const {
        const int row0 = u.pm * BM + wr * 64 + fr, col0 = u.pn * BM + wc * 32 + 8 * fq;
#pragma unroll
        for (int ai = 0; ai < 2; ++ai)
#pragma unroll
            for (int m = 0; m < 4; ++m) { bf16_t* rowp = O + (size_t)(row0 + ai * HALF + m * 16) * ldc + col0;
#pragma unroll
                for (int bj = 0; bj < 2; ++bj) { const f32x4 v0 = acc[ai][bj][m][0], v1 = acc[ai][bj][m][1];
                    u32x4 w; w.x = cvt_pk_bf16(v0[0], v0[1]); w.y = cvt_pk_bf16(v0[2], v0[3]); w.z = cvt_pk_bf16(v1[0], v1[1]); w.w = cvt_pk_bf16(v1[2], v1[3]);
                    *(u32x4*)(rowp + bj * HALF) = w; } }
    }
};

struct EpiSwiglu {
    static constexpr bool PERM = true, AFTER_DRAIN = false;
    bf16_t* H; int ldh;
    __device__ __forceinline__ void operator()(const f32x4 (&acc)[2][2][4][2], const Unit& u, int wr, int wc, int fr, int fq) const {
        const int row0 = u.pm * BM + wr * 64 + fr, col0 = u.pn * 128 + wc * 32 + 8 * fq;
#pragma unroll
        for (int ai = 0; ai < 2; ++ai)
#pragma unroll
            for (int m = 0; m < 4; ++m) { bf16_t* rowp = H + (size_t)(row0 + ai * HALF + m * 16) * ldh + col0;
                f32x4 o[2];
#pragma unroll
                for (int n = 0; n < 2; ++n) { const f32x4 g = acc[ai][0][m][n], up = acc[ai][1][m][n];
#pragma unroll
                    for (int e = 0; e < 4; ++e) { const float sg = __builtin_amdgcn_rcpf(1.0f + __builtin_amdgcn_exp2f(-1.4426950408889634f * g[e])); o[n][e] = g[e] * sg * up[e]; } }
                u32x4 w; w.x = cvt_pk_bf16(o[0][0], o[0][1]); w.y = cvt_pk_bf16(o[0][2], o[0][3]); w.z = cvt_pk_bf16(o[1][0], o[1][1]); w.w = cvt_pk_bf16(o[1][2], o[1][3]);
                *(u32x4*)rowp = w; }
    }
};

typedef int v8i_t __attribute__((ext_vector_type(8))); typedef int v4i_t __attribute__((ext_vector_type(4)));
__device__ __forceinline__ v8i_t cat16(bf16x8 a, bf16x8 b) { return __builtin_shufflevector(__builtin_bit_cast(v4i_t, a), __builtin_bit_cast(v4i_t, b), 0, 1, 2, 3, 4, 5, 6, 7); }
template <class Epi, class Sched, bool ALIGN_EPI = false, bool SP2 = false, int SCW = 0, int SCA = 0>
__device__ __forceinline__ void gemm_phase(PG8_LAS unsigned char* lds, const Gemm g, const Sched& S, const Epi& E) {
    const int tid = threadIdx.x, wid = __builtin_amdgcn_readfirstlane(tid >> 6), lane = tid & 63, wr = wid >> 2, wc = wid & 3, fr = lane & 15, fq = lane >> 4;
    const int K = g.K, nt = K / BK;
    unsigned voffA[2], voffB[2];
#pragma unroll
    for (int i = 0; i < 2; ++i) { int R, C; stage_rc(tid * 16 + i * 8192, R, C); const int Rb = Epi::PERM ? ((R & ~31) + perm32(R & 31)) : R;
        voffA[i] = (unsigned)(R * K + C) * 2u; voffB[i] = (unsigned)(Rb * K + C) * 2u; }
    const size_t kstep = (size_t)(BK * 2);
    const size_t hstep = (size_t)HALF * K * 2;
    const size_t tstep = 2 * hstep;
    const unsigned ldsw = (unsigned)wid * 1024u;
    const int aoff = lds_byte(wr * 64 + fr, fq * 8), boff = lds_byte(wc * 32 + fr, fq * 8);
#define PG8_SA(b, h) (((b) * 2 + (h)) * HTB)
#define PG8_SB(b, h) ((4 + (b) * 2 + (h)) * HTB)
#define PG8_STAGE(bufoff, gbase, voff) do { _Pragma("unroll") for (int _i = 0; _i < 2; ++_i) \
        __builtin_amdgcn_global_load_lds((const unsigned*)((const char*)(gbase) + (voff)[_i]), (PG8_LAS unsigned*)(lds + (bufoff) + ldsw + _i * 8192), 16, 0, 0); } while (0)
#define PG8_LDA(dst, b, h) do { _Pragma("unroll") for (int m = 0; m < 4; ++m) { if constexpr (SCW != 0) dst##8[m] = cat16(*(const PG8_LAS bf16x8*)(lds + PG8_SA(b, h) + aoff + m * 2048), *(const PG8_LAS bf16x8*)(lds + PG8_SA(b, h) + aoff + m * 2048 + 1024)); \
        else { _Pragma("unroll") for (int k = 0; k < 2; ++k) dst[m][k] = *(const PG8_LAS bf16x8*)(lds + PG8_SA(b, h) + aoff + m * 2048 + k * 1024); } } } while (0)
#define PG8_LDB(dst, b, h) do { _Pragma("unroll") for (int n = 0; n < 2; ++n) { if constexpr (SCW != 0) dst##8[n] = cat16(*(const PG8_LAS bf16x8*)(lds + PG8_SB(b, h) + boff + n * 2048), *(const PG8_LAS bf16x8*)(lds + PG8_SB(b, h) + boff + n * 2048 + 1024)); \
        else { _Pragma("unroll") for (int k = 0; k < 2; ++k) dst[n][k] = *(const PG8_LAS bf16x8*)(lds + PG8_SB(b, h) + boff + n * 2048 + k * 1024); } } } while (0)
#define PG8_MMA(ai, bj, At, Bt) do { __builtin_amdgcn_s_setprio(1); _Pragma("unroll") for (int m = 0; m < 4; ++m) _Pragma("unroll") for (int n = 0; n < 2; ++n) { \
        if constexpr (SCW != 0) asm volatile("v_mfma_scale_f32_16x16x128_f8f6f4 %0, %1, %2, %0, %3, %4 op_sel_hi:[0,0,0]" : "+v"(acc[ai][bj][m][n]) : "v"(Bt##8[n]), "v"(At##8[m]), "v"(scw_), "v"(sca_));     \
        else { _Pragma("unroll") for (int k = 0; k < 2; ++k) acc[ai][bj][m][n] = __builtin_amdgcn_mfma_f32_16x16x32_bf16(Bt[n][k], At[m][k], acc[ai][bj][m][n], 0, 0, 0); } } \
        __builtin_amdgcn_s_setprio(0); } while (0)
#define PG8_WAIT_V(n) asm volatile("s_waitcnt vmcnt(" #n ")" ::: "memory")
#define PG8_WAIT_L(n) asm volatile("s_waitcnt lgkmcnt(" #n ")" ::: "memory")
#define PG8_BAR __builtin_amdgcn_s_barrier()
#define PG8_SCHED __builtin_amdgcn_sched_barrier(0)
    Unit cur, nxt; int ui = 0;
    if (!S.next(0, cur)) return;
    f32x4 acc[2][2][4][2];
#pragma unroll
    for (int a = 0; a < 2; ++a)
#pragma unroll
        for (int b = 0; b < 2; ++b)
#pragma unroll
            for (int m = 0; m < 4; ++m)
#pragma unroll
                for (int n = 0; n < 2; ++n) acc[a][b][m][n] = (f32x4){0.f, 0.f, 0.f, 0.f};
    int scw_ = SCW, sca_ = SCA; asm volatile("" : "+v"(scw_), "+v"(sca_));
    bf16x8 At[4][2], B0[2][2], B1[2][2]; v8i_t At8[4], B08[2], B18[2];
    const char* cA = (const char*)g.A + (size_t)cur.pm * tstep; const char* cB = (const char*)g.Bt + (size_t)cur.pn * tstep;
    S.a_ready(cur);
    if constexpr (SP2) {
        PG8_STAGE(PG8_SB(0, 0), cB, voffB); PG8_STAGE(PG8_SB(0, 1), cB + hstep, voffB); PG8_STAGE(PG8_SA(0, 0), cA, voffA); PG8_STAGE(PG8_SA(0, 1), cA + hstep, voffA);
        if (wr == 1) PG8_BAR;
        PG8_WAIT_V(2); PG8_BAR;
        PG8_STAGE(PG8_SB(1, 0), cB + kstep, voffB); PG8_STAGE(PG8_SA(1, 0), cA + kstep, voffA); PG8_STAGE(PG8_SB(1, 1), cB + hstep + kstep, voffB);
        PG8_WAIT_V(6); PG8_BAR;
    } else {
        PG8_STAGE(PG8_SB(0, 0), cB, voffB); PG8_STAGE(PG8_SA(0, 0), cA, voffA); PG8_STAGE(PG8_SB(0, 1), cB + hstep, voffB); PG8_STAGE(PG8_SA(0, 1), cA + hstep, voffA);
        if (wr == 1) PG8_BAR;
        PG8_WAIT_V(4); PG8_BAR;
        PG8_STAGE(PG8_SB(1, 0), cB + kstep, voffB); PG8_STAGE(PG8_SA(1, 0), cA + kstep, voffA); PG8_STAGE(PG8_SB(1, 1), cB + hstep + kstep, voffB);
        PG8_WAIT_V(6); PG8_BAR;
    }
    for (;;) {
        const bool has_next = S.next(ui + 1, nxt);
        const char* nA = has_next ? (const char*)g.A + (size_t)nxt.pm * tstep : cA; const char* nB = has_next ? (const char*)g.Bt + (size_t)nxt.pn * tstep : cB;
        for (int t = 0; t < nt; t += 2) {
            const bool last = (t == nt - 2);
            const char* a1 = cA + (size_t)(t + 1) * kstep;
            const char* a2 = last ? nA : cA + (size_t)(t + 2) * kstep; const char* b2 = last ? nB : cB + (size_t)(t + 2) * kstep;
            const char* a3 = a2 + kstep; const char* b3 = b2 + kstep;
            if (last && has_next) S.a_ready(nxt);
            if constexpr (SP2) {
            PG8_LDB(B0, 0, 0); PG8_LDB(B1, 0, 1); PG8_SCHED; PG8_LDA(At, 0, 0); PG8_STAGE(PG8_SA(1, 1), a1 + hstep, voffA);
            PG8_WAIT_V(8); PG8_WAIT_L(0); PG8_BAR; PG8_MMA(0, 0, At, B0); PG8_MMA(0, 1, At, B1); PG8_BAR; PG8_SCHED;
            PG8_LDA(At, 0, 1); PG8_STAGE(PG8_SB(0, 0), b2, voffB); PG8_STAGE(PG8_SB(0, 1), b2 + hstep, voffB); PG8_STAGE(PG8_SA(0, 0), a2, voffA);
            PG8_WAIT_V(8); PG8_WAIT_L(0); PG8_BAR; PG8_MMA(1, 0, At, B0); PG8_MMA(1, 1, At, B1); PG8_BAR; PG8_SCHED;
            PG8_LDB(B0, 1, 0); PG8_LDB(B1, 1, 1); PG8_SCHED; PG8_LDA(At, 1, 0); PG8_STAGE(PG8_SA(0, 1), a2 + hstep, voffA);
            PG8_WAIT_V(8); PG8_WAIT_L(0); PG8_BAR; PG8_MMA(0, 0, At, B0); PG8_MMA(0, 1, At, B1); PG8_BAR; PG8_SCHED;
            PG8_LDA(At, 1, 1); PG8_STAGE(PG8_SB(1, 0), b3, voffB); PG8_STAGE(PG8_SB(1, 1), b3 + hstep, voffB); PG8_STAGE(PG8_SA(1, 0), a3, voffA);
            PG8_WAIT_V(8); PG8_WAIT_L(0); PG8_BAR; PG8_MMA(1, 0, At, B0); PG8_MMA(1, 1, At, B1); PG8_BAR; PG8_SCHED;
            } else {
            PG8_LDB(B0, 0, 0); PG8_SCHED; PG8_LDA(At, 0, 0); PG8_STAGE(PG8_SA(1, 1), a1 + hstep, voffA);
            PG8_WAIT_L(8); PG8_BAR; PG8_WAIT_L(0); PG8_MMA(0, 0, At, B0); PG8_BAR; PG8_SCHED;
            PG8_LDB(B1, 0, 1); PG8_STAGE(PG8_SB(0, 0), b2, voffB);
            PG8_BAR; PG8_WAIT_L(0); PG8_MMA(0, 1, At, B1); PG8_BAR;
            PG8_LDA(At, 0, 1); PG8_STAGE(PG8_SA(0, 0), a2, voffA);
            PG8_BAR; PG8_WAIT_L(0); PG8_MMA(1, 0, At, B0); PG8_BAR; PG8_SCHED;
            PG8_STAGE(PG8_SB(0, 1), b2 + hstep, voffB);
            PG8_WAIT_V(6); PG8_BAR; PG8_MMA(1, 1, At, B1); PG8_BAR;
            PG8_LDB(B0, 1, 0); PG8_SCHED; PG8_LDA(At, 1, 0); PG8_STAGE(PG8_SA(0, 1), a2 + hstep, voffA);
            PG8_WAIT_L(8); PG8_BAR; PG8_WAIT_L(0); PG8_MMA(0, 0, At, B0); PG8_BAR; PG8_SCHED;
            PG8_LDB(B1, 1, 1); PG8_STAGE(PG8_SB(1, 0), b3, voffB);
            PG8_BAR; PG8_WAIT_L(0); PG8_MMA(0, 1, At, B1); PG8_BAR;
            PG8_LDA(At, 1, 1); PG8_STAGE(PG8_SA(1, 0), a3, voffA);
            PG8_BAR; PG8_WAIT_L(0); PG8_MMA(1, 0, At, B0); PG8_BAR; PG8_SCHED;
            PG8_STAGE(PG8_SB(1, 1), b3 + hstep, voffB);
            PG8_WAIT_V(6); PG8_BAR; PG8_MMA(1, 1, At, B1); PG8_BAR;
            }
        }
        if constexpr (ALIGN_EPI) { if (wr == 0) PG8_BAR; }
        if constexpr (SCW != 0) asm volatile("s_nop 15\n\ts_nop 15" ::: "memory");
        if constexpr (!Epi::AFTER_DRAIN) { E(acc, cur, wr, wc, fr, fq); S.done(cur); }
        if (!has_next) break;
#pragma unroll
        for (int a = 0; a < 2; ++a)
#pragma unroll
            for (int b = 0; b < 2; ++b)
#pragma unroll
                for (int m = 0; m < 4; ++m)
#pragma unroll
                    for (int n = 0; n < 2; ++n) acc[a][b][m][n] = (f32x4){0.f, 0.f, 0.f, 0.f};
        cur = nxt; cA = nA; cB = nB; ++ui;
        if constexpr (ALIGN_EPI) { if (wr == 1) PG8_BAR; }
    }
    PG8_WAIT_V(0);
    if constexpr (!ALIGN_EPI) { if (wr == 0) PG8_BAR; }
    PG8_BAR;
#undef PG8_SA
#undef PG8_SB
#undef PG8_STAGE
#undef PG8_LDA
#undef PG8_LDB
#undef PG8_MMA
#undef PG8_WAIT_V
#undef PG8_WAIT_L
#undef PG8_BAR
#undef PG8_SCHED
}
}

namespace att {
typedef unsigned short bf16;
using bf16x8 = __attribute__((ext_vector_type(8))) short;
using s16x4  = __attribute__((ext_vector_type(4))) short;
using f32x16 = __attribute__((ext_vector_type(16))) float;
using u32x4  = __attribute__((ext_vector_type(4))) unsigned;
constexpr int D = 128, NW = 8, QBLK = 32, KVBLK = 64;
constexpr float SCALE = 0.088388347648318440f;
constexpr float THR = 8.f;
constexpr int LDQ = 2048, LDK = 128, LDO = 2048;
constexpr float OSCL = 16.f;
constexpr int SHM_V = KVBLK * D * 2, SHM_K = KVBLK * D  , SHM_ATTN = 2 * SHM_V + 2 * SHM_K + NW * 64 * 4;
#define KSWZ(row, colB) ((row) * 256 + ((colB) ^ (((row) & 7) << 4)))
#define SBAR() __builtin_amdgcn_sched_barrier(0)
__device__ __forceinline__ int crow(int r, int hi) { return (r & 3) + 8 * (r >> 2) + 4 * hi; }
__device__ __forceinline__ unsigned cvtpk(float lo, float hi) { unsigned r; asm volatile("v_cvt_pk_bf16_f32 %0, %1, %2" : "=v"(r) : "v"(lo), "v"(hi)); return r; }

__device__ __forceinline__ void partialSM(f32x16& p0, f32x16& p1, float& m_reg, float& mn, float& alpha, bool fixedm) {
  constexpr float C = SCALE * 1.4426950408889634f;
  if (fixedm) { mn = m_reg; alpha = 1.f; }
  else {
  float pmax = p0[0]; for (int r = 1; r < 16; ++r) pmax = fmaxf(pmax, p0[r]); for (int r = 0; r < 16; ++r) pmax = fmaxf(pmax, p1[r]);
  { auto rr = __builtin_amdgcn_permlane32_swap(__float_as_uint(pmax), __float_as_uint(pmax), false, false);
    pmax = fmaxf(__uint_as_float(rr[0]), __uint_as_float(rr[1])); }
  if (__builtin_expect(__all(pmax - m_reg <= THR / SCALE), 1)) { mn = m_reg; alpha = 1.f; }
  else { mn = fmaxf(m_reg, pmax); alpha = __builtin_amdgcn_exp2f((m_reg - mn) * C); m_reg = mn; }
  }
  float mnC = -mn * C;
  for (int r = 0; r < 16; ++r) p0[r] = fmaf(p0[r], C, mnC); for (int r = 0; r < 16; ++r) p1[r] = fmaf(p1[r], C, mnC);
  for (int r = 0; r < 16; ++r) p0[r] = __builtin_amdgcn_exp2f(p0[r]);
}
__device__ __forceinline__ void finishSM(f32x16& p0, f32x16& p1, float alpha, float& l_reg, bf16x8& pa0, bf16x8& pa1, bf16x8& pa2, bf16x8& pa3) {
  for (int r = 0; r < 16; ++r) p1[r] = __builtin_amdgcn_exp2f(p1[r]);
  float ps = 0; for (int r = 0; r < 16; ++r) ps += p0[r]; for (int r = 0; r < 16; ++r) ps += p1[r];
  { auto rr = __builtin_amdgcn_permlane32_swap(__float_as_uint(ps), __float_as_uint(ps), false, false);
    ps = __uint_as_float(rr[0]) + __uint_as_float(rr[1]); }
  l_reg = l_reg * alpha + ps;
#define PK4(P, BASE, OUT) do { unsigned a0 = cvtpk(P[BASE + 0], P[BASE + 1]), a1 = cvtpk(P[BASE + 2], P[BASE + 3]);   \
    unsigned b0 = cvtpk(P[BASE + 4], P[BASE + 5]), b1 = cvtpk(P[BASE + 6], P[BASE + 7]);                              \
    auto r0 = __builtin_amdgcn_permlane32_swap(a0, b0, false, false); auto r1 = __builtin_amdgcn_permlane32_swap(a1, b1, false, false); \
    u32x4 w = {r0[0], r1[0], r0[1], r1[1]}; OUT = *reinterpret_cast<bf16x8*>(&w); } while (0)
  PK4(p0, 0, pa0); PK4(p0, 8, pa1); PK4(p1, 0, pa2); PK4(p1, 8, pa3);
#undef PK4
}
__device__ __forceinline__ void qkt(f32x16& p0, f32x16& p1, const bf16* Ks, const bf16x8* qr, int r32, int hi) {
  p0 = f32x16{}; p1 = f32x16{};
  for (int d0 = 0; d0 < 8; ++d0) { int cb = (d0 * 16 + hi * 8) * 2;
    bf16x8 b0 = *reinterpret_cast<const bf16x8*>((const char*)Ks + KSWZ(r32, cb));
    bf16x8 b1 = *reinterpret_cast<const bf16x8*>((const char*)Ks + KSWZ(32 + r32, cb));
    p0 = __builtin_amdgcn_mfma_f32_32x32x16_bf16(b0, qr[d0], p0, 0, 0, 0);
    p1 = __builtin_amdgcn_mfma_f32_32x32x16_bf16(b1, qr[d0], p1, 0, 0, 0); }
}
__device__ __forceinline__ void wmask(f32x16& p0, f32x16& p1, int kb, int qpos) {
  const int dq = qpos - kb + 128;
#pragma unroll
  for (int r = 0; r < 16; ++r) { const int d = dq - ((r & 3) + 8 * (r >> 2));
    if ((unsigned)d > 256u) p0[r] = -INFINITY;
    if ((unsigned)(d - 32) > 256u) p1[r] = -INFINITY; }
}
__device__ __forceinline__ int v_st(int k, int c) { const int kk = (k & ~0xC) | ((k & 4) << 1) | ((k & 8) >> 1); return ((kk >> 3) * 4 + (c >> 5)) * 512 + ((kk & 7) * 32 + (c & 31)) * 2; }
__device__ __forceinline__ int v_rd_base(int lane) { return ((lane & 3) << 3) | (((lane >> 2) & 3) << 6) | (((lane >> 4) & 1) << 5) | (((lane >> 5) & 1) << 8); }
constexpr int v_rd_off(int d0, int ks, int half) { return d0 * 512 + ks * 4096 + half * 2048; }
template <int OFF> __device__ __forceinline__ s16x4 tr_read(int vb) {
  s16x4 r; asm volatile("ds_read_b64_tr_b16 %0, %1 offset:%2" : "=&v"(r) : "v"(vb), "i"(OFF) : "memory"); return r;
}
template <int D0> __device__ __forceinline__ void pv_one(f32x16& od, int vb, bf16x8 pa0, bf16x8 pa1, bf16x8 pa2, bf16x8 pa3) {
  const s16x4 l0 = tr_read<v_rd_off(D0, 0, 0)>(vb), h0 = tr_read<v_rd_off(D0, 0, 1)>(vb), l1 = tr_read<v_rd_off(D0, 1, 0)>(vb), h1 = tr_read<v_rd_off(D0, 1, 1)>(vb);
  const s16x4 l2 = tr_read<v_rd_off(D0, 2, 0)>(vb), h2 = tr_read<v_rd_off(D0, 2, 1)>(vb), l3 = tr_read<v_rd_off(D0, 3, 0)>(vb), h3 = tr_read<v_rd_off(D0, 3, 1)>(vb);
  asm volatile("s_waitcnt lgkmcnt(0)" ::: "memory"); SBAR();
#define PK(L, H) (bf16x8){L[0], L[1], L[2], L[3], H[0], H[1], H[2], H[3]}
  od = __builtin_amdgcn_mfma_f32_32x32x16_bf16(pa0, PK(l0, h0), od, 0, 0, 0);
  od = __builtin_amdgcn_mfma_f32_32x32x16_bf16(pa1, PK(l1, h1), od, 0, 0, 0);
  od = __builtin_amdgcn_mfma_f32_32x32x16_bf16(pa2, PK(l2, h2), od, 0, 0, 0);
  od = __builtin_amdgcn_mfma_f32_32x32x16_bf16(pa3, PK(l3, h3), od, 0, 0, 0);
#undef PK
}
__device__ __forceinline__ void pv_d0(f32x16* o, int vb, bf16x8 pa0, bf16x8 pa1, bf16x8 pa2, bf16x8 pa3) {
  pv_one<0>(o[0], vb, pa0, pa1, pa2, pa3); pv_one<1>(o[1], vb, pa0, pa1, pa2, pa3); pv_one<2>(o[2], vb, pa0, pa1, pa2, pa3); pv_one<3>(o[3], vb, pa0, pa1, pa2, pa3);
}

typedef int v8i __attribute__((ext_vector_type(8))); typedef int v4i __attribute__((ext_vector_type(4)));
struct Stg { bf16x8 vs0, vs1; v4i k8; };
#define K8OFF(row, ch) ((row) * 128 + ((((ch) ^ (((row) >> 1) & 7))) << 4))
__device__ __forceinline__ v8i cat8(v4i a, v4i b) { return __builtin_shufflevector(a, b, 0, 1, 2, 3, 4, 5, 6, 7); }
__device__ __forceinline__ void qkt8(f32x16& p0, f32x16& p1, const char* Ks, const v8i (&q8)[2], int r32, int hi, int sc) {
  const v8i a00 = cat8(*(const v4i*)(Ks + K8OFF(r32, 2 * hi)), *(const v4i*)(Ks + K8OFF(r32, 2 * hi + 1)));
  const v8i a10 = cat8(*(const v4i*)(Ks + K8OFF(32 + r32, 2 * hi)), *(const v4i*)(Ks + K8OFF(32 + r32, 2 * hi + 1)));
  const v8i a01 = cat8(*(const v4i*)(Ks + K8OFF(r32, 4 + 2 * hi)), *(const v4i*)(Ks + K8OFF(r32, 4 + 2 * hi + 1)));
  const v8i a11 = cat8(*(const v4i*)(Ks + K8OFF(32 + r32, 4 + 2 * hi)), *(const v4i*)(Ks + K8OFF(32 + r32, 4 + 2 * hi + 1)));
  asm volatile("s_nop 1\n\tv_mfma_scale_f32_32x32x64_f8f6f4 %0, %1, %2, 0, %3, %3 op_sel_hi:[0,0,0]" : "=&v"(p0) : "v"(a00), "v"(q8[0]), "v"(sc));
  asm volatile("s_nop 1\n\tv_mfma_scale_f32_32x32x64_f8f6f4 %0, %1, %2, 0, %3, %3 op_sel_hi:[0,0,0]" : "=&v"(p1) : "v"(a10), "v"(q8[0]), "v"(sc));
  asm volatile("s_nop 1\n\tv_mfma_scale_f32_32x32x64_f8f6f4 %0, %1, %2, %0, %3, %3 op_sel_hi:[0,0,0]" : "+v"(p0) : "v"(a01), "v"(q8[1]), "v"(sc));
  asm volatile("s_nop 1\n\tv_mfma_scale_f32_32x32x64_f8f6f4 %0, %1, %2, %0, %3, %3 op_sel_hi:[0,0,0]" : "+v"(p1) : "v"(a11), "v"(q8[1]), "v"(sc));
}
#define QKT_SETTLE(P0, P1) asm volatile("s_nop 15\n\ts_nop 7" : "+v"(P0), "+v"(P1))
struct AUnit { const unsigned char* Q; const unsigned char* K; const bf16* V; unsigned char* O; int NT, nctx, jlo, q0; bool masked; float sinkl2, kbound; };
#define KOFU(u, t) (((t) < (u).nctx) ? (4096 + 64 * (t)) : 64 * ((u).jlo + (t) - (u).nctx))
#define SLOADX(dst, Kp, Vp, k0) do { const int k0_ = (k0); (dst).vs0 = *reinterpret_cast<const bf16x8*>(&(Vp)[(long)(k0_ + sr) * LDK + sc]); (dst).vs1 = *reinterpret_cast<const bf16x8*>(&(Vp)[(long)(k0_ + 32 + sr) * LDK + sc]); \
    (dst).k8 = *reinterpret_cast<const v4i*>(&(Kp)[(long)(k0_ + (tid >> 3)) * 128 + (tid & 7) * 16]); } while (0)
__device__ __forceinline__ void attn_prime(const AUnit& u, v8i (&qr)[2], Stg (&sr_)[2]) {
  const int tid = threadIdx.x, wid = tid >> 6, lane = tid & 63, r32 = lane & 31, hi = lane >> 5, sr = tid >> 4, sc = (tid & 15) * 8;
  const unsigned char* Qw = u.Q + (long)(wid * QBLK + r32) * LDQ + hi * 32;
#pragma unroll
  for (int j = 0; j < 2; ++j) qr[j] = cat8(*reinterpret_cast<const v4i*>(Qw + 64 * j), *reinterpret_cast<const v4i*>(Qw + 64 * j + 16));
  SLOADX(sr_[0], u.K, u.V, KOFU(u, 0)); SLOADX(sr_[1], u.K, u.V, KOFU(u, 1));
}
__device__ __forceinline__ void attn_unit(const AUnit& u, bool has_next, const AUnit& nx, v8i (&qr)[2], Stg (&sr_)[2], char* lds) {
  const int tid = threadIdx.x, wid = tid >> 6, lane = tid & 63, r32 = lane & 31, hi = lane >> 5;
  const unsigned char* __restrict__ Kh = u.K; const bf16* __restrict__ Vh = u.V;
  int qksc = (127 - 4) * 0x01010101; asm volatile("" : "+v"(qksc));
  const int NT = u.NT, nctx = u.nctx, jlo = u.jlo; const bool masked = u.masked;
  bf16* V_lds = (bf16*)lds; bf16* K_lds = (bf16*)(lds + 2 * SHM_V);
  float* ws = (float*)(lds + 2 * SHM_V + 2 * SHM_K) + wid * 64; float* li_l = ws; float* al_l = ws + 32;
  float m_reg = -1e30f, l_reg = 0; f32x16 o[4] = {};
  const bool fixedm = u.kbound > 0.f;
  if (fixedm) { float ss = 0.f;
#pragma unroll
    for (int j = 0; j < 2; ++j)
#pragma unroll
      for (int e = 0; e < 8; ++e) { const int w = qr[j][e];
        const float q0_ = __builtin_amdgcn_cvt_f32_fp8(w, 0), q1_ = __builtin_amdgcn_cvt_f32_fp8(w, 1), q2_ = __builtin_amdgcn_cvt_f32_fp8(w, 2), q3_ = __builtin_amdgcn_cvt_f32_fp8(w, 3);
        ss += (q0_ * q0_ + q1_ * q1_) + (q2_ * q2_ + q3_ * q3_); }
    { auto rr = __builtin_amdgcn_permlane32_swap(__float_as_uint(ss), __float_as_uint(ss), false, false); ss = __uint_as_float(rr[0]) + __uint_as_float(rr[1]); }
    m_reg = sqrtf(ss) * (1.0f / 16.0f) * u.kbound; }
  const int sr = tid >> 4, sc = (tid & 15) * 8, vst0 = v_st(sr, sc), vst1 = v_st(32 + sr, sc);
  const int vb0 = (int)(uintptr_t)V_lds + v_rd_base(lane);
  const int qpos = u.q0 + wid * QBLK + r32;
#define KOF(t) (((t) < nctx) ? (4096 + 64 * (t)) : 64 * (jlo + (t) - nctx))
#define SLOAD(i, k0) SLOADX(sr_[i], Kh, Vh, k0)
#define SWRITE(b, i) do { *(bf16x8*)((char*)V_lds + (b) * SHM_V + vst0) = sr_[i].vs0;          \
    *(bf16x8*)((char*)V_lds + (b) * SHM_V + vst1) = sr_[i].vs1;                                \
    *(v4i*)((char*)K_lds + (b) * SHM_K + K8OFF(tid >> 3, tid & 7)) = sr_[i].k8; } while (0)
#define SWAIT() asm volatile("s_waitcnt vmcnt(4)" ::: "memory")
#define RESC(a) do { if (__any((a) < 1.f)) { if (hi == 0) al_l[r32] = (a); asm volatile("s_waitcnt lgkmcnt(0)" ::: "memory"); \
    for (int d = 0; d < 4; ++d) for (int r = 0; r < 16; ++r) o[d][r] *= al_l[crow(r, hi)]; } } while (0)
#define MASK(P0, P1, t) do { if (masked && (t) >= nctx) wmask(P0, P1, KOF(t) + 4 * hi, qpos); } while (0)
  f32x16 pA0, pA1, pB0, pB1; float mnA, mnB, alA, alB; bf16x8 pa0, pa1, pa2, pa3;
  constexpr int SE = 0, SO = 1;
  SWAIT(); SWRITE(0, SE); __syncthreads();
  if (2 < NT) SLOAD(SE, KOF(2));
  qkt8(pA0, pA1, (const char*)K_lds, qr, r32, hi, qksc); QKT_SETTLE(pA0, pA1); MASK(pA0, pA1, 0); partialSM(pA0, pA1, m_reg, mnA, alA, fixedm);
  SWAIT(); SWRITE(1, SO); __syncthreads();
  for (int j = 1; j + 1 < NT; j += 2) {
    SBAR(); qkt8(pB0, pB1, (const char*)K_lds + SHM_K, qr, r32, hi, qksc);
    finishSM(pA0, pA1, alA, l_reg, pa0, pa1, pa2, pa3); SBAR();
    SLOAD(SO, KOF(j + 2)); SBAR();
    pv_d0(o, vb0, pa0, pa1, pa2, pa3); QKT_SETTLE(pB0, pB1); MASK(pB0, pB1, j); partialSM(pB0, pB1, m_reg, mnB, alB, fixedm);
    __syncthreads(); SWAIT(); SWRITE(0, SE);
    RESC(alB); __syncthreads();
    SBAR(); qkt8(pA0, pA1, (const char*)K_lds, qr, r32, hi, qksc);
    finishSM(pB0, pB1, alB, l_reg, pa0, pa1, pa2, pa3); SBAR();
    if (j + 3 < NT) SLOAD(SE, KOF(j + 3)); SBAR();
    pv_d0(o, vb0 + (int)SHM_V, pa0, pa1, pa2, pa3); QKT_SETTLE(pA0, pA1); MASK(pA0, pA1, j + 1); partialSM(pA0, pA1, m_reg, mnA, alA, fixedm);
    __syncthreads(); SWAIT(); SWRITE(1, SO);
    RESC(alA); __syncthreads();
  }
  SBAR(); qkt8(pB0, pB1, (const char*)K_lds + SHM_K, qr, r32, hi, qksc);
  finishSM(pA0, pA1, alA, l_reg, pa0, pa1, pa2, pa3); SBAR();
  pv_d0(o, vb0, pa0, pa1, pa2, pa3); QKT_SETTLE(pB0, pB1); MASK(pB0, pB1, NT - 1); partialSM(pB0, pB1, m_reg, mnB, alB, fixedm);
  SBAR(); if (has_next) attn_prime(nx, qr, sr_); SBAR();
  __syncthreads(); RESC(alB);
  finishSM(pB0, pB1, alB, l_reg, pa0, pa1, pa2, pa3); SBAR();
  pv_d0(o, vb0 + (int)SHM_V, pa0, pa1, pa2, pa3);
  l_reg += __builtin_amdgcn_exp2f(u.sinkl2 - m_reg * (SCALE * 1.4426950408889634f));
  if (hi == 0) li_l[r32] = l_reg; asm volatile("s_waitcnt lgkmcnt(0)" ::: "memory");
  float rli[16];
#pragma unroll
  for (int r = 0; r < 16; ++r) rli[r] = __builtin_amdgcn_rcpf(li_l[crow(r, hi)]);
  __syncthreads();
  { char* stg = lds + wid * 8192 + (4 * hi * 128 + r32) * 2;
#pragma unroll
    for (int r = 0; r < 16; ++r) {
#pragma unroll
      for (int d0 = 0; d0 < 4; ++d0) { const float v = o[d0][r] * rli[r]; *(bf16*)(stg + ((r & 3) + 8 * (r >> 2)) * 256 + d0 * 64) = (bf16)(cvtpk(v, v) & 0xffffu); }
      asm volatile("" ::: "memory"); }
    asm volatile("s_waitcnt lgkmcnt(0)" ::: "memory");
    unsigned char* Ow = u.O + (long)(wid * QBLK + (lane >> 4)) * LDO + (lane & 15) * 8;
    const char* rd = lds + wid * 8192 + (lane >> 4) * 256 + (lane & 15) * 16;
#pragma unroll
    for (int i = 0; i < 8; ++i) { const u32x4 v = *(const u32x4*)(rd + i * 1024);
      typedef unsigned u2v __attribute__((ext_vector_type(2))); u2v w;
#define LO16(x) (__uint_as_float((x) << 16) * OSCL)
#define HI16(x) (__uint_as_float((x) & 0xffff0000u) * OSCL)
      { int t = __builtin_amdgcn_cvt_pk_fp8_f32(LO16(v.x), HI16(v.x), 0, false); t = __builtin_amdgcn_cvt_pk_fp8_f32(LO16(v.y), HI16(v.y), t, true); w.x = (unsigned)t; }
      { int t = __builtin_amdgcn_cvt_pk_fp8_f32(LO16(v.z), HI16(v.z), 0, false); t = __builtin_amdgcn_cvt_pk_fp8_f32(LO16(v.w), HI16(v.w), t, true); w.y = (unsigned)t; }
#undef LO16
#undef HI16
      *(u2v*)(Ow + (long)i * 4 * LDO) = w; } }
  __syncthreads();
#undef KOF
#undef SLOAD
#undef SWRITE
#undef SWAIT
#undef RESC
#undef MASK
}
#undef KOFU
#undef SLOADX
#undef K8OFF
#undef QKT_SETTLE
#undef KSWZ
#undef SBAR
}

constexpr int NWAVES = 8;
constexpr int N_LAUNCHES = MK_N_LAUNCHES;
constexpr int N_PHASES = 10;
constexpr int DM = 2048, NB = 4, SEQ = 4096, CTXL = 256, FFN = 5632, INW = 3072, NMOD = 12288;
constexpr int M = NB * SEQ, MC = NB * CTXL, MU = M + MC;
constexpr int SKV = SEQ + CTXL;
constexpr float LN_EPS = 1e-6f;
constexpr float DN_ALPHA = 1.189207115002721f;

constexpr size_t MiB = 1u << 20;
constexpr size_t WS_CTL = 0, CTL_ZERO_BYTES = 64 * 1024;
constexpr size_t WS_MODP = 1 * MiB;
constexpr size_t WS_MODS = 2 * MiB;
constexpr size_t WS_ROPE = 2 * MiB + 512 * 1024;
constexpr size_t WS_WIN = 3 * MiB, WS_WOUT = 15 * MiB, WS_WGU = 23 * MiB, WS_WDN = 67 * MiB;
constexpr size_t WS_U = 89 * MiB;
constexpr size_t WS_Y = 157 * MiB;
constexpr size_t WS_QO = 285 * MiB;
constexpr size_t WS_KV = 349 * MiB;
constexpr size_t KV_BYTES = (size_t)NB * 2 * SKV * 128 * 2;
constexpr size_t WS_H = 285 * MiB;
constexpr size_t WS_END = 461 * MiB;
static_assert(WS_WIN + (size_t)INW * DM * 2 <= WS_WOUT && WS_WOUT + (size_t)DM * DM * 2 <= WS_WGU && WS_WGU + (size_t)2 * FFN * DM * 2 <= WS_WDN && WS_WDN + (size_t)DM * FFN * 2 <= WS_U, "ws map (weights)");
static_assert(WS_U + (size_t)MU * DM * 2 <= WS_Y && WS_Y + (size_t)M * DM * 4 <= WS_QO && WS_QO + (size_t)M * DM * 2 <= WS_KV && WS_KV + 4 * KV_BYTES <= WS_END && WS_H + (size_t)M * FFN * 2 <= WS_END, "ws map");
constexpr int CW_BAR = 4096;
constexpr int S_U = 2, S_W = 6, S_O = 4;
constexpr int E8(int s) { return (127 - s) * 0x01010101; }

constexpr int RING_OFF = 0, RING_BYTES = 131072;
constexpr int LDSCTL_OFF = RING_BYTES, MISC_OFF = LDSCTL_OFF + 320;
constexpr int XCH_OFF = RING_BYTES + 1024;
constexpr int LDS_BYTES = 147456;
static_assert(XCH_OFF + 4096 <= LDS_BYTES, "LDS map");

#define GAS __attribute__((address_space(1)))
#define LAS __attribute__((address_space(3)))
typedef unsigned short bf16;
typedef unsigned v4u __attribute__((ext_vector_type(4)));
typedef float f32x4 __attribute__((ext_vector_type(4)));
typedef GAS unsigned gu32;
#define RLX_AGENT __ATOMIC_RELAXED, __HIP_MEMORY_SCOPE_AGENT
#define LDS_WAIT() asm volatile("s_waitcnt lgkmcnt(0)" ::: "memory")
#define VM_WAIT() asm volatile("s_waitcnt vmcnt(0)" ::: "memory")
__device__ __forceinline__ unsigned f2bf(float f) { unsigned u = __builtin_bit_cast(unsigned, f); return (u + 0x7fffu + ((u >> 16) & 1u)) >> 16; }
__device__ __forceinline__ unsigned pk2(float lo, float hi) { return f2bf(lo) | (f2bf(hi) << 16); }

#define XB_TMO      128
#define XB_XCNT(j)  (256  + 64 * (j))
#define XB_XSUB(j)  (1280 + 64 * (j))
#define XB_XGEN(j)  (2304 + 64 * (j))
#define XB_TOP      3328
#define XB_TOPGEN   3392
#define XCD_BAR_WORDS 3456
#define XB_SPIN_CAP (1u << 18)
__device__ __forceinline__ unsigned xb_ld(unsigned* p)              { return __hip_atomic_load(p, __ATOMIC_RELAXED, __HIP_MEMORY_SCOPE_AGENT); }
__device__ __forceinline__ unsigned xb_add(unsigned* p, unsigned v) { return __hip_atomic_fetch_add(p, v, __ATOMIC_RELAXED, __HIP_MEMORY_SCOPE_AGENT); }
__device__ __forceinline__ unsigned xb_xcc_id() { return (unsigned)__builtin_amdgcn_s_getreg((3 << 11) | 20) & 0xFu; }
#define XB_SPIN(cond, bar) do { unsigned _sp = 0; while (cond) { __builtin_amdgcn_s_sleep(1); \
    if ((++_sp & 255u) == 0u) { if (xb_ld(&(bar)[XB_TMO])) break; if (_sp > XB_SPIN_CAP) { atomicAdd(&(bar)[XB_TMO], 1u); break; } } } } while (0)
struct XcdBarrier { unsigned* bar; unsigned x; volatile LAS unsigned* st; };
__device__ __forceinline__ XcdBarrier xcd_barrier_post(unsigned* bar, volatile LAS unsigned* st) {
    XcdBarrier b; b.bar = bar; b.x = xb_xcc_id(); b.st = st;
    if (threadIdx.x == 0) (void)xb_add(&bar[XB_XCNT(b.x)], 1u);
    return b;
}
__device__ __forceinline__ void xcd_barrier_complete(unsigned* bar, unsigned x, unsigned& nloc, unsigned& nx) {
    const unsigned G = gridDim.x * gridDim.y * gridDim.z;
    unsigned sum, cnt, mine, sp = 0u;
    for (;;) {
        sum = 0u; cnt = 0u; mine = 0u;
#pragma unroll
        for (unsigned j = 0; j < 16; ++j) { const unsigned c = xb_ld(&bar[XB_XCNT(j)]); sum += c; cnt += (c > 0u) ? 1u : 0u; mine = (j == x) ? c : mine; }
        if (sum == G) break;
        __builtin_amdgcn_s_sleep(1);
        if ((++sp & 255u) == 0u) { if (xb_ld(&bar[XB_TMO])) break; if (sp > XB_SPIN_CAP) { atomicAdd(&bar[XB_TMO], 1u); break; } }
    }
    nloc = mine > 0u ? mine : 1u; nx = cnt > 0u ? cnt : 1u;
}
__device__ __forceinline__ void xcd_barrier(const XcdBarrier& b) {
    asm volatile("s_waitcnt vmcnt(0)" ::: "memory");
    __syncthreads();
    if (threadIdx.x == 0) {
        unsigned* bar = b.bar;
        __builtin_amdgcn_s_waitcnt(0);
        unsigned nloc = b.st[0], nx = b.st[1];
        if (nloc == 0u) { xcd_barrier_complete(bar, b.x, nloc, nx); b.st[0] = nloc; b.st[1] = nx; }
        const unsigned old = xb_add(&bar[XB_XSUB(b.x)], 1u);
        const unsigned gen = old / nloc;
        if (old + 1u == (gen + 1u) * nloc) {
            __builtin_amdgcn_fence(__ATOMIC_RELEASE, "agent");
            asm volatile("s_waitcnt vmcnt(0)" ::: "memory");
            const unsigned og = xb_add(&bar[XB_TOP], 1u);
            const unsigned tg = og / nx;
            if (og + 1u == (tg + 1u) * nx) xb_add(&bar[XB_TOPGEN], 1u);
            else XB_SPIN(xb_ld(&bar[XB_TOPGEN]) == tg, bar);
            __builtin_amdgcn_fence(__ATOMIC_ACQUIRE, "agent");
            xb_add(&bar[XB_XGEN(b.x)], 1u);
            asm volatile("s_waitcnt vmcnt(0)" ::: "memory");
        } else {
            XB_SPIN(xb_ld(&bar[XB_XGEN(b.x)]) == gen, bar);
            __builtin_amdgcn_fence(__ATOMIC_ACQUIRE, "agent");
            asm volatile("s_waitcnt vmcnt(0)" ::: "memory");
        }
    }
    __syncthreads();
}

__device__ __forceinline__ float wave_sum(float v) {
#pragma unroll
    for (int o = 1; o < 64; o <<= 1) v += __shfl_xor(v, o);
    return v;
}
__device__ __forceinline__ void transpose_item(const float* W, int ldw, int k0, int n0, bf16* WT, int Kd, int dst_row0, LAS float* scr, int lane) {
#pragma unroll 8
    for (int i = 0; i < 32; ++i) { const int kk = 2 * i + (lane >> 5); scr[kk * 33 + (lane & 31)] = W[(size_t)(k0 + kk) * ldw + n0 + (lane & 31)]; }
    LDS_WAIT(); asm volatile("" ::: "memory");
    const int c = lane & 7;
#pragma unroll
    for (int j = 0; j < 4; ++j) { const int n = (lane >> 3) + 8 * j; const LAS float* s = scr + (8 * c) * 33 + n;
        v4u o; o.x = pk2(s[0 * 33], s[1 * 33]); o.y = pk2(s[2 * 33], s[3 * 33]); o.z = pk2(s[4 * 33], s[5 * 33]); o.w = pk2(s[6 * 33], s[7 * 33]);
        *(GAS v4u*)(WT + (size_t)(dst_row0 + n) * Kd + k0 + 8 * c) = o; }
    LDS_WAIT(); asm volatile("" ::: "memory");
}
__device__ __forceinline__ float clamp448(float v) { return __builtin_fminf(__builtin_fmaxf(v, -448.f), 448.f); }
__device__ __forceinline__ unsigned pk4_fp8(float a, float b, float c, float d) {
    int w = __builtin_amdgcn_cvt_pk_fp8_f32(clamp448(a), clamp448(b), 0, false); w = __builtin_amdgcn_cvt_pk_fp8_f32(clamp448(c), clamp448(d), w, true); return (unsigned)w; }
__device__ __forceinline__ void transpose_item8(const float* W, int ldw, int k0, int n0, unsigned char* WT, int Kd, int dst_row0, float scl, LAS float* scr, int lane) {
#pragma unroll 8
    for (int i = 0; i < 32; ++i) { const int kk = 2 * i + (lane >> 5); scr[kk * 33 + (lane & 31)] = W[(size_t)(k0 + kk) * ldw + n0 + (lane & 31)]; }
    LDS_WAIT(); asm volatile("" ::: "memory");
    const int c = lane & 7;
#pragma unroll
    for (int j = 0; j < 4; ++j) { const int n = (lane >> 3) + 8 * j; const LAS float* s = scr + (8 * c) * 33 + n;
        typedef unsigned u2v __attribute__((ext_vector_type(2)));
        u2v o; o.x = pk4_fp8(s[0 * 33] * scl, s[1 * 33] * scl, s[2 * 33] * scl, s[3 * 33] * scl); o.y = pk4_fp8(s[4 * 33] * scl, s[5 * 33] * scl, s[6 * 33] * scl, s[7 * 33] * scl);
        *(GAS u2v*)(WT + (size_t)(dst_row0 + n) * Kd + k0 + 8 * c) = o; }
    LDS_WAIT(); asm volatile("" ::: "memory");
}
__device__ __forceinline__ float silu_f(float x) { return x / (1.0f + __expf(-x)); }

struct Args { const float* in[18]; float* out; unsigned char* ws; int ph_lo, ph_hi, li, flags; };

__device__ __forceinline__ void modulate_row8(const float* xrow, unsigned char* orow, const LAS float* p0, const LAS float* p1, float scl, int lane) {
    const GAS f32x4* xr = (const GAS f32x4*)xrow + lane;
    GAS unsigned* o4 = (GAS unsigned*)orow + lane;
    f32x4 v[8];
#pragma unroll
    for (int j = 0; j < 8; ++j) v[j] = xr[64 * j];
#pragma unroll
    for (int j = 0; j < 8; ++j) { const f32x4 a = *(const LAS f32x4*)(p0 + 256 * j + 4 * lane), s = *(const LAS f32x4*)(p1 + 256 * j + 4 * lane); const f32x4 r = (v[j] * a + s) * scl;
        o4[64 * j] = pk4_fp8(r.x, r.y, r.z, r.w); }
}
__device__ __forceinline__ void modulate_row(const float* xrow, bf16* orow, const LAS float* p0, const LAS float* p1, int lane) {
    const GAS f32x4* xr = (const GAS f32x4*)xrow + lane;
    GAS unsigned long long* o8 = (GAS unsigned long long*)orow + lane;
    f32x4 v[8];
#pragma unroll
    for (int j = 0; j < 8; ++j) v[j] = xr[64 * j];
#pragma unroll
    for (int j = 0; j < 8; ++j) { const f32x4 a = *(const LAS f32x4*)(p0 + 256 * j + 4 * lane), s = *(const LAS f32x4*)(p1 + 256 * j + 4 * lane); const f32x4 r = v[j] * a + s;
        o8[64 * j] = (unsigned long long)pk2(r.x, r.y) | ((unsigned long long)pk2(r.z, r.w) << 32); }
}
typedef unsigned u32x2 __attribute__((ext_vector_type(2)));
__device__ __forceinline__ f32x4 bf4_to_f32(u32x2 w) { f32x4 r; r.x = __uint_as_float(w.x << 16); r.y = __uint_as_float(w.x & 0xffff0000u); r.z = __uint_as_float(w.y << 16); r.w = __uint_as_float(w.y & 0xffff0000u); return r; }
__device__ __forceinline__ void ln_regs(f32x4 (&v)[8], const LAS float* g, const LAS float* bb, int lane) {
    float s = 0.f;
#pragma unroll
    for (int j = 0; j < 8; ++j) s += (v[j].x + v[j].y) + (v[j].z + v[j].w);
    const float mean = wave_sum(s) * (1.f / DM); float s2 = 0.f;
#pragma unroll
    for (int j = 0; j < 8; ++j) { v[j] = v[j] - mean; s2 += (v[j].x * v[j].x + v[j].y * v[j].y) + (v[j].z * v[j].z + v[j].w * v[j].w); }
    const float rstd = __builtin_amdgcn_rsqf(wave_sum(s2) * (1.f / DM) + LN_EPS);
#pragma unroll
    for (int j = 0; j < 8; ++j) { const int c = 256 * j + 4 * lane; v[j] = v[j] * rstd * *(const LAS f32x4*)(g + c) + *(const LAS f32x4*)(bb + c); }
}
__device__ __forceinline__ void x1_row(f32x4 (&v)[8], const float* xrow, const bf16* arow, const LAS float* P, int lane) {
    const GAS f32x4* xr = (const GAS f32x4*)xrow + lane; const GAS u32x2* ar = (const GAS u32x2*)arow + lane;
    u32x2 aw[8];
#pragma unroll
    for (int j = 0; j < 8; ++j) { v[j] = xr[64 * j]; aw[j] = ar[64 * j]; }
#pragma unroll
    for (int j = 0; j < 8; ++j) v[j] = v[j] * DN_ALPHA + *(const LAS f32x4*)(P + 256 * j + 4 * lane) * bf4_to_f32(aw[j]);
    ln_regs(v, P + 2048, P + 4096, lane);
}

__global__ void __launch_bounds__(NWAVES * 64, 2) dit_fwd(Args args) {
    extern __shared__ __attribute__((aligned(16))) unsigned char lds[];
    LAS unsigned char* L = (LAS unsigned char*)lds;
    volatile LAS unsigned* MISC = (volatile LAS unsigned*)(L + MISC_OFF);
    const int tid = threadIdx.x, lane = tid & 63, wave = __builtin_amdgcn_readfirstlane(tid >> 6);
    const int G = gridDim.x, bx = blockIdx.x;
    unsigned char* ws = args.ws;
    gu32* ctl = (gu32*)(ws + WS_CTL);
    const float* x = args.in[0]; const float* cvec = args.in[1]; const float* ctx = args.in[2]; const float* c_ctx = args.in[3];
    const float* w_ada = args.in[4]; const float* b_ada = args.in[5]; const float* w_in = args.in[6]; const float* qng = args.in[7]; const float* kng = args.in[8];
    const float* sink = args.in[9]; const float* w_out = args.in[10]; const float* ln1g = args.in[11]; const float* ln1b = args.in[12];
    const float* w_gate = args.in[13]; const float* w_up = args.in[14]; const float* w_down = args.in[15]; const float* ln2g = args.in[16]; const float* ln2b = args.in[17];
    float* MODP = (float*)(ws + WS_MODP); float* MODS = (float*)(ws + WS_MODS); float* ROPEC = (float*)(ws + WS_ROPE); float* ROPES = ROPEC + 2048;
    bf16* WIN = (bf16*)(ws + WS_WIN); bf16* WOUT = (bf16*)(ws + WS_WOUT); bf16* WGU = (bf16*)(ws + WS_WGU); bf16* WDN = (bf16*)(ws + WS_WDN);
    bf16* U = (bf16*)(ws + WS_U); bf16* AB = (bf16*)(ws + WS_Y); bf16* DB = (bf16*)(ws + WS_Y + 64 * MiB);
    unsigned char* U8 = ws + WS_U;
    unsigned char* WIN8 = ws + WS_WIN; unsigned char* WOUT8 = ws + WS_WOUT;
    unsigned char* OF8 = ws + WS_Y + 64 * MiB;
    unsigned char* QO8 = ws + WS_QO; unsigned char* KA8 = ws + WS_KV; unsigned char* KB8 = ws + WS_KV + 2 * KV_BYTES;
    bf16* KA = (bf16*)(ws + WS_KV); bf16* VA = (bf16*)(ws + WS_KV + KV_BYTES); bf16* KB = (bf16*)(ws + WS_KV + 2 * KV_BYTES); bf16* VB = (bf16*)(ws + WS_KV + 3 * KV_BYTES);
    bf16* HB = (bf16*)(ws + WS_H);

    for (int u = tid; u < (LDS_BYTES - LDSCTL_OFF) / 4; u += NWAVES * 64) ((LAS unsigned*)(L + LDSCTL_OFF))[u] = 0u;
    __syncthreads();
    XcdBarrier bar; bar.bar = (unsigned*)(ctl + CW_BAR); bar.x = 0; bar.st = nullptr;
    if (N_LAUNCHES == 1) bar = xcd_barrier_post((unsigned*)(ctl + CW_BAR), MISC + 8);
#define GRID_BAR() do { if (N_LAUNCHES == 1) xcd_barrier(bar); } while (0)
    const int lo = args.ph_lo, hi = args.ph_hi;
#ifndef PHMASK
#define PHMASK 0x3FF
#endif
#define IN(k) (((PHMASK >> (k)) & 1) && lo <= (k) && (k) < hi)
#define BOTH(k) (IN(k) && IN((k) + 1))

    if (IN(0)) {
        if (bx < 192) {
            const int cb = bx >> 2, kq = bx & 3, k0 = kq * 512 + wave * 64;
            float sv[5];
#pragma unroll
            for (int b = 0; b < 4; ++b) sv[b] = silu_f(cvec[b * DM + k0 + lane]);
            sv[4] = silu_f(c_ctx[k0 + lane]);
            f32x4 acc[5];
#pragma unroll
            for (int b = 0; b < 5; ++b) acc[b] = (f32x4){0.f, 0.f, 0.f, 0.f};
            const float* wp = w_ada + (size_t)k0 * NMOD + cb * 256 + lane * 4;
#pragma unroll 16
            for (int kk = 0; kk < 64; ++kk) { const f32x4 wv = *(const f32x4*)(wp + (size_t)kk * NMOD);
#pragma unroll
                for (int b = 0; b < 5; ++b) { const float s = __builtin_bit_cast(float, __builtin_amdgcn_readlane(__builtin_bit_cast(int, sv[b]), kk)); acc[b] += wv * s; } }
            LAS f32x4* red = (LAS f32x4*)(L + RING_OFF);
#pragma unroll
            for (int b = 0; b < 5; ++b) red[(wave * 5 + b) * 64 + lane] = acc[b];
            LDS_WAIT(); __syncthreads();
            if (tid < 320) { const int b = tid >> 6, l = tid & 63; f32x4 s = red[b * 64 + l];
#pragma unroll
                for (int w = 1; w < 8; ++w) s += red[(w * 5 + b) * 64 + l];
                *(f32x4*)(MODP + ((size_t)kq * 5 + b) * NMOD + cb * 256 + l * 4) = s; }
            __syncthreads();
        }
        if (bx == 255) {
            for (int e = tid; e < 2048; e += NWAVES * 64) { const int pos = e >> 5, f = e & 31;
                const float inv = exp2f(-(float)f * (13.287712379549449f / 32.0f)); const float ang = (float)pos * inv;
                float sn, cs; sincosf(ang, &sn, &cs); ROPEC[e] = cs; ROPES[e] = sn; }
        }
        {
            LAS float* scr = (LAS float*)(L + RING_OFF + wave * 16384);
            constexpr int I_IN = 32 * 96, I_OUT = 32 * 64, I_G = 32 * 176, NITEMS = I_IN + I_OUT + I_G, NSLOT = 192 * 8 * 2 + 64 * 8 * 5;
            const int nsl = bx < 192 ? 2 : 5, sl0 = bx < 192 ? (bx * 8 + wave) * 2 : 3072 + ((bx - 192) * 8 + wave) * 5;
            for (int s = 0; s < nsl; ++s)
                for (int it = sl0 + s; it < NITEMS; it += NSLOT) {
                    int r = it;
                    if (r < I_IN) { const int kb = r / 96, nb = r % 96, pn = nb >> 3, q = nb & 7, hh = q >> 2, part = (q >> 1) & 1, bj = q & 1;
                        transpose_item8(w_in, INW, 64 * kb, 32 * nb, WIN8, DM, 256 * pn + 32 * (4 * bj + 2 * hh + part), (float)(1 << S_W), scr, lane); continue; } r -= I_IN;
                    if (r < I_OUT) { const int kb = r / 64, nb = r % 64; transpose_item8(w_out, DM, 64 * kb, 32 * nb, WOUT8, DM, 32 * nb, (float)(1 << S_W), scr, lane); continue; } r -= I_OUT;
                    { const int kb = r / 176, nb = r % 176; transpose_item(w_gate, FFN, 64 * kb, 32 * nb, WGU, DM, 256 * (nb >> 2) + 32 * (nb & 3), scr, lane); }
                }
        }
        if (BOTH(0)) GRID_BAR();
    }

    if (IN(1)) {
        { const int idx = bx * 512 + tid;
          if (idx < 5 * NMOD) { float s = b_ada[idx % NMOD];
#pragma unroll
              for (int q = 0; q < 4; ++q) s += MODP[(size_t)q * 5 * NMOD + idx];
              MODS[idx] = s; } }
        if (bx < 128) {
            LAS float* P0 = (LAS float*)(L + RING_OFF); LAS float* P1 = P0 + 2048;
            for (int i = tid; i < 2048; i += NWAVES * 64) { float sh = b_ada[i], sc = b_ada[2048 + i];
#pragma unroll
                for (int q = 0; q < 4; ++q) { sh += MODP[((size_t)q * 5 + 4) * NMOD + i]; sc += MODP[((size_t)q * 5 + 4) * NMOD + 2048 + i]; }
                P0[i] = 1.0f + sc; P1[i] = sh; }
            LDS_WAIT(); __syncthreads();
            const int r = bx * 8 + wave;
            modulate_row8(ctx + (size_t)r * DM, U8 + (size_t)(M + r) * DM, P0, P1, (float)(1 << S_U), lane);
            __syncthreads();
        }
        if (BOTH(1)) GRID_BAR();
    }

    if (IN(2)) {
        if (bx < 16) {
            const int pnl[4] = {4, 5, 10, 11};
            pg8::Gemm g{(const bf16*)U8, (const bf16*)WIN8, MU, INW, DM / 2}; pg8::OneUnit S{64 + (bx >> 2), (bx & 3) == 0 ? 4 : (bx & 3) == 1 ? 5 : (bx & 3) == 2 ? 10 : 11}; (void)pnl;
            pg8::EpiQKV E{QO8, KA8, VA, KB8, VB, qng, kng, ROPEC, ROPES, (LAS float*)(L + XCH_OFF)};
            pg8::gemm_phase<pg8::EpiQKV, pg8::OneUnit, true, true, E8(S_W), E8(S_U)>(L + RING_OFF, g, S, E);
        } else {
            LAS float* P0 = (LAS float*)(L + RING_OFF); LAS float* P1 = P0 + 2048;
            const int i = bx - 16, r0 = (int)(((long)i * M) / 240), r1 = (int)(((long)(i + 1) * M) / 240);
            int r = r0;
            while (r < r1) {
                const int b = r >> 12; int re = (b + 1) << 12; if (re > r1) re = r1;
                __syncthreads();
                for (int k = tid; k < 2048; k += NWAVES * 64) { P0[k] = 1.0f + MODS[b * NMOD + 2048 + k]; P1[k] = MODS[b * NMOD + k]; }
                LDS_WAIT(); __syncthreads();
                for (int rr = r + wave; rr < re; rr += NWAVES) modulate_row8(x + (size_t)rr * DM, U8 + (size_t)rr * DM, P0, P1, (float)(1 << S_U), lane);
                r = re;
            }
            __syncthreads();
            {
                LAS float* scr = (LAS float*)(L + RING_OFF + wave * 16384);
                constexpr int I_G = 32 * 176, I_D = 88 * 64, NITEMS2 = I_G + I_D;
                for (int it = i * 8 + wave; it < NITEMS2; it += 240 * 8) {
                    if (it < I_G) { const int kb = it / 176, nb = it % 176; transpose_item(w_up, FFN, 64 * kb, 32 * nb, WGU, DM, 256 * (nb >> 2) + 128 + 32 * (nb & 3), scr, lane); }
                    else { const int r2 = it - I_G, kb = r2 / 64, nb = r2 % 64; transpose_item(w_down, DM, 64 * kb, 32 * nb, WDN, FFN, 32 * nb, scr, lane); }
                }
            }
        }
        if (BOTH(2)) GRID_BAR();
    }

    if (IN(3)) {
        pg8::Gemm g{(const bf16*)U8, (const bf16*)WIN8, M, INW, DM / 2}; pg8::StaticOrder S; S.init(M, INW, G, bx);
        pg8::EpiQKV E{QO8, KA8, VA, KB8, VB, qng, kng, ROPEC, ROPES, (LAS float*)(L + XCH_OFF)};
        pg8::gemm_phase<pg8::EpiQKV, pg8::StaticOrder, true, true, E8(S_W), E8(S_U)>(L + RING_OFF, g, S, E);
        if (BOTH(3)) GRID_BAR();
    }

    if (IN(4)) {
        const int xg = bx & 7, y = bx >> 3, b = xg >> 1, kvh = xg & 1;
        const size_t kvoff = (size_t)(b * 2 + kvh) * SKV * 128;
        float kbnd; { float gm = fmaxf(fabsf(kng[lane]), fabsf(kng[64 + lane]));
#pragma unroll
            for (int o = 1; o < 64; o <<= 1) gm = fmaxf(gm, __shfl_xor(gm, o));
            kbnd = gm * 11.313708498984761f * 1.08f; }
#define MKUNIT(u, i_) do { const int i__ = (i_); const int uu = 2 * y + (i__ & 1), gq = uu >> 4, qb = uu & 15, q0 = qb * 256; const bool isA = i__ >= 2; const int head = kvh * 4 + gq; \
            unsigned char* Qp = QO8 + (size_t)(b * SEQ + q0) * DM + (isA ? 0 : 1024) + head * 128; \
            const int jlo = !isA ? 0 : ((q0 >> 6) - 2 < 0 ? 0 : (q0 >> 6) - 2), jhi = (q0 >> 6) + 6 > 64 ? 64 : (q0 >> 6) + 6; \
            (u).Q = Qp; (u).K = (isA ? KA8 : KB8) + kvoff; (u).V = (isA ? VA : VB) + kvoff; (u).O = ((args.flags & 1) ? ws + 384 * MiB : OF8) + (Qp - QO8); \
            (u).NT = isA ? 4 + (jhi - jlo) : SKV / 64; (u).nctx = isA ? 4 : 0; (u).jlo = jlo; (u).q0 = q0; (u).masked = isA; (u).sinkl2 = isA ? sink[head] * 1.4426950408889634f : -INFINITY; (u).kbound = isA ? -1.f : kbnd; } while (0)
        att::v8i qr[2]; att::Stg stg[2];
        att::AUnit cur, nx; MKUNIT(cur, 0); att::attn_prime(cur, qr, stg);
        for (int i = 0; i < 4; ++i) {
            MKUNIT(nx, i < 3 ? i + 1 : 3);
            att::attn_unit(cur, i < 3, nx, qr, stg, (char*)lds + RING_OFF);
            cur = nx;
        }
#undef MKUNIT
        if (BOTH(4)) GRID_BAR();
    }

    if (IN(5)) {
        pg8::Gemm g{(const bf16*)OF8, (const bf16*)WOUT8, M, DM, DM / 2}; pg8::StaticOrder S; S.init(M, DM, G, bx);
        pg8::EpiBf16Plain E{AB, DM};
        pg8::gemm_phase<pg8::EpiBf16Plain, pg8::StaticOrder, true, true, E8(S_W), E8(S_O)>(L + RING_OFF, g, S, E);
        if (BOTH(5)) GRID_BAR();
    }

    if (IN(6)) {
        LAS float* P = (LAS float*)(L + RING_OFF);
        const int b = bx >> 6;
        for (int k = tid; k < 2048; k += NWAVES * 64) { P[k] = MODS[b * NMOD + 2 * 2048 + k]; P[2048 + k] = ln1g[k]; P[4096 + k] = ln1b[k]; P[6144 + k] = 1.0f + MODS[b * NMOD + 4 * 2048 + k]; P[8192 + k] = MODS[b * NMOD + 3 * 2048 + k]; }
        LDS_WAIT(); __syncthreads();
        for (int rr = bx * 64 + wave; rr < bx * 64 + 64; rr += NWAVES) {
            f32x4 v[8]; x1_row(v, x + (size_t)rr * DM, AB + (size_t)rr * DM, P, lane);
            GAS unsigned long long* o8 = (GAS unsigned long long*)(U + (size_t)rr * DM) + lane;
#pragma unroll
            for (int j = 0; j < 8; ++j) { const int c = 256 * j + 4 * lane; const f32x4 r = v[j] * *(const LAS f32x4*)(P + 6144 + c) + *(const LAS f32x4*)(P + 8192 + c);
                o8[64 * j] = (unsigned long long)pk2(r.x, r.y) | ((unsigned long long)pk2(r.z, r.w) << 32); }
        }
        __syncthreads();
        if (BOTH(6)) GRID_BAR();
    }

    if (IN(7)) {
        pg8::Gemm g{U, WGU, M, 2 * FFN, DM}; pg8::StaticOrder S; S.init(M, 2 * FFN, G, bx);
        pg8::EpiSwiglu E{HB, FFN};
        pg8::gemm_phase<pg8::EpiSwiglu, pg8::StaticOrder, true, true>(L + RING_OFF, g, S, E);
        if (BOTH(7)) GRID_BAR();
    }

    if (IN(8)) {
        pg8::Gemm g{HB, WDN, M, DM, FFN}; pg8::StaticOrder S; S.init(M, DM, G, bx);
        pg8::EpiBf16Plain E{DB, DM};
        pg8::gemm_phase<pg8::EpiBf16Plain, pg8::StaticOrder, true, true>(L + RING_OFF, g, S, E);
        if (BOTH(8)) GRID_BAR();
    }

    if (IN(9)) {
        LAS float* P = (LAS float*)(L + RING_OFF);
        const int b = bx >> 6;
        for (int k = tid; k < 2048; k += NWAVES * 64) { P[k] = MODS[b * NMOD + 2 * 2048 + k]; P[2048 + k] = ln1g[k]; P[4096 + k] = ln1b[k]; P[6144 + k] = MODS[b * NMOD + 5 * 2048 + k]; P[8192 + k] = ln2g[k]; P[10240 + k] = ln2b[k]; }
        LDS_WAIT(); __syncthreads();
        for (int rr = bx * 64 + wave; rr < bx * 64 + 64; rr += NWAVES) {
            f32x4 v[8]; x1_row(v, x + (size_t)rr * DM, AB + (size_t)rr * DM, P, lane);
            const GAS u32x2* dr = (const GAS u32x2*)(DB + (size_t)rr * DM) + lane;
#pragma unroll
            for (int j = 0; j < 8; ++j) v[j] = v[j] * DN_ALPHA + *(const LAS f32x4*)(P + 6144 + 256 * j + 4 * lane) * bf4_to_f32(dr[64 * j]);
            ln_regs(v, P + 8192, P + 10240, lane);
            GAS f32x4* orow = (GAS f32x4*)(args.out + (size_t)rr * DM) + lane;
#pragma unroll
            for (int j = 0; j < 8; ++j) orow[64 * j] = v[j];
        }
    }
#undef IN
#undef BOTH
#undef GRID_BAR
}

extern "C" void kernel_launch(void* const* d_in, const int* in_sizes, int n_in, void* d_out, int out_size, void* d_ws, size_t ws_size, hipStream_t stream) {
    static int grid = 0;
    if (grid == 0) {
        if (n_in != 18 || in_sizes[0] != M * DM || out_size != M * DM || ws_size < WS_END) {
            fprintf(stderr, "kernel_launch: shape mismatch (n_in %d, in0 %d, out %d, ws %zu; need ws >= %zu); nothing launched\n", n_in, n_in > 0 ? in_sizes[0] : -1, out_size, ws_size, (size_t)WS_END); grid = -1; return; }
        int dev = 0, cus = 0, per_cu = 0;
        if (hipGetDevice(&dev) != hipSuccess || hipDeviceGetAttribute(&cus, hipDeviceAttributeMultiprocessorCount, dev) != hipSuccess) { fprintf(stderr, "kernel_launch: device query failed\n"); grid = -1; return; }
        if (hipFuncSetAttribute((const void*)dit_fwd, hipFuncAttributeMaxDynamicSharedMemorySize, LDS_BYTES) != hipSuccess) { fprintf(stderr, "kernel_launch: hipFuncSetAttribute failed\n"); grid = -1; return; }
        if (hipOccupancyMaxActiveBlocksPerMultiprocessor(&per_cu, (const void*)dit_fwd, NWAVES * 64, LDS_BYTES) != hipSuccess || per_cu < 1)
            fprintf(stderr, "kernel_launch: note: occupancy query reports %d workgroups per CU\n", per_cu);
        (void)hipGetLastError();
        if (cus != 256) { fprintf(stderr, "kernel_launch: built for a 256-CU device, found %d CUs; nothing launched\n", cus); grid = -1; return; }
        grid = 256;
    }
    if (grid < 0) return;
    if (hipMemsetAsync((char*)d_ws + WS_CTL, 0, CTL_ZERO_BYTES, stream) != hipSuccess) { fprintf(stderr, "kernel_launch: hipMemsetAsync failed\n"); return; }
    Args a{};
    for (int i = 0; i < 18; ++i) a.in[i] = (const float*)d_in[i];
    a.out = (float*)d_out; a.ws = (unsigned char*)d_ws;
    if (N_LAUNCHES == 1) { a.ph_lo = 0; a.ph_hi = N_PHASES; a.li = 0; hipLaunchKernelGGL(dit_fwd, dim3(grid), dim3(NWAVES * 64), LDS_BYTES, stream, a); }
    else { const int plist[] = PHASE_LIST;
        for (unsigned i = 0; i < sizeof(plist) / sizeof(int); ++i) { const int p = plist[i] % 100; a.ph_lo = p; a.ph_hi = p + 1; a.li = 0; a.flags = plist[i] >= 100 ? 1 : 0;
            hipLaunchKernelGGL(dit_fwd, dim3(grid), dim3(NWAVES * 64), LDS_BYTES, stream, a); } }
    const hipError_t le = hipPeekAtLastError();
    if (le != hipSuccess) fprintf(stderr, "kernel_launch: launch failed: %s\n", hipGetErrorName(le));
}
```

```cpp
#include <hip/hip_runtime.h>
#include <hip/hip_bf16.h>
#include <cstdio>
#include <cstdint>

#ifndef PHASE_LIST
#define PHASE_LIST {0, 1, 2, 3, 4, 5, 6, 7, 8, 9}
#endif
#ifndef MK_N_LAUNCHES
#define MK_N_LAUNCHES 1
#endif

namespace pg8 {
#define PG8_LAS __attribute__((address_space(3)))
typedef unsigned short bf16_t;
typedef short bf16x8 __attribute__((ext_vector_type(8)));
typedef float f32x4 __attribute__((ext_vector_type(4)));
typedef unsigned u32x4 __attribute__((ext_vector_type(4)));
constexpr int BM = 256, BK = 64, HALF = 128, HTB = HALF * BK * 2, STAGE_BYTES = 8 * HTB, NXCD = 8, WGM = 8;

__host__ __device__ __forceinline__ int lds_byte(int r, int c) { const int st = (r >> 4) * 2 + (c >> 5), rr = r & 15, cc = c & 31, ob = rr * 64 + cc * 2; return st * 1024 + (ob ^ (((ob >> 9) & 1) << 5)); }
__host__ __device__ __forceinline__ void stage_rc(int b, int& R, int& C) { const int st = b / 1024, sb = b % 1024, swz = sb ^ (((sb >> 9) & 1) << 5); R = (st >> 1) * 16 + swz / 64; C = (st & 1) * 32 + (swz % 64) / 2; }
__host__ __device__ __forceinline__ int perm32(int rho) { const int n = rho >> 4, i = rho & 15; return 8 * (i >> 2) + 4 * n + (i & 3); }

struct Unit { int pm, pn; };
struct Gemm { const bf16_t* A; const bf16_t* Bt; int M, N, K; };

struct StaticOrder {
    int nM, nN, nwg, G, c;
    __host__ __device__ void init(int M, int N, int G_, int c_) { nM = M / BM; nN = N / BM; nwg = nM * nN; G = G_; c = c_; }
    __host__ __device__ bool next(int i, Unit& u) const {
        const long L = (long)i * G + c; if (L >= nwg) return false;
        int wgid = (int)L; { const int q = nwg / NXCD, r = nwg % NXCD, xcd = wgid % NXCD, off = wgid / NXCD; wgid = (xcd < r ? xcd * (q + 1) : r * (q + 1) + (xcd - r) * q) + off; }
        const int nig = WGM * nN, gid = wgid / nig, fm = gid * WGM, gsz = (nM - fm) < WGM ? (nM - fm) : WGM;
        u.pm = fm + ((wgid % nig) % gsz); u.pn = (wgid % nig) / gsz; return true;
    }
    __device__ __forceinline__ void a_ready(const Unit&) const {}
    __device__ __forceinline__ void done(const Unit&) const {}
};
struct OneUnit {
    int pm, pn;
    __device__ bool next(int i, Unit& u) const { if (i > 0) return false; u.pm = pm; u.pn = pn; return true; }
    __device__ __forceinline__ void a_ready(const Unit&) const {}
    __device__ __forceinline__ void done(const Unit&) const {}
};

__device__ __forceinline__ unsigned cvt_pk_bf16(float lo, float hi) { unsigned r; asm volatile("v_cvt_pk_bf16_f32 %0, %1, %2" : "=v"(r) : "v"(lo), "v"(hi)); return r; }


struct EpiQKV {
    static constexpr bool PERM = true, AFTER_DRAIN = false;
    unsigned char* QO; unsigned char* KA; unsigned char* VA; unsigned char* KB; unsigned char* VB;
    const float* qg; const float* kg; const float* ropec; const float* ropes;
    PG8_LAS float* xch;
    __device__ __forceinline__ void operator()(const f32x4 (&acc)[2][2][4][2], const Unit& u, int wr, int wc, int fr, int fq) const {
        const int pn = u.pn; const bool is_ctx = u.pm >= 64;
        const int b = is_ctx ? (u.pm - 64) : (u.pm >> 4), t0 = is_ctx ? 4096 : ((u.pm & 15) << 8);
        const int hh = wc >> 1, part = wc & 1, wid = wr * 4 + wc;
        const bool isq = (pn < 4) || (pn >= 6 && pn < 10), donorm = (pn >= 6 && pn <= 10), dorope = (!is_ctx) && pn != 5 && pn != 11;
        const bool isv = (pn == 5 || pn == 11);
        bf16_t* base = nullptr; unsigned char* base8 = nullptr; size_t rstride;
        if (isq) { const int head = (pn < 4 ? 2 * pn : 8 + 2 * (pn - 6)) + hh; base8 = QO + (size_t)(b * 4096 + t0) * 2048 + head * 128; rstride = 2048; }
        else if (isv) {
            unsigned char* vt = (pn == 5 ? VA : VB) + (size_t)(b * 2 + hh) * 128 * 4352;
            int frl = fr, fql = fq; asm volatile("" : "+v"(frl), "+v"(fql));
            const unsigned p_ = (unsigned)(frl & 3);
            const unsigned sel2 = p_ | ((4u + p_) << 8);
#pragma unroll
            for (int bj = 0; bj < 2; ++bj)
#pragma unroll
                for (int n = 0; n < 2; ++n) {
                    unsigned char* dp = vt + (size_t)(64 * part + 32 * bj + 8 * fql + 4 * n + (frl & 3)) * 4352 + t0 + wr * 64 + 32 * ((frl >> 2) & 1) + 4 * (frl >> 3);
#pragma unroll
                    for (int ai = 0; ai < 2; ++ai)
#pragma unroll
                        for (int m = 0; m < 4; ++m) { const f32x4 v = acc[ai][bj][m][n] * 16.f;
                            int w_ = __builtin_amdgcn_cvt_pk_fp8_f32(__builtin_fminf(__builtin_fmaxf(v[0], -448.f), 448.f), __builtin_fminf(__builtin_fmaxf(v[1], -448.f), 448.f), 0, false);
                            w_ = __builtin_amdgcn_cvt_pk_fp8_f32(__builtin_fminf(__builtin_fmaxf(v[2], -448.f), 448.f), __builtin_fminf(__builtin_fmaxf(v[3], -448.f), 448.f), w_, true);
                            const unsigned W0 = (unsigned)__builtin_amdgcn_mov_dpp(w_, 0x00, 0xf, 0xf, true), W1 = (unsigned)__builtin_amdgcn_mov_dpp(w_, 0x55, 0xf, 0xf, true);
                            const unsigned W2 = (unsigned)__builtin_amdgcn_mov_dpp(w_, 0xaa, 0xf, 0xf, true), W3 = (unsigned)__builtin_amdgcn_mov_dpp(w_, 0xff, 0xf, 0xf, true);
                            const unsigned lo2 = __builtin_amdgcn_perm(W1, W0, sel2), hi2 = __builtin_amdgcn_perm(W3, W2, sel2);
                            *(unsigned*)(dp + ai * HALF + 8 * m) = __builtin_amdgcn_perm(hi2, lo2, 0x05040100u); }
                    asm volatile("" ::: "memory"); }
            return; }
        else { unsigned char* buf = pn == 4 ? KA : KB; base8 = buf + ((size_t)(b * 2 + hh) * 4352 + t0) * 128; rstride = 128; }
        const int d0 = 64 * part + 8 * fq;
        float rs[2][4];
        f32x4 gv[2][2];
#pragma unroll
        for (int bj = 0; bj < 2; ++bj)
#pragma unroll
            for (int n = 0; n < 2; ++n) gv[bj][n] = (f32x4){1.f, 1.f, 1.f, 1.f};
#pragma unroll
        for (int ai = 0; ai < 2; ++ai)
#pragma unroll
            for (int m = 0; m < 4; ++m) rs[ai][m] = 1.f;
        if (donorm) {
            const float* g = (pn == 10) ? kg : qg;
#pragma unroll
            for (int bj = 0; bj < 2; ++bj)
#pragma unroll
                for (int n = 0; n < 2; ++n) gv[bj][n] = *(const f32x4*)(g + d0 + 32 * bj + 4 * n);
#pragma unroll
            for (int ai = 0; ai < 2; ++ai)
#pragma unroll
                for (int m = 0; m < 4; ++m) {
                    float s = 0.f;
#pragma unroll
                    for (int bj = 0; bj < 2; ++bj)
#pragma unroll
                        for (int n = 0; n < 2; ++n) { const f32x4 x = acc[ai][bj][m][n]; s += (x[0] * x[0] + x[1] * x[1]) + (x[2] * x[2] + x[3] * x[3]); }
                    s += __shfl_xor(s, 16); s += __shfl_xor(s, 32);
                    if (fq == 0) xch[wid * 128 + ai * 64 + m * 16 + fr] = s;
                    rs[ai][m] = s;
                }
            asm volatile("s_waitcnt lgkmcnt(0)" ::: "memory"); __builtin_amdgcn_s_barrier(); asm volatile("" ::: "memory");
#pragma unroll
            for (int ai = 0; ai < 2; ++ai)
#pragma unroll
                for (int m = 0; m < 4; ++m) { const float o = xch[(wid ^ 1) * 128 + ai * 64 + m * 16 + fr]; rs[ai][m] = __builtin_amdgcn_rsqf((rs[ai][m] + o) * (1.0f / 128.0f) + 1e-6f); }
        }
#pragma unroll
        for (int ai = 0; ai < 2; ++ai)
#pragma unroll
            for (int m = 0; m < 4; ++m) {
                const int rt = ai * HALF + wr * 64 + m * 16 + fr;
                f32x4 lo[2], hi[2];
#pragma unroll
                for (int n = 0; n < 2; ++n) { lo[n] = acc[ai][0][m][n] * rs[ai][m] * gv[0][n]; hi[n] = acc[ai][1][m][n] * rs[ai][m] * gv[1][n]; }
                if (dorope) {
                    const int t = t0 + rt, pos = part ? (t & 63) : (t >> 6);
#pragma unroll
                    for (int n = 0; n < 2; ++n) {
                        const f32x4 c4 = *(const f32x4*)(ropec + pos * 32 + 8 * fq + 4 * n), s4 = *(const f32x4*)(ropes + pos * 32 + 8 * fq + 4 * n);
                        const f32x4 a = lo[n], bb = hi[n];
                        lo[n] = a * c4 - bb * s4; hi[n] = bb * c4 + a * s4;
                    }
                }
                if (false) {
                bf16_t* rowp = base + (size_t)rt * rstride + d0;
                u32x4 w0, w1;
                w0.x = cvt_pk_bf16(lo[0][0], lo[0][1]); w0.y = cvt_pk_bf16(lo[0][2], lo[0][3]); w0.z = cvt_pk_bf16(lo[1][0], lo[1][1]); w0.w = cvt_pk_bf16(lo[1][2], lo[1][3]);
                w1.x = cvt_pk_bf16(hi[0][0], hi[0][1]); w1.y = cvt_pk_bf16(hi[0][2], hi[0][3]); w1.z = cvt_pk_bf16(hi[1][0], hi[1][1]); w1.w = cvt_pk_bf16(hi[1][2], hi[1][3]);
                *(u32x4*)(rowp) = w0; *(u32x4*)(rowp + 32) = w1;
                } else {
                unsigned char* rowp = base8 + (size_t)rt * rstride + d0;
                typedef unsigned u2v __attribute__((ext_vector_type(2))); u2v w0, w1;
#define QK8(a, b, c, d) ({ int t_ = __builtin_amdgcn_cvt_pk_fp8_f32(__builtin_fminf(__builtin_fmaxf((a) * 16.f, -448.f), 448.f), __builtin_fminf(__builtin_fmaxf((b) * 16.f, -448.f), 448.f), 0, false); \
                        (unsigned)__builtin_amdgcn_cvt_pk_fp8_f32(__builtin_fminf(__builtin_fmaxf((c) * 16.f, -448.f), 448.f), __builtin_fminf(__builtin_fmaxf((d) * 16.f, -448.f), 448.f), t_, true); })
                w0.x = QK8(lo[0][0], lo[0][1], lo[0][2], lo[0][3]); w0.y = QK8(lo[1][0], lo[1][1], lo[1][2], lo[1][3]);
                w1.x = QK8(hi[0][0], hi[0][1], hi[0][2], hi[0][3]); w1.y = QK8(hi[1][0], hi[1][1], hi[1][2], hi[1][3]);
#undef QK8
                *(u2v*)(rowp) = w0; *(u2v*)(rowp + 32) = w1;
                }
            }
    }
};

struct EpiResid {
    static constexpr bool PERM = false, AFTER_DRAIN = false;
    const float* res; const float* gate; float* out; float alpha;
    __device__ __forceinline__ void operator()(const f32x4 (&acc)[2][2][4][2], const Unit& u, int wr, int wc, int fr, int fq) const {
        const int row0 = u.pm * BM + wr * 64 + fr, col0 = u.pn * BM + wc * 32 + 4 * fq, b = u.pm >> 4;
        f32x4 gv[2][2];
#pragma unroll
        for (int bj = 0; bj < 2; ++bj)
#pragma unroll
            for (int n = 0; n < 2; ++n) gv[bj][n] = *(const f32x4*)(gate + b * 12288 + col0 + bj * HALF + n * 16);
#pragma unroll
        for (int ai = 0; ai < 2; ++ai)
#pragma unroll
            for (int m = 0; m < 4; ++m) { const size_t off = (size_t)(row0 + ai * HALF + m * 16) * 2048 + col0;
#pragma unroll
                for (int bj = 0; bj < 2; ++bj)
#pragma unroll
                    for (int n = 0; n < 2; ++n) { const f32x4 xv = *(const f32x4*)(res + off + bj * HALF + n * 16);
                        *(f32x4*)(out + off + bj * HALF + n * 16) = xv * alpha + gv[bj][n] * acc[ai][bj][m][n]; } }
    }
};


struct EpiBf16Plain {
    static constexpr bool PERM = true, AFTER_DRAIN = false;
    bf16_t* O; int ldc;
    __device__ __forceinline__ void operator()(const f32x4 (&acc)[2][2][4][2], const Unit& u, int wr, int wc, int fr, int fq) const {
        const int row0 = u.pm * BM + wr * 64 + fr, col0 = u.pn * BM + wc * 32 + 8 * fq;
#pragma unroll
        for (int ai = 0; ai < 2; ++ai)
#pragma unroll
            for (int m = 0; m < 4; ++m) { bf16_t* rowp = O + (size_t)(row0 + ai * HALF + m * 16) * ldc + col0;
#pragma unroll
                for (int bj = 0; bj < 2; ++bj) { const f32x4 v0 = acc[ai][bj][m][0], v1 = acc[ai][bj][m][1];
                    u32x4 w; w.x = cvt_pk_bf16(v0[0], v0[1]); w.y = cvt_pk_bf16(v0[2], v0[3]); w.z = cvt_pk_bf16(v1[0], v1[1]); w.w = cvt_pk_bf16(v1[2], v1[3]);
                    *(u32x4*)(rowp + bj * HALF) = w; } }
    }
};

struct EpiSwiglu {
    static constexpr bool PERM = true, AFTER_DRAIN = false;
    bf16_t* H; int ldh;
    __device__ __forceinline__ void operator()(const f32x4 (&acc)[2][2][4][2], const Unit& u, int wr, int wc, int fr, int fq) const {
        const int row0 = u.pm * BM + wr * 64 + fr, col0 = u.pn * 128 + wc * 32 + 8 * fq;
#pragma unroll
        for (int ai = 0; ai < 2; ++ai)
#pragma unroll
            for (int m = 0; m < 4; ++m) { bf16_t* rowp = H + (size_t)(row0 + ai * HALF + m * 16) * ldh + col0;
                f32x4 o[2];
#pragma unroll
                for (int n = 0; n < 2; ++n) { const f32x4 g = acc[ai][0][m][n], up = acc[ai][1][m][n];
#pragma unroll
                    for (int e = 0; e < 4; ++e) { const float sg = __builtin_amdgcn_rcpf(1.0f + __builtin_amdgcn_exp2f(-1.4426950408889634f * g[e])); o[n][e] = g[e] * sg * up[e]; } }
                u32x4 w; w.x = cvt_pk_bf16(o[0][0], o[0][1]); w.y = cvt_pk_bf16(o[0][2], o[0][3]); w.z = cvt_pk_bf16(o[1][0], o[1][1]); w.w = cvt_pk_bf16(o[1][2], o[1][3]);
                *(u32x4*)rowp = w; }
    }
};

typedef int v8i_t __attribute__((ext_vector_type(8))); typedef int v4i_t __attribute__((ext_vector_type(4)));
__device__ __forceinline__ v8i_t cat16(bf16x8 a, bf16x8 b) { return __builtin_shufflevector(__builtin_bit_cast(v4i_t, a), __builtin_bit_cast(v4i_t, b), 0, 1, 2, 3, 4, 5, 6, 7); }
template <class Epi, class Sched, bool ALIGN_EPI = false, bool SP2 = false, int SCW = 0, int SCA = 0, bool SWAPV = false>
__device__ __forceinline__ void gemm_phase(PG8_LAS unsigned char* lds, const Gemm g, const Sched& S, const Epi& E) {
    const int tid = threadIdx.x, wid = __builtin_amdgcn_readfirstlane(tid >> 6), lane = tid & 63, wr = wid >> 2, wc = wid & 3, fr = lane & 15, fq = lane >> 4;
    const int K = g.K, nt = K / BK;
    unsigned voffA[2], voffB[2];
#pragma unroll
    for (int i = 0; i < 2; ++i) { int R, C; stage_rc(tid * 16 + i * 8192, R, C); const int Rb = Epi::PERM ? ((R & ~31) + perm32(R & 31)) : R;
        voffA[i] = (unsigned)(R * K + C) * 2u; voffB[i] = (unsigned)(Rb * K + C) * 2u; }
    const size_t kstep = (size_t)(BK * 2);
    const size_t hstep = (size_t)HALF * K * 2;
    const size_t tstep = 2 * hstep;
    const unsigned ldsw = (unsigned)wid * 1024u;
    const int aoff = lds_byte(wr * 64 + fr, fq * 8), boff = lds_byte(wc * 32 + fr, fq * 8);
#define PG8_SA(b, h) (((b) * 2 + (h)) * HTB)
#define PG8_SB(b, h) ((4 + (b) * 2 + (h)) * HTB)
#define PG8_STAGE(bufoff, gbase, voff) do { _Pragma("unroll") for (int _i = 0; _i < 2; ++_i) \
        __builtin_amdgcn_global_load_lds((const unsigned*)((const char*)(gbase) + (voff)[_i]), (PG8_LAS unsigned*)(lds + (bufoff) + ldsw + _i * 8192), 16, 0, 0); } while (0)
#define PG8_LDA(dst, b, h) do { _Pragma("unroll") for (int m = 0; m < 4; ++m) { if constexpr (SCW != 0) dst##8[m] = cat16(*(const PG8_LAS bf16x8*)(lds + PG8_SA(b, h) + aoff + m * 2048), *(const PG8_LAS bf16x8*)(lds + PG8_SA(b, h) + aoff + m * 2048 + 1024)); \
        else { _Pragma("unroll") for (int k = 0; k < 2; ++k) dst[m][k] = *(const PG8_LAS bf16x8*)(lds + PG8_SA(b, h) + aoff + m * 2048 + k * 1024); } } } while (0)
#define PG8_LDB(dst, b, h) do { _Pragma("unroll") for (int n = 0; n < 2; ++n) { if constexpr (SCW != 0) dst##8[n] = cat16(*(const PG8_LAS bf16x8*)(lds + PG8_SB(b, h) + boff + n * 2048), *(const PG8_LAS bf16x8*)(lds + PG8_SB(b, h) + boff + n * 2048 + 1024)); \
        else { _Pragma("unroll") for (int k = 0; k < 2; ++k) dst[n][k] = *(const PG8_LAS bf16x8*)(lds + PG8_SB(b, h) + boff + n * 2048 + k * 1024); } } } while (0)
#define PG8_MMA(ai, bj, At, Bt) do { __builtin_amdgcn_s_setprio(1); _Pragma("unroll") for (int m = 0; m < 4; ++m) _Pragma("unroll") for (int n = 0; n < 2; ++n) { \
        if constexpr (SCW != 0) asm volatile("v_mfma_scale_f32_16x16x128_f8f6f4 %0, %1, %2, %0, %3, %4 op_sel_hi:[0,0,0]" : "+v"(acc[ai][bj][m][n]) : "v"(Bt##8[n]), "v"(At##8[m]), "v"(scw_), "v"(sca_));     \
        else { _Pragma("unroll") for (int k = 0; k < 2; ++k) acc[ai][bj][m][n] = __builtin_amdgcn_mfma_f32_16x16x32_bf16(Bt[n][k], At[m][k], acc[ai][bj][m][n], 0, 0, 0); } } \
        __builtin_amdgcn_s_setprio(0); } while (0)
#define PG8_WAIT_V(n) asm volatile("s_waitcnt vmcnt(" #n ")" ::: "memory")
#define PG8_WAIT_L(n) asm volatile("s_waitcnt lgkmcnt(" #n ")" ::: "memory")
#define PG8_BAR __builtin_amdgcn_s_barrier()
#define PG8_SCHED __builtin_amdgcn_sched_barrier(0)
    Unit cur, nxt; int ui = 0;
    if (!S.next(0, cur)) return;
    f32x4 acc[2][2][4][2];
#pragma unroll
    for (int a = 0; a < 2; ++a)
#pragma unroll
        for (int b = 0; b < 2; ++b)
#pragma unroll
            for (int m = 0; m < 4; ++m)
#pragma unroll
                for (int n = 0; n < 2; ++n) acc[a][b][m][n] = (f32x4){0.f, 0.f, 0.f, 0.f};
    int scw_ = SCW, sca_ = SCA; asm volatile("" : "+v"(scw_), "+v"(sca_));
    bf16x8 At[4][2], B0[2][2], B1[2][2]; v8i_t At8[4], B08[2], B18[2];
    const char* cA = (const char*)g.A + (size_t)cur.pm * tstep; const char* cB = (const char*)g.Bt + (size_t)cur.pn * tstep;
    S.a_ready(cur);
    if constexpr (SP2) {
        PG8_STAGE(PG8_SB(0, 0), cB, voffB); PG8_STAGE(PG8_SB(0, 1), cB + hstep, voffB); PG8_STAGE(PG8_SA(0, 0), cA, voffA); PG8_STAGE(PG8_SA(0, 1), cA + hstep, voffA);
        if (wr == 1) PG8_BAR;
        PG8_WAIT_V(2); PG8_BAR;
        PG8_STAGE(PG8_SB(1, 0), cB + kstep, voffB); PG8_STAGE(PG8_SA(1, 0), cA + kstep, voffA); PG8_STAGE(PG8_SB(1, 1), cB + hstep + kstep, voffB);
        PG8_WAIT_V(6); PG8_BAR;
    } else {
        PG8_STAGE(PG8_SB(0, 0), cB, voffB); PG8_STAGE(PG8_SA(0, 0), cA, voffA); PG8_STAGE(PG8_SB(0, 1), cB + hstep, voffB); PG8_STAGE(PG8_SA(0, 1), cA + hstep, voffA);
        if (wr == 1) PG8_BAR;
        PG8_WAIT_V(4); PG8_BAR;
        PG8_STAGE(PG8_SB(1, 0), cB + kstep, voffB); PG8_STAGE(PG8_SA(1, 0), cA + kstep, voffA); PG8_STAGE(PG8_SB(1, 1), cB + hstep + kstep, voffB);
        PG8_WAIT_V(6); PG8_BAR;
    }
    for (;;) {
        const bool has_next = S.next(ui + 1, nxt);
        const char* nA = has_next ? (const char*)g.A + (size_t)nxt.pm * tstep : cA; const char* nB = has_next ? (const char*)g.Bt + (size_t)nxt.pn * tstep : cB;
        for (int t = 0; t < nt; t += 2) {
            const bool last = (t == nt - 2);
            const char* a1 = cA + (size_t)(t + 1) * kstep;
            const char* a2 = last ? nA : cA + (size_t)(t + 2) * kstep; const char* b2 = last ? nB : cB + (size_t)(t + 2) * kstep;
            const char* a3 = a2 + kstep; const char* b3 = b2 + kstep;
            if (last && has_next) S.a_ready(nxt);
            if constexpr (SP2) {
            PG8_LDB(B0, 0, 0); PG8_LDB(B1, 0, 1); PG8_SCHED; PG8_LDA(At, 0, 0); PG8_STAGE(PG8_SA(1, 1), a1 + hstep, voffA);
            PG8_WAIT_V(8); PG8_WAIT_L(0); PG8_BAR; PG8_MMA(0, 0, At, B0); PG8_MMA(0, 1, At, B1); PG8_BAR; PG8_SCHED;
            PG8_LDA(At, 0, 1); PG8_STAGE(PG8_SB(0, 0), b2, voffB); PG8_STAGE(PG8_SB(0, 1), b2 + hstep, voffB); PG8_STAGE(PG8_SA(0, 0), a2, voffA);
            PG8_WAIT_V(8); PG8_WAIT_L(0); PG8_BAR; PG8_MMA(1, 0, At, B0); PG8_MMA(1, 1, At, B1); PG8_BAR; PG8_SCHED;
            PG8_LDB(B0, 1, 0); PG8_LDB(B1, 1, 1); PG8_SCHED; PG8_LDA(At, 1, 0); PG8_STAGE(PG8_SA(0, 1), a2 + hstep, voffA);
            PG8_WAIT_V(8); PG8_WAIT_L(0); PG8_BAR; PG8_MMA(0, 0, At, B0); PG8_MMA(0, 1, At, B1); PG8_BAR; PG8_SCHED;
            PG8_LDA(At, 1, 1); PG8_STAGE(PG8_SB(1, 0), b3, voffB); PG8_STAGE(PG8_SB(1, 1), b3 + hstep, voffB); PG8_STAGE(PG8_SA(1, 0), a3, voffA);
            PG8_WAIT_V(8); PG8_WAIT_L(0); PG8_BAR; PG8_MMA(1, 0, At, B0); PG8_MMA(1, 1, At, B1); PG8_BAR; PG8_SCHED;
            } else {
            PG8_LDB(B0, 0, 0); PG8_SCHED; PG8_LDA(At, 0, 0); PG8_STAGE(PG8_SA(1, 1), a1 + hstep, voffA);
            PG8_WAIT_L(8); PG8_BAR; PG8_WAIT_L(0); PG8_MMA(0, 0, At, B0); PG8_BAR; PG8_SCHED;
            PG8_LDB(B1, 0, 1); PG8_STAGE(PG8_SB(0, 0), b2, voffB);
            PG8_BAR; PG8_WAIT_L(0); PG8_MMA(0, 1, At, B1); PG8_BAR;
            PG8_LDA(At, 0, 1); PG8_STAGE(PG8_SA(0, 0), a2, voffA);
            PG8_BAR; PG8_WAIT_L(0); PG8_MMA(1, 0, At, B0); PG8_BAR; PG8_SCHED;
            PG8_STAGE(PG8_SB(0, 1), b2 + hstep, voffB);
            PG8_WAIT_V(6); PG8_BAR; PG8_MMA(1, 1, At, B1); PG8_BAR;
            PG8_LDB(B0, 1, 0); PG8_SCHED; PG8_LDA(At, 1, 0); PG8_STAGE(PG8_SA(0, 1), a2 + hstep, voffA);
            PG8_WAIT_L(8); PG8_BAR; PG8_WAIT_L(0); PG8_MMA(0, 0, At, B0); PG8_BAR; PG8_SCHED;
            PG8_LDB(B1, 1, 1); PG8_STAGE(PG8_SB(1, 0), b3, voffB);
            PG8_BAR; PG8_WAIT_L(0); PG8_MMA(0, 1, At, B1); PG8_BAR;
            PG8_LDA(At, 1, 1); PG8_STAGE(PG8_SA(1, 0), a3, voffA);
            PG8_BAR; PG8_WAIT_L(0); PG8_MMA(1, 0, At, B0); PG8_BAR; PG8_SCHED;
            PG8_STAGE(PG8_SB(1, 1), b3 + hstep, voffB);
            PG8_WAIT_V(6); PG8_BAR; PG8_MMA(1, 1, At, B1); PG8_BAR;
            }
        }
        if constexpr (ALIGN_EPI) { if (wr == 0) PG8_BAR; }
        if constexpr (SCW != 0) asm volatile("s_nop 15\n\ts_nop 15" ::: "memory");
        if constexpr (!Epi::AFTER_DRAIN) { E(acc, cur, wr, wc, fr, fq); S.done(cur); }
        if (!has_next) break;
#pragma unroll
        for (int a = 0; a < 2; ++a)
#pragma unroll
            for (int b = 0; b < 2; ++b)
#pragma unroll
                for (int m = 0; m < 4; ++m)
#pragma unroll
                    for (int n = 0; n < 2; ++n) acc[a][b][m][n] = (f32x4){0.f, 0.f, 0.f, 0.f};
        cur = nxt; cA = nA; cB = nB; ++ui;
        if constexpr (ALIGN_EPI) { if (wr == 1) PG8_BAR; }
    }
    PG8_WAIT_V(0);
    if constexpr (!ALIGN_EPI) { if (wr == 0) PG8_BAR; }
    PG8_BAR;
#undef PG8_SA
#undef PG8_SB
#undef PG8_STAGE
#undef PG8_LDA
#undef PG8_LDB
#undef PG8_MMA
#undef PG8_WAIT_V
#undef PG8_WAIT_L
#undef PG8_BAR
#undef PG8_SCHED
}
}

namespace att {
typedef unsigned short bf16;
using bf16x8 = __attribute__((ext_vector_type(8))) short;
using s16x4  = __attribute__((ext_vector_type(4))) short;
using f32x16 = __attribute__((ext_vector_type(16))) float;
using u32x4  = __attribute__((ext_vector_type(4))) unsigned;
typedef int v8i __attribute__((ext_vector_type(8))); typedef int v4i __attribute__((ext_vector_type(4)));
constexpr int D = 128, NW = 8, QBLK = 32, KVBLK = 64;
constexpr float SCALE = 0.088388347648318440f;
constexpr float THR = 1.5f;
constexpr float PSHIFT = 6.0f;
constexpr int LDQ = 2048, LDK = 128, LDO = 2048;
constexpr float OSCL = 16.f;
constexpr int SHM_V = KVBLK * D  , SHM_K = KVBLK * D  , SHM_ATTN = 2 * SHM_V + 2 * SHM_K + NW * 64 * 4;
#define KSWZ(row, colB) ((row) * 256 + ((colB) ^ (((row) & 7) << 4)))
#define SBAR() __builtin_amdgcn_sched_barrier(0)
__device__ __forceinline__ int crow(int r, int hi) { return (r & 3) + 8 * (r >> 2) + 4 * hi; }
__device__ __forceinline__ unsigned cvtpk(float lo, float hi) { unsigned r; asm volatile("v_cvt_pk_bf16_f32 %0, %1, %2" : "=v"(r) : "v"(lo), "v"(hi)); return r; }

__device__ __forceinline__ void partialSM(f32x16& p0, f32x16& p1, float& m_reg, float& mn, float& alpha, bool fixedm) {
  constexpr float C = SCALE * 1.4426950408889634f;
  if (fixedm) { mn = m_reg; alpha = 1.f; }
  else {
  float pmax = p0[0]; for (int r = 1; r < 16; ++r) pmax = fmaxf(pmax, p0[r]); for (int r = 0; r < 16; ++r) pmax = fmaxf(pmax, p1[r]);
  { auto rr = __builtin_amdgcn_permlane32_swap(__float_as_uint(pmax), __float_as_uint(pmax), false, false);
    pmax = fmaxf(__uint_as_float(rr[0]), __uint_as_float(rr[1])); }
  if (__builtin_expect(__all(pmax - m_reg <= THR / SCALE), 1)) { mn = m_reg; alpha = 1.f; }
  else { mn = fmaxf(m_reg, pmax); alpha = __builtin_amdgcn_exp2f((m_reg - mn) * C); m_reg = mn; }
  }
  float mnC = -mn * C + PSHIFT;
  for (int r = 0; r < 16; ++r) p0[r] = fmaf(p0[r], C, mnC); for (int r = 0; r < 16; ++r) p1[r] = fmaf(p1[r], C, mnC);
  for (int r = 0; r < 16; ++r) p0[r] = __builtin_amdgcn_exp2f(p0[r]);
}
__device__ __forceinline__ void finishSM8(f32x16& p0, f32x16& p1, float alpha, float& l_reg, v8i& pa) {
  for (int r = 0; r < 16; ++r) p1[r] = __builtin_amdgcn_exp2f(p1[r]);
  float ps = 0; for (int r = 0; r < 16; ++r) ps += p0[r]; for (int r = 0; r < 16; ++r) ps += p1[r];
  { auto rr = __builtin_amdgcn_permlane32_swap(__float_as_uint(ps), __float_as_uint(ps), false, false);
    ps = __uint_as_float(rr[0]) + __uint_as_float(rr[1]); }
  l_reg = l_reg * alpha + ps * (1.0f / 64.0f);
#pragma unroll
  for (int w = 0; w < 4; ++w) {
    int t0_ = __builtin_amdgcn_cvt_pk_fp8_f32(p0[4 * w], p0[4 * w + 1], 0, false); pa[w] = __builtin_amdgcn_cvt_pk_fp8_f32(p0[4 * w + 2], p0[4 * w + 3], t0_, true);
    int t1_ = __builtin_amdgcn_cvt_pk_fp8_f32(p1[4 * w], p1[4 * w + 1], 0, false); pa[4 + w] = __builtin_amdgcn_cvt_pk_fp8_f32(p1[4 * w + 2], p1[4 * w + 3], t1_, true); }
}
__device__ __forceinline__ void finishSM(f32x16& p0, f32x16& p1, float alpha, float& l_reg, bf16x8& pa0, bf16x8& pa1, bf16x8& pa2, bf16x8& pa3) {
  for (int r = 0; r < 16; ++r) p1[r] = __builtin_amdgcn_exp2f(p1[r]);
  float ps = 0; for (int r = 0; r < 16; ++r) ps += p0[r]; for (int r = 0; r < 16; ++r) ps += p1[r];
  { auto rr = __builtin_amdgcn_permlane32_swap(__float_as_uint(ps), __float_as_uint(ps), false, false);
    ps = __uint_as_float(rr[0]) + __uint_as_float(rr[1]); }
  l_reg = l_reg * alpha + ps;
#define PK4(P, BASE, OUT) do { unsigned a0 = cvtpk(P[BASE + 0], P[BASE + 1]), a1 = cvtpk(P[BASE + 2], P[BASE + 3]);   \
    unsigned b0 = cvtpk(P[BASE + 4], P[BASE + 5]), b1 = cvtpk(P[BASE + 6], P[BASE + 7]);                              \
    auto r0 = __builtin_amdgcn_permlane32_swap(a0, b0, false, false); auto r1 = __builtin_amdgcn_permlane32_swap(a1, b1, false, false); \
    u32x4 w = {r0[0], r1[0], r0[1], r1[1]}; OUT = *reinterpret_cast<bf16x8*>(&w); } while (0)
  PK4(p0, 0, pa0); PK4(p0, 8, pa1); PK4(p1, 0, pa2); PK4(p1, 8, pa3);
#undef PK4
}
__device__ __forceinline__ void qkt(f32x16& p0, f32x16& p1, const bf16* Ks, const bf16x8* qr, int r32, int hi) {
  p0 = f32x16{}; p1 = f32x16{};
  for (int d0 = 0; d0 < 8; ++d0) { int cb = (d0 * 16 + hi * 8) * 2;
    bf16x8 b0 = *reinterpret_cast<const bf16x8*>((const char*)Ks + KSWZ(r32, cb));
    bf16x8 b1 = *reinterpret_cast<const bf16x8*>((const char*)Ks + KSWZ(32 + r32, cb));
    p0 = __builtin_amdgcn_mfma_f32_32x32x16_bf16(b0, qr[d0], p0, 0, 0, 0);
    p1 = __builtin_amdgcn_mfma_f32_32x32x16_bf16(b1, qr[d0], p1, 0, 0, 0); }
}
__device__ __forceinline__ void wmask(f32x16& p0, f32x16& p1, int kb, int qpos) {
  const int dq = qpos - kb + 128;
#pragma unroll
  for (int r = 0; r < 16; ++r) { const int d = dq - ((r & 3) + 8 * (r >> 2));
    if ((unsigned)d > 256u) p0[r] = -INFINITY;
    if ((unsigned)(d - 32) > 256u) p1[r] = -INFINITY; }
}
__device__ __forceinline__ int v_st(int k, int c) { const int kk = (k & ~0xC) | ((k & 4) << 1) | ((k & 8) >> 1); return ((kk >> 3) * 4 + (c >> 5)) * 512 + ((kk & 7) * 32 + (c & 31)) * 2; }
__device__ __forceinline__ int v_rd_base(int lane) { return ((lane & 3) << 3) | (((lane >> 2) & 3) << 6) | (((lane >> 4) & 1) << 5) | (((lane >> 5) & 1) << 8); }
constexpr int v_rd_off(int d0, int ks, int half) { return d0 * 512 + ks * 4096 + half * 2048; }
template <int OFF> __device__ __forceinline__ s16x4 tr_read(int vb) {
  s16x4 r; asm volatile("ds_read_b64_tr_b16 %0, %1 offset:%2" : "=&v"(r) : "v"(vb), "i"(OFF) : "memory"); return r;
}
template <int D0> __device__ __forceinline__ void pv_one(f32x16& od, int vb, bf16x8 pa0, bf16x8 pa1, bf16x8 pa2, bf16x8 pa3) {
  const s16x4 l0 = tr_read<v_rd_off(D0, 0, 0)>(vb), h0 = tr_read<v_rd_off(D0, 0, 1)>(vb), l1 = tr_read<v_rd_off(D0, 1, 0)>(vb), h1 = tr_read<v_rd_off(D0, 1, 1)>(vb);
  const s16x4 l2 = tr_read<v_rd_off(D0, 2, 0)>(vb), h2 = tr_read<v_rd_off(D0, 2, 1)>(vb), l3 = tr_read<v_rd_off(D0, 3, 0)>(vb), h3 = tr_read<v_rd_off(D0, 3, 1)>(vb);
  asm volatile("s_waitcnt lgkmcnt(0)" ::: "memory"); SBAR();
#define PK(L, H) (bf16x8){L[0], L[1], L[2], L[3], H[0], H[1], H[2], H[3]}
  od = __builtin_amdgcn_mfma_f32_32x32x16_bf16(pa0, PK(l0, h0), od, 0, 0, 0);
  od = __builtin_amdgcn_mfma_f32_32x32x16_bf16(pa1, PK(l1, h1), od, 0, 0, 0);
  od = __builtin_amdgcn_mfma_f32_32x32x16_bf16(pa2, PK(l2, h2), od, 0, 0, 0);
  od = __builtin_amdgcn_mfma_f32_32x32x16_bf16(pa3, PK(l3, h3), od, 0, 0, 0);
#undef PK
}
__device__ __forceinline__ void pv_d0(f32x16* o, int vb, bf16x8 pa0, bf16x8 pa1, bf16x8 pa2, bf16x8 pa3) {
  pv_one<0>(o[0], vb, pa0, pa1, pa2, pa3); pv_one<1>(o[1], vb, pa0, pa1, pa2, pa3); pv_one<2>(o[2], vb, pa0, pa1, pa2, pa3); pv_one<3>(o[3], vb, pa0, pa1, pa2, pa3);
}

struct Stg { v4i v8; v4i k8; };
#define V8OFF(d, ch) ((d) * 64 + ((((ch) ^ (((d) >> 2) & 3))) << 4))
#define K8OFF(row, ch) ((row) * 128 + ((((ch) ^ (((row) >> 1) & 7))) << 4))
__device__ __forceinline__ v8i cat8(v4i a, v4i b) { return __builtin_shufflevector(a, b, 0, 1, 2, 3, 4, 5, 6, 7); }
__device__ __forceinline__ void qkt8(f32x16& p0, f32x16& p1, const char* Ks, const v8i (&q8)[2], int r32, int hi, int sc) {
  const v8i a00 = cat8(*(const v4i*)(Ks + K8OFF(r32, 2 * hi)), *(const v4i*)(Ks + K8OFF(r32, 2 * hi + 1)));
  const v8i a10 = cat8(*(const v4i*)(Ks + K8OFF(32 + r32, 2 * hi)), *(const v4i*)(Ks + K8OFF(32 + r32, 2 * hi + 1)));
  const v8i a01 = cat8(*(const v4i*)(Ks + K8OFF(r32, 4 + 2 * hi)), *(const v4i*)(Ks + K8OFF(r32, 4 + 2 * hi + 1)));
  const v8i a11 = cat8(*(const v4i*)(Ks + K8OFF(32 + r32, 4 + 2 * hi)), *(const v4i*)(Ks + K8OFF(32 + r32, 4 + 2 * hi + 1)));
  asm volatile("s_nop 1\n\tv_mfma_scale_f32_32x32x64_f8f6f4 %0, %1, %2, 0, %3, %3 op_sel_hi:[0,0,0]" : "=&v"(p0) : "v"(a00), "v"(q8[0]), "v"(sc));
  asm volatile("s_nop 1\n\tv_mfma_scale_f32_32x32x64_f8f6f4 %0, %1, %2, 0, %3, %3 op_sel_hi:[0,0,0]" : "=&v"(p1) : "v"(a10), "v"(q8[0]), "v"(sc));
  asm volatile("s_nop 1\n\tv_mfma_scale_f32_32x32x64_f8f6f4 %0, %1, %2, %0, %3, %3 op_sel_hi:[0,0,0]" : "+v"(p0) : "v"(a01), "v"(q8[1]), "v"(sc));
  asm volatile("s_nop 1\n\tv_mfma_scale_f32_32x32x64_f8f6f4 %0, %1, %2, %0, %3, %3 op_sel_hi:[0,0,0]" : "+v"(p1) : "v"(a11), "v"(q8[1]), "v"(sc));
}
__device__ __forceinline__ void pv8(f32x16* o, const char* Vs, const v8i& pa, int r32, int hi, int scp, int scv) {
#pragma unroll
  for (int d0 = 0; d0 < 4; ++d0) { const int d = 32 * d0 + r32;
    const v8i bfr = cat8(*(const v4i*)(Vs + V8OFF(d, 2 * hi)), *(const v4i*)(Vs + V8OFF(d, 2 * hi + 1)));
    asm volatile("s_nop 1\n\tv_mfma_scale_f32_32x32x64_f8f6f4 %0, %1, %2, %0, %3, %4 op_sel_hi:[0,0,0]" : "+v"(o[d0]) : "v"(pa), "v"(bfr), "v"(scp), "v"(scv)); }
}
#define O_SETTLE() asm volatile("s_nop 15\n\ts_nop 7" : "+v"(o[0]), "+v"(o[1]), "+v"(o[2]), "+v"(o[3]))
#define QKT_SETTLE(P0, P1) asm volatile("s_nop 15\n\ts_nop 7" : "+v"(P0), "+v"(P1))
struct AUnit { const unsigned char* Q; const unsigned char* K; const unsigned char* V; unsigned char* O; int NT, nctx, jlo, q0; bool masked; float sinkl2, kbound; };
#define KOFU(u, t) (((t) < (u).nctx) ? (4096 + 64 * (t)) : 64 * ((u).jlo + (t) - (u).nctx))
#define SLOADX(dst, Kp, Vp, k0) do { const int k0_ = (k0); (dst).v8 = *reinterpret_cast<const v4i*>(&(Vp)[(long)(tid >> 2) * 4352 + k0_ + (tid & 3) * 16]); \
    (dst).k8 = *reinterpret_cast<const v4i*>(&(Kp)[(long)(k0_ + (tid >> 3)) * 128 + (tid & 7) * 16]); } while (0)
__device__ __forceinline__ void attn_prime(const AUnit& u, v8i (&qr)[2], Stg (&sr_)[2]) {
  const int tid = threadIdx.x, wid = tid >> 6, lane = tid & 63, r32 = lane & 31, hi = lane >> 5;
  const unsigned char* Qw = u.Q + (long)(wid * QBLK + r32) * LDQ + hi * 32;
#pragma unroll
  for (int j = 0; j < 2; ++j) qr[j] = cat8(*reinterpret_cast<const v4i*>(Qw + 64 * j), *reinterpret_cast<const v4i*>(Qw + 64 * j + 16));
  SLOADX(sr_[0], u.K, u.V, KOFU(u, 0)); SLOADX(sr_[1], u.K, u.V, KOFU(u, 1));
}
__device__ __forceinline__ void attn_unit(const AUnit& u, bool has_next, const AUnit& nx, v8i (&qr)[2], Stg (&sr_)[2], char* lds) {
  const int tid = threadIdx.x, wid = tid >> 6, lane = tid & 63, r32 = lane & 31, hi = lane >> 5;
  const unsigned char* __restrict__ Kh = u.K; const unsigned char* __restrict__ Vh = u.V;
  int qksc = (127 - 4) * 0x01010101, pvsc = (127 - 6) * 0x01010101; asm volatile("" : "+v"(qksc), "+v"(pvsc));
  const int NT = u.NT, nctx = u.nctx, jlo = u.jlo; const bool masked = u.masked;
  bf16* V_lds = (bf16*)lds; bf16* K_lds = (bf16*)(lds + 2 * SHM_V);
  float* ws = (float*)(lds + 2 * SHM_V + 2 * SHM_K) + wid * 64; float* li_l = ws; float* al_l = ws + 32;
  float m_reg = -1e30f, l_reg = 0; f32x16 o[4] = {};
  const bool fixedm = u.kbound > 0.f;
  if (fixedm) { float ss = 0.f;
#pragma unroll
    for (int j = 0; j < 2; ++j)
#pragma unroll
      for (int e = 0; e < 8; ++e) { const int w = qr[j][e];
        const float q0_ = __builtin_amdgcn_cvt_f32_fp8(w, 0), q1_ = __builtin_amdgcn_cvt_f32_fp8(w, 1), q2_ = __builtin_amdgcn_cvt_f32_fp8(w, 2), q3_ = __builtin_amdgcn_cvt_f32_fp8(w, 3);
        ss += (q0_ * q0_ + q1_ * q1_) + (q2_ * q2_ + q3_ * q3_); }
    { auto rr = __builtin_amdgcn_permlane32_swap(__float_as_uint(ss), __float_as_uint(ss), false, false); ss = __uint_as_float(rr[0]) + __uint_as_float(rr[1]); }
    m_reg = sqrtf(ss) * (1.0f / 16.0f) * u.kbound; }

  const int qpos = u.q0 + wid * QBLK + r32;
#define KOF(t) (((t) < nctx) ? (4096 + 64 * (t)) : 64 * (jlo + (t) - nctx))
#define SLOAD(i, k0) SLOADX(sr_[i], Kh, Vh, k0)
#define SWRITE(b, i) do { *(v4i*)((char*)V_lds + (b) * SHM_V + V8OFF(tid >> 2, tid & 3)) = sr_[i].v8;          \
    *(v4i*)((char*)K_lds + (b) * SHM_K + K8OFF(tid >> 3, tid & 7)) = sr_[i].k8; } while (0)
#define SWAIT() asm volatile("s_waitcnt vmcnt(4)" ::: "memory")
#define RESC(a) do { if (__any((a) < 1.f)) { if (hi == 0) al_l[r32] = (a); asm volatile("s_waitcnt lgkmcnt(0)" ::: "memory"); O_SETTLE(); \
    for (int d = 0; d < 4; ++d) for (int r = 0; r < 16; ++r) o[d][r] *= al_l[crow(r, hi)]; } } while (0)
#define MASK(P0, P1, t) do { if (masked && (t) >= nctx) wmask(P0, P1, KOF(t) + 4 * hi, qpos); } while (0)
  f32x16 pA0, pA1, pB0, pB1; float mnA, mnB, alA, alB; v8i pa;
  constexpr int SE = 0, SO = 1;
  SWAIT(); SWRITE(0, SE); __syncthreads();
  if (2 < NT) SLOAD(SE, KOF(2));
  qkt8(pA0, pA1, (const char*)K_lds, qr, r32, hi, qksc); QKT_SETTLE(pA0, pA1); MASK(pA0, pA1, 0); partialSM(pA0, pA1, m_reg, mnA, alA, fixedm);
  SWAIT(); SWRITE(1, SO); __syncthreads();
  for (int j = 1; j + 1 < NT; j += 2) {
    SBAR(); qkt8(pB0, pB1, (const char*)K_lds + SHM_K, qr, r32, hi, qksc);
    finishSM8(pA0, pA1, alA, l_reg, pa); SBAR();
    SLOAD(SO, KOF(j + 2)); SBAR();
    pv8(o, (const char*)V_lds, pa, r32, hi, pvsc, qksc); QKT_SETTLE(pB0, pB1); MASK(pB0, pB1, j); partialSM(pB0, pB1, m_reg, mnB, alB, fixedm);
    __syncthreads(); SWAIT(); SWRITE(0, SE);
    RESC(alB); __syncthreads();
    SBAR(); qkt8(pA0, pA1, (const char*)K_lds, qr, r32, hi, qksc);
    finishSM8(pB0, pB1, alB, l_reg, pa); SBAR();
    if (j + 3 < NT) SLOAD(SE, KOF(j + 3)); SBAR();
    pv8(o, (const char*)V_lds + SHM_V, pa, r32, hi, pvsc, qksc); QKT_SETTLE(pA0, pA1); MASK(pA0, pA1, j + 1); partialSM(pA0, pA1, m_reg, mnA, alA, fixedm);
    __syncthreads(); SWAIT(); SWRITE(1, SO);
    RESC(alA); __syncthreads();
  }
  SBAR(); qkt8(pB0, pB1, (const char*)K_lds + SHM_K, qr, r32, hi, qksc);
  finishSM8(pA0, pA1, alA, l_reg, pa); SBAR();
  pv8(o, (const char*)V_lds, pa, r32, hi, pvsc, qksc); QKT_SETTLE(pB0, pB1); MASK(pB0, pB1, NT - 1); partialSM(pB0, pB1, m_reg, mnB, alB, fixedm);
  SBAR(); if (has_next) attn_prime(nx, qr, sr_); SBAR();
  __syncthreads(); RESC(alB);
  finishSM8(pB0, pB1, alB, l_reg, pa); SBAR();
  pv8(o, (const char*)V_lds + SHM_V, pa, r32, hi, pvsc, qksc);
  O_SETTLE();
  l_reg += __builtin_amdgcn_exp2f(u.sinkl2 - m_reg * (SCALE * 1.4426950408889634f));
  if (hi == 0) li_l[r32] = l_reg; asm volatile("s_waitcnt lgkmcnt(0)" ::: "memory");
  float rli[16];
#pragma unroll
  for (int r = 0; r < 16; ++r) rli[r] = __builtin_amdgcn_rcpf(li_l[crow(r, hi)]);
  __syncthreads();
  { char* stg = lds + wid * 8192 + (4 * hi * 128 + r32) * 2;
#pragma unroll
    for (int r = 0; r < 16; ++r) {
#pragma unroll
      for (int d0 = 0; d0 < 4; ++d0) { const float v = o[d0][r] * rli[r]; *(bf16*)(stg + ((r & 3) + 8 * (r >> 2)) * 256 + d0 * 64) = (bf16)(cvtpk(v, v) & 0xffffu); }
      asm volatile("" ::: "memory"); }
    asm volatile("s_waitcnt lgkmcnt(0)" ::: "memory");
    unsigned char* Ow = u.O + (long)(wid * QBLK + (lane >> 4)) * LDO + (lane & 15) * 8;
    const char* rd = lds + wid * 8192 + (lane >> 4) * 256 + (lane & 15) * 16;
#pragma unroll
    for (int i = 0; i < 8; ++i) { const u32x4 v = *(const u32x4*)(rd + i * 1024);
      typedef unsigned u2v __attribute__((ext_vector_type(2))); u2v w;
#define LO16(x) (__uint_as_float((x) << 16) * OSCL)
#define HI16(x) (__uint_as_float((x) & 0xffff0000u) * OSCL)
      { int t = __builtin_amdgcn_cvt_pk_fp8_f32(LO16(v.x), HI16(v.x), 0, false); t = __builtin_amdgcn_cvt_pk_fp8_f32(LO16(v.y), HI16(v.y), t, true); w.x = (unsigned)t; }
      { int t = __builtin_amdgcn_cvt_pk_fp8_f32(LO16(v.z), HI16(v.z), 0, false); t = __builtin_amdgcn_cvt_pk_fp8_f32(LO16(v.w), HI16(v.w), t, true); w.y = (unsigned)t; }
#undef LO16
#undef HI16
      *(u2v*)(Ow + (long)i * 4 * LDO) = w; } }
  __syncthreads();
#undef KOF
#undef SLOAD
#undef SWRITE
#undef SWAIT
#undef RESC
#undef MASK
}
#undef KOFU
#undef SLOADX
#undef K8OFF
#undef V8OFF
#undef QKT_SETTLE
#undef O_SETTLE
#undef KSWZ
#undef SBAR
}

constexpr int NWAVES = 8;
constexpr int N_LAUNCHES = MK_N_LAUNCHES;
constexpr int N_PHASES = 10;
constexpr int DM = 2048, NB = 4, SEQ = 4096, CTXL = 256, FFN = 5632, INW = 3072, NMOD = 12288;
constexpr int M = NB * SEQ, MC = NB * CTXL, MU = M + MC;
constexpr int SKV = SEQ + CTXL;
constexpr float LN_EPS = 1e-6f;
constexpr float DN_ALPHA = 1.189207115002721f;

constexpr size_t MiB = 1u << 20;
constexpr size_t WS_CTL = 0, CTL_ZERO_BYTES = 64 * 1024;
constexpr size_t WS_MODP = 1 * MiB;
constexpr size_t WS_MODS = 2 * MiB;
constexpr size_t WS_ROPE = 2 * MiB + 512 * 1024;
constexpr size_t WS_WIN = 3 * MiB, WS_WOUT = 15 * MiB, WS_WGU = 23 * MiB, WS_WDN = 67 * MiB;
constexpr size_t WS_U = 89 * MiB;
constexpr size_t WS_Y = 157 * MiB;
constexpr size_t WS_QO = 285 * MiB;
constexpr size_t WS_KV = 349 * MiB;
constexpr size_t KV_BYTES = (size_t)NB * 2 * SKV * 128 * 2;
constexpr size_t WS_H = 285 * MiB;
constexpr size_t WS_END = 461 * MiB;
static_assert(WS_WIN + (size_t)INW * DM * 2 <= WS_WOUT && WS_WOUT + (size_t)DM * DM * 2 <= WS_WGU && WS_WGU + (size_t)2 * FFN * DM * 2 <= WS_WDN && WS_WDN + (size_t)DM * FFN * 2 <= WS_U, "ws map (weights)");
static_assert(WS_U + (size_t)MU * DM * 2 <= WS_Y && WS_Y + (size_t)M * DM * 4 <= WS_QO && WS_QO + (size_t)M * DM * 2 <= WS_KV && WS_KV + 4 * KV_BYTES <= WS_END && WS_H + (size_t)M * FFN * 2 <= WS_END, "ws map");
constexpr int CW_BAR = 4096;
constexpr int S_U = 2, S_W = 6, S_O = 4;
constexpr int E8(int s) { return (127 - s) * 0x01010101; }

constexpr int RING_OFF = 0, RING_BYTES = 131072;
constexpr int LDSCTL_OFF = RING_BYTES, MISC_OFF = LDSCTL_OFF + 320;
constexpr int XCH_OFF = RING_BYTES + 1024;
constexpr int LDS_BYTES = 147456;
static_assert(XCH_OFF + 4096 <= LDS_BYTES, "LDS map");

#define GAS __attribute__((address_space(1)))
#define LAS __attribute__((address_space(3)))
typedef unsigned short bf16;
typedef unsigned v4u __attribute__((ext_vector_type(4)));
typedef float f32x4 __attribute__((ext_vector_type(4)));
typedef GAS unsigned gu32;
#define RLX_AGENT __ATOMIC_RELAXED, __HIP_MEMORY_SCOPE_AGENT
#define LDS_WAIT() asm volatile("s_waitcnt lgkmcnt(0)" ::: "memory")
#define VM_WAIT() asm volatile("s_waitcnt vmcnt(0)" ::: "memory")
__device__ __forceinline__ unsigned f2bf(float f) { unsigned u = __builtin_bit_cast(unsigned, f); return (u + 0x7fffu + ((u >> 16) & 1u)) >> 16; }
__device__ __forceinline__ unsigned pk2(float lo, float hi) { return f2bf(lo) | (f2bf(hi) << 16); }

#define XB_TMO      128
#define XB_XCNT(j)  (256  + 64 * (j))
#define XB_XSUB(j)  (1280 + 64 * (j))
#define XB_XGEN(j)  (2304 + 64 * (j))
#define XB_TOP      3328
#define XB_TOPGEN   3392
#define XCD_BAR_WORDS 3456
#define XB_SPIN_CAP (1u << 18)
__device__ __forceinline__ unsigned xb_ld(unsigned* p)              { return __hip_atomic_load(p, __ATOMIC_RELAXED, __HIP_MEMORY_SCOPE_AGENT); }
__device__ __forceinline__ unsigned xb_add(unsigned* p, unsigned v) { return __hip_atomic_fetch_add(p, v, __ATOMIC_RELAXED, __HIP_MEMORY_SCOPE_AGENT); }
__device__ __forceinline__ unsigned xb_xcc_id() { return (unsigned)__builtin_amdgcn_s_getreg((3 << 11) | 20) & 0xFu; }
#define XB_SPIN(cond, bar) do { unsigned _sp = 0; while (cond) { __builtin_amdgcn_s_sleep(1); \
    if ((++_sp & 255u) == 0u) { if (xb_ld(&(bar)[XB_TMO])) break; if (_sp > XB_SPIN_CAP) { atomicAdd(&(bar)[XB_TMO], 1u); break; } } } } while (0)
struct XcdBarrier { unsigned* bar; unsigned x; volatile LAS unsigned* st; };
__device__ __forceinline__ XcdBarrier xcd_barrier_post(unsigned* bar, volatile LAS unsigned* st) {
    XcdBarrier b; b.bar = bar; b.x = xb_xcc_id(); b.st = st;
    if (threadIdx.x == 0) (void)xb_add(&bar[XB_XCNT(b.x)], 1u);
    return b;
}
__device__ __forceinline__ void xcd_barrier_complete(unsigned* bar, unsigned x, unsigned& nloc, unsigned& nx) {
    const unsigned G = gridDim.x * gridDim.y * gridDim.z;
    unsigned sum, cnt, mine, sp = 0u;
    for (;;) {
        sum = 0u; cnt = 0u; mine = 0u;
#pragma unroll
        for (unsigned j = 0; j < 16; ++j) { const unsigned c = xb_ld(&bar[XB_XCNT(j)]); sum += c; cnt += (c > 0u) ? 1u : 0u; mine = (j == x) ? c : mine; }
        if (sum == G) break;
        __builtin_amdgcn_s_sleep(1);
        if ((++sp & 255u) == 0u) { if (xb_ld(&bar[XB_TMO])) break; if (sp > XB_SPIN_CAP) { atomicAdd(&bar[XB_TMO], 1u); break; } }
    }
    nloc = mine > 0u ? mine : 1u; nx = cnt > 0u ? cnt : 1u;
}
__device__ __forceinline__ void xcd_barrier(const XcdBarrier& b) {
    asm volatile("s_waitcnt vmcnt(0)" ::: "memory");
    __syncthreads();
    if (threadIdx.x == 0) {
        unsigned* bar = b.bar;
        __builtin_amdgcn_s_waitcnt(0);
        unsigned nloc = b.st[0], nx = b.st[1];
        if (nloc == 0u) { xcd_barrier_complete(bar, b.x, nloc, nx); b.st[0] = nloc; b.st[1] = nx; }
        const unsigned old = xb_add(&bar[XB_XSUB(b.x)], 1u);
        const unsigned gen = old / nloc;
        if (old + 1u == (gen + 1u) * nloc) {
            __builtin_amdgcn_fence(__ATOMIC_RELEASE, "agent");
            asm volatile("s_waitcnt vmcnt(0)" ::: "memory");
            const unsigned og = xb_add(&bar[XB_TOP], 1u);
            const unsigned tg = og / nx;
            if (og + 1u == (tg + 1u) * nx) xb_add(&bar[XB_TOPGEN], 1u);
            else XB_SPIN(xb_ld(&bar[XB_TOPGEN]) == tg, bar);
            __builtin_amdgcn_fence(__ATOMIC_ACQUIRE, "agent");
            xb_add(&bar[XB_XGEN(b.x)], 1u);
            asm volatile("s_waitcnt vmcnt(0)" ::: "memory");
        } else {
            XB_SPIN(xb_ld(&bar[XB_XGEN(b.x)]) == gen, bar);
            __builtin_amdgcn_fence(__ATOMIC_ACQUIRE, "agent");
            asm volatile("s_waitcnt vmcnt(0)" ::: "memory");
        }
    }
    __syncthreads();
}

__device__ __forceinline__ float wave_sum(float v) {
#pragma unroll
    for (int o = 1; o < 64; o <<= 1) v += __shfl_xor(v, o);
    return v;
}
__device__ __forceinline__ void transpose_item(const float* W, int ldw, int k0, int n0, bf16* WT, int Kd, int dst_row0, LAS float* scr, int lane) {
#pragma unroll 8
    for (int i = 0; i < 32; ++i) { const int kk = 2 * i + (lane >> 5); scr[kk * 33 + (lane & 31)] = W[(size_t)(k0 + kk) * ldw + n0 + (lane & 31)]; }
    LDS_WAIT(); asm volatile("" ::: "memory");
    const int c = lane & 7;
#pragma unroll
    for (int j = 0; j < 4; ++j) { const int n = (lane >> 3) + 8 * j; const LAS float* s = scr + (8 * c) * 33 + n;
        v4u o; o.x = pk2(s[0 * 33], s[1 * 33]); o.y = pk2(s[2 * 33], s[3 * 33]); o.z = pk2(s[4 * 33], s[5 * 33]); o.w = pk2(s[6 * 33], s[7 * 33]);
        *(GAS v4u*)(WT + (size_t)(dst_row0 + n) * Kd + k0 + 8 * c) = o; }
    LDS_WAIT(); asm volatile("" ::: "memory");
}
__device__ __forceinline__ float clamp448(float v) { return __builtin_fminf(__builtin_fmaxf(v, -448.f), 448.f); }
__device__ __forceinline__ unsigned pk4_fp8(float a, float b, float c, float d) {
    int w = __builtin_amdgcn_cvt_pk_fp8_f32(clamp448(a), clamp448(b), 0, false); w = __builtin_amdgcn_cvt_pk_fp8_f32(clamp448(c), clamp448(d), w, true); return (unsigned)w; }
__device__ __forceinline__ void transpose_item8(const float* W, int ldw, int k0, int n0, unsigned char* WT, int Kd, int dst_row0, float scl, LAS float* scr, int lane) {
#pragma unroll 8
    for (int i = 0; i < 32; ++i) { const int kk = 2 * i + (lane >> 5); scr[kk * 33 + (lane & 31)] = W[(size_t)(k0 + kk) * ldw + n0 + (lane & 31)]; }
    LDS_WAIT(); asm volatile("" ::: "memory");
    const int c = lane & 7;
#pragma unroll
    for (int j = 0; j < 4; ++j) { const int n = (lane >> 3) + 8 * j; const LAS float* s = scr + (8 * c) * 33 + n;
        typedef unsigned u2v __attribute__((ext_vector_type(2)));
        u2v o; o.x = pk4_fp8(s[0 * 33] * scl, s[1 * 33] * scl, s[2 * 33] * scl, s[3 * 33] * scl); o.y = pk4_fp8(s[4 * 33] * scl, s[5 * 33] * scl, s[6 * 33] * scl, s[7 * 33] * scl);
        *(GAS u2v*)(WT + (size_t)(dst_row0 + n) * Kd + k0 + 8 * c) = o; }
    LDS_WAIT(); asm volatile("" ::: "memory");
}
__device__ __forceinline__ float silu_f(float x) { return x / (1.0f + __expf(-x)); }

struct Args { const float* in[18]; float* out; unsigned char* ws; int ph_lo, ph_hi, li, flags; };

__device__ __forceinline__ void modulate_row8(const float* xrow, unsigned char* orow, const LAS float* p0, const LAS float* p1, float scl, int lane) {
    const GAS f32x4* xr = (const GAS f32x4*)xrow + lane;
    GAS unsigned* o4 = (GAS unsigned*)orow + lane;
    f32x4 v[8];
#pragma unroll
    for (int j = 0; j < 8; ++j) v[j] = xr[64 * j];
#pragma unroll
    for (int j = 0; j < 8; ++j) { const f32x4 a = *(const LAS f32x4*)(p0 + 256 * j + 4 * lane), s = *(const LAS f32x4*)(p1 + 256 * j + 4 * lane); const f32x4 r = (v[j] * a + s) * scl;
        o4[64 * j] = pk4_fp8(r.x, r.y, r.z, r.w); }
}
__device__ __forceinline__ void modulate_row(const float* xrow, bf16* orow, const LAS float* p0, const LAS float* p1, int lane) {
    const GAS f32x4* xr = (const GAS f32x4*)xrow + lane;
    GAS unsigned long long* o8 = (GAS unsigned long long*)orow + lane;
    f32x4 v[8];
#pragma unroll
    for (int j = 0; j < 8; ++j) v[j] = xr[64 * j];
#pragma unroll
    for (int j = 0; j < 8; ++j) { const f32x4 a = *(const LAS f32x4*)(p0 + 256 * j + 4 * lane), s = *(const LAS f32x4*)(p1 + 256 * j + 4 * lane); const f32x4 r = v[j] * a + s;
        o8[64 * j] = (unsigned long long)pk2(r.x, r.y) | ((unsigned long long)pk2(r.z, r.w) << 32); }
}
typedef unsigned u32x2 __attribute__((ext_vector_type(2)));
__device__ __forceinline__ f32x4 bf4_to_f32(u32x2 w) { f32x4 r; r.x = __uint_as_float(w.x << 16); r.y = __uint_as_float(w.x & 0xffff0000u); r.z = __uint_as_float(w.y << 16); r.w = __uint_as_float(w.y & 0xffff0000u); return r; }
__device__ __forceinline__ void ln_regs(f32x4 (&v)[8], const LAS float* g, const LAS float* bb, int lane) {
    float s = 0.f;
#pragma unroll
    for (int j = 0; j < 8; ++j) s += (v[j].x + v[j].y) + (v[j].z + v[j].w);
    const float mean = wave_sum(s) * (1.f / DM); float s2 = 0.f;
#pragma unroll
    for (int j = 0; j < 8; ++j) { v[j] = v[j] - mean; s2 += (v[j].x * v[j].x + v[j].y * v[j].y) + (v[j].z * v[j].z + v[j].w * v[j].w); }
    const float rstd = __builtin_amdgcn_rsqf(wave_sum(s2) * (1.f / DM) + LN_EPS);
#pragma unroll
    for (int j = 0; j < 8; ++j) { const int c = 256 * j + 4 * lane; v[j] = v[j] * rstd * *(const LAS f32x4*)(g + c) + *(const LAS f32x4*)(bb + c); }
}
__device__ __forceinline__ void x1_row(f32x4 (&v)[8], const float* xrow, const bf16* arow, const LAS float* P, int lane) {
    const GAS f32x4* xr = (const GAS f32x4*)xrow + lane; const GAS u32x2* ar = (const GAS u32x2*)arow + lane;
    u32x2 aw[8];
#pragma unroll
    for (int j = 0; j < 8; ++j) { v[j] = xr[64 * j]; aw[j] = ar[64 * j]; }
#pragma unroll
    for (int j = 0; j < 8; ++j) v[j] = v[j] * DN_ALPHA + *(const LAS f32x4*)(P + 256 * j + 4 * lane) * bf4_to_f32(aw[j]);
    ln_regs(v, P + 2048, P + 4096, lane);
}

__global__ void __launch_bounds__(NWAVES * 64, 2) dit_fwd(Args args) {
    extern __shared__ __attribute__((aligned(16))) unsigned char lds[];
    LAS unsigned char* L = (LAS unsigned char*)lds;
    volatile LAS unsigned* MISC = (volatile LAS unsigned*)(L + MISC_OFF);
    const int tid = threadIdx.x, lane = tid & 63, wave = __builtin_amdgcn_readfirstlane(tid >> 6);
    const int G = gridDim.x, bx = blockIdx.x;
    unsigned char* ws = args.ws;
    gu32* ctl = (gu32*)(ws + WS_CTL);
    const float* x = args.in[0]; const float* cvec = args.in[1]; const float* ctx = args.in[2]; const float* c_ctx = args.in[3];
    const float* w_ada = args.in[4]; const float* b_ada = args.in[5]; const float* w_in = args.in[6]; const float* qng = args.in[7]; const float* kng = args.in[8];
    const float* sink = args.in[9]; const float* w_out = args.in[10]; const float* ln1g = args.in[11]; const float* ln1b = args.in[12];
    const float* w_gate = args.in[13]; const float* w_up = args.in[14]; const float* w_down = args.in[15]; const float* ln2g = args.in[16]; const float* ln2b = args.in[17];
    float* MODP = (float*)(ws + WS_MODP); float* MODS = (float*)(ws + WS_MODS); float* ROPEC = (float*)(ws + WS_ROPE); float* ROPES = ROPEC + 2048;
    bf16* WIN = (bf16*)(ws + WS_WIN); bf16* WOUT = (bf16*)(ws + WS_WOUT); bf16* WGU = (bf16*)(ws + WS_WGU); bf16* WDN = (bf16*)(ws + WS_WDN);
    bf16* U = (bf16*)(ws + WS_U); bf16* AB = (bf16*)(ws + WS_Y); bf16* DB = (bf16*)(ws + WS_Y + 64 * MiB);
    unsigned char* U8 = ws + WS_U;
    unsigned char* WIN8 = ws + WS_WIN; unsigned char* WOUT8 = ws + WS_WOUT;
    unsigned char* OF8 = ws + WS_Y + 64 * MiB;
    unsigned char* VTA = ws + WS_KV + KV_BYTES; unsigned char* VTB = ws + WS_KV + 3 * KV_BYTES;
    unsigned char* QO8 = ws + WS_QO; unsigned char* KA8 = ws + WS_KV; unsigned char* KB8 = ws + WS_KV + 2 * KV_BYTES;
    bf16* KA = (bf16*)(ws + WS_KV); bf16* VA = (bf16*)(ws + WS_KV + KV_BYTES); bf16* KB = (bf16*)(ws + WS_KV + 2 * KV_BYTES); bf16* VB = (bf16*)(ws + WS_KV + 3 * KV_BYTES);
    bf16* HB = (bf16*)(ws + WS_H);

    for (int u = tid; u < (LDS_BYTES - LDSCTL_OFF) / 4; u += NWAVES * 64) ((LAS unsigned*)(L + LDSCTL_OFF))[u] = 0u;
    __syncthreads();
    XcdBarrier bar; bar.bar = (unsigned*)(ctl + CW_BAR); bar.x = 0; bar.st = nullptr;
    if (N_LAUNCHES == 1) bar = xcd_barrier_post((unsigned*)(ctl + CW_BAR), MISC + 8);
#define GRID_BAR() do { if (N_LAUNCHES == 1) xcd_barrier(bar); } while (0)
    const int lo = args.ph_lo, hi = args.ph_hi;
#ifndef PHMASK
#define PHMASK 0x3FF
#endif
#define IN(k) (((PHMASK >> (k)) & 1) && lo <= (k) && (k) < hi)
#define BOTH(k) (IN(k) && IN((k) + 1))

    if (IN(0)) {
        if (bx < 192) {
            const int cb = bx >> 2, kq = bx & 3, k0 = kq * 512 + wave * 64;
            float sv[5];
#pragma unroll
            for (int b = 0; b < 4; ++b) sv[b] = silu_f(cvec[b * DM + k0 + lane]);
            sv[4] = silu_f(c_ctx[k0 + lane]);
            f32x4 acc[5];
#pragma unroll
            for (int b = 0; b < 5; ++b) acc[b] = (f32x4){0.f, 0.f, 0.f, 0.f};
            const float* wp = w_ada + (size_t)k0 * NMOD + cb * 256 + lane * 4;
#pragma unroll 16
            for (int kk = 0; kk < 64; ++kk) { const f32x4 wv = *(const f32x4*)(wp + (size_t)kk * NMOD);
#pragma unroll
                for (int b = 0; b < 5; ++b) { const float s = __builtin_bit_cast(float, __builtin_amdgcn_readlane(__builtin_bit_cast(int, sv[b]), kk)); acc[b] += wv * s; } }
            LAS f32x4* red = (LAS f32x4*)(L + RING_OFF);
#pragma unroll
            for (int b = 0; b < 5; ++b) red[(wave * 5 + b) * 64 + lane] = acc[b];
            LDS_WAIT(); __syncthreads();
            if (tid < 320) { const int b = tid >> 6, l = tid & 63; f32x4 s = red[b * 64 + l];
#pragma unroll
                for (int w = 1; w < 8; ++w) s += red[(w * 5 + b) * 64 + l];
                *(f32x4*)(MODP + ((size_t)kq * 5 + b) * NMOD + cb * 256 + l * 4) = s; }
            __syncthreads();
        }
        if (bx == 255) {
            for (int e = tid; e < 2048; e += NWAVES * 64) { const int pos = e >> 5, f = e & 31;
                const float inv = exp2f(-(float)f * (13.287712379549449f / 32.0f)); const float ang = (float)pos * inv;
                float sn, cs; sincosf(ang, &sn, &cs); ROPEC[e] = cs; ROPES[e] = sn; }
        }
        {
            LAS float* scr = (LAS float*)(L + RING_OFF + wave * 16384);
            constexpr int I_IN = 32 * 96, I_OUT = 32 * 64, I_G = 32 * 176, NITEMS = I_IN + I_OUT + I_G, NSLOT = 192 * 8 * 2 + 64 * 8 * 5;
            const int nsl = bx < 192 ? 2 : 5, sl0 = bx < 192 ? (bx * 8 + wave) * 2 : 3072 + ((bx - 192) * 8 + wave) * 5;
            for (int s = 0; s < nsl; ++s)
                for (int it = sl0 + s; it < NITEMS; it += NSLOT) {
                    int r = it;
                    if (r < I_IN) { const int kb = r / 96, nb = r % 96, pn = nb >> 3, q = nb & 7, hh = q >> 2, part = (q >> 1) & 1, bj = q & 1;
                        transpose_item8(w_in, INW, 64 * kb, 32 * nb, WIN8, DM, 256 * pn + 32 * (4 * bj + 2 * hh + part), (float)(1 << S_W), scr, lane); continue; } r -= I_IN;
                    if (r < I_OUT) { const int kb = r / 64, nb = r % 64; transpose_item8(w_out, DM, 64 * kb, 32 * nb, WOUT8, DM, 32 * nb, (float)(1 << S_W), scr, lane); continue; } r -= I_OUT;
                    { const int kb = r / 176, nb = r % 176; transpose_item(w_gate, FFN, 64 * kb, 32 * nb, WGU, DM, 256 * (nb >> 2) + 32 * (nb & 3), scr, lane); }
                }
        }
        if (BOTH(0)) GRID_BAR();
    }

    if (IN(1)) {
        { const int idx = bx * 512 + tid;
          if (idx < 5 * NMOD) { float s = b_ada[idx % NMOD];
#pragma unroll
              for (int q = 0; q < 4; ++q) s += MODP[(size_t)q * 5 * NMOD + idx];
              MODS[idx] = s; } }
        if (bx < 128) {
            LAS float* P0 = (LAS float*)(L + RING_OFF); LAS float* P1 = P0 + 2048;
            for (int i = tid; i < 2048; i += NWAVES * 64) { float sh = b_ada[i], sc = b_ada[2048 + i];
#pragma unroll
                for (int q = 0; q < 4; ++q) { sh += MODP[((size_t)q * 5 + 4) * NMOD + i]; sc += MODP[((size_t)q * 5 + 4) * NMOD + 2048 + i]; }
                P0[i] = 1.0f + sc; P1[i] = sh; }
            LDS_WAIT(); __syncthreads();
            const int r = bx * 8 + wave;
            modulate_row8(ctx + (size_t)r * DM, U8 + (size_t)(M + r) * DM, P0, P1, (float)(1 << S_U), lane);
            __syncthreads();
        }
        if (BOTH(1)) GRID_BAR();
    }

    if (IN(2)) {
        if (bx < 16) {
            const int pnl[4] = {4, 5, 10, 11};
            pg8::Gemm g{(const bf16*)U8, (const bf16*)WIN8, MU, INW, DM / 2}; pg8::OneUnit S{64 + (bx >> 2), (bx & 3) == 0 ? 4 : (bx & 3) == 1 ? 5 : (bx & 3) == 2 ? 10 : 11}; (void)pnl;
            pg8::EpiQKV E{QO8, KA8, VTA, KB8, VTB, qng, kng, ROPEC, ROPES, (LAS float*)(L + XCH_OFF)};
            pg8::gemm_phase<pg8::EpiQKV, pg8::OneUnit, true, true, E8(S_W), E8(S_U)>(L + RING_OFF, g, S, E);
        } else {
            LAS float* P0 = (LAS float*)(L + RING_OFF); LAS float* P1 = P0 + 2048;
            const int i = bx - 16, r0 = (int)(((long)i * M) / 240), r1 = (int)(((long)(i + 1) * M) / 240);
            int r = r0;
            while (r < r1) {
                const int b = r >> 12; int re = (b + 1) << 12; if (re > r1) re = r1;
                __syncthreads();
                for (int k = tid; k < 2048; k += NWAVES * 64) { P0[k] = 1.0f + MODS[b * NMOD + 2048 + k]; P1[k] = MODS[b * NMOD + k]; }
                LDS_WAIT(); __syncthreads();
                for (int rr = r + wave; rr < re; rr += NWAVES) modulate_row8(x + (size_t)rr * DM, U8 + (size_t)rr * DM, P0, P1, (float)(1 << S_U), lane);
                r = re;
            }
            __syncthreads();
            {
                LAS float* scr = (LAS float*)(L + RING_OFF + wave * 16384);
                constexpr int I_G = 32 * 176, I_D = 88 * 64, NITEMS2 = I_G + I_D;
                for (int it = i * 8 + wave; it < NITEMS2; it += 240 * 8) {
                    if (it < I_G) { const int kb = it / 176, nb = it % 176; transpose_item(w_up, FFN, 64 * kb, 32 * nb, WGU, DM, 256 * (nb >> 2) + 128 + 32 * (nb & 3), scr, lane); }
                    else { const int r2 = it - I_G, kb = r2 / 64, nb = r2 % 64; transpose_item(w_down, DM, 64 * kb, 32 * nb, WDN, FFN, 32 * nb, scr, lane); }
                }
            }
        }
        if (BOTH(2)) GRID_BAR();
    }

    if (IN(3)) {
        pg8::Gemm g{(const bf16*)U8, (const bf16*)WIN8, M, INW, DM / 2}; pg8::StaticOrder S; S.init(M, INW, G, bx);
        pg8::EpiQKV E{QO8, KA8, VTA, KB8, VTB, qng, kng, ROPEC, ROPES, (LAS float*)(L + XCH_OFF)};
        pg8::gemm_phase<pg8::EpiQKV, pg8::StaticOrder, true, true, E8(S_W), E8(S_U)>(L + RING_OFF, g, S, E);
        if (BOTH(3)) GRID_BAR();
    }

    if (IN(4)) {
        const int xg = bx & 7, y = bx >> 3, b = xg >> 1, kvh = xg & 1;
        const size_t kvoff = (size_t)(b * 2 + kvh) * SKV * 128;
        float kbnd; { float gm = fmaxf(fabsf(kng[lane]), fabsf(kng[64 + lane]));
#pragma unroll
            for (int o = 1; o < 64; o <<= 1) gm = fmaxf(gm, __shfl_xor(gm, o));
            kbnd = gm * 11.313708498984761f * 1.08f; }
#define MKUNIT(u, i_) do { const int i__ = (i_); const int uu = 2 * y + (i__ & 1), gq = uu >> 4, qb = uu & 15, q0 = qb * 256; const bool isA = i__ >= 2; const int head = kvh * 4 + gq; \
            unsigned char* Qp = QO8 + (size_t)(b * SEQ + q0) * DM + (isA ? 0 : 1024) + head * 128; \
            const int jlo = !isA ? 0 : ((q0 >> 6) - 2 < 0 ? 0 : (q0 >> 6) - 2), jhi = (q0 >> 6) + 6 > 64 ? 64 : (q0 >> 6) + 6; \
            (u).Q = Qp; (u).K = (isA ? KA8 : KB8) + kvoff; (u).V = (isA ? VTA : VTB) + kvoff; (u).O = ((args.flags & 1) ? ws + 384 * MiB : OF8) + (Qp - QO8); \
            (u).NT = isA ? 4 + (jhi - jlo) : SKV / 64; (u).nctx = isA ? 4 : 0; (u).jlo = jlo; (u).q0 = q0; (u).masked = isA; (u).sinkl2 = isA ? sink[head] * 1.4426950408889634f : -INFINITY; (u).kbound = -1.f; (void)kbnd; } while (0)
        att::v8i qr[2]; att::Stg stg[2];
        att::AUnit cur, nx; MKUNIT(cur, 0); att::attn_prime(cur, qr, stg);
        for (int i = 0; i < 4; ++i) {
            MKUNIT(nx, i < 3 ? i + 1 : 3);
            att::attn_unit(cur, i < 3, nx, qr, stg, (char*)lds + RING_OFF);
            cur = nx;
        }
#undef MKUNIT
        if (BOTH(4)) GRID_BAR();
    }

    if (IN(5)) {
        pg8::Gemm g{(const bf16*)OF8, (const bf16*)WOUT8, M, DM, DM / 2}; pg8::StaticOrder S; S.init(M, DM, G, bx);
        pg8::EpiBf16Plain E{AB, DM};
        pg8::gemm_phase<pg8::EpiBf16Plain, pg8::StaticOrder, true, true, E8(S_W), E8(S_O)>(L + RING_OFF, g, S, E);
        if (BOTH(5)) GRID_BAR();
    }

    if (IN(6)) {
        LAS float* P = (LAS float*)(L + RING_OFF);
        const int b = bx >> 6;
        for (int k = tid; k < 2048; k += NWAVES * 64) { P[k] = MODS[b * NMOD + 2 * 2048 + k]; P[2048 + k] = ln1g[k]; P[4096 + k] = ln1b[k]; P[6144 + k] = 1.0f + MODS[b * NMOD + 4 * 2048 + k]; P[8192 + k] = MODS[b * NMOD + 3 * 2048 + k]; }
        LDS_WAIT(); __syncthreads();
        for (int rr = bx * 64 + wave; rr < bx * 64 + 64; rr += NWAVES) {
            f32x4 v[8]; x1_row(v, x + (size_t)rr * DM, AB + (size_t)rr * DM, P, lane);
            GAS unsigned long long* o8 = (GAS unsigned long long*)(U + (size_t)rr * DM) + lane;
#pragma unroll
            for (int j = 0; j < 8; ++j) { const int c = 256 * j + 4 * lane; const f32x4 r = v[j] * *(const LAS f32x4*)(P + 6144 + c) + *(const LAS f32x4*)(P + 8192 + c);
                o8[64 * j] = (unsigned long long)pk2(r.x, r.y) | ((unsigned long long)pk2(r.z, r.w) << 32); }
        }
        __syncthreads();
        if (BOTH(6)) GRID_BAR();
    }

    if (IN(7)) {
        pg8::Gemm g{U, WGU, M, 2 * FFN, DM}; pg8::StaticOrder S; S.init(M, 2 * FFN, G, bx);
        pg8::EpiSwiglu E{HB, FFN};
        pg8::gemm_phase<pg8::EpiSwiglu, pg8::StaticOrder, true, true>(L + RING_OFF, g, S, E);
        if (BOTH(7)) GRID_BAR();
    }

    if (IN(8)) {
        pg8::Gemm g{HB, WDN, M, DM, FFN}; pg8::StaticOrder S; S.init(M, DM, G, bx);
        pg8::EpiBf16Plain E{DB, DM};
        pg8::gemm_phase<pg8::EpiBf16Plain, pg8::StaticOrder, true, true>(L + RING_OFF, g, S, E);
        if (BOTH(8)) GRID_BAR();
    }

    if (IN(9)) {
        LAS float* P = (LAS float*)(L + RING_OFF);
        const int b = bx >> 6;
        for (int k = tid; k < 2048; k += NWAVES * 64) { P[k] = MODS[b * NMOD + 2 * 2048 + k]; P[2048 + k] = ln1g[k]; P[4096 + k] = ln1b[k]; P[6144 + k] = MODS[b * NMOD + 5 * 2048 + k]; P[8192 + k] = ln2g[k]; P[10240 + k] = ln2b[k]; }
        LDS_WAIT(); __syncthreads();
        for (int rr = bx * 64 + wave; rr < bx * 64 + 64; rr += NWAVES) {
            f32x4 v[8]; x1_row(v, x + (size_t)rr * DM, AB + (size_t)rr * DM, P, lane);
            const GAS u32x2* dr = (const GAS u32x2*)(DB + (size_t)rr * DM) + lane;
#pragma unroll
            for (int j = 0; j < 8; ++j) v[j] = v[j] * DN_ALPHA + *(const LAS f32x4*)(P + 6144 + 256 * j + 4 * lane) * bf4_to_f32(dr[64 * j]);
            ln_regs(v, P + 8192, P + 10240, lane);
            GAS f32x4* orow = (GAS f32x4*)(args.out + (size_t)rr * DM) + lane;
#pragma unroll
            for (int j = 0; j < 8; ++j) orow[64 * j] = v[j];
        }
    }
#undef IN
#undef BOTH
#undef GRID_BAR
}

extern "C" void kernel_launch(void* const* d_in, const int* in_sizes, int n_in, void* d_out, int out_size, void* d_ws, size_t ws_size, hipStream_t stream) {
    static int grid = 0;
    if (grid == 0) {
        if (n_in != 18 || in_sizes[0] != M * DM || out_size != M * DM || ws_size < WS_END) {
            fprintf(stderr, "kernel_launch: shape mismatch (n_in %d, in0 %d, out %d, ws %zu; need ws >= %zu); nothing launched\n", n_in, n_in > 0 ? in_sizes[0] : -1, out_size, ws_size, (size_t)WS_END); grid = -1; return; }
        int dev = 0, cus = 0, per_cu = 0;
        if (hipGetDevice(&dev) != hipSuccess || hipDeviceGetAttribute(&cus, hipDeviceAttributeMultiprocessorCount, dev) != hipSuccess) { fprintf(stderr, "kernel_launch: device query failed\n"); grid = -1; return; }
        if (hipFuncSetAttribute((const void*)dit_fwd, hipFuncAttributeMaxDynamicSharedMemorySize, LDS_BYTES) != hipSuccess) { fprintf(stderr, "kernel_launch: hipFuncSetAttribute failed\n"); grid = -1; return; }
        if (hipOccupancyMaxActiveBlocksPerMultiprocessor(&per_cu, (const void*)dit_fwd, NWAVES * 64, LDS_BYTES) != hipSuccess || per_cu < 1)
            fprintf(stderr, "kernel_launch: note: occupancy query reports %d workgroups per CU\n", per_cu);
        (void)hipGetLastError();
        if (cus != 256) { fprintf(stderr, "kernel_launch: built for a 256-CU device, found %d CUs; nothing launched\n", cus); grid = -1; return; }
        grid = 256;
    }
    if (grid < 0) return;
    if (hipMemsetAsync((char*)d_ws + WS_CTL, 0, CTL_ZERO_BYTES, stream) != hipSuccess) { fprintf(stderr, "kernel_launch: hipMemsetAsync failed\n"); return; }
    Args a{};
    for (int i = 0; i < 18; ++i) a.in[i] = (const float*)d_in[i];
    a.out = (float*)d_out; a.ws = (unsigned char*)d_ws;
    if (N_LAUNCHES == 1) { a.ph_lo = 0; a.ph_hi = N_PHASES; a.li = 0; hipLaunchKernelGGL(dit_fwd, dim3(grid), dim3(NWAVES * 64), LDS_BYTES, stream, a); }
    else { const int plist[] = PHASE_LIST;
        for (unsigned i = 0; i < sizeof(plist) / sizeof(int); ++i) { const int p = plist[i] % 100; a.ph_lo = p; a.ph_hi = p + 1; a.li = 0; a.flags = plist[i] >= 100 ? 1 : 0;
            hipLaunchKernelGGL(dit_fwd, dim3(grid), dim3(NWAVES * 64), LDS_BYTES, stream, a); } }
    const hipError_t le = hipPeekAtLastError();
    if (le != hipSuccess) fprintf(stderr, "kernel_launch: launch failed: %s\n", hipGetErrorName(le));
}
```

```cpp
#include <hip/hip_runtime.h>
#include <hip/hip_bf16.h>
#include <cstdio>
#include <cstdint>

#ifndef PHASE_LIST
#define PHASE_LIST {0, 1, 2, 3, 4, 5, 6, 7, 8, 9}
#endif
#ifndef MK_N_LAUNCHES
#define MK_N_LAUNCHES 1
#endif

namespace pg8 {
#define PG8_LAS __attribute__((address_space(3)))
typedef unsigned short bf16_t;
typedef short bf16x8 __attribute__((ext_vector_type(8)));
typedef float f32x4 __attribute__((ext_vector_type(4)));
typedef unsigned u32x4 __attribute__((ext_vector_type(4)));
constexpr int BM = 256, BK = 64, HALF = 128, HTB = HALF * BK * 2, STAGE_BYTES = 8 * HTB, NXCD = 8, WGM = 8;

__host__ __device__ __forceinline__ int lds_byte(int r, int c) { const int st = (r >> 4) * 2 + (c >> 5), rr = r & 15, cc = c & 31, ob = rr * 64 + cc * 2; return st * 1024 + (ob ^ (((ob >> 9) & 1) << 5)); }
__host__ __device__ __forceinline__ void stage_rc(int b, int& R, int& C) { const int st = b / 1024, sb = b % 1024, swz = sb ^ (((sb >> 9) & 1) << 5); R = (st >> 1) * 16 + swz / 64; C = (st & 1) * 32 + (swz % 64) / 2; }
__host__ __device__ __forceinline__ int perm32(int rho) { const int n = rho >> 4, i = rho & 15; return 8 * (i >> 2) + 4 * n + (i & 3); }

struct Unit { int pm, pn; };
struct Gemm { const bf16_t* A; const bf16_t* Bt; int M, N, K; };

struct StaticOrder {
    int nM, nN, nwg, G, c;
    __host__ __device__ void init(int M, int N, int G_, int c_) { nM = M / BM; nN = N / BM; nwg = nM * nN; G = G_; c = c_; }
    __host__ __device__ bool next(int i, Unit& u) const {
        const long L = (long)i * G + c; if (L >= nwg) return false;
        int wgid = (int)L; { const int q = nwg / NXCD, r = nwg % NXCD, xcd = wgid % NXCD, off = wgid / NXCD; wgid = (xcd < r ? xcd * (q + 1) : r * (q + 1) + (xcd - r) * q) + off; }
        const int nig = WGM * nN, gid = wgid / nig, fm = gid * WGM, gsz = (nM - fm) < WGM ? (nM - fm) : WGM;
        u.pm = fm + ((wgid % nig) % gsz); u.pn = (wgid % nig) / gsz; return true;
    }
    __device__ __forceinline__ void a_ready(const Unit&) const {}
    __device__ __forceinline__ void done(const Unit&) const {}
};
struct OneUnit {
    int pm, pn;
    __device__ bool next(int i, Unit& u) const { if (i > 0) return false; u.pm = pm; u.pn = pn; return true; }
    __device__ __forceinline__ void a_ready(const Unit&) const {}
    __device__ __forceinline__ void done(const Unit&) const {}
};

__device__ __forceinline__ unsigned cvt_pk_bf16(float lo, float hi) { unsigned r; asm volatile("v_cvt_pk_bf16_f32 %0, %1, %2" : "=v"(r) : "v"(lo), "v"(hi)); return r; }


struct EpiQKV {
    static constexpr bool PERM = true, AFTER_DRAIN = false;
    unsigned char* QO; unsigned char* KA; unsigned char* VA; unsigned char* KB; unsigned char* VB;
    const float* qg; const float* kg; const float* ropec; const float* ropes;
    PG8_LAS float* xch;
    __device__ __forceinline__ void operator()(const f32x4 (&acc)[2][2][4][2], const Unit& u, int wr, int wc, int fr, int fq) const {
        const int pn = u.pn; const bool is_ctx = u.pm >= 64;
        const int b = is_ctx ? (u.pm - 64) : (u.pm >> 4), t0 = is_ctx ? 4096 : ((u.pm & 15) << 8);
        const int hh = wc >> 1, part = wc & 1, wid = wr * 4 + wc;
        const bool isq = (pn < 4) || (pn >= 6 && pn < 10), donorm = (pn >= 6 && pn <= 10), dorope = (!is_ctx) && pn != 5 && pn != 11;
        const bool isv = (pn == 5 || pn == 11);
        bf16_t* base = nullptr; unsigned char* base8 = nullptr; size_t rstride;
        if (isq) { const int head = (pn < 4 ? 2 * pn : 8 + 2 * (pn - 6)) + hh; base8 = QO + (size_t)(b * 4096 + t0) * 2048 + head * 128; rstride = 2048; }
        else if (isv) {
            unsigned char* vt = (pn == 5 ? VA : VB) + (size_t)(b * 2 + hh) * 128 * 4352;
            int frl = fr, fql = fq; asm volatile("" : "+v"(frl), "+v"(fql));
            const unsigned p_ = (unsigned)(frl & 3);
            const unsigned sel2 = p_ | ((4u + p_) << 8);
#pragma unroll
            for (int bj = 0; bj < 2; ++bj)
#pragma unroll
                for (int n = 0; n < 2; ++n) {
                    unsigned char* dp = vt + (size_t)(64 * part + 32 * bj + 8 * fql + 4 * n + (frl & 3)) * 4352 + t0 + wr * 64 + 32 * ((frl >> 2) & 1) + 4 * (frl >> 3);
#pragma unroll
                    for (int ai = 0; ai < 2; ++ai)
#pragma unroll
                        for (int m = 0; m < 4; ++m) { const f32x4 v = acc[ai][bj][m][n] * 16.f;
                            int w_ = __builtin_amdgcn_cvt_pk_fp8_f32(__builtin_fminf(__builtin_fmaxf(v[0], -448.f), 448.f), __builtin_fminf(__builtin_fmaxf(v[1], -448.f), 448.f), 0, false);
                            w_ = __builtin_amdgcn_cvt_pk_fp8_f32(__builtin_fminf(__builtin_fmaxf(v[2], -448.f), 448.f), __builtin_fminf(__builtin_fmaxf(v[3], -448.f), 448.f), w_, true);
                            const unsigned W0 = (unsigned)__builtin_amdgcn_mov_dpp(w_, 0x00, 0xf, 0xf, true), W1 = (unsigned)__builtin_amdgcn_mov_dpp(w_, 0x55, 0xf, 0xf, true);
                            const unsigned W2 = (unsigned)__builtin_amdgcn_mov_dpp(w_, 0xaa, 0xf, 0xf, true), W3 = (unsigned)__builtin_amdgcn_mov_dpp(w_, 0xff, 0xf, 0xf, true);
                            const unsigned lo2 = __builtin_amdgcn_perm(W1, W0, sel2), hi2 = __builtin_amdgcn_perm(W3, W2, sel2);
                            *(unsigned*)(dp + ai * HALF + 8 * m) = __builtin_amdgcn_perm(hi2, lo2, 0x05040100u); }
                    asm volatile("" ::: "memory"); }
            return; }
        else { unsigned char* buf = pn == 4 ? KA : KB; base8 = buf + ((size_t)(b * 2 + hh) * 4352 + t0) * 128; rstride = 128; }
        const int d0 = 64 * part + 8 * fq;
        float rs[2][4];
        f32x4 gv[2][2];
#pragma unroll
        for (int bj = 0; bj < 2; ++bj)
#pragma unroll
            for (int n = 0; n < 2; ++n) gv[bj][n] = (f32x4){1.f, 1.f, 1.f, 1.f};
#pragma unroll
        for (int ai = 0; ai < 2; ++ai)
#pragma unroll
            for (int m = 0; m < 4; ++m) rs[ai][m] = 1.f;
        if (donorm) {
            const float* g = (pn == 10) ? kg : qg;
#pragma unroll
            for (int bj = 0; bj < 2; ++bj)
#pragma unroll
                for (int n = 0; n < 2; ++n) gv[bj][n] = *(const f32x4*)(g + d0 + 32 * bj + 4 * n);
#pragma unroll
            for (int ai = 0; ai < 2; ++ai)
#pragma unroll
                for (int m = 0; m < 4; ++m) {
                    float s = 0.f;
#pragma unroll
                    for (int bj = 0; bj < 2; ++bj)
#pragma unroll
                        for (int n = 0; n < 2; ++n) { const f32x4 x = acc[ai][bj][m][n]; s += (x[0] * x[0] + x[1] * x[1]) + (x[2] * x[2] + x[3] * x[3]); }
                    s += __shfl_xor(s, 16); s += __shfl_xor(s, 32);
                    if (fq == 0) xch[wid * 128 + ai * 64 + m * 16 + fr] = s;
                    rs[ai][m] = s;
                }
            asm volatile("s_waitcnt lgkmcnt(0)" ::: "memory"); __builtin_amdgcn_s_barrier(); asm volatile("" ::: "memory");
#pragma unroll
            for (int ai = 0; ai < 2; ++ai)
#pragma unroll
                for (int m = 0; m < 4; ++m) { const float o = xch[(wid ^ 1) * 128 + ai * 64 + m * 16 + fr]; rs[ai][m] = __builtin_amdgcn_rsqf((rs[ai][m] + o) * (1.0f / 128.0f) + 1e-6f); }
        }
#pragma unroll
        for (int ai = 0; ai < 2; ++ai)
#pragma unroll
            for (int m = 0; m < 4; ++m) {
                const int rt = ai * HALF + wr * 64 + m * 16 + fr;
                f32x4 lo[2], hi[2];
#pragma unroll
                for (int n = 0; n < 2; ++n) { lo[n] = acc[ai][0][m][n] * rs[ai][m] * gv[0][n]; hi[n] = acc[ai][1][m][n] * rs[ai][m] * gv[1][n]; }
                if (dorope) {
                    const int t = t0 + rt, pos = part ? (t & 63) : (t >> 6);
#pragma unroll
                    for (int n = 0; n < 2; ++n) {
                        const f32x4 c4 = *(const f32x4*)(ropec + pos * 32 + 8 * fq + 4 * n), s4 = *(const f32x4*)(ropes + pos * 32 + 8 * fq + 4 * n);
                        const f32x4 a = lo[n], bb = hi[n];
                        lo[n] = a * c4 - bb * s4; hi[n] = bb * c4 + a * s4;
                    }
                }
                if (false) {
                bf16_t* rowp = base + (size_t)rt * rstride + d0;
                u32x4 w0, w1;
                w0.x = cvt_pk_bf16(lo[0][0], lo[0][1]); w0.y = cvt_pk_bf16(lo[0][2], lo[0][3]); w0.z = cvt_pk_bf16(lo[1][0], lo[1][1]); w0.w = cvt_pk_bf16(lo[1][2], lo[1][3]);
                w1.x = cvt_pk_bf16(hi[0][0], hi[0][1]); w1.y = cvt_pk_bf16(hi[0][2], hi[0][3]); w1.z = cvt_pk_bf16(hi[1][0], hi[1][1]); w1.w = cvt_pk_bf16(hi[1][2], hi[1][3]);
                *(u32x4*)(rowp) = w0; *(u32x4*)(rowp + 32) = w1;
                } else {
                unsigned char* rowp = base8 + (size_t)rt * rstride + d0;
                typedef unsigned u2v __attribute__((ext_vector_type(2))); u2v w0, w1;
#define QK8(a, b, c, d) ({ int t_ = __builtin_amdgcn_cvt_pk_fp8_f32(__builtin_fminf(__builtin_fmaxf((a) * 16.f, -448.f), 448.f), __builtin_fminf(__builtin_fmaxf((b) * 16.f, -448.f), 448.f), 0, false); \
                        (unsigned)__builtin_amdgcn_cvt_pk_fp8_f32(__builtin_fminf(__builtin_fmaxf((c) * 16.f, -448.f), 448.f), __builtin_fminf(__builtin_fmaxf((d) * 16.f, -448.f), 448.f), t_, true); })
                w0.x = QK8(lo[0][0], lo[0][1], lo[0][2], lo[0][3]); w0.y = QK8(lo[1][0], lo[1][1], lo[1][2], lo[1][3]);
                w1.x = QK8(hi[0][0], hi[0][1], hi[0][2], hi[0][3]); w1.y = QK8(hi[1][0], hi[1][1], hi[1][2], hi[1][3]);
#undef QK8
                *(u2v*)(rowp) = w0; *(u2v*)(rowp + 32) = w1;
                }
            }
    }
};

struct EpiResid {
    static constexpr bool PERM = false, AFTER_DRAIN = false;
    const float* res; const float* gate; float* out; float alpha;
    __device__ __forceinline__ void operator()(const f32x4 (&acc)[2][2][4][2], const Unit& u, int wr, int wc, int fr, int fq) const {
        const int row0 = u.pm * BM + wr * 64 + fr, col0 = u.pn * BM + wc * 32 + 4 * fq, b = u.pm >> 4;
        f32x4 gv[2][2];
#pragma unroll
        for (int bj = 0; bj < 2; ++bj)
#pragma unroll
            for (int n = 0; n < 2; ++n) gv[bj][n] = *(const f32x4*)(gate + b * 12288 + col0 + bj * HALF + n * 16);
#pragma unroll
        for (int ai = 0; ai < 2; ++ai)
#pragma unroll
            for (int m = 0; m < 4; ++m) { const size_t off = (size_t)(row0 + ai * HALF + m * 16) * 2048 + col0;
#pragma unroll
                for (int bj = 0; bj < 2; ++bj)
#pragma unroll
                    for (int n = 0; n < 2; ++n) { const f32x4 xv = *(const f32x4*)(res + off + bj * HALF + n * 16);
                        *(f32x4*)(out + off + bj * HALF + n * 16) = xv * alpha + gv[bj][n] * acc[ai][bj][m][n]; } }
    }
};


struct EpiBf16Plain {
    static constexpr bool PERM = true, AFTER_DRAIN = false;
    bf16_t* O; int ldc;
    __device__ __forceinline__ void operator()(const f32x4 (&acc)[2][2][4][2], const Unit& u, int wr, int wc, int fr, int fq) const {
        const int row0 = u.pm * BM + wr * 64 + fr, col0 = u.pn * BM + wc * 32 + 8 * fq;
#pragma unroll
        for (int ai = 0; ai < 2; ++ai)
#pragma unroll
            for (int m = 0; m < 4; ++m) { bf16_t* rowp = O + (size_t)(row0 + ai * HALF + m * 16) * ldc + col0;
#pragma unroll
                for (int bj = 0; bj < 2; ++bj) { const f32x4 v0 = acc[ai][bj][m][0], v1 = acc[ai][bj][m][1];
                    u32x4 w; w.x = cvt_pk_bf16(v0[0], v0[1]); w.y = cvt_pk_bf16(v0[2], v0[3]); w.z = cvt_pk_bf16(v1[0], v1[1]); w.w = cvt_pk_bf16(v1[2], v1[3]);
                    *(u32x4*)(rowp + bj * HALF) = w; } }
    }
};


struct EpiFp8Plain {
    static constexpr bool PERM = true, AFTER_DRAIN = false;
    unsigned char* O; int ldc; float scl;
    __device__ __forceinline__ void operator()(const f32x4 (&acc)[2][2][4][2], const Unit& u, int wr, int wc, int fr, int fq) const {
        const int row0 = u.pm * BM + wr * 64 + fr, col0 = u.pn * BM + wc * 32 + 8 * fq;
        typedef unsigned u2v __attribute__((ext_vector_type(2)));
#pragma unroll
        for (int ai = 0; ai < 2; ++ai)
#pragma unroll
            for (int m = 0; m < 4; ++m) { unsigned char* rowp = O + (size_t)(row0 + ai * HALF + m * 16) * ldc + col0;
#pragma unroll
                for (int bj = 0; bj < 2; ++bj) { const f32x4 v0 = acc[ai][bj][m][0] * scl, v1 = acc[ai][bj][m][1] * scl; u2v w;
                    { int t = __builtin_amdgcn_cvt_pk_fp8_f32(__builtin_fminf(__builtin_fmaxf(v0[0], -448.f), 448.f), __builtin_fminf(__builtin_fmaxf(v0[1], -448.f), 448.f), 0, false);
                      w.x = (unsigned)__builtin_amdgcn_cvt_pk_fp8_f32(__builtin_fminf(__builtin_fmaxf(v0[2], -448.f), 448.f), __builtin_fminf(__builtin_fmaxf(v0[3], -448.f), 448.f), t, true); }
                    { int t = __builtin_amdgcn_cvt_pk_fp8_f32(__builtin_fminf(__builtin_fmaxf(v1[0], -448.f), 448.f), __builtin_fminf(__builtin_fmaxf(v1[1], -448.f), 448.f), 0, false);
                      w.y = (unsigned)__builtin_amdgcn_cvt_pk_fp8_f32(__builtin_fminf(__builtin_fmaxf(v1[2], -448.f), 448.f), __builtin_fminf(__builtin_fmaxf(v1[3], -448.f), 448.f), t, true); }
                    *(u2v*)(rowp + bj * HALF) = w; } }
    }
};

struct EpiSwiglu {
    static constexpr bool PERM = true, AFTER_DRAIN = false;
    bf16_t* H; int ldh;
    __device__ __forceinline__ void operator()(const f32x4 (&acc)[2][2][4][2], const Unit& u, int wr, int wc, int fr, int fq) const {
        const int row0 = u.pm * BM + wr * 64 + fr, col0 = u.pn * 128 + wc * 32 + 8 * fq;
#pragma unroll
        for (int ai = 0; ai < 2; ++ai)
#pragma unroll
            for (int m = 0; m < 4; ++m) { bf16_t* rowp = H + (size_t)(row0 + ai * HALF + m * 16) * ldh + col0;
                f32x4 o[2];
#pragma unroll
                for (int n = 0; n < 2; ++n) { const f32x4 g = acc[ai][0][m][n], up = acc[ai][1][m][n];
#pragma unroll
                    for (int e = 0; e < 4; ++e) { const float sg = __builtin_amdgcn_rcpf(1.0f + __builtin_amdgcn_exp2f(-1.4426950408889634f * g[e])); o[n][e] = g[e] * sg * up[e]; } }
                u32x4 w; w.x = cvt_pk_bf16(o[0][0], o[0][1]); w.y = cvt_pk_bf16(o[0][2], o[0][3]); w.z = cvt_pk_bf16(o[1][0], o[1][1]); w.w = cvt_pk_bf16(o[1][2], o[1][3]);
                *(u32x4*)rowp = w; }
    }
};

typedef int v8i_t __attribute__((ext_vector_type(8))); typedef int v4i_t __attribute__((ext_vector_type(4)));
__device__ __forceinline__ v8i_t cat16(bf16x8 a, bf16x8 b) { return __builtin_shufflevector(__builtin_bit_cast(v4i_t, a), __builtin_bit_cast(v4i_t, b), 0, 1, 2, 3, 4, 5, 6, 7); }
template <class Epi, class Sched, bool ALIGN_EPI = false, bool SP2 = false, int SCW = 0, int SCA = 0, bool SWAPV = false>
__device__ __forceinline__ void gemm_phase(PG8_LAS unsigned char* lds, const Gemm g, const Sched& S, const Epi& E) {
    const int tid = threadIdx.x, wid = __builtin_amdgcn_readfirstlane(tid >> 6), lane = tid & 63, wr = wid >> 2, wc = wid & 3, fr = lane & 15, fq = lane >> 4;
    const int K = g.K, nt = K / BK;
    unsigned voffA[2], voffB[2];
#pragma unroll
    for (int i = 0; i < 2; ++i) { int R, C; stage_rc(tid * 16 + i * 8192, R, C); const int Rb = Epi::PERM ? ((R & ~31) + perm32(R & 31)) : R;
        voffA[i] = (unsigned)(R * K + C) * 2u; voffB[i] = (unsigned)(Rb * K + C) * 2u; }
    const size_t kstep = (size_t)(BK * 2);
    const size_t hstep = (size_t)HALF * K * 2;
    const size_t tstep = 2 * hstep;
    const unsigned ldsw = (unsigned)wid * 1024u;
    const int aoff = lds_byte(wr * 64 + fr, fq * 8), boff = lds_byte(wc * 32 + fr, fq * 8);
#define PG8_SA(b, h) (((b) * 2 + (h)) * HTB)
#define PG8_SB(b, h) ((4 + (b) * 2 + (h)) * HTB)
#define PG8_STAGE(bufoff, gbase, voff) do { _Pragma("unroll") for (int _i = 0; _i < 2; ++_i) \
        __builtin_amdgcn_global_load_lds((const unsigned*)((const char*)(gbase) + (voff)[_i]), (PG8_LAS unsigned*)(lds + (bufoff) + ldsw + _i * 8192), 16, 0, 0); } while (0)
#define PG8_LDA(dst, b, h) do { _Pragma("unroll") for (int m = 0; m < 4; ++m) { if constexpr (SCW != 0) dst##8[m] = cat16(*(const PG8_LAS bf16x8*)(lds + PG8_SA(b, h) + aoff + m * 2048), *(const PG8_LAS bf16x8*)(lds + PG8_SA(b, h) + aoff + m * 2048 + 1024)); \
        else { _Pragma("unroll") for (int k = 0; k < 2; ++k) dst[m][k] = *(const PG8_LAS bf16x8*)(lds + PG8_SA(b, h) + aoff + m * 2048 + k * 1024); } } } while (0)
#define PG8_LDB(dst, b, h) do { _Pragma("unroll") for (int n = 0; n < 2; ++n) { if constexpr (SCW != 0) dst##8[n] = cat16(*(const PG8_LAS bf16x8*)(lds + PG8_SB(b, h) + boff + n * 2048), *(const PG8_LAS bf16x8*)(lds + PG8_SB(b, h) + boff + n * 2048 + 1024)); \
        else { _Pragma("unroll") for (int k = 0; k < 2; ++k) dst[n][k] = *(const PG8_LAS bf16x8*)(lds + PG8_SB(b, h) + boff + n * 2048 + k * 1024); } } } while (0)
#define PG8_MMA(ai, bj, At, Bt) do { __builtin_amdgcn_s_setprio(1); _Pragma("unroll") for (int m = 0; m < 4; ++m) _Pragma("unroll") for (int n = 0; n < 2; ++n) { \
        if constexpr (SCW != 0) asm volatile("v_mfma_scale_f32_16x16x128_f8f6f4 %0, %1, %2, %0, %3, %4 op_sel_hi:[0,0,0]" : "+v"(acc[ai][bj][m][n]) : "v"(Bt##8[n]), "v"(At##8[m]), "v"(scw_), "v"(sca_));     \
        else { _Pragma("unroll") for (int k = 0; k < 2; ++k) acc[ai][bj][m][n] = __builtin_amdgcn_mfma_f32_16x16x32_bf16(Bt[n][k], At[m][k], acc[ai][bj][m][n], 0, 0, 0); } } \
        __builtin_amdgcn_s_setprio(0); } while (0)
#define PG8_WAIT_V(n) asm volatile("s_waitcnt vmcnt(" #n ")" ::: "memory")
#define PG8_WAIT_L(n) asm volatile("s_waitcnt lgkmcnt(" #n ")" ::: "memory")
#define PG8_BAR __builtin_amdgcn_s_barrier()
#define PG8_SCHED __builtin_amdgcn_sched_barrier(0)
    Unit cur, nxt; int ui = 0;
    if (!S.next(0, cur)) return;
    f32x4 acc[2][2][4][2];
#pragma unroll
    for (int a = 0; a < 2; ++a)
#pragma unroll
        for (int b = 0; b < 2; ++b)
#pragma unroll
            for (int m = 0; m < 4; ++m)
#pragma unroll
                for (int n = 0; n < 2; ++n) acc[a][b][m][n] = (f32x4){0.f, 0.f, 0.f, 0.f};
    int scw_ = SCW, sca_ = SCA; asm volatile("" : "+v"(scw_), "+v"(sca_));
    bf16x8 At[4][2], B0[2][2], B1[2][2]; v8i_t At8[4], B08[2], B18[2];
    const char* cA = (const char*)g.A + (size_t)cur.pm * tstep; const char* cB = (const char*)g.Bt + (size_t)cur.pn * tstep;
    S.a_ready(cur);
    if constexpr (SP2) {
        PG8_STAGE(PG8_SB(0, 0), cB, voffB); PG8_STAGE(PG8_SB(0, 1), cB + hstep, voffB); PG8_STAGE(PG8_SA(0, 0), cA, voffA); PG8_STAGE(PG8_SA(0, 1), cA + hstep, voffA);
        if (wr == 1) PG8_BAR;
        PG8_WAIT_V(2); PG8_BAR;
        PG8_STAGE(PG8_SB(1, 0), cB + kstep, voffB); PG8_STAGE(PG8_SA(1, 0), cA + kstep, voffA); PG8_STAGE(PG8_SB(1, 1), cB + hstep + kstep, voffB);
        PG8_WAIT_V(6); PG8_BAR;
    } else {
        PG8_STAGE(PG8_SB(0, 0), cB, voffB); PG8_STAGE(PG8_SA(0, 0), cA, voffA); PG8_STAGE(PG8_SB(0, 1), cB + hstep, voffB); PG8_STAGE(PG8_SA(0, 1), cA + hstep, voffA);
        if (wr == 1) PG8_BAR;
        PG8_WAIT_V(4); PG8_BAR;
        PG8_STAGE(PG8_SB(1, 0), cB + kstep, voffB); PG8_STAGE(PG8_SA(1, 0), cA + kstep, voffA); PG8_STAGE(PG8_SB(1, 1), cB + hstep + kstep, voffB);
        PG8_WAIT_V(6); PG8_BAR;
    }
    for (;;) {
        const bool has_next = S.next(ui + 1, nxt);
        const char* nA = has_next ? (const char*)g.A + (size_t)nxt.pm * tstep : cA; const char* nB = has_next ? (const char*)g.Bt + (size_t)nxt.pn * tstep : cB;
        for (int t = 0; t < nt; t += 2) {
            const bool last = (t == nt - 2);
            const char* a1 = cA + (size_t)(t + 1) * kstep;
            const char* a2 = last ? nA : cA + (size_t)(t + 2) * kstep; const char* b2 = last ? nB : cB + (size_t)(t + 2) * kstep;
            const char* a3 = a2 + kstep; const char* b3 = b2 + kstep;
            if (last && has_next) S.a_ready(nxt);
            if constexpr (SP2) {
            PG8_LDB(B0, 0, 0); PG8_LDB(B1, 0, 1); PG8_SCHED; PG8_LDA(At, 0, 0); PG8_STAGE(PG8_SA(1, 1), a1 + hstep, voffA);
            PG8_WAIT_V(8); PG8_WAIT_L(0); PG8_BAR; PG8_MMA(0, 0, At, B0); PG8_MMA(0, 1, At, B1); PG8_BAR; PG8_SCHED;
            PG8_LDA(At, 0, 1); PG8_STAGE(PG8_SB(0, 0), b2, voffB); PG8_STAGE(PG8_SB(0, 1), b2 + hstep, voffB); PG8_STAGE(PG8_SA(0, 0), a2, voffA);
            PG8_WAIT_V(8); PG8_WAIT_L(0); PG8_BAR; PG8_MMA(1, 0, At, B0); PG8_MMA(1, 1, At, B1); PG8_BAR; PG8_SCHED;
            PG8_LDB(B0, 1, 0); PG8_LDB(B1, 1, 1); PG8_SCHED; PG8_LDA(At, 1, 0); PG8_STAGE(PG8_SA(0, 1), a2 + hstep, voffA);
            PG8_WAIT_V(8); PG8_WAIT_L(0); PG8_BAR; PG8_MMA(0, 0, At, B0); PG8_MMA(0, 1, At, B1); PG8_BAR; PG8_SCHED;
            PG8_LDA(At, 1, 1); PG8_STAGE(PG8_SB(1, 0), b3, voffB); PG8_STAGE(PG8_SB(1, 1), b3 + hstep, voffB); PG8_STAGE(PG8_SA(1, 0), a3, voffA);
            PG8_WAIT_V(8); PG8_WAIT_L(0); PG8_BAR; PG8_MMA(1, 0, At, B0); PG8_MMA(1, 1, At, B1); PG8_BAR; PG8_SCHED;
            } else {
            PG8_LDB(B0, 0, 0); PG8_SCHED; PG8_LDA(At, 0, 0); PG8_STAGE(PG8_SA(1, 1), a1 + hstep, voffA);
            PG8_WAIT_L(8); PG8_BAR; PG8_WAIT_L(0); PG8_MMA(0, 0, At, B0); PG8_BAR; PG8_SCHED;
            PG8_LDB(B1, 0, 1); PG8_STAGE(PG8_SB(0, 0), b2, voffB);
            PG8_BAR; PG8_WAIT_L(0); PG8_MMA(0, 1, At, B1); PG8_BAR;
            PG8_LDA(At, 0, 1); PG8_STAGE(PG8_SA(0, 0), a2, voffA);
            PG8_BAR; PG8_WAIT_L(0); PG8_MMA(1, 0, At, B0); PG8_BAR; PG8_SCHED;
            PG8_STAGE(PG8_SB(0, 1), b2 + hstep, voffB);
            PG8_WAIT_V(6); PG8_BAR; PG8_MMA(1, 1, At, B1); PG8_BAR;
            PG8_LDB(B0, 1, 0); PG8_SCHED; PG8_LDA(At, 1, 0); PG8_STAGE(PG8_SA(0, 1), a2 + hstep, voffA);
            PG8_WAIT_L(8); PG8_BAR; PG8_WAIT_L(0); PG8_MMA(0, 0, At, B0); PG8_BAR; PG8_SCHED;
            PG8_LDB(B1, 1, 1); PG8_STAGE(PG8_SB(1, 0), b3, voffB);
            PG8_BAR; PG8_WAIT_L(0); PG8_MMA(0, 1, At, B1); PG8_BAR;
            PG8_LDA(At, 1, 1); PG8_STAGE(PG8_SA(1, 0), a3, voffA);
            PG8_BAR; PG8_WAIT_L(0); PG8_MMA(1, 0, At, B0); PG8_BAR; PG8_SCHED;
            PG8_STAGE(PG8_SB(1, 1), b3 + hstep, voffB);
            PG8_WAIT_V(6); PG8_BAR; PG8_MMA(1, 1, At, B1); PG8_BAR;
            }
        }
        if constexpr (ALIGN_EPI) { if (wr == 0) PG8_BAR; }
        if constexpr (SCW != 0) asm volatile("s_nop 15\n\ts_nop 15" ::: "memory");
        if constexpr (!Epi::AFTER_DRAIN) { E(acc, cur, wr, wc, fr, fq); S.done(cur); }
        if (!has_next) break;
#pragma unroll
        for (int a = 0; a < 2; ++a)
#pragma unroll
            for (int b = 0; b < 2; ++b)
#pragma unroll
                for (int m = 0; m < 4; ++m)
#pragma unroll
                    for (int n = 0; n < 2; ++n) acc[a][b][m][n] = (f32x4){0.f, 0.f, 0.f, 0.f};
        cur = nxt; cA = nA; cB = nB; ++ui;
        if constexpr (ALIGN_EPI) { if (wr == 1) PG8_BAR; }
    }
    PG8_WAIT_V(0);
    if constexpr (!ALIGN_EPI) { if (wr == 0) PG8_BAR; }
    PG8_BAR;
#undef PG8_SA
#undef PG8_SB
#undef PG8_STAGE
#undef PG8_LDA
#undef PG8_LDB
#undef PG8_MMA
#undef PG8_WAIT_V
#undef PG8_WAIT_L
#undef PG8_BAR
#undef PG8_SCHED
}
}

namespace att {
typedef unsigned short bf16;
using bf16x8 = __attribute__((ext_vector_type(8))) short;
using s16x4  = __attribute__((ext_vector_type(4))) short;
using f32x16 = __attribute__((ext_vector_type(16))) float;
using u32x4  = __attribute__((ext_vector_type(4))) unsigned;
typedef int v8i __attribute__((ext_vector_type(8))); typedef int v4i __attribute__((ext_vector_type(4)));
constexpr int D = 128, NW = 8, QBLK = 32, KVBLK = 64;
constexpr float SCALE = 0.088388347648318440f;
constexpr float THR = 1.5f;
constexpr float PSHIFT = 6.0f;
constexpr int LDQ = 2048, LDK = 128, LDO = 2048;
constexpr float OSCL = 16.f;
constexpr int SHM_V = KVBLK * D  , SHM_K = KVBLK * D  , SHM_ATTN = 2 * SHM_V + 2 * SHM_K + NW * 64 * 4;
#define KSWZ(row, colB) ((row) * 256 + ((colB) ^ (((row) & 7) << 4)))
#define SBAR() __builtin_amdgcn_sched_barrier(0)
__device__ __forceinline__ int crow(int r, int hi) { return (r & 3) + 8 * (r >> 2) + 4 * hi; }
__device__ __forceinline__ unsigned cvtpk(float lo, float hi) { unsigned r; asm volatile("v_cvt_pk_bf16_f32 %0, %1, %2" : "=v"(r) : "v"(lo), "v"(hi)); return r; }

__device__ __forceinline__ void partialSM(f32x16& p0, f32x16& p1, float& m_reg, float& mn, float& alpha, bool fixedm) {
  constexpr float C = SCALE * 1.4426950408889634f;
  if (fixedm) { mn = m_reg; alpha = 1.f; }
  else {
  float pmax = p0[0]; for (int r = 1; r < 16; ++r) pmax = fmaxf(pmax, p0[r]); for (int r = 0; r < 16; ++r) pmax = fmaxf(pmax, p1[r]);
  { auto rr = __builtin_amdgcn_permlane32_swap(__float_as_uint(pmax), __float_as_uint(pmax), false, false);
    pmax = fmaxf(__uint_as_float(rr[0]), __uint_as_float(rr[1])); }
  if (__builtin_expect(__all(pmax - m_reg <= THR / SCALE), 1)) { mn = m_reg; alpha = 1.f; }
  else { mn = fmaxf(m_reg, pmax); alpha = __builtin_amdgcn_exp2f((m_reg - mn) * C); m_reg = mn; }
  }
  float mnC = -mn * C + PSHIFT;
  for (int r = 0; r < 16; ++r) p0[r] = fmaf(p0[r], C, mnC); for (int r = 0; r < 16; ++r) p1[r] = fmaf(p1[r], C, mnC);
  for (int r = 0; r < 16; ++r) p0[r] = __builtin_amdgcn_exp2f(p0[r]);
}
__device__ __forceinline__ void finishSM8(f32x16& p0, f32x16& p1, float alpha, float& l_reg, v8i& pa) {
  for (int r = 0; r < 16; ++r) p1[r] = __builtin_amdgcn_exp2f(p1[r]);
  float ps = 0; for (int r = 0; r < 16; ++r) ps += p0[r]; for (int r = 0; r < 16; ++r) ps += p1[r];
  { auto rr = __builtin_amdgcn_permlane32_swap(__float_as_uint(ps), __float_as_uint(ps), false, false);
    ps = __uint_as_float(rr[0]) + __uint_as_float(rr[1]); }
  l_reg = l_reg * alpha + ps * (1.0f / 64.0f);
#pragma unroll
  for (int w = 0; w < 4; ++w) {
    int t0_ = __builtin_amdgcn_cvt_pk_fp8_f32(p0[4 * w], p0[4 * w + 1], 0, false); pa[w] = __builtin_amdgcn_cvt_pk_fp8_f32(p0[4 * w + 2], p0[4 * w + 3], t0_, true);
    int t1_ = __builtin_amdgcn_cvt_pk_fp8_f32(p1[4 * w], p1[4 * w + 1], 0, false); pa[4 + w] = __builtin_amdgcn_cvt_pk_fp8_f32(p1[4 * w + 2], p1[4 * w + 3], t1_, true); }
}
__device__ __forceinline__ void finishSM(f32x16& p0, f32x16& p1, float alpha, float& l_reg, bf16x8& pa0, bf16x8& pa1, bf16x8& pa2, bf16x8& pa3) {
  for (int r = 0; r < 16; ++r) p1[r] = __builtin_amdgcn_exp2f(p1[r]);
  float ps = 0; for (int r = 0; r < 16; ++r) ps += p0[r]; for (int r = 0; r < 16; ++r) ps += p1[r];
  { auto rr = __builtin_amdgcn_permlane32_swap(__float_as_uint(ps), __float_as_uint(ps), false, false);
    ps = __uint_as_float(rr[0]) + __uint_as_float(rr[1]); }
  l_reg = l_reg * alpha + ps;
#define PK4(P, BASE, OUT) do { unsigned a0 = cvtpk(P[BASE + 0], P[BASE + 1]), a1 = cvtpk(P[BASE + 2], P[BASE + 3]);   \
    unsigned b0 = cvtpk(P[BASE + 4], P[BASE + 5]), b1 = cvtpk(P[BASE + 6], P[BASE + 7]);                              \
    auto r0 = __builtin_amdgcn_permlane32_swap(a0, b0, false, false); auto r1 = __builtin_amdgcn_permlane32_swap(a1, b1, false, false); \
    u32x4 w = {r0[0], r1[0], r0[1], r1[1]}; OUT = *reinterpret_cast<bf16x8*>(&w); } while (0)
  PK4(p0, 0, pa0); PK4(p0, 8, pa1); PK4(p1, 0, pa2); PK4(p1, 8, pa3);
#undef PK4
}
__device__ __forceinline__ void qkt(f32x16& p0, f32x16& p1, const bf16* Ks, const bf16x8* qr, int r32, int hi) {
  p0 = f32x16{}; p1 = f32x16{};
  for (int d0 = 0; d0 < 8; ++d0) { int cb = (d0 * 16 + hi * 8) * 2;
    bf16x8 b0 = *reinterpret_cast<const bf16x8*>((const char*)Ks + KSWZ(r32, cb));
    bf16x8 b1 = *reinterpret_cast<const bf16x8*>((const char*)Ks + KSWZ(32 + r32, cb));
    p0 = __builtin_amdgcn_mfma_f32_32x32x16_bf16(b0, qr[d0], p0, 0, 0, 0);
    p1 = __builtin_amdgcn_mfma_f32_32x32x16_bf16(b1, qr[d0], p1, 0, 0, 0); }
}
__device__ __forceinline__ void wmask(f32x16& p0, f32x16& p1, int kb, int qpos) {
  const int dq = qpos - kb + 128;
#pragma unroll
  for (int r = 0; r < 16; ++r) { const int d = dq - ((r & 3) + 8 * (r >> 2));
    if ((unsigned)d > 256u) p0[r] = -INFINITY;
    if ((unsigned)(d - 32) > 256u) p1[r] = -INFINITY; }
}
__device__ __forceinline__ int v_st(int k, int c) { const int kk = (k & ~0xC) | ((k & 4) << 1) | ((k & 8) >> 1); return ((kk >> 3) * 4 + (c >> 5)) * 512 + ((kk & 7) * 32 + (c & 31)) * 2; }
__device__ __forceinline__ int v_rd_base(int lane) { return ((lane & 3) << 3) | (((lane >> 2) & 3) << 6) | (((lane >> 4) & 1) << 5) | (((lane >> 5) & 1) << 8); }
constexpr int v_rd_off(int d0, int ks, int half) { return d0 * 512 + ks * 4096 + half * 2048; }
template <int OFF> __device__ __forceinline__ s16x4 tr_read(int vb) {
  s16x4 r; asm volatile("ds_read_b64_tr_b16 %0, %1 offset:%2" : "=&v"(r) : "v"(vb), "i"(OFF) : "memory"); return r;
}
template <int D0> __device__ __forceinline__ void pv_one(f32x16& od, int vb, bf16x8 pa0, bf16x8 pa1, bf16x8 pa2, bf16x8 pa3) {
  const s16x4 l0 = tr_read<v_rd_off(D0, 0, 0)>(vb), h0 = tr_read<v_rd_off(D0, 0, 1)>(vb), l1 = tr_read<v_rd_off(D0, 1, 0)>(vb), h1 = tr_read<v_rd_off(D0, 1, 1)>(vb);
  const s16x4 l2 = tr_read<v_rd_off(D0, 2, 0)>(vb), h2 = tr_read<v_rd_off(D0, 2, 1)>(vb), l3 = tr_read<v_rd_off(D0, 3, 0)>(vb), h3 = tr_read<v_rd_off(D0, 3, 1)>(vb);
  asm volatile("s_waitcnt lgkmcnt(0)" ::: "memory"); SBAR();
#define PK(L, H) (bf16x8){L[0], L[1], L[2], L[3], H[0], H[1], H[2], H[3]}
  od = __builtin_amdgcn_mfma_f32_32x32x16_bf16(pa0, PK(l0, h0), od, 0, 0, 0);
  od = __builtin_amdgcn_mfma_f32_32x32x16_bf16(pa1, PK(l1, h1), od, 0, 0, 0);
  od = __builtin_amdgcn_mfma_f32_32x32x16_bf16(pa2, PK(l2, h2), od, 0, 0, 0);
  od = __builtin_amdgcn_mfma_f32_32x32x16_bf16(pa3, PK(l3, h3), od, 0, 0, 0);
#undef PK
}
__device__ __forceinline__ void pv_d0(f32x16* o, int vb, bf16x8 pa0, bf16x8 pa1, bf16x8 pa2, bf16x8 pa3) {
  pv_one<0>(o[0], vb, pa0, pa1, pa2, pa3); pv_one<1>(o[1], vb, pa0, pa1, pa2, pa3); pv_one<2>(o[2], vb, pa0, pa1, pa2, pa3); pv_one<3>(o[3], vb, pa0, pa1, pa2, pa3);
}

struct Stg { v4i v8; v4i k8; };
#define V8OFF(d, ch) ((d) * 64 + ((((ch) ^ (((d) >> 2) & 3))) << 4))
#define K8OFF(row, ch) ((row) * 128 + ((((ch) ^ (((row) >> 1) & 7))) << 4))
__device__ __forceinline__ v8i cat8(v4i a, v4i b) { return __builtin_shufflevector(a, b, 0, 1, 2, 3, 4, 5, 6, 7); }
__device__ __forceinline__ void qkt8(f32x16& p0, f32x16& p1, const char* Ks, const v8i (&q8)[2], int r32, int hi, int sc) {
  const v8i a00 = cat8(*(const v4i*)(Ks + K8OFF(r32, 2 * hi)), *(const v4i*)(Ks + K8OFF(r32, 2 * hi + 1)));
  const v8i a10 = cat8(*(const v4i*)(Ks + K8OFF(32 + r32, 2 * hi)), *(const v4i*)(Ks + K8OFF(32 + r32, 2 * hi + 1)));
  const v8i a01 = cat8(*(const v4i*)(Ks + K8OFF(r32, 4 + 2 * hi)), *(const v4i*)(Ks + K8OFF(r32, 4 + 2 * hi + 1)));
  const v8i a11 = cat8(*(const v4i*)(Ks + K8OFF(32 + r32, 4 + 2 * hi)), *(const v4i*)(Ks + K8OFF(32 + r32, 4 + 2 * hi + 1)));
  asm volatile("s_nop 1\n\tv_mfma_scale_f32_32x32x64_f8f6f4 %0, %1, %2, 0, %3, %3 op_sel_hi:[0,0,0]" : "=&v"(p0) : "v"(a00), "v"(q8[0]), "v"(sc));
  asm volatile("s_nop 1\n\tv_mfma_scale_f32_32x32x64_f8f6f4 %0, %1, %2, 0, %3, %3 op_sel_hi:[0,0,0]" : "=&v"(p1) : "v"(a10), "v"(q8[0]), "v"(sc));
  asm volatile("s_nop 1\n\tv_mfma_scale_f32_32x32x64_f8f6f4 %0, %1, %2, %0, %3, %3 op_sel_hi:[0,0,0]" : "+v"(p0) : "v"(a01), "v"(q8[1]), "v"(sc));
  asm volatile("s_nop 1\n\tv_mfma_scale_f32_32x32x64_f8f6f4 %0, %1, %2, %0, %3, %3 op_sel_hi:[0,0,0]" : "+v"(p1) : "v"(a11), "v"(q8[1]), "v"(sc));
}
__device__ __forceinline__ void pv8(f32x16* o, const char* Vs, const v8i& pa, int r32, int hi, int scp, int scv) {
#pragma unroll
  for (int d0 = 0; d0 < 4; ++d0) { const int d = 32 * d0 + r32;
    const v8i bfr = cat8(*(const v4i*)(Vs + V8OFF(d, 2 * hi)), *(const v4i*)(Vs + V8OFF(d, 2 * hi + 1)));
    asm volatile("s_nop 1\n\tv_mfma_scale_f32_32x32x64_f8f6f4 %0, %1, %2, %0, %3, %4 op_sel_hi:[0,0,0]" : "+v"(o[d0]) : "v"(pa), "v"(bfr), "v"(scp), "v"(scv)); }
}
#define O_SETTLE() asm volatile("s_nop 15\n\ts_nop 7" : "+v"(o[0]), "+v"(o[1]), "+v"(o[2]), "+v"(o[3]))
#define QKT_SETTLE(P0, P1) asm volatile("s_nop 15\n\ts_nop 7" : "+v"(P0), "+v"(P1))
struct AUnit { const unsigned char* Q; const unsigned char* K; const unsigned char* V; unsigned char* O; int NT, nctx, jlo, q0; bool masked; float sinkl2, kbound; };
#define KOFU(u, t) (((t) < (u).nctx) ? (4096 + 64 * (t)) : 64 * ((u).jlo + (t) - (u).nctx))
#define SLOADX(dst, Kp, Vp, k0) do { const int k0_ = (k0); (dst).v8 = *reinterpret_cast<const v4i*>(&(Vp)[(long)(tid >> 2) * 4352 + k0_ + (tid & 3) * 16]); \
    (dst).k8 = *reinterpret_cast<const v4i*>(&(Kp)[(long)(k0_ + (tid >> 3)) * 128 + (tid & 7) * 16]); } while (0)
__device__ __forceinline__ void attn_prime(const AUnit& u, v8i (&qr)[2], Stg (&sr_)[2]) {
  const int tid = threadIdx.x, wid = tid >> 6, lane = tid & 63, r32 = lane & 31, hi = lane >> 5;
  const unsigned char* Qw = u.Q + (long)(wid * QBLK + r32) * LDQ + hi * 32;
#pragma unroll
  for (int j = 0; j < 2; ++j) qr[j] = cat8(*reinterpret_cast<const v4i*>(Qw + 64 * j), *reinterpret_cast<const v4i*>(Qw + 64 * j + 16));
  SLOADX(sr_[0], u.K, u.V, KOFU(u, 0)); SLOADX(sr_[1], u.K, u.V, KOFU(u, 1));
}
__device__ __forceinline__ void attn_unit(const AUnit& u, bool has_next, const AUnit& nx, v8i (&qr)[2], Stg (&sr_)[2], char* lds) {
  const int tid = threadIdx.x, wid = tid >> 6, lane = tid & 63, r32 = lane & 31, hi = lane >> 5;
  const unsigned char* __restrict__ Kh = u.K; const unsigned char* __restrict__ Vh = u.V;
  int qksc = (127 - 4) * 0x01010101, pvsc = (127 - 6) * 0x01010101; asm volatile("" : "+v"(qksc), "+v"(pvsc));
  const int NT = u.NT, nctx = u.nctx, jlo = u.jlo; const bool masked = u.masked;
  bf16* V_lds = (bf16*)lds; bf16* K_lds = (bf16*)(lds + 2 * SHM_V);
  float* ws = (float*)(lds + 2 * SHM_V + 2 * SHM_K) + wid * 64; float* li_l = ws; float* al_l = ws + 32;
  float m_reg = -1e30f, l_reg = 0; f32x16 o[4] = {};
  const bool fixedm = u.kbound > 0.f;
  if (fixedm) { float ss = 0.f;
#pragma unroll
    for (int j = 0; j < 2; ++j)
#pragma unroll
      for (int e = 0; e < 8; ++e) { const int w = qr[j][e];
        const float q0_ = __builtin_amdgcn_cvt_f32_fp8(w, 0), q1_ = __builtin_amdgcn_cvt_f32_fp8(w, 1), q2_ = __builtin_amdgcn_cvt_f32_fp8(w, 2), q3_ = __builtin_amdgcn_cvt_f32_fp8(w, 3);
        ss += (q0_ * q0_ + q1_ * q1_) + (q2_ * q2_ + q3_ * q3_); }
    { auto rr = __builtin_amdgcn_permlane32_swap(__float_as_uint(ss), __float_as_uint(ss), false, false); ss = __uint_as_float(rr[0]) + __uint_as_float(rr[1]); }
    m_reg = sqrtf(ss) * (1.0f / 16.0f) * u.kbound; }

  const int qpos = u.q0 + wid * QBLK + r32;
#define KOF(t) (((t) < nctx) ? (4096 + 64 * (t)) : 64 * (jlo + (t) - nctx))
#define SLOAD(i, k0) SLOADX(sr_[i], Kh, Vh, k0)
#define SWRITE(b, i) do { *(v4i*)((char*)V_lds + (b) * SHM_V + V8OFF(tid >> 2, tid & 3)) = sr_[i].v8;          \
    *(v4i*)((char*)K_lds + (b) * SHM_K + K8OFF(tid >> 3, tid & 7)) = sr_[i].k8; } while (0)
#define SWAIT() asm volatile("s_waitcnt vmcnt(4)" ::: "memory")
#define RESC(a) do { if (__any((a) < 1.f)) { if (hi == 0) al_l[r32] = (a); asm volatile("s_waitcnt lgkmcnt(0)" ::: "memory"); O_SETTLE(); \
    for (int d = 0; d < 4; ++d) for (int r = 0; r < 16; ++r) o[d][r] *= al_l[crow(r, hi)]; } } while (0)
#define MASK(P0, P1, t) do { if (masked && (t) >= nctx) wmask(P0, P1, KOF(t) + 4 * hi, qpos); } while (0)
  f32x16 pA0, pA1, pB0, pB1; float mnA, mnB, alA, alB; v8i pa;
  constexpr int SE = 0, SO = 1;
  SWAIT(); SWRITE(0, SE); __syncthreads();
  if (2 < NT) SLOAD(SE, KOF(2));
  qkt8(pA0, pA1, (const char*)K_lds, qr, r32, hi, qksc); QKT_SETTLE(pA0, pA1); MASK(pA0, pA1, 0); partialSM(pA0, pA1, m_reg, mnA, alA, fixedm);
  SWAIT(); SWRITE(1, SO); __syncthreads();
  for (int j = 1; j + 1 < NT; j += 2) {
    SBAR(); qkt8(pB0, pB1, (const char*)K_lds + SHM_K, qr, r32, hi, qksc);
    finishSM8(pA0, pA1, alA, l_reg, pa); SBAR();
    SLOAD(SO, KOF(j + 2)); SBAR();
    pv8(o, (const char*)V_lds, pa, r32, hi, pvsc, qksc); QKT_SETTLE(pB0, pB1); MASK(pB0, pB1, j); partialSM(pB0, pB1, m_reg, mnB, alB, fixedm);
    __syncthreads(); SWAIT(); SWRITE(0, SE);
    RESC(alB); __syncthreads();
    SBAR(); qkt8(pA0, pA1, (const char*)K_lds, qr, r32, hi, qksc);
    finishSM8(pB0, pB1, alB, l_reg, pa); SBAR();
    if (j + 3 < NT) SLOAD(SE, KOF(j + 3)); SBAR();
    pv8(o, (const char*)V_lds + SHM_V, pa, r32, hi, pvsc, qksc); QKT_SETTLE(pA0, pA1); MASK(pA0, pA1, j + 1); partialSM(pA0, pA1, m_reg, mnA, alA, fixedm);
    __syncthreads(); SWAIT(); SWRITE(1, SO);
    RESC(alA); __syncthreads();
  }
  SBAR(); qkt8(pB0, pB1, (const char*)K_lds + SHM_K, qr, r32, hi, qksc);
  finishSM8(pA0, pA1, alA, l_reg, pa); SBAR();
  pv8(o, (const char*)V_lds, pa, r32, hi, pvsc, qksc); QKT_SETTLE(pB0, pB1); MASK(pB0, pB1, NT - 1); partialSM(pB0, pB1, m_reg, mnB, alB, fixedm);
  SBAR(); if (has_next) attn_prime(nx, qr, sr_); SBAR();
  __syncthreads(); RESC(alB);
  finishSM8(pB0, pB1, alB, l_reg, pa); SBAR();
  pv8(o, (const char*)V_lds + SHM_V, pa, r32, hi, pvsc, qksc);
  O_SETTLE();
  l_reg += __builtin_amdgcn_exp2f(u.sinkl2 - m_reg * (SCALE * 1.4426950408889634f));
  if (hi == 0) li_l[r32] = l_reg; asm volatile("s_waitcnt lgkmcnt(0)" ::: "memory");
  float rli[16];
#pragma unroll
  for (int r = 0; r < 16; ++r) rli[r] = __builtin_amdgcn_rcpf(li_l[crow(r, hi)]);
  __syncthreads();
  { char* stg = lds + wid * 8192 + (4 * hi * 128 + r32) * 2;
#pragma unroll
    for (int r = 0; r < 16; ++r) {
#pragma unroll
      for (int d0 = 0; d0 < 4; ++d0) { const float v = o[d0][r] * rli[r]; *(bf16*)(stg + ((r & 3) + 8 * (r >> 2)) * 256 + d0 * 64) = (bf16)(cvtpk(v, v) & 0xffffu); }
      asm volatile("" ::: "memory"); }
    asm volatile("s_waitcnt lgkmcnt(0)" ::: "memory");
    unsigned char* Ow = u.O + (long)(wid * QBLK + (lane >> 4)) * LDO + (lane & 15) * 8;
    const char* rd = lds + wid * 8192 + (lane >> 4) * 256 + (lane & 15) * 16;
#pragma unroll
    for (int i = 0; i < 8; ++i) { const u32x4 v = *(const u32x4*)(rd + i * 1024);
      typedef unsigned u2v __attribute__((ext_vector_type(2))); u2v w;
#define LO16(x) (__uint_as_float((x) << 16) * OSCL)
#define HI16(x) (__uint_as_float((x) & 0xffff0000u) * OSCL)
      { int t = __builtin_amdgcn_cvt_pk_fp8_f32(LO16(v.x), HI16(v.x), 0, false); t = __builtin_amdgcn_cvt_pk_fp8_f32(LO16(v.y), HI16(v.y), t, true); w.x = (unsigned)t; }
      { int t = __builtin_amdgcn_cvt_pk_fp8_f32(LO16(v.z), HI16(v.z), 0, false); t = __builtin_amdgcn_cvt_pk_fp8_f32(LO16(v.w), HI16(v.w), t, true); w.y = (unsigned)t; }
#undef LO16
#undef HI16
      *(u2v*)(Ow + (long)i * 4 * LDO) = w; } }
  __syncthreads();
#undef KOF
#undef SLOAD
#undef SWRITE
#undef SWAIT
#undef RESC
#undef MASK
}
#undef KOFU
#undef SLOADX
#undef K8OFF
#undef V8OFF
#undef QKT_SETTLE
#undef O_SETTLE
#undef KSWZ
#undef SBAR
}

constexpr int NWAVES = 8;
constexpr int N_LAUNCHES = MK_N_LAUNCHES;
constexpr int N_PHASES = 10;
constexpr int DM = 2048, NB = 4, SEQ = 4096, CTXL = 256, FFN = 5632, INW = 3072, NMOD = 12288;
constexpr int M = NB * SEQ, MC = NB * CTXL, MU = M + MC;
constexpr int SKV = SEQ + CTXL;
constexpr float LN_EPS = 1e-6f;
constexpr float DN_ALPHA = 1.189207115002721f;

constexpr size_t MiB = 1u << 20;
constexpr size_t WS_CTL = 0, CTL_ZERO_BYTES = 64 * 1024;
constexpr size_t WS_MODP = 1 * MiB;
constexpr size_t WS_MODS = 2 * MiB;
constexpr size_t WS_ROPE = 2 * MiB + 512 * 1024;
constexpr size_t WS_WIN = 3 * MiB, WS_WOUT = 15 * MiB, WS_WGU = 23 * MiB, WS_WDN = 67 * MiB;
constexpr size_t WS_U = 89 * MiB;
constexpr size_t WS_Y = 157 * MiB;
constexpr size_t WS_QO = 285 * MiB;
constexpr size_t WS_KV = 349 * MiB;
constexpr size_t KV_BYTES = (size_t)NB * 2 * SKV * 128 * 2;
constexpr size_t WS_H = 285 * MiB;
constexpr size_t WS_END = 461 * MiB;
static_assert(WS_WIN + (size_t)INW * DM * 2 <= WS_WOUT && WS_WOUT + (size_t)DM * DM * 2 <= WS_WGU && WS_WGU + (size_t)2 * FFN * DM * 2 <= WS_WDN && WS_WDN + (size_t)DM * FFN * 2 <= WS_U, "ws map (weights)");
static_assert(WS_U + (size_t)MU * DM * 2 <= WS_Y && WS_Y + (size_t)M * DM * 4 <= WS_QO && WS_QO + (size_t)M * DM * 2 <= WS_KV && WS_KV + 4 * KV_BYTES <= WS_END && WS_H + (size_t)M * FFN * 2 <= WS_END, "ws map");
constexpr int CW_BAR = 4096;
constexpr int S_U = 2, S_W = 6, S_O = 4, S_AO = 4;
constexpr int E8(int s) { return (127 - s) * 0x01010101; }

constexpr int RING_OFF = 0, RING_BYTES = 131072;
constexpr int LDSCTL_OFF = RING_BYTES, MISC_OFF = LDSCTL_OFF + 320;
constexpr int XCH_OFF = RING_BYTES + 1024;
constexpr int LDS_BYTES = 147456;
static_assert(XCH_OFF + 4096 <= LDS_BYTES, "LDS map");

#define GAS __attribute__((address_space(1)))
#define LAS __attribute__((address_space(3)))
typedef unsigned short bf16;
typedef unsigned v4u __attribute__((ext_vector_type(4)));
typedef float f32x4 __attribute__((ext_vector_type(4)));
typedef GAS unsigned gu32;
#define RLX_AGENT __ATOMIC_RELAXED, __HIP_MEMORY_SCOPE_AGENT
#define LDS_WAIT() asm volatile("s_waitcnt lgkmcnt(0)" ::: "memory")
#define VM_WAIT() asm volatile("s_waitcnt vmcnt(0)" ::: "memory")
__device__ __forceinline__ unsigned f2bf(float f) { unsigned u = __builtin_bit_cast(unsigned, f); return (u + 0x7fffu + ((u >> 16) & 1u)) >> 16; }
__device__ __forceinline__ unsigned pk2(float lo, float hi) { return f2bf(lo) | (f2bf(hi) << 16); }

#define XB_TMO      128
#define XB_XCNT(j)  (256  + 64 * (j))
#define XB_XSUB(j)  (1280 + 64 * (j))
#define XB_XGEN(j)  (2304 + 64 * (j))
#define XB_TOP      3328
#define XB_TOPGEN   3392
#define XCD_BAR_WORDS 3456
#define XB_SPIN_CAP (1u << 18)
__device__ __forceinline__ unsigned xb_ld(unsigned* p)              { return __hip_atomic_load(p, __ATOMIC_RELAXED, __HIP_MEMORY_SCOPE_AGENT); }
__device__ __forceinline__ unsigned xb_add(unsigned* p, unsigned v) { return __hip_atomic_fetch_add(p, v, __ATOMIC_RELAXED, __HIP_MEMORY_SCOPE_AGENT); }
__device__ __forceinline__ unsigned xb_xcc_id() { return (unsigned)__builtin_amdgcn_s_getreg((3 << 11) | 20) & 0xFu; }
#define XB_SPIN(cond, bar) do { unsigned _sp = 0; while (cond) { __builtin_amdgcn_s_sleep(1); \
    if ((++_sp & 255u) == 0u) { if (xb_ld(&(bar)[XB_TMO])) break; if (_sp > XB_SPIN_CAP) { atomicAdd(&(bar)[XB_TMO], 1u); break; } } } } while (0)
struct XcdBarrier { unsigned* bar; unsigned x; volatile LAS unsigned* st; };
__device__ __forceinline__ XcdBarrier xcd_barrier_post(unsigned* bar, volatile LAS unsigned* st) {
    XcdBarrier b; b.bar = bar; b.x = xb_xcc_id(); b.st = st;
    if (threadIdx.x == 0) (void)xb_add(&bar[XB_XCNT(b.x)], 1u);
    return b;
}
__device__ __forceinline__ void xcd_barrier_complete(unsigned* bar, unsigned x, unsigned& nloc, unsigned& nx) {
    const unsigned G = gridDim.x * gridDim.y * gridDim.z;
    unsigned sum, cnt, mine, sp = 0u;
    for (;;) {
        sum = 0u; cnt = 0u; mine = 0u;
#pragma unroll
        for (unsigned j = 0; j < 16; ++j) { const unsigned c = xb_ld(&bar[XB_XCNT(j)]); sum += c; cnt += (c > 0u) ? 1u : 0u; mine = (j == x) ? c : mine; }
        if (sum == G) break;
        __builtin_amdgcn_s_sleep(1);
        if ((++sp & 255u) == 0u) { if (xb_ld(&bar[XB_TMO])) break; if (sp > XB_SPIN_CAP) { atomicAdd(&bar[XB_TMO], 1u); break; } }
    }
    nloc = mine > 0u ? mine : 1u; nx = cnt > 0u ? cnt : 1u;
}
__device__ __forceinline__ void xcd_barrier(const XcdBarrier& b) {
    asm volatile("s_waitcnt vmcnt(0)" ::: "memory");
    __syncthreads();
    if (threadIdx.x == 0) {
        unsigned* bar = b.bar;
        __builtin_amdgcn_s_waitcnt(0);
        unsigned nloc = b.st[0], nx = b.st[1];
        if (nloc == 0u) { xcd_barrier_complete(bar, b.x, nloc, nx); b.st[0] = nloc; b.st[1] = nx; }
        const unsigned old = xb_add(&bar[XB_XSUB(b.x)], 1u);
        const unsigned gen = old / nloc;
        if (old + 1u == (gen + 1u) * nloc) {
            __builtin_amdgcn_fence(__ATOMIC_RELEASE, "agent");
            asm volatile("s_waitcnt vmcnt(0)" ::: "memory");
            const unsigned og = xb_add(&bar[XB_TOP], 1u);
            const unsigned tg = og / nx;
            if (og + 1u == (tg + 1u) * nx) xb_add(&bar[XB_TOPGEN], 1u);
            else XB_SPIN(xb_ld(&bar[XB_TOPGEN]) == tg, bar);
            __builtin_amdgcn_fence(__ATOMIC_ACQUIRE, "agent");
            xb_add(&bar[XB_XGEN(b.x)], 1u);
            asm volatile("s_waitcnt vmcnt(0)" ::: "memory");
        } else {
            XB_SPIN(xb_ld(&bar[XB_XGEN(b.x)]) == gen, bar);
            __builtin_amdgcn_fence(__ATOMIC_ACQUIRE, "agent");
            asm volatile("s_waitcnt vmcnt(0)" ::: "memory");
        }
    }
    __syncthreads();
}

__device__ __forceinline__ float wave_sum(float v) {
#pragma unroll
    for (int o = 1; o < 64; o <<= 1) v += __shfl_xor(v, o);
    return v;
}
__device__ __forceinline__ void transpose_item(const float* W, int ldw, int k0, int n0, bf16* WT, int Kd, int dst_row0, LAS float* scr, int lane) {
#pragma unroll 8
    for (int i = 0; i < 32; ++i) { const int kk = 2 * i + (lane >> 5); scr[kk * 33 + (lane & 31)] = W[(size_t)(k0 + kk) * ldw + n0 + (lane & 31)]; }
    LDS_WAIT(); asm volatile("" ::: "memory");
    const int c = lane & 7;
#pragma unroll
    for (int j = 0; j < 4; ++j) { const int n = (lane >> 3) + 8 * j; const LAS float* s = scr + (8 * c) * 33 + n;
        v4u o; o.x = pk2(s[0 * 33], s[1 * 33]); o.y = pk2(s[2 * 33], s[3 * 33]); o.z = pk2(s[4 * 33], s[5 * 33]); o.w = pk2(s[6 * 33], s[7 * 33]);
        *(GAS v4u*)(WT + (size_t)(dst_row0 + n) * Kd + k0 + 8 * c) = o; }
    LDS_WAIT(); asm volatile("" ::: "memory");
}
__device__ __forceinline__ float clamp448(float v) { return __builtin_fminf(__builtin_fmaxf(v, -448.f), 448.f); }
__device__ __forceinline__ unsigned pk4_fp8(float a, float b, float c, float d) {
    int w = __builtin_amdgcn_cvt_pk_fp8_f32(clamp448(a), clamp448(b), 0, false); w = __builtin_amdgcn_cvt_pk_fp8_f32(clamp448(c), clamp448(d), w, true); return (unsigned)w; }
__device__ __forceinline__ void transpose_item8(const float* W, int ldw, int k0, int n0, unsigned char* WT, int Kd, int dst_row0, float scl, LAS float* scr, int lane) {
#pragma unroll 8
    for (int i = 0; i < 32; ++i) { const int kk = 2 * i + (lane >> 5); scr[kk * 33 + (lane & 31)] = W[(size_t)(k0 + kk) * ldw + n0 + (lane & 31)]; }
    LDS_WAIT(); asm volatile("" ::: "memory");
    const int c = lane & 7;
#pragma unroll
    for (int j = 0; j < 4; ++j) { const int n = (lane >> 3) + 8 * j; const LAS float* s = scr + (8 * c) * 33 + n;
        typedef unsigned u2v __attribute__((ext_vector_type(2)));
        u2v o; o.x = pk4_fp8(s[0 * 33] * scl, s[1 * 33] * scl, s[2 * 33] * scl, s[3 * 33] * scl); o.y = pk4_fp8(s[4 * 33] * scl, s[5 * 33] * scl, s[6 * 33] * scl, s[7 * 33] * scl);
        *(GAS u2v*)(WT + (size_t)(dst_row0 + n) * Kd + k0 + 8 * c) = o; }
    LDS_WAIT(); asm volatile("" ::: "memory");
}
__device__ __forceinline__ float silu_f(float x) { return x / (1.0f + __expf(-x)); }

struct Args { const float* in[18]; float* out; unsigned char* ws; int ph_lo, ph_hi, li, flags; };

__device__ __forceinline__ void modulate_row8(const float* xrow, unsigned char* orow, const LAS float* p0, const LAS float* p1, float scl, int lane) {
    const GAS f32x4* xr = (const GAS f32x4*)xrow + lane;
    GAS unsigned* o4 = (GAS unsigned*)orow + lane;
    f32x4 v[8];
#pragma unroll
    for (int j = 0; j < 8; ++j) v[j] = xr[64 * j];
#pragma unroll
    for (int j = 0; j < 8; ++j) { const f32x4 a = *(const LAS f32x4*)(p0 + 256 * j + 4 * lane), s = *(const LAS f32x4*)(p1 + 256 * j + 4 * lane); const f32x4 r = (v[j] * a + s) * scl;
        o4[64 * j] = pk4_fp8(r.x, r.y, r.z, r.w); }
}
__device__ __forceinline__ void modulate_row(const float* xrow, bf16* orow, const LAS float* p0, const LAS float* p1, int lane) {
    const GAS f32x4* xr = (const GAS f32x4*)xrow + lane;
    GAS unsigned long long* o8 = (GAS unsigned long long*)orow + lane;
    f32x4 v[8];
#pragma unroll
    for (int j = 0; j < 8; ++j) v[j] = xr[64 * j];
#pragma unroll
    for (int j = 0; j < 8; ++j) { const f32x4 a = *(const LAS f32x4*)(p0 + 256 * j + 4 * lane), s = *(const LAS f32x4*)(p1 + 256 * j + 4 * lane); const f32x4 r = v[j] * a + s;
        o8[64 * j] = (unsigned long long)pk2(r.x, r.y) | ((unsigned long long)pk2(r.z, r.w) << 32); }
}
typedef unsigned u32x2 __attribute__((ext_vector_type(2)));
__device__ __forceinline__ f32x4 bf4_to_f32(u32x2 w) { f32x4 r; r.x = __uint_as_float(w.x << 16); r.y = __uint_as_float(w.x & 0xffff0000u); r.z = __uint_as_float(w.y << 16); r.w = __uint_as_float(w.y & 0xffff0000u); return r; }
__device__ __forceinline__ void ln_regs(f32x4 (&v)[8], const LAS float* g, const LAS float* bb, int lane) {
    float s = 0.f;
#pragma unroll
    for (int j = 0; j < 8; ++j) s += (v[j].x + v[j].y) + (v[j].z + v[j].w);
    const float mean = wave_sum(s) * (1.f / DM); float s2 = 0.f;
#pragma unroll
    for (int j = 0; j < 8; ++j) { v[j] = v[j] - mean; s2 += (v[j].x * v[j].x + v[j].y * v[j].y) + (v[j].z * v[j].z + v[j].w * v[j].w); }
    const float rstd = __builtin_amdgcn_rsqf(wave_sum(s2) * (1.f / DM) + LN_EPS);
#pragma unroll
    for (int j = 0; j < 8; ++j) { const int c = 256 * j + 4 * lane; v[j] = v[j] * rstd * *(const LAS f32x4*)(g + c) + *(const LAS f32x4*)(bb + c); if (j & 1) asm volatile("" ::: "memory"); }
}
__device__ __forceinline__ f32x4 fp8x4_to_f32(unsigned w) { f32x4 r; r.x = __builtin_amdgcn_cvt_f32_fp8((int)w, 0); r.y = __builtin_amdgcn_cvt_f32_fp8((int)w, 1); r.z = __builtin_amdgcn_cvt_f32_fp8((int)w, 2); r.w = __builtin_amdgcn_cvt_f32_fp8((int)w, 3); return r; }
__device__ __forceinline__ void x1_row(f32x4 (&v)[8], const float* xrow, const unsigned char* arow, const LAS float* P, int lane) {
    const GAS f32x4* xr = (const GAS f32x4*)xrow + lane; const GAS unsigned* ar = (const GAS unsigned*)arow + lane;
    unsigned aw[8];
#pragma unroll
    for (int j = 0; j < 8; ++j) { v[j] = xr[64 * j]; aw[j] = ar[64 * j]; }
#pragma unroll
    for (int j = 0; j < 8; ++j) { v[j] = v[j] * DN_ALPHA + *(const LAS f32x4*)(P + 256 * j + 4 * lane) * (fp8x4_to_f32(aw[j]) * (1.0f / (float)(1 << S_AO))); if (j & 1) asm volatile("" ::: "memory"); }
    ln_regs(v, P + 2048, P + 4096, lane);
}

__global__ void __launch_bounds__(NWAVES * 64, 2) dit_fwd(Args args) {
    extern __shared__ __attribute__((aligned(16))) unsigned char lds[];
    LAS unsigned char* L = (LAS unsigned char*)lds;
    volatile LAS unsigned* MISC = (volatile LAS unsigned*)(L + MISC_OFF);
    const int tid = threadIdx.x, lane = tid & 63, wave = __builtin_amdgcn_readfirstlane(tid >> 6);
    const int G = gridDim.x, bx = blockIdx.x;
    unsigned char* ws = args.ws;
    gu32* ctl = (gu32*)(ws + WS_CTL);
    const float* x = args.in[0]; const float* cvec = args.in[1]; const float* ctx = args.in[2]; const float* c_ctx = args.in[3];
    const float* w_ada = args.in[4]; const float* b_ada = args.in[5]; const float* w_in = args.in[6]; const float* qng = args.in[7]; const float* kng = args.in[8];
    const float* sink = args.in[9]; const float* w_out = args.in[10]; const float* ln1g = args.in[11]; const float* ln1b = args.in[12];
    const float* w_gate = args.in[13]; const float* w_up = args.in[14]; const float* w_down = args.in[15]; const float* ln2g = args.in[16]; const float* ln2b = args.in[17];
    float* MODP = (float*)(ws + WS_MODP); float* MODS = (float*)(ws + WS_MODS); float* ROPEC = (float*)(ws + WS_ROPE); float* ROPES = ROPEC + 2048;
    bf16* WIN = (bf16*)(ws + WS_WIN); bf16* WOUT = (bf16*)(ws + WS_WOUT); bf16* WGU = (bf16*)(ws + WS_WGU); bf16* WDN = (bf16*)(ws + WS_WDN);
    bf16* U = (bf16*)(ws + WS_U); unsigned char* AB8 = ws + WS_Y; bf16* DB = (bf16*)(ws + WS_Y + 64 * MiB);
    unsigned char* U8 = ws + WS_U;
    unsigned char* WIN8 = ws + WS_WIN; unsigned char* WOUT8 = ws + WS_WOUT;
    unsigned char* OF8 = ws + WS_Y + 64 * MiB;
    unsigned char* VTA = ws + WS_KV + KV_BYTES; unsigned char* VTB = ws + WS_KV + 3 * KV_BYTES;
    unsigned char* QO8 = ws + WS_QO; unsigned char* KA8 = ws + WS_KV; unsigned char* KB8 = ws + WS_KV + 2 * KV_BYTES;
    bf16* KA = (bf16*)(ws + WS_KV); bf16* VA = (bf16*)(ws + WS_KV + KV_BYTES); bf16* KB = (bf16*)(ws + WS_KV + 2 * KV_BYTES); bf16* VB = (bf16*)(ws + WS_KV + 3 * KV_BYTES);
    bf16* HB = (bf16*)(ws + WS_H);

    for (int u = tid; u < (LDS_BYTES - LDSCTL_OFF) / 4; u += NWAVES * 64) ((LAS unsigned*)(L + LDSCTL_OFF))[u] = 0u;
    __syncthreads();
    XcdBarrier bar; bar.bar = (unsigned*)(ctl + CW_BAR); bar.x = 0; bar.st = nullptr;
    if (N_LAUNCHES == 1) bar = xcd_barrier_post((unsigned*)(ctl + CW_BAR), MISC + 8);
#define GRID_BAR() do { if (N_LAUNCHES == 1) xcd_barrier(bar); } while (0)
    const int lo = args.ph_lo, hi = args.ph_hi;
#ifndef PHMASK
#define PHMASK 0x3FF
#endif
#define IN(k) (((PHMASK >> (k)) & 1) && lo <= (k) && (k) < hi)
#define BOTH(k) (IN(k) && IN((k) + 1))

    if (IN(0)) {
        if (bx < 192) {
            const int cb = bx >> 2, kq = bx & 3, k0 = kq * 512 + wave * 64;
            float sv[5];
#pragma unroll
            for (int b = 0; b < 4; ++b) sv[b] = silu_f(cvec[b * DM + k0 + lane]);
            sv[4] = silu_f(c_ctx[k0 + lane]);
            f32x4 acc[5];
#pragma unroll
            for (int b = 0; b < 5; ++b) acc[b] = (f32x4){0.f, 0.f, 0.f, 0.f};
            const float* wp = w_ada + (size_t)k0 * NMOD + cb * 256 + lane * 4;
#pragma unroll 16
            for (int kk = 0; kk < 64; ++kk) { const f32x4 wv = *(const f32x4*)(wp + (size_t)kk * NMOD);
#pragma unroll
                for (int b = 0; b < 5; ++b) { const float s = __builtin_bit_cast(float, __builtin_amdgcn_readlane(__builtin_bit_cast(int, sv[b]), kk)); acc[b] += wv * s; } }
            LAS f32x4* red = (LAS f32x4*)(L + RING_OFF);
#pragma unroll
            for (int b = 0; b < 5; ++b) red[(wave * 5 + b) * 64 + lane] = acc[b];
            LDS_WAIT(); __syncthreads();
            if (tid < 320) { const int b = tid >> 6, l = tid & 63; f32x4 s = red[b * 64 + l];
#pragma unroll
                for (int w = 1; w < 8; ++w) s += red[(w * 5 + b) * 64 + l];
                *(f32x4*)(MODP + ((size_t)kq * 5 + b) * NMOD + cb * 256 + l * 4) = s; }
            __syncthreads();
        }
        if (bx == 255) {
            for (int e = tid; e < 2048; e += NWAVES * 64) { const int pos = e >> 5, f = e & 31;
                const float inv = exp2f(-(float)f * (13.287712379549449f / 32.0f)); const float ang = (float)pos * inv;
                float sn, cs; sincosf(ang, &sn, &cs); ROPEC[e] = cs; ROPES[e] = sn; }
        }
        {
            LAS float* scr = (LAS float*)(L + RING_OFF + wave * 16384);
            constexpr int I_IN = 32 * 96, I_OUT = 32 * 64, I_G = 32 * 176, NITEMS = I_IN + I_OUT + I_G, NSLOT = 192 * 8 * 2 + 64 * 8 * 5;
            const int nsl = bx < 192 ? 2 : 5, sl0 = bx < 192 ? (bx * 8 + wave) * 2 : 3072 + ((bx - 192) * 8 + wave) * 5;
            for (int s = 0; s < nsl; ++s)
                for (int it = sl0 + s; it < NITEMS; it += NSLOT) {
                    int r = it;
                    if (r < I_IN) { const int kb = r / 96, nb = r % 96, pn = nb >> 3, q = nb & 7, hh = q >> 2, part = (q >> 1) & 1, bj = q & 1;
                        transpose_item8(w_in, INW, 64 * kb, 32 * nb, WIN8, DM, 256 * pn + 32 * (4 * bj + 2 * hh + part), (float)(1 << S_W), scr, lane); continue; } r -= I_IN;
                    if (r < I_OUT) { const int kb = r / 64, nb = r % 64; transpose_item8(w_out, DM, 64 * kb, 32 * nb, WOUT8, DM, 32 * nb, (float)(1 << S_W), scr, lane); continue; } r -= I_OUT;
                    { const int kb = r / 176, nb = r % 176; transpose_item(w_gate, FFN, 64 * kb, 32 * nb, WGU, DM, 256 * (nb >> 2) + 32 * (nb & 3), scr, lane); }
                }
        }
        if (BOTH(0)) GRID_BAR();
    }

    if (IN(1)) {
        { const int idx = bx * 512 + tid;
          if (idx < 5 * NMOD) { float s = b_ada[idx % NMOD];
#pragma unroll
              for (int q = 0; q < 4; ++q) s += MODP[(size_t)q * 5 * NMOD + idx];
              MODS[idx] = s; } }
        if (bx < 128) {
            LAS float* P0 = (LAS float*)(L + RING_OFF); LAS float* P1 = P0 + 2048;
            for (int i = tid; i < 2048; i += NWAVES * 64) { float sh = b_ada[i], sc = b_ada[2048 + i];
#pragma unroll
                for (int q = 0; q < 4; ++q) { sh += MODP[((size_t)q * 5 + 4) * NMOD + i]; sc += MODP[((size_t)q * 5 + 4) * NMOD + 2048 + i]; }
                P0[i] = 1.0f + sc; P1[i] = sh; }
            LDS_WAIT(); __syncthreads();
            const int r = bx * 8 + wave;
            modulate_row8(ctx + (size_t)r * DM, U8 + (size_t)(M + r) * DM, P0, P1, (float)(1 << S_U), lane);
            __syncthreads();
        }
        if (BOTH(1)) GRID_BAR();
    }

    if (IN(2)) {
        if (bx < 16) {
            const int pnl[4] = {4, 5, 10, 11};
            pg8::Gemm g{(const bf16*)U8, (const bf16*)WIN8, MU, INW, DM / 2}; pg8::OneUnit S{64 + (bx >> 2), (bx & 3) == 0 ? 4 : (bx & 3) == 1 ? 5 : (bx & 3) == 2 ? 10 : 11}; (void)pnl;
            pg8::EpiQKV E{QO8, KA8, VTA, KB8, VTB, qng, kng, ROPEC, ROPES, (LAS float*)(L + XCH_OFF)};
            pg8::gemm_phase<pg8::EpiQKV, pg8::OneUnit, true, true, E8(S_W), E8(S_U)>(L + RING_OFF, g, S, E);
        } else {
            LAS float* P0 = (LAS float*)(L + RING_OFF); LAS float* P1 = P0 + 2048;
            const int i = bx - 16, r0 = (int)(((long)i * M) / 240), r1 = (int)(((long)(i + 1) * M) / 240);
            int r = r0;
            while (r < r1) {
                const int b = r >> 12; int re = (b + 1) << 12; if (re > r1) re = r1;
                __syncthreads();
                for (int k = tid; k < 2048; k += NWAVES * 64) { P0[k] = 1.0f + MODS[b * NMOD + 2048 + k]; P1[k] = MODS[b * NMOD + k]; }
                LDS_WAIT(); __syncthreads();
                for (int rr = r + wave; rr < re; rr += NWAVES) modulate_row8(x + (size_t)rr * DM, U8 + (size_t)rr * DM, P0, P1, (float)(1 << S_U), lane);
                r = re;
            }
            __syncthreads();
            {
                LAS float* scr = (LAS float*)(L + RING_OFF + wave * 16384);
                constexpr int I_G = 32 * 176, I_D = 88 * 64, NITEMS2 = I_G + I_D;
                for (int it = i * 8 + wave; it < NITEMS2; it += 240 * 8) {
                    if (it < I_G) { const int kb = it / 176, nb = it % 176; transpose_item(w_up, FFN, 64 * kb, 32 * nb, WGU, DM, 256 * (nb >> 2) + 128 + 32 * (nb & 3), scr, lane); }
                    else { const int r2 = it - I_G, kb = r2 / 64, nb = r2 % 64; transpose_item(w_down, DM, 64 * kb, 32 * nb, WDN, FFN, 32 * nb, scr, lane); }
                }
            }
        }
        if (BOTH(2)) GRID_BAR();
    }

    if (IN(3)) {
        pg8::Gemm g{(const bf16*)U8, (const bf16*)WIN8, M, INW, DM / 2}; pg8::StaticOrder S; S.init(M, INW, G, bx);
        pg8::EpiQKV E{QO8, KA8, VTA, KB8, VTB, qng, kng, ROPEC, ROPES, (LAS float*)(L + XCH_OFF)};
        pg8::gemm_phase<pg8::EpiQKV, pg8::StaticOrder, true, true, E8(S_W), E8(S_U)>(L + RING_OFF, g, S, E);
        if (BOTH(3)) GRID_BAR();
    }

    if (IN(4)) {
        const int xg = bx & 7, y = bx >> 3, b = xg >> 1, kvh = xg & 1;
        const size_t kvoff = (size_t)(b * 2 + kvh) * SKV * 128;
        float kbnd; { float gm = fmaxf(fabsf(kng[lane]), fabsf(kng[64 + lane]));
#pragma unroll
            for (int o = 1; o < 64; o <<= 1) gm = fmaxf(gm, __shfl_xor(gm, o));
            kbnd = gm * 11.313708498984761f * 1.08f; }
#define MKUNIT(u, i_) do { const int i__ = (i_); const int uu = 2 * y + (i__ & 1), gq = uu >> 4, qb = uu & 15, q0 = qb * 256; const bool isA = i__ >= 2; const int head = kvh * 4 + gq; \
            unsigned char* Qp = QO8 + (size_t)(b * SEQ + q0) * DM + (isA ? 0 : 1024) + head * 128; \
            const int jlo = !isA ? 0 : ((q0 >> 6) - 2 < 0 ? 0 : (q0 >> 6) - 2), jhi = (q0 >> 6) + 6 > 64 ? 64 : (q0 >> 6) + 6; \
            (u).Q = Qp; (u).K = (isA ? KA8 : KB8) + kvoff; (u).V = (isA ? VTA : VTB) + kvoff; (u).O = ((args.flags & 1) ? ws + 384 * MiB : OF8) + (Qp - QO8); \
            (u).NT = isA ? 4 + (jhi - jlo) : SKV / 64; (u).nctx = isA ? 4 : 0; (u).jlo = jlo; (u).q0 = q0; (u).masked = isA; (u).sinkl2 = isA ? sink[head] * 1.4426950408889634f : -INFINITY; (u).kbound = -1.f; (void)kbnd; } while (0)
        att::v8i qr[2]; att::Stg stg[2];
        att::AUnit cur, nx; MKUNIT(cur, 0); att::attn_prime(cur, qr, stg);
        for (int i = 0; i < 4; ++i) {
            MKUNIT(nx, i < 3 ? i + 1 : 3);
            att::attn_unit(cur, i < 3, nx, qr, stg, (char*)lds + RING_OFF);
            cur = nx;
        }
#undef MKUNIT
        if (BOTH(4)) GRID_BAR();
    }

    if (IN(5)) {
        pg8::Gemm g{(const bf16*)OF8, (const bf16*)WOUT8, M, DM, DM / 2}; pg8::StaticOrder S; S.init(M, DM, G, bx);
        pg8::EpiFp8Plain E{AB8, DM, (float)(1 << S_AO)};
        pg8::gemm_phase<pg8::EpiFp8Plain, pg8::StaticOrder, true, true, E8(S_W), E8(S_O)>(L + RING_OFF, g, S, E);
        if (BOTH(5)) GRID_BAR();
    }

    if (IN(6)) {
        LAS float* P = (LAS float*)(L + RING_OFF);
        const int b = bx >> 6;
        for (int k = tid; k < 2048; k += NWAVES * 64) { P[k] = MODS[b * NMOD + 2 * 2048 + k]; P[2048 + k] = ln1g[k]; P[4096 + k] = ln1b[k]; P[6144 + k] = 1.0f + MODS[b * NMOD + 4 * 2048 + k]; P[8192 + k] = MODS[b * NMOD + 3 * 2048 + k]; }
        LDS_WAIT(); __syncthreads();
        for (int rr = bx * 64 + wave; rr < bx * 64 + 64; rr += NWAVES) {
            f32x4 v[8]; x1_row(v, x + (size_t)rr * DM, AB8 + (size_t)rr * DM, P, lane);
            GAS unsigned long long* o8 = (GAS unsigned long long*)(U + (size_t)rr * DM) + lane;
#pragma unroll
            for (int j = 0; j < 8; ++j) { const int c = 256 * j + 4 * lane; const f32x4 r = v[j] * *(const LAS f32x4*)(P + 6144 + c) + *(const LAS f32x4*)(P + 8192 + c);
                o8[64 * j] = (unsigned long long)pk2(r.x, r.y) | ((unsigned long long)pk2(r.z, r.w) << 32); }
        }
        __syncthreads();
        if (BOTH(6)) GRID_BAR();
    }

    if (IN(7)) {
        pg8::Gemm g{U, WGU, M, 2 * FFN, DM}; pg8::StaticOrder S; S.init(M, 2 * FFN, G, bx);
        pg8::EpiSwiglu E{HB, FFN};
        pg8::gemm_phase<pg8::EpiSwiglu, pg8::StaticOrder, true, true>(L + RING_OFF, g, S, E);
        if (BOTH(7)) GRID_BAR();
    }

    if (IN(8)) {
        pg8::Gemm g{HB, WDN, M, DM, FFN}; pg8::StaticOrder S; S.init(M, DM, G, bx);
        pg8::EpiBf16Plain E{DB, DM};
        pg8::gemm_phase<pg8::EpiBf16Plain, pg8::StaticOrder, true, true>(L + RING_OFF, g, S, E);
        if (BOTH(8)) GRID_BAR();
    }

    if (IN(9)) {
        LAS float* P = (LAS float*)(L + RING_OFF);
        const int b = bx >> 6;
        for (int k = tid; k < 2048; k += NWAVES * 64) { P[k] = MODS[b * NMOD + 2 * 2048 + k]; P[2048 + k] = ln1g[k]; P[4096 + k] = ln1b[k]; P[6144 + k] = MODS[b * NMOD + 5 * 2048 + k]; P[8192 + k] = ln2g[k]; P[10240 + k] = ln2b[k]; }
        LDS_WAIT(); __syncthreads();
        for (int rr = bx * 64 + wave; rr < bx * 64 + 64; rr += NWAVES) {
            f32x4 v[8]; x1_row(v, x + (size_t)rr * DM, AB8 + (size_t)rr * DM, P, lane);
            const GAS u32x2* dr = (const GAS u32x2*)(DB + (size_t)rr * DM) + lane;
#pragma unroll
            for (int j = 0; j < 8; ++j) { v[j] = v[j] * DN_ALPHA + *(const LAS f32x4*)(P + 6144 + 256 * j + 4 * lane) * bf4_to_f32(dr[64 * j]); if ((j & 3) == 3) asm volatile("" ::: "memory"); }
            ln_regs(v, P + 8192, P + 10240, lane);
            GAS f32x4* orow = (GAS f32x4*)(args.out + (size_t)rr * DM) + lane;
#pragma unroll
            for (int j = 0; j < 8; ++j) orow[64 * j] = v[j];
        }
    }
#undef IN
#undef BOTH
#undef GRID_BAR
}

extern "C" void kernel_launch(void* const* d_in, const int* in_sizes, int n_in, void* d_out, int out_size, void* d_ws, size_t ws_size, hipStream_t stream) {
    static int grid = 0;
    if (grid == 0) {
        if (n_in != 18 || in_sizes[0] != M * DM || out_size != M * DM || ws_size < WS_END) {
            fprintf(stderr, "kernel_launch: shape mismatch (n_in %d, in0 %d, out %d, ws %zu; need ws >= %zu); nothing launched\n", n_in, n_in > 0 ? in_sizes[0] : -1, out_size, ws_size, (size_t)WS_END); grid = -1; return; }
        int dev = 0, cus = 0, per_cu = 0;
        if (hipGetDevice(&dev) != hipSuccess || hipDeviceGetAttribute(&cus, hipDeviceAttributeMultiprocessorCount, dev) != hipSuccess) { fprintf(stderr, "kernel_launch: device query failed\n"); grid = -1; return; }
        if (hipFuncSetAttribute((const void*)dit_fwd, hipFuncAttributeMaxDynamicSharedMemorySize, LDS_BYTES) != hipSuccess) { fprintf(stderr, "kernel_launch: hipFuncSetAttribute failed\n"); grid = -1; return; }
        if (hipOccupancyMaxActiveBlocksPerMultiprocessor(&per_cu, (const void*)dit_fwd, NWAVES * 64, LDS_BYTES) != hipSuccess || per_cu < 1)
            fprintf(stderr, "kernel_launch: note: occupancy query reports %d workgroups per CU\n", per_cu);
        (void)hipGetLastError();
        if (cus != 256) { fprintf(stderr, "kernel_launch: built for a 256-CU device, found %d CUs; nothing launched\n", cus); grid = -1; return; }
        grid = 256;
    }
    if (grid < 0) return;
    if (hipMemsetAsync((char*)d_ws + WS_CTL, 0, CTL_ZERO_BYTES, stream) != hipSuccess) { fprintf(stderr, "kernel_launch: hipMemsetAsync failed\n"); return; }
    Args a{};
    for (int i = 0; i < 18; ++i) a.in[i] = (const float*)d_in[i];
    a.out = (float*)d_out; a.ws = (unsigned char*)d_ws;
    if (N_LAUNCHES == 1) { a.ph_lo = 0; a.ph_hi = N_PHASES; a.li = 0; hipLaunchKernelGGL(dit_fwd, dim3(grid), dim3(NWAVES * 64), LDS_BYTES, stream, a); }
    else { const int plist[] = PHASE_LIST;
        for (unsigned i = 0; i < sizeof(plist) / sizeof(int); ++i) { const int p = plist[i] % 100; a.ph_lo = p; a.ph_hi = p + 1; a.li = 0; a.flags = plist[i] >= 100 ? 1 : 0;
            hipLaunchKernelGGL(dit_fwd, dim3(grid), dim3(NWAVES * 64), LDS_BYTES, stream, a); } }
    const hipError_t le = hipPeekAtLastError();
    if (le != hipSuccess) fprintf(stderr, "kernel_launch: launch failed: %s\n", hipGetErrorName(le));
}
```

```cpp
#include <hip/hip_runtime.h>
#include <hip/hip_bf16.h>
#include <cstdio>
#include <cstdint>

#ifndef PHASE_LIST
#define PHASE_LIST {0, 1, 2, 3, 4, 5, 6, 7, 8, 9}
#endif
#ifndef MK_N_LAUNCHES
#define MK_N_LAUNCHES 1
#endif

namespace pg8 {
#define PG8_LAS __attribute__((address_space(3)))
typedef unsigned short bf16_t;
typedef short bf16x8 __attribute__((ext_vector_type(8)));
typedef float f32x4 __attribute__((ext_vector_type(4)));
typedef unsigned u32x4 __attribute__((ext_vector_type(4)));
typedef int v8i_t __attribute__((ext_vector_type(8))); typedef int v4i_t __attribute__((ext_vector_type(4)));
constexpr int BM = 256, BK = 64, HALF = 128, HTB = HALF * BK * 2, STAGE_BYTES = 8 * HTB, NXCD = 8, WGM = 8;

__host__ __device__ __forceinline__ int lds_byte(int r, int c) { const int st = (r >> 4) * 2 + (c >> 5), rr = r & 15, cc = c & 31, ob = rr * 64 + cc * 2; return st * 1024 + (ob ^ (((ob >> 9) & 1) << 5)); }
__host__ __device__ __forceinline__ void stage_rc(int b, int& R, int& C) { const int st = b / 1024, sb = b % 1024, swz = sb ^ (((sb >> 9) & 1) << 5); R = (st >> 1) * 16 + swz / 64; C = (st & 1) * 32 + (swz % 64) / 2; }
__host__ __device__ __forceinline__ int perm32(int rho) { const int n = rho >> 4, i = rho & 15; return 8 * (i >> 2) + 4 * n + (i & 3); }

struct Unit { int pm, pn; };
struct Gemm { const bf16_t* A; const bf16_t* Bt; int M, N, K; };

struct StaticOrder {
    int nM, nN, nwg, G, c;
    __host__ __device__ void init(int M, int N, int G_, int c_) { nM = M / BM; nN = N / BM; nwg = nM * nN; G = G_; c = c_; }
    __host__ __device__ bool next(int i, Unit& u) const {
        const long L = (long)i * G + c; if (L >= nwg) return false;
        int wgid = (int)L; { const int q = nwg / NXCD, r = nwg % NXCD, xcd = wgid % NXCD, off = wgid / NXCD; wgid = (xcd < r ? xcd * (q + 1) : r * (q + 1) + (xcd - r) * q) + off; }
        const int nig = WGM * nN, gid = wgid / nig, fm = gid * WGM, gsz = (nM - fm) < WGM ? (nM - fm) : WGM;
        u.pm = fm + ((wgid % nig) % gsz); u.pn = (wgid % nig) / gsz; return true;
    }
    __device__ __forceinline__ void a_ready(const Unit&) const {}
    __device__ __forceinline__ void done(const Unit&) const {}
};
struct OneUnit {
    int pm, pn;
    __device__ bool next(int i, Unit& u) const { if (i > 0) return false; u.pm = pm; u.pn = pn; return true; }
    __device__ __forceinline__ void a_ready(const Unit&) const {}
    __device__ __forceinline__ void done(const Unit&) const {}
};

__device__ __forceinline__ unsigned cvt_pk_bf16(float lo, float hi) { unsigned r; asm volatile("v_cvt_pk_bf16_f32 %0, %1, %2" : "=v"(r) : "v"(lo), "v"(hi)); return r; }


struct EpiQKV {
    static constexpr bool PERM = true, AFTER_DRAIN = false;
    unsigned char* QO; unsigned char* KA; unsigned char* VA; unsigned char* KB; unsigned char* VB;
    const float* qg; const float* kg; const float* ropec; const float* ropes;
    PG8_LAS float* xch;
    __device__ __forceinline__ void operator()(const f32x4 (&acc)[2][2][4][2], const Unit& u, int wr, int wc, int fr, int fq) const {
        const int pn = u.pn; const bool is_ctx = u.pm >= 64;
        const int b = is_ctx ? (u.pm - 64) : (u.pm >> 4), t0 = is_ctx ? 4096 : ((u.pm & 15) << 8);
        const int hh = wc >> 1, part = wc & 1, wid = wr * 4 + wc;
        const bool isq = (pn < 4) || (pn >= 6 && pn < 10), donorm = (pn >= 6 && pn <= 10), dorope = (!is_ctx) && pn != 5 && pn != 11;
        const bool isv = (pn == 5 || pn == 11);
        bf16_t* base = nullptr; unsigned char* base8 = nullptr; size_t rstride;
        if (isq) { const int head = (pn < 4 ? 2 * pn : 8 + 2 * (pn - 6)) + hh; base8 = QO + (size_t)(b * 4096 + t0) * 2048 + head * 128; rstride = 2048; }
        else if (isv) {
            unsigned char* vt = (pn == 5 ? VA : VB) + (size_t)(b * 2 + hh) * 128 * 4352;
            int frl = fr, fql = fq; asm volatile("" : "+v"(frl), "+v"(fql));
            const unsigned p_ = (unsigned)(frl & 3);
            const unsigned sel2 = p_ | ((4u + p_) << 8);
#pragma unroll
            for (int bj = 0; bj < 2; ++bj)
#pragma unroll
                for (int n = 0; n < 2; ++n) {
                    unsigned char* dp = vt + (size_t)(64 * part + 32 * bj + 8 * fql + 4 * n + (frl & 3)) * 4352 + t0 + wr * 64 + 32 * ((frl >> 2) & 1) + 4 * (frl >> 3);
#pragma unroll
                    for (int ai = 0; ai < 2; ++ai)
#pragma unroll
                        for (int m = 0; m < 4; ++m) { const f32x4 v = acc[ai][bj][m][n] * 16.f;
                            int w_ = __builtin_amdgcn_cvt_pk_fp8_f32(__builtin_fminf(__builtin_fmaxf(v[0], -448.f), 448.f), __builtin_fminf(__builtin_fmaxf(v[1], -448.f), 448.f), 0, false);
                            w_ = __builtin_amdgcn_cvt_pk_fp8_f32(__builtin_fminf(__builtin_fmaxf(v[2], -448.f), 448.f), __builtin_fminf(__builtin_fmaxf(v[3], -448.f), 448.f), w_, true);
                            const unsigned W0 = (unsigned)__builtin_amdgcn_mov_dpp(w_, 0x00, 0xf, 0xf, true), W1 = (unsigned)__builtin_amdgcn_mov_dpp(w_, 0x55, 0xf, 0xf, true);
                            const unsigned W2 = (unsigned)__builtin_amdgcn_mov_dpp(w_, 0xaa, 0xf, 0xf, true), W3 = (unsigned)__builtin_amdgcn_mov_dpp(w_, 0xff, 0xf, 0xf, true);
                            const unsigned lo2 = __builtin_amdgcn_perm(W1, W0, sel2), hi2 = __builtin_amdgcn_perm(W3, W2, sel2);
                            *(unsigned*)(dp + ai * HALF + 8 * m) = __builtin_amdgcn_perm(hi2, lo2, 0x05040100u); }
                    asm volatile("" ::: "memory"); }
            return; }
        else { unsigned char* buf = pn == 4 ? KA : KB; base8 = buf + ((size_t)(b * 2 + hh) * 4352 + t0) * 128; rstride = 128; }
        const int d0 = 64 * part + 8 * fq;
        float rs[2][4];
        f32x4 gv[2][2];
#pragma unroll
        for (int bj = 0; bj < 2; ++bj)
#pragma unroll
            for (int n = 0; n < 2; ++n) gv[bj][n] = (f32x4){1.f, 1.f, 1.f, 1.f};
#pragma unroll
        for (int ai = 0; ai < 2; ++ai)
#pragma unroll
            for (int m = 0; m < 4; ++m) rs[ai][m] = 1.f;
        if (donorm) {
            const float* g = (pn == 10) ? kg : qg;
#pragma unroll
            for (int bj = 0; bj < 2; ++bj)
#pragma unroll
                for (int n = 0; n < 2; ++n) gv[bj][n] = *(const f32x4*)(g + d0 + 32 * bj + 4 * n);
#pragma unroll
            for (int ai = 0; ai < 2; ++ai)
#pragma unroll
                for (int m = 0; m < 4; ++m) {
                    float s = 0.f;
#pragma unroll
                    for (int bj = 0; bj < 2; ++bj)
#pragma unroll
                        for (int n = 0; n < 2; ++n) { const f32x4 x = acc[ai][bj][m][n]; s += (x[0] * x[0] + x[1] * x[1]) + (x[2] * x[2] + x[3] * x[3]); }
                    s += __shfl_xor(s, 16); s += __shfl_xor(s, 32);
                    if (fq == 0) xch[wid * 128 + ai * 64 + m * 16 + fr] = s;
                    rs[ai][m] = s;
                }
            asm volatile("s_waitcnt lgkmcnt(0)" ::: "memory"); __builtin_amdgcn_s_barrier(); asm volatile("" ::: "memory");
#pragma unroll
            for (int ai = 0; ai < 2; ++ai)
#pragma unroll
                for (int m = 0; m < 4; ++m) { const float o = xch[(wid ^ 1) * 128 + ai * 64 + m * 16 + fr]; rs[ai][m] = __builtin_amdgcn_rsqf((rs[ai][m] + o) * (1.0f / 128.0f) + 1e-6f); }
        }
#pragma unroll
        for (int ai = 0; ai < 2; ++ai)
#pragma unroll
            for (int m = 0; m < 4; ++m) {
                const int rt = ai * HALF + wr * 64 + m * 16 + fr;
                f32x4 lo[2], hi[2];
#pragma unroll
                for (int n = 0; n < 2; ++n) { lo[n] = acc[ai][0][m][n] * rs[ai][m] * gv[0][n]; hi[n] = acc[ai][1][m][n] * rs[ai][m] * gv[1][n]; }
                if (dorope) {
                    const int t = t0 + rt, pos = part ? (t & 63) : (t >> 6);
#pragma unroll
                    for (int n = 0; n < 2; ++n) {
                        const f32x4 c4 = *(const f32x4*)(ropec + pos * 32 + 8 * fq + 4 * n), s4 = *(const f32x4*)(ropes + pos * 32 + 8 * fq + 4 * n);
                        const f32x4 a = lo[n], bb = hi[n];
                        lo[n] = a * c4 - bb * s4; hi[n] = bb * c4 + a * s4;
                    }
                }
                if (false) {
                bf16_t* rowp = base + (size_t)rt * rstride + d0;
                u32x4 w0, w1;
                w0.x = cvt_pk_bf16(lo[0][0], lo[0][1]); w0.y = cvt_pk_bf16(lo[0][2], lo[0][3]); w0.z = cvt_pk_bf16(lo[1][0], lo[1][1]); w0.w = cvt_pk_bf16(lo[1][2], lo[1][3]);
                w1.x = cvt_pk_bf16(hi[0][0], hi[0][1]); w1.y = cvt_pk_bf16(hi[0][2], hi[0][3]); w1.z = cvt_pk_bf16(hi[1][0], hi[1][1]); w1.w = cvt_pk_bf16(hi[1][2], hi[1][3]);
                *(u32x4*)(rowp) = w0; *(u32x4*)(rowp + 32) = w1;
                } else {
                unsigned char* rowp = base8 + (size_t)rt * rstride + d0;
                typedef unsigned u2v __attribute__((ext_vector_type(2))); u2v w0, w1;
#define QK8(a, b, c, d) ({ int t_ = __builtin_amdgcn_cvt_pk_fp8_f32(__builtin_fminf(__builtin_fmaxf((a) * 16.f, -448.f), 448.f), __builtin_fminf(__builtin_fmaxf((b) * 16.f, -448.f), 448.f), 0, false); \
                        (unsigned)__builtin_amdgcn_cvt_pk_fp8_f32(__builtin_fminf(__builtin_fmaxf((c) * 16.f, -448.f), 448.f), __builtin_fminf(__builtin_fmaxf((d) * 16.f, -448.f), 448.f), t_, true); })
                w0.x = QK8(lo[0][0], lo[0][1], lo[0][2], lo[0][3]); w0.y = QK8(lo[1][0], lo[1][1], lo[1][2], lo[1][3]);
                w1.x = QK8(hi[0][0], hi[0][1], hi[0][2], hi[0][3]); w1.y = QK8(hi[1][0], hi[1][1], hi[1][2], hi[1][3]);
#undef QK8
                *(u2v*)(rowp) = w0; *(u2v*)(rowp + 32) = w1;
                }
            }
    }
};

struct EpiResid {
    static constexpr bool PERM = false, AFTER_DRAIN = false;
    const float* res; const float* gate; float* out; float alpha;
    __device__ __forceinline__ void operator()(const f32x4 (&acc)[2][2][4][2], const Unit& u, int wr, int wc, int fr, int fq) const {
        const int row0 = u.pm * BM + wr * 64 + fr, col0 = u.pn * BM + wc * 32 + 4 * fq, b = u.pm >> 4;
        f32x4 gv[2][2];
#pragma unroll
        for (int bj = 0; bj < 2; ++bj)
#pragma unroll
            for (int n = 0; n < 2; ++n) gv[bj][n] = *(const f32x4*)(gate + b * 12288 + col0 + bj * HALF + n * 16);
#pragma unroll
        for (int ai = 0; ai < 2; ++ai)
#pragma unroll
            for (int m = 0; m < 4; ++m) { const size_t off = (size_t)(row0 + ai * HALF + m * 16) * 2048 + col0;
#pragma unroll
                for (int bj = 0; bj < 2; ++bj)
#pragma unroll
                    for (int n = 0; n < 2; ++n) { const f32x4 xv = *(const f32x4*)(res + off + bj * HALF + n * 16);
                        *(f32x4*)(out + off + bj * HALF + n * 16) = xv * alpha + gv[bj][n] * acc[ai][bj][m][n]; } }
    }
};


struct EpiBf16Plain {
    static constexpr bool PERM = true, AFTER_DRAIN = false;
    bf16_t* O; int ldc;
    __device__ __forceinline__ void operator()(const f32x4 (&acc)[2][2][4][2], const Unit& u, int wr, int wc, int fr, int fq) const {
        const int row0 = u.pm * BM + wr * 64 + fr, col0 = u.pn * BM + wc * 32 + 8 * fq;
#pragma unroll
        for (int ai = 0; ai < 2; ++ai)
#pragma unroll
            for (int m = 0; m < 4; ++m) { bf16_t* rowp = O + (size_t)(row0 + ai * HALF + m * 16) * ldc + col0;
#pragma unroll
                for (int bj = 0; bj < 2; ++bj) { const f32x4 v0 = acc[ai][bj][m][0], v1 = acc[ai][bj][m][1];
                    u32x4 w; w.x = cvt_pk_bf16(v0[0], v0[1]); w.y = cvt_pk_bf16(v0[2], v0[3]); w.z = cvt_pk_bf16(v1[0], v1[1]); w.w = cvt_pk_bf16(v1[2], v1[3]);
                    *(u32x4*)(rowp + bj * HALF) = w; } }
    }
};


struct EpiFp8Plain {
    static constexpr bool PERM = true, AFTER_DRAIN = false;
    unsigned char* O; int ldc; float scl;
    __device__ __forceinline__ void operator()(const f32x4 (&acc)[2][2][4][2], const Unit& u, int wr, int wc, int fr, int fq) const {
        const int row0 = u.pm * BM + wr * 64 + fr, col0 = u.pn * BM + wc * 32 + 8 * fq;
        typedef unsigned u2v __attribute__((ext_vector_type(2)));
#pragma unroll
        for (int ai = 0; ai < 2; ++ai)
#pragma unroll
            for (int m = 0; m < 4; ++m) { unsigned char* rowp = O + (size_t)(row0 + ai * HALF + m * 16) * ldc + col0;
#pragma unroll
                for (int bj = 0; bj < 2; ++bj) { const f32x4 v0 = acc[ai][bj][m][0] * scl, v1 = acc[ai][bj][m][1] * scl; u2v w;
                    { int t = __builtin_amdgcn_cvt_pk_fp8_f32(__builtin_fminf(__builtin_fmaxf(v0[0], -448.f), 448.f), __builtin_fminf(__builtin_fmaxf(v0[1], -448.f), 448.f), 0, false);
                      w.x = (unsigned)__builtin_amdgcn_cvt_pk_fp8_f32(__builtin_fminf(__builtin_fmaxf(v0[2], -448.f), 448.f), __builtin_fminf(__builtin_fmaxf(v0[3], -448.f), 448.f), t, true); }
                    { int t = __builtin_amdgcn_cvt_pk_fp8_f32(__builtin_fminf(__builtin_fmaxf(v1[0], -448.f), 448.f), __builtin_fminf(__builtin_fmaxf(v1[1], -448.f), 448.f), 0, false);
                      w.y = (unsigned)__builtin_amdgcn_cvt_pk_fp8_f32(__builtin_fminf(__builtin_fmaxf(v1[2], -448.f), 448.f), __builtin_fminf(__builtin_fmaxf(v1[3], -448.f), 448.f), t, true); }
                    *(u2v*)(rowp + bj * HALF) = w; } }
    }
};

struct EpiSwiglu {
    static constexpr bool PERM = true, AFTER_DRAIN = false;
    bf16_t* H; int ldh;
    __device__ __forceinline__ void operator()(const f32x4 (&acc)[2][2][4][2], const Unit& u, int wr, int wc, int fr, int fq) const {
        const int row0 = u.pm * BM + wr * 64 + fr, col0 = u.pn * 128 + wc * 32 + 8 * fq;
#pragma unroll
        for (int ai = 0; ai < 2; ++ai)
#pragma unroll
            for (int m = 0; m < 4; ++m) { bf16_t* rowp = H + (size_t)(row0 + ai * HALF + m * 16) * ldh + col0;
                f32x4 o[2];
#pragma unroll
                for (int n = 0; n < 2; ++n) { const f32x4 g = acc[ai][0][m][n], up = acc[ai][1][m][n];
#pragma unroll
                    for (int e = 0; e < 4; ++e) { const float sg = __builtin_amdgcn_rcpf(1.0f + __builtin_amdgcn_exp2f(-1.4426950408889634f * g[e])); o[n][e] = g[e] * sg * up[e]; } }
                u32x4 w; w.x = cvt_pk_bf16(o[0][0], o[0][1]); w.y = cvt_pk_bf16(o[0][2], o[0][3]); w.z = cvt_pk_bf16(o[1][0], o[1][1]); w.w = cvt_pk_bf16(o[1][2], o[1][3]);
                *(u32x4*)rowp = w; }
    }
};


struct EpiSwiglu8 {
    static constexpr bool PERM = true, AFTER_DRAIN = false;
    bf16_t* H; int ldh; const float* rowscale; float dqg, dqu;
    __device__ __forceinline__ void operator()(const f32x4 (&acc)[2][2][4][2], const Unit& u, int wr, int wc, int fr, int fq) const {
        const int row0 = u.pm * BM + wr * 64 + fr, col0 = u.pn * 128 + wc * 32 + 8 * fq;
#pragma unroll
        for (int ai = 0; ai < 2; ++ai)
#pragma unroll
            for (int m = 0; m < 4; ++m) { const int row = row0 + ai * HALF + m * 16; bf16_t* rowp = H + (size_t)row * ldh + col0;
                const float rs = rowscale[row], sg_ = rs * dqg, su_ = rs * dqu;
                f32x4 o[2];
#pragma unroll
                for (int n = 0; n < 2; ++n) { const v4i_t gi = __builtin_bit_cast(v4i_t, acc[ai][0][m][n]), ui = __builtin_bit_cast(v4i_t, acc[ai][1][m][n]);
#pragma unroll
                    for (int e = 0; e < 4; ++e) { const float g = (float)gi[e] * sg_, up = (float)ui[e] * su_;
                        const float sg = __builtin_amdgcn_rcpf(1.0f + __builtin_amdgcn_exp2f(-1.4426950408889634f * g)); o[n][e] = g * sg * up; } }
                u32x4 w; w.x = cvt_pk_bf16(o[0][0], o[0][1]); w.y = cvt_pk_bf16(o[0][2], o[0][3]); w.z = cvt_pk_bf16(o[1][0], o[1][1]); w.w = cvt_pk_bf16(o[1][2], o[1][3]);
                *(u32x4*)rowp = w; }
    }
};

__device__ __forceinline__ v8i_t cat16(bf16x8 a, bf16x8 b) { return __builtin_shufflevector(__builtin_bit_cast(v4i_t, a), __builtin_bit_cast(v4i_t, b), 0, 1, 2, 3, 4, 5, 6, 7); }
template <class Epi, class Sched, bool ALIGN_EPI = false, bool SP2 = false, int SCW = 0, int SCA = 0, bool SWAPV = false, bool I8 = false>
__device__ __forceinline__ void gemm_phase(PG8_LAS unsigned char* lds, const Gemm g, const Sched& S, const Epi& E) {
    const int tid = threadIdx.x, wid = __builtin_amdgcn_readfirstlane(tid >> 6), lane = tid & 63, wr = wid >> 2, wc = wid & 3, fr = lane & 15, fq = lane >> 4;
    const int K = g.K, nt = K / BK;
    unsigned voffA[2], voffB[2];
#pragma unroll
    for (int i = 0; i < 2; ++i) { int R, C; stage_rc(tid * 16 + i * 8192, R, C); const int Rb = Epi::PERM ? ((R & ~31) + perm32(R & 31)) : R;
        voffA[i] = (unsigned)(R * K + C) * 2u; voffB[i] = (unsigned)(Rb * K + C) * 2u; }
    const size_t kstep = (size_t)(BK * 2);
    const size_t hstep = (size_t)HALF * K * 2;
    const size_t tstep = 2 * hstep;
    const unsigned ldsw = (unsigned)wid * 1024u;
    const int aoff = lds_byte(wr * 64 + fr, fq * 8), boff = lds_byte(wc * 32 + fr, fq * 8);
#define PG8_SA(b, h) (((b) * 2 + (h)) * HTB)
#define PG8_SB(b, h) ((4 + (b) * 2 + (h)) * HTB)
#define PG8_STAGE(bufoff, gbase, voff) do { _Pragma("unroll") for (int _i = 0; _i < 2; ++_i) \
        __builtin_amdgcn_global_load_lds((const unsigned*)((const char*)(gbase) + (voff)[_i]), (PG8_LAS unsigned*)(lds + (bufoff) + ldsw + _i * 8192), 16, 0, 0); } while (0)
#define PG8_LDA(dst, b, h) do { _Pragma("unroll") for (int m = 0; m < 4; ++m) { if constexpr (SCW != 0) dst##8[m] = cat16(*(const PG8_LAS bf16x8*)(lds + PG8_SA(b, h) + aoff + m * 2048), *(const PG8_LAS bf16x8*)(lds + PG8_SA(b, h) + aoff + m * 2048 + 1024)); \
        else { _Pragma("unroll") for (int k = 0; k < 2; ++k) dst[m][k] = *(const PG8_LAS bf16x8*)(lds + PG8_SA(b, h) + aoff + m * 2048 + k * 1024); } } } while (0)
#define PG8_LDB(dst, b, h) do { _Pragma("unroll") for (int n = 0; n < 2; ++n) { if constexpr (SCW != 0) dst##8[n] = cat16(*(const PG8_LAS bf16x8*)(lds + PG8_SB(b, h) + boff + n * 2048), *(const PG8_LAS bf16x8*)(lds + PG8_SB(b, h) + boff + n * 2048 + 1024)); \
        else { _Pragma("unroll") for (int k = 0; k < 2; ++k) dst[n][k] = *(const PG8_LAS bf16x8*)(lds + PG8_SB(b, h) + boff + n * 2048 + k * 1024); } } } while (0)
#define PG8_MMA(ai, bj, At, Bt) do { __builtin_amdgcn_s_setprio(1); _Pragma("unroll") for (int m = 0; m < 4; ++m) _Pragma("unroll") for (int n = 0; n < 2; ++n) { \
        if constexpr (SCW != 0) asm volatile("v_mfma_scale_f32_16x16x128_f8f6f4 %0, %1, %2, %0, %3, %4 op_sel_hi:[0,0,0]" : "+v"(acc[ai][bj][m][n]) : "v"(Bt##8[n]), "v"(At##8[m]), "v"(scw_), "v"(sca_));     \
        else if constexpr (I8) { _Pragma("unroll") for (int k = 0; k < 2; ++k) acc[ai][bj][m][n] = __builtin_bit_cast(f32x4, __builtin_amdgcn_mfma_i32_16x16x64_i8(__builtin_bit_cast(v4i_t, Bt[n][k]), __builtin_bit_cast(v4i_t, At[m][k]), __builtin_bit_cast(v4i_t, acc[ai][bj][m][n]), 0, 0, 0)); } \
        else { _Pragma("unroll") for (int k = 0; k < 2; ++k) acc[ai][bj][m][n] = __builtin_amdgcn_mfma_f32_16x16x32_bf16(Bt[n][k], At[m][k], acc[ai][bj][m][n], 0, 0, 0); } } \
        __builtin_amdgcn_s_setprio(0); } while (0)
#define PG8_WAIT_V(n) asm volatile("s_waitcnt vmcnt(" #n ")" ::: "memory")
#define PG8_WAIT_L(n) asm volatile("s_waitcnt lgkmcnt(" #n ")" ::: "memory")
#define PG8_BAR __builtin_amdgcn_s_barrier()
#define PG8_SCHED __builtin_amdgcn_sched_barrier(0)
    Unit cur, nxt; int ui = 0;
    if (!S.next(0, cur)) return;
    f32x4 acc[2][2][4][2];
#pragma unroll
    for (int a = 0; a < 2; ++a)
#pragma unroll
        for (int b = 0; b < 2; ++b)
#pragma unroll
            for (int m = 0; m < 4; ++m)
#pragma unroll
                for (int n = 0; n < 2; ++n) acc[a][b][m][n] = (f32x4){0.f, 0.f, 0.f, 0.f};
    int scw_ = SCW, sca_ = SCA; asm volatile("" : "+v"(scw_), "+v"(sca_));
    bf16x8 At[4][2], B0[2][2], B1[2][2]; v8i_t At8[4], B08[2], B18[2];
    const char* cA = (const char*)g.A + (size_t)cur.pm * tstep; const char* cB = (const char*)g.Bt + (size_t)cur.pn * tstep;
    S.a_ready(cur);
    if constexpr (SP2) {
        PG8_STAGE(PG8_SB(0, 0), cB, voffB); PG8_STAGE(PG8_SB(0, 1), cB + hstep, voffB); PG8_STAGE(PG8_SA(0, 0), cA, voffA); PG8_STAGE(PG8_SA(0, 1), cA + hstep, voffA);
        if (wr == 1) PG8_BAR;
        PG8_WAIT_V(2); PG8_BAR;
        PG8_STAGE(PG8_SB(1, 0), cB + kstep, voffB); PG8_STAGE(PG8_SA(1, 0), cA + kstep, voffA); PG8_STAGE(PG8_SB(1, 1), cB + hstep + kstep, voffB);
        PG8_WAIT_V(6); PG8_BAR;
    } else {
        PG8_STAGE(PG8_SB(0, 0), cB, voffB); PG8_STAGE(PG8_SA(0, 0), cA, voffA); PG8_STAGE(PG8_SB(0, 1), cB + hstep, voffB); PG8_STAGE(PG8_SA(0, 1), cA + hstep, voffA);
        if (wr == 1) PG8_BAR;
        PG8_WAIT_V(4); PG8_BAR;
        PG8_STAGE(PG8_SB(1, 0), cB + kstep, voffB); PG8_STAGE(PG8_SA(1, 0), cA + kstep, voffA); PG8_STAGE(PG8_SB(1, 1), cB + hstep + kstep, voffB);
        PG8_WAIT_V(6); PG8_BAR;
    }
    for (;;) {
        const bool has_next = S.next(ui + 1, nxt);
        const char* nA = has_next ? (const char*)g.A + (size_t)nxt.pm * tstep : cA; const char* nB = has_next ? (const char*)g.Bt + (size_t)nxt.pn * tstep : cB;
        for (int t = 0; t < nt; t += 2) {
            const bool last = (t == nt - 2);
            const char* a1 = cA + (size_t)(t + 1) * kstep;
            const char* a2 = last ? nA : cA + (size_t)(t + 2) * kstep; const char* b2 = last ? nB : cB + (size_t)(t + 2) * kstep;
            const char* a3 = a2 + kstep; const char* b3 = b2 + kstep;
            if (last && has_next) S.a_ready(nxt);
            if constexpr (SP2) {
            PG8_LDB(B0, 0, 0); PG8_LDB(B1, 0, 1); PG8_SCHED; PG8_LDA(At, 0, 0); PG8_STAGE(PG8_SA(1, 1), a1 + hstep, voffA);
            PG8_WAIT_V(8); PG8_WAIT_L(0); PG8_BAR; PG8_MMA(0, 0, At, B0); PG8_MMA(0, 1, At, B1); PG8_BAR; PG8_SCHED;
            PG8_LDA(At, 0, 1); PG8_STAGE(PG8_SB(0, 0), b2, voffB); PG8_STAGE(PG8_SB(0, 1), b2 + hstep, voffB); PG8_STAGE(PG8_SA(0, 0), a2, voffA);
            PG8_WAIT_V(8); PG8_WAIT_L(0); PG8_BAR; PG8_MMA(1, 0, At, B0); PG8_MMA(1, 1, At, B1); PG8_BAR; PG8_SCHED;
            PG8_LDB(B0, 1, 0); PG8_LDB(B1, 1, 1); PG8_SCHED; PG8_LDA(At, 1, 0); PG8_STAGE(PG8_SA(0, 1), a2 + hstep, voffA);
            PG8_WAIT_V(8); PG8_WAIT_L(0); PG8_BAR; PG8_MMA(0, 0, At, B0); PG8_MMA(0, 1, At, B1); PG8_BAR; PG8_SCHED;
            PG8_LDA(At, 1, 1); PG8_STAGE(PG8_SB(1, 0), b3, voffB); PG8_STAGE(PG8_SB(1, 1), b3 + hstep, voffB); PG8_STAGE(PG8_SA(1, 0), a3, voffA);
            PG8_WAIT_V(8); PG8_WAIT_L(0); PG8_BAR; PG8_MMA(1, 0, At, B0); PG8_MMA(1, 1, At, B1); PG8_BAR; PG8_SCHED;
            } else {
            PG8_LDB(B0, 0, 0); PG8_SCHED; PG8_LDA(At, 0, 0); PG8_STAGE(PG8_SA(1, 1), a1 + hstep, voffA);
            PG8_WAIT_L(8); PG8_BAR; PG8_WAIT_L(0); PG8_MMA(0, 0, At, B0); PG8_BAR; PG8_SCHED;
            PG8_LDB(B1, 0, 1); PG8_STAGE(PG8_SB(0, 0), b2, voffB);
            PG8_BAR; PG8_WAIT_L(0); PG8_MMA(0, 1, At, B1); PG8_BAR;
            PG8_LDA(At, 0, 1); PG8_STAGE(PG8_SA(0, 0), a2, voffA);
            PG8_BAR; PG8_WAIT_L(0); PG8_MMA(1, 0, At, B0); PG8_BAR; PG8_SCHED;
            PG8_STAGE(PG8_SB(0, 1), b2 + hstep, voffB);
            PG8_WAIT_V(6); PG8_BAR; PG8_MMA(1, 1, At, B1); PG8_BAR;
            PG8_LDB(B0, 1, 0); PG8_SCHED; PG8_LDA(At, 1, 0); PG8_STAGE(PG8_SA(0, 1), a2 + hstep, voffA);
            PG8_WAIT_L(8); PG8_BAR; PG8_WAIT_L(0); PG8_MMA(0, 0, At, B0); PG8_BAR; PG8_SCHED;
            PG8_LDB(B1, 1, 1); PG8_STAGE(PG8_SB(1, 0), b3, voffB);
            PG8_BAR; PG8_WAIT_L(0); PG8_MMA(0, 1, At, B1); PG8_BAR;
            PG8_LDA(At, 1, 1); PG8_STAGE(PG8_SA(1, 0), a3, voffA);
            PG8_BAR; PG8_WAIT_L(0); PG8_MMA(1, 0, At, B0); PG8_BAR; PG8_SCHED;
            PG8_STAGE(PG8_SB(1, 1), b3 + hstep, voffB);
            PG8_WAIT_V(6); PG8_BAR; PG8_MMA(1, 1, At, B1); PG8_BAR;
            }
        }
        if constexpr (ALIGN_EPI) { if (wr == 0) PG8_BAR; }
        if constexpr (SCW != 0) asm volatile("s_nop 15\n\ts_nop 15" ::: "memory");
        if constexpr (!Epi::AFTER_DRAIN) { E(acc, cur, wr, wc, fr, fq); S.done(cur); }
        if (!has_next) break;
#pragma unroll
        for (int a = 0; a < 2; ++a)
#pragma unroll
            for (int b = 0; b < 2; ++b)
#pragma unroll
                for (int m = 0; m < 4; ++m)
#pragma unroll
                    for (int n = 0; n < 2; ++n) acc[a][b][m][n] = (f32x4){0.f, 0.f, 0.f, 0.f};
        cur = nxt; cA = nA; cB = nB; ++ui;
        if constexpr (ALIGN_EPI) { if (wr == 1) PG8_BAR; }
    }
    PG8_WAIT_V(0);
    if constexpr (!ALIGN_EPI) { if (wr == 0) PG8_BAR; }
    PG8_BAR;
#undef PG8_SA
#undef PG8_SB
#undef PG8_STAGE
#undef PG8_LDA
#undef PG8_LDB
#undef PG8_MMA
#undef PG8_WAIT_V
#undef PG8_WAIT_L
#undef PG8_BAR
#undef PG8_SCHED
}
}

namespace att {
typedef unsigned short bf16;
using bf16x8 = __attribute__((ext_vector_type(8))) short;
using s16x4  = __attribute__((ext_vector_type(4))) short;
using f32x16 = __attribute__((ext_vector_type(16))) float;
using u32x4  = __attribute__((ext_vector_type(4))) unsigned;
typedef int v8i __attribute__((ext_vector_type(8))); typedef int v4i __attribute__((ext_vector_type(4)));
constexpr int D = 128, NW = 8, QBLK = 32, KVBLK = 64;
constexpr float SCALE = 0.088388347648318440f;
constexpr float THR = 1.5f;
constexpr float PSHIFT = 6.0f;
constexpr int LDQ = 2048, LDK = 128, LDO = 2048;
constexpr float OSCL = 16.f;
constexpr int SHM_V = KVBLK * D  , SHM_K = KVBLK * D  , SHM_ATTN = 2 * SHM_V + 2 * SHM_K + NW * 64 * 4;
#define KSWZ(row, colB) ((row) * 256 + ((colB) ^ (((row) & 7) << 4)))
#define SBAR() __builtin_amdgcn_sched_barrier(0)
__device__ __forceinline__ int crow(int r, int hi) { return (r & 3) + 8 * (r >> 2) + 4 * hi; }
__device__ __forceinline__ unsigned cvtpk(float lo, float hi) { unsigned r; asm volatile("v_cvt_pk_bf16_f32 %0, %1, %2" : "=v"(r) : "v"(lo), "v"(hi)); return r; }

__device__ __forceinline__ void partialSM(f32x16& p0, f32x16& p1, float& m_reg, float& mn, float& alpha, bool fixedm) {
  constexpr float C = SCALE * 1.4426950408889634f;
  if (fixedm) { mn = m_reg; alpha = 1.f; }
  else {
  float pmax = p0[0]; for (int r = 1; r < 16; ++r) pmax = fmaxf(pmax, p0[r]); for (int r = 0; r < 16; ++r) pmax = fmaxf(pmax, p1[r]);
  { auto rr = __builtin_amdgcn_permlane32_swap(__float_as_uint(pmax), __float_as_uint(pmax), false, false);
    pmax = fmaxf(__uint_as_float(rr[0]), __uint_as_float(rr[1])); }
  if (__builtin_expect(__all(pmax - m_reg <= THR / SCALE), 1)) { mn = m_reg; alpha = 1.f; }
  else { mn = fmaxf(m_reg, pmax); alpha = __builtin_amdgcn_exp2f((m_reg - mn) * C); m_reg = mn; }
  }
  float mnC = -mn * C + PSHIFT;
  for (int r = 0; r < 16; ++r) p0[r] = fmaf(p0[r], C, mnC); for (int r = 0; r < 16; ++r) p1[r] = fmaf(p1[r], C, mnC);
  for (int r = 0; r < 16; ++r) p0[r] = __builtin_amdgcn_exp2f(p0[r]);
}
__device__ __forceinline__ void finishSM8(f32x16& p0, f32x16& p1, float alpha, float& l_reg, v8i& pa) {
  for (int r = 0; r < 16; ++r) p1[r] = __builtin_amdgcn_exp2f(p1[r]);
  float ps = 0; for (int r = 0; r < 16; ++r) ps += p0[r]; for (int r = 0; r < 16; ++r) ps += p1[r];
  { auto rr = __builtin_amdgcn_permlane32_swap(__float_as_uint(ps), __float_as_uint(ps), false, false);
    ps = __uint_as_float(rr[0]) + __uint_as_float(rr[1]); }
  l_reg = l_reg * alpha + ps * (1.0f / 64.0f);
#pragma unroll
  for (int w = 0; w < 4; ++w) {
    int t0_ = __builtin_amdgcn_cvt_pk_fp8_f32(p0[4 * w], p0[4 * w + 1], 0, false); pa[w] = __builtin_amdgcn_cvt_pk_fp8_f32(p0[4 * w + 2], p0[4 * w + 3], t0_, true);
    int t1_ = __builtin_amdgcn_cvt_pk_fp8_f32(p1[4 * w], p1[4 * w + 1], 0, false); pa[4 + w] = __builtin_amdgcn_cvt_pk_fp8_f32(p1[4 * w + 2], p1[4 * w + 3], t1_, true); }
}
__device__ __forceinline__ void finishSM(f32x16& p0, f32x16& p1, float alpha, float& l_reg, bf16x8& pa0, bf16x8& pa1, bf16x8& pa2, bf16x8& pa3) {
  for (int r = 0; r < 16; ++r) p1[r] = __builtin_amdgcn_exp2f(p1[r]);
  float ps = 0; for (int r = 0; r < 16; ++r) ps += p0[r]; for (int r = 0; r < 16; ++r) ps += p1[r];
  { auto rr = __builtin_amdgcn_permlane32_swap(__float_as_uint(ps), __float_as_uint(ps), false, false);
    ps = __uint_as_float(rr[0]) + __uint_as_float(rr[1]); }
  l_reg = l_reg * alpha + ps;
#define PK4(P, BASE, OUT) do { unsigned a0 = cvtpk(P[BASE + 0], P[BASE + 1]), a1 = cvtpk(P[BASE + 2], P[BASE + 3]);   \
    unsigned b0 = cvtpk(P[BASE + 4], P[BASE + 5]), b1 = cvtpk(P[BASE + 6], P[BASE + 7]);                              \
    auto r0 = __builtin_amdgcn_permlane32_swap(a0, b0, false, false); auto r1 = __builtin_amdgcn_permlane32_swap(a1, b1, false, false); \
    u32x4 w = {r0[0], r1[0], r0[1], r1[1]}; OUT = *reinterpret_cast<bf16x8*>(&w); } while (0)
  PK4(p0, 0, pa0); PK4(p0, 8, pa1); PK4(p1, 0, pa2); PK4(p1, 8, pa3);
#undef PK4
}
__device__ __forceinline__ void qkt(f32x16& p0, f32x16& p1, const bf16* Ks, const bf16x8* qr, int r32, int hi) {
  p0 = f32x16{}; p1 = f32x16{};
  for (int d0 = 0; d0 < 8; ++d0) { int cb = (d0 * 16 + hi * 8) * 2;
    bf16x8 b0 = *reinterpret_cast<const bf16x8*>((const char*)Ks + KSWZ(r32, cb));
    bf16x8 b1 = *reinterpret_cast<const bf16x8*>((const char*)Ks + KSWZ(32 + r32, cb));
    p0 = __builtin_amdgcn_mfma_f32_32x32x16_bf16(b0, qr[d0], p0, 0, 0, 0);
    p1 = __builtin_amdgcn_mfma_f32_32x32x16_bf16(b1, qr[d0], p1, 0, 0, 0); }
}
__device__ __forceinline__ void wmask(f32x16& p0, f32x16& p1, int kb, int qpos) {
  const int dq = qpos - kb + 128;
#pragma unroll
  for (int r = 0; r < 16; ++r) { const int d = dq - ((r & 3) + 8 * (r >> 2));
    if ((unsigned)d > 256u) p0[r] = -INFINITY;
    if ((unsigned)(d - 32) > 256u) p1[r] = -INFINITY; }
}
__device__ __forceinline__ int v_st(int k, int c) { const int kk = (k & ~0xC) | ((k & 4) << 1) | ((k & 8) >> 1); return ((kk >> 3) * 4 + (c >> 5)) * 512 + ((kk & 7) * 32 + (c & 31)) * 2; }
__device__ __forceinline__ int v_rd_base(int lane) { return ((lane & 3) << 3) | (((lane >> 2) & 3) << 6) | (((lane >> 4) & 1) << 5) | (((lane >> 5) & 1) << 8); }
constexpr int v_rd_off(int d0, int ks, int half) { return d0 * 512 + ks * 4096 + half * 2048; }
template <int OFF> __device__ __forceinline__ s16x4 tr_read(int vb) {
  s16x4 r; asm volatile("ds_read_b64_tr_b16 %0, %1 offset:%2" : "=&v"(r) : "v"(vb), "i"(OFF) : "memory"); return r;
}
template <int D0> __device__ __forceinline__ void pv_one(f32x16& od, int vb, bf16x8 pa0, bf16x8 pa1, bf16x8 pa2, bf16x8 pa3) {
  const s16x4 l0 = tr_read<v_rd_off(D0, 0, 0)>(vb), h0 = tr_read<v_rd_off(D0, 0, 1)>(vb), l1 = tr_read<v_rd_off(D0, 1, 0)>(vb), h1 = tr_read<v_rd_off(D0, 1, 1)>(vb);
  const s16x4 l2 = tr_read<v_rd_off(D0, 2, 0)>(vb), h2 = tr_read<v_rd_off(D0, 2, 1)>(vb), l3 = tr_read<v_rd_off(D0, 3, 0)>(vb), h3 = tr_read<v_rd_off(D0, 3, 1)>(vb);
  asm volatile("s_waitcnt lgkmcnt(0)" ::: "memory"); SBAR();
#define PK(L, H) (bf16x8){L[0], L[1], L[2], L[3], H[0], H[1], H[2], H[3]}
  od = __builtin_amdgcn_mfma_f32_32x32x16_bf16(pa0, PK(l0, h0), od, 0, 0, 0);
  od = __builtin_amdgcn_mfma_f32_32x32x16_bf16(pa1, PK(l1, h1), od, 0, 0, 0);
  od = __builtin_amdgcn_mfma_f32_32x32x16_bf16(pa2, PK(l2, h2), od, 0, 0, 0);
  od = __builtin_amdgcn_mfma_f32_32x32x16_bf16(pa3, PK(l3, h3), od, 0, 0, 0);
#undef PK
}
__device__ __forceinline__ void pv_d0(f32x16* o, int vb, bf16x8 pa0, bf16x8 pa1, bf16x8 pa2, bf16x8 pa3) {
  pv_one<0>(o[0], vb, pa0, pa1, pa2, pa3); pv_one<1>(o[1], vb, pa0, pa1, pa2, pa3); pv_one<2>(o[2], vb, pa0, pa1, pa2, pa3); pv_one<3>(o[3], vb, pa0, pa1, pa2, pa3);
}

struct Stg { v4i v8; v4i k8; };
#define V8OFF(d, ch) ((d) * 64 + ((((ch) ^ (((d) >> 2) & 3))) << 4))
#define K8OFF(row, ch) ((row) * 128 + ((((ch) ^ (((row) >> 1) & 7))) << 4))
__device__ __forceinline__ v8i cat8(v4i a, v4i b) { return __builtin_shufflevector(a, b, 0, 1, 2, 3, 4, 5, 6, 7); }
__device__ __forceinline__ void qkt8(f32x16& p0, f32x16& p1, const char* Ks, const v8i (&q8)[2], int r32, int hi, int sc) {
  const v8i a00 = cat8(*(const v4i*)(Ks + K8OFF(r32, 2 * hi)), *(const v4i*)(Ks + K8OFF(r32, 2 * hi + 1)));
  const v8i a10 = cat8(*(const v4i*)(Ks + K8OFF(32 + r32, 2 * hi)), *(const v4i*)(Ks + K8OFF(32 + r32, 2 * hi + 1)));
  const v8i a01 = cat8(*(const v4i*)(Ks + K8OFF(r32, 4 + 2 * hi)), *(const v4i*)(Ks + K8OFF(r32, 4 + 2 * hi + 1)));
  const v8i a11 = cat8(*(const v4i*)(Ks + K8OFF(32 + r32, 4 + 2 * hi)), *(const v4i*)(Ks + K8OFF(32 + r32, 4 + 2 * hi + 1)));
  asm volatile("s_nop 1\n\tv_mfma_scale_f32_32x32x64_f8f6f4 %0, %1, %2, 0, %3, %3 op_sel_hi:[0,0,0]" : "=&v"(p0) : "v"(a00), "v"(q8[0]), "v"(sc));
  asm volatile("s_nop 1\n\tv_mfma_scale_f32_32x32x64_f8f6f4 %0, %1, %2, 0, %3, %3 op_sel_hi:[0,0,0]" : "=&v"(p1) : "v"(a10), "v"(q8[0]), "v"(sc));
  asm volatile("s_nop 1\n\tv_mfma_scale_f32_32x32x64_f8f6f4 %0, %1, %2, %0, %3, %3 op_sel_hi:[0,0,0]" : "+v"(p0) : "v"(a01), "v"(q8[1]), "v"(sc));
  asm volatile("s_nop 1\n\tv_mfma_scale_f32_32x32x64_f8f6f4 %0, %1, %2, %0, %3, %3 op_sel_hi:[0,0,0]" : "+v"(p1) : "v"(a11), "v"(q8[1]), "v"(sc));
}
__device__ __forceinline__ void pv8(f32x16* o, const char* Vs, const v8i& pa, int r32, int hi, int scp, int scv) {
#pragma unroll
  for (int d0 = 0; d0 < 4; ++d0) { const int d = 32 * d0 + r32;
    const v8i bfr = cat8(*(const v4i*)(Vs + V8OFF(d, 2 * hi)), *(const v4i*)(Vs + V8OFF(d, 2 * hi + 1)));
    asm volatile("s_nop 1\n\tv_mfma_scale_f32_32x32x64_f8f6f4 %0, %1, %2, %0, %3, %4 op_sel_hi:[0,0,0]" : "+v"(o[d0]) : "v"(pa), "v"(bfr), "v"(scp), "v"(scv)); }
}
#define O_SETTLE() asm volatile("s_nop 15\n\ts_nop 7" : "+v"(o[0]), "+v"(o[1]), "+v"(o[2]), "+v"(o[3]))
#define QKT_SETTLE(P0, P1) asm volatile("s_nop 15\n\ts_nop 7" : "+v"(P0), "+v"(P1))
struct AUnit { const unsigned char* Q; const unsigned char* K; const unsigned char* V; unsigned char* O; int NT, nctx, jlo, q0; bool masked; float sinkl2, kbound; };
#define KOFU(u, t) (((t) < (u).nctx) ? (4096 + 64 * (t)) : 64 * ((u).jlo + (t) - (u).nctx))
#define SLOADX(dst, Kp, Vp, k0) do { const int k0_ = (k0); (dst).v8 = *reinterpret_cast<const v4i*>(&(Vp)[(long)(tid >> 2) * 4352 + k0_ + (tid & 3) * 16]); \
    (dst).k8 = *reinterpret_cast<const v4i*>(&(Kp)[(long)(k0_ + (tid >> 3)) * 128 + (tid & 7) * 16]); } while (0)
__device__ __forceinline__ void attn_prime(const AUnit& u, v8i (&qr)[2], Stg (&sr_)[2]) {
  const int tid = threadIdx.x, wid = tid >> 6, lane = tid & 63, r32 = lane & 31, hi = lane >> 5;
  const unsigned char* Qw = u.Q + (long)(wid * QBLK + r32) * LDQ + hi * 32;
#pragma unroll
  for (int j = 0; j < 2; ++j) qr[j] = cat8(*reinterpret_cast<const v4i*>(Qw + 64 * j), *reinterpret_cast<const v4i*>(Qw + 64 * j + 16));
  SLOADX(sr_[0], u.K, u.V, KOFU(u, 0)); SLOADX(sr_[1], u.K, u.V, KOFU(u, 1));
}
__device__ __forceinline__ void attn_unit(const AUnit& u, bool has_next, const AUnit& nx, v8i (&qr)[2], Stg (&sr_)[2], char* lds) {
  const int tid = threadIdx.x, wid = tid >> 6, lane = tid & 63, r32 = lane & 31, hi = lane >> 5;
  const unsigned char* __restrict__ Kh = u.K; const unsigned char* __restrict__ Vh = u.V;
  int qksc = (127 - 4) * 0x01010101, pvsc = (127 - 6) * 0x01010101; asm volatile("" : "+v"(qksc), "+v"(pvsc));
  const int NT = u.NT, nctx = u.nctx, jlo = u.jlo; const bool masked = u.masked;
  bf16* V_lds = (bf16*)lds; bf16* K_lds = (bf16*)(lds + 2 * SHM_V);
  float* ws = (float*)(lds + 2 * SHM_V + 2 * SHM_K) + wid * 64; float* li_l = ws; float* al_l = ws + 32;
  float m_reg = -1e30f, l_reg = 0; f32x16 o[4] = {};
  const bool fixedm = u.kbound > 0.f;
  if (fixedm) { float ss = 0.f;
#pragma unroll
    for (int j = 0; j < 2; ++j)
#pragma unroll
      for (int e = 0; e < 8; ++e) { const int w = qr[j][e];
        const float q0_ = __builtin_amdgcn_cvt_f32_fp8(w, 0), q1_ = __builtin_amdgcn_cvt_f32_fp8(w, 1), q2_ = __builtin_amdgcn_cvt_f32_fp8(w, 2), q3_ = __builtin_amdgcn_cvt_f32_fp8(w, 3);
        ss += (q0_ * q0_ + q1_ * q1_) + (q2_ * q2_ + q3_ * q3_); }
    { auto rr = __builtin_amdgcn_permlane32_swap(__float_as_uint(ss), __float_as_uint(ss), false, false); ss = __uint_as_float(rr[0]) + __uint_as_float(rr[1]); }
    m_reg = sqrtf(ss) * (1.0f / 16.0f) * u.kbound; }

  const int qpos = u.q0 + wid * QBLK + r32;
#define KOF(t) (((t) < nctx) ? (4096 + 64 * (t)) : 64 * (jlo + (t) - nctx))
#define SLOAD(i, k0) SLOADX(sr_[i], Kh, Vh, k0)
#define SWRITE(b, i) do { *(v4i*)((char*)V_lds + (b) * SHM_V + V8OFF(tid >> 2, tid & 3)) = sr_[i].v8;          \
    *(v4i*)((char*)K_lds + (b) * SHM_K + K8OFF(tid >> 3, tid & 7)) = sr_[i].k8; } while (0)
#define SWAIT() asm volatile("s_waitcnt vmcnt(4)" ::: "memory")
#define RESC(a) do { if (__any((a) < 1.f)) { if (hi == 0) al_l[r32] = (a); asm volatile("s_waitcnt lgkmcnt(0)" ::: "memory"); O_SETTLE(); \
    for (int d = 0; d < 4; ++d) for (int r = 0; r < 16; ++r) o[d][r] *= al_l[crow(r, hi)]; } } while (0)
#define MASK(P0, P1, t) do { if (masked && (t) >= nctx) wmask(P0, P1, KOF(t) + 4 * hi, qpos); } while (0)
  f32x16 pA0, pA1, pB0, pB1; float mnA, mnB, alA, alB; v8i pa;
  constexpr int SE = 0, SO = 1;
  SWAIT(); SWRITE(0, SE); __syncthreads();
  if (2 < NT) SLOAD(SE, KOF(2));
  qkt8(pA0, pA1, (const char*)K_lds, qr, r32, hi, qksc); QKT_SETTLE(pA0, pA1); MASK(pA0, pA1, 0); partialSM(pA0, pA1, m_reg, mnA, alA, fixedm);
  SWAIT(); SWRITE(1, SO); __syncthreads();
  for (int j = 1; j + 1 < NT; j += 2) {
    SBAR(); qkt8(pB0, pB1, (const char*)K_lds + SHM_K, qr, r32, hi, qksc);
    finishSM8(pA0, pA1, alA, l_reg, pa); SBAR();
    SLOAD(SO, KOF(j + 2)); SBAR();
    pv8(o, (const char*)V_lds, pa, r32, hi, pvsc, qksc); QKT_SETTLE(pB0, pB1); MASK(pB0, pB1, j); partialSM(pB0, pB1, m_reg, mnB, alB, fixedm);
    __syncthreads(); SWAIT(); SWRITE(0, SE);
    RESC(alB); __syncthreads();
    SBAR(); qkt8(pA0, pA1, (const char*)K_lds, qr, r32, hi, qksc);
    finishSM8(pB0, pB1, alB, l_reg, pa); SBAR();
    if (j + 3 < NT) SLOAD(SE, KOF(j + 3)); SBAR();
    pv8(o, (const char*)V_lds + SHM_V, pa, r32, hi, pvsc, qksc); QKT_SETTLE(pA0, pA1); MASK(pA0, pA1, j + 1); partialSM(pA0, pA1, m_reg, mnA, alA, fixedm);
    __syncthreads(); SWAIT(); SWRITE(1, SO);
    RESC(alA); __syncthreads();
  }
  SBAR(); qkt8(pB0, pB1, (const char*)K_lds + SHM_K, qr, r32, hi, qksc);
  finishSM8(pA0, pA1, alA, l_reg, pa); SBAR();
  pv8(o, (const char*)V_lds, pa, r32, hi, pvsc, qksc); QKT_SETTLE(pB0, pB1); MASK(pB0, pB1, NT - 1); partialSM(pB0, pB1, m_reg, mnB, alB, fixedm);
  SBAR(); if (has_next) attn_prime(nx, qr, sr_); SBAR();
  __syncthreads(); RESC(alB);
  finishSM8(pB0, pB1, alB, l_reg, pa); SBAR();
  pv8(o, (const char*)V_lds + SHM_V, pa, r32, hi, pvsc, qksc);
  O_SETTLE();
  l_reg += __builtin_amdgcn_exp2f(u.sinkl2 - m_reg * (SCALE * 1.4426950408889634f));
  if (hi == 0) li_l[r32] = l_reg; asm volatile("s_waitcnt lgkmcnt(0)" ::: "memory");
  float rli[16];
#pragma unroll
  for (int r = 0; r < 16; ++r) rli[r] = __builtin_amdgcn_rcpf(li_l[crow(r, hi)]);
  __syncthreads();
  { char* stg = lds + wid * 8192 + (4 * hi * 128 + r32) * 2;
#pragma unroll
    for (int r = 0; r < 16; ++r) {
#pragma unroll
      for (int d0 = 0; d0 < 4; ++d0) { const float v = o[d0][r] * rli[r]; *(bf16*)(stg + ((r & 3) + 8 * (r >> 2)) * 256 + d0 * 64) = (bf16)(cvtpk(v, v) & 0xffffu); }
      asm volatile("" ::: "memory"); }
    asm volatile("s_waitcnt lgkmcnt(0)" ::: "memory");
    unsigned char* Ow = u.O + (long)(wid * QBLK + (lane >> 4)) * LDO + (lane & 15) * 8;
    const char* rd = lds + wid * 8192 + (lane >> 4) * 256 + (lane & 15) * 16;
#pragma unroll
    for (int i = 0; i < 8; ++i) { const u32x4 v = *(const u32x4*)(rd + i * 1024);
      typedef unsigned u2v __attribute__((ext_vector_type(2))); u2v w;
#define LO16(x) (__uint_as_float((x) << 16) * OSCL)
#define HI16(x) (__uint_as_float((x) & 0xffff0000u) * OSCL)
      { int t = __builtin_amdgcn_cvt_pk_fp8_f32(LO16(v.x), HI16(v.x), 0, false); t = __builtin_amdgcn_cvt_pk_fp8_f32(LO16(v.y), HI16(v.y), t, true); w.x = (unsigned)t; }
      { int t = __builtin_amdgcn_cvt_pk_fp8_f32(LO16(v.z), HI16(v.z), 0, false); t = __builtin_amdgcn_cvt_pk_fp8_f32(LO16(v.w), HI16(v.w), t, true); w.y = (unsigned)t; }
#undef LO16
#undef HI16
      *(u2v*)(Ow + (long)i * 4 * LDO) = w; } }
  __syncthreads();
#undef KOF
#undef SLOAD
#undef SWRITE
#undef SWAIT
#undef RESC
#undef MASK
}
#undef KOFU
#undef SLOADX
#undef K8OFF
#undef V8OFF
#undef QKT_SETTLE
#undef O_SETTLE
#undef KSWZ
#undef SBAR
}

constexpr int NWAVES = 8;
constexpr int N_LAUNCHES = MK_N_LAUNCHES;
constexpr int N_PHASES = 10;
constexpr int DM = 2048, NB = 4, SEQ = 4096, CTXL = 256, FFN = 5632, INW = 3072, NMOD = 12288;
constexpr int M = NB * SEQ, MC = NB * CTXL, MU = M + MC;
constexpr int SKV = SEQ + CTXL;
constexpr float LN_EPS = 1e-6f;
constexpr float DN_ALPHA = 1.189207115002721f;

constexpr size_t MiB = 1u << 20;
constexpr size_t WS_CTL = 0, CTL_ZERO_BYTES = 64 * 1024;
constexpr size_t WS_MODP = 1 * MiB;
constexpr size_t WS_MODS = 2 * MiB;
constexpr size_t WS_ROPE = 2 * MiB + 512 * 1024;
constexpr size_t WS_WIN = 3 * MiB, WS_WOUT = 15 * MiB, WS_WGU = 23 * MiB, WS_WDN = 67 * MiB;
constexpr size_t WS_U = 89 * MiB;
constexpr size_t WS_Y = 157 * MiB;
constexpr size_t WS_QO = 285 * MiB;
constexpr size_t WS_KV = 349 * MiB;
constexpr size_t KV_BYTES = (size_t)NB * 2 * SKV * 128 * 2;
constexpr size_t WS_H = 285 * MiB;
constexpr size_t WS_END = 461 * MiB;
static_assert(WS_WIN + (size_t)INW * DM * 2 <= WS_WOUT && WS_WOUT + (size_t)DM * DM * 2 <= WS_WGU && WS_WGU + (size_t)2 * FFN * DM * 2 <= WS_WDN && WS_WDN + (size_t)DM * FFN * 2 <= WS_U, "ws map (weights)");
static_assert(WS_U + (size_t)MU * DM * 2 <= WS_Y && WS_Y + (size_t)M * DM * 4 <= WS_QO && WS_QO + (size_t)M * DM * 2 <= WS_KV && WS_KV + 4 * KV_BYTES <= WS_END && WS_H + (size_t)M * FFN * 2 <= WS_END, "ws map");
constexpr int CW_BAR = 4096;
constexpr int S_U = 2, S_W = 6, S_O = 4, S_AO = 4;
constexpr int E8(int s) { return (127 - s) * 0x01010101; }

constexpr int RING_OFF = 0, RING_BYTES = 131072;
constexpr int LDSCTL_OFF = RING_BYTES, MISC_OFF = LDSCTL_OFF + 320;
constexpr int XCH_OFF = RING_BYTES + 1024;
constexpr int LDS_BYTES = 147456;
static_assert(XCH_OFF + 4096 <= LDS_BYTES, "LDS map");

#define GAS __attribute__((address_space(1)))
#define LAS __attribute__((address_space(3)))
typedef unsigned short bf16;
typedef unsigned v4u __attribute__((ext_vector_type(4)));
typedef float f32x4 __attribute__((ext_vector_type(4)));
typedef GAS unsigned gu32;
#define RLX_AGENT __ATOMIC_RELAXED, __HIP_MEMORY_SCOPE_AGENT
#define LDS_WAIT() asm volatile("s_waitcnt lgkmcnt(0)" ::: "memory")
#define VM_WAIT() asm volatile("s_waitcnt vmcnt(0)" ::: "memory")
__device__ __forceinline__ unsigned f2bf(float f) { unsigned u = __builtin_bit_cast(unsigned, f); return (u + 0x7fffu + ((u >> 16) & 1u)) >> 16; }
__device__ __forceinline__ unsigned pk2(float lo, float hi) { return f2bf(lo) | (f2bf(hi) << 16); }

#define XB_TMO      128
#define XB_XCNT(j)  (256  + 64 * (j))
#define XB_XSUB(j)  (1280 + 64 * (j))
#define XB_XGEN(j)  (2304 + 64 * (j))
#define XB_TOP      3328
#define XB_TOPGEN   3392
#define XCD_BAR_WORDS 3456
#define XB_SPIN_CAP (1u << 18)
__device__ __forceinline__ unsigned xb_ld(unsigned* p)              { return __hip_atomic_load(p, __ATOMIC_RELAXED, __HIP_MEMORY_SCOPE_AGENT); }
__device__ __forceinline__ unsigned xb_add(unsigned* p, unsigned v) { return __hip_atomic_fetch_add(p, v, __ATOMIC_RELAXED, __HIP_MEMORY_SCOPE_AGENT); }
__device__ __forceinline__ unsigned xb_xcc_id() { return (unsigned)__builtin_amdgcn_s_getreg((3 << 11) | 20) & 0xFu; }
#define XB_SPIN(cond, bar) do { unsigned _sp = 0; while (cond) { __builtin_amdgcn_s_sleep(1); \
    if ((++_sp & 255u) == 0u) { if (xb_ld(&(bar)[XB_TMO])) break; if (_sp > XB_SPIN_CAP) { atomicAdd(&(bar)[XB_TMO], 1u); break; } } } } while (0)
struct XcdBarrier { unsigned* bar; unsigned x; volatile LAS unsigned* st; };
__device__ __forceinline__ XcdBarrier xcd_barrier_post(unsigned* bar, volatile LAS unsigned* st) {
    XcdBarrier b; b.bar = bar; b.x = xb_xcc_id(); b.st = st;
    if (threadIdx.x == 0) (void)xb_add(&bar[XB_XCNT(b.x)], 1u);
    return b;
}
__device__ __forceinline__ void xcd_barrier_complete(unsigned* bar, unsigned x, unsigned& nloc, unsigned& nx) {
    const unsigned G = gridDim.x * gridDim.y * gridDim.z;
    unsigned sum, cnt, mine, sp = 0u;
    for (;;) {
        sum = 0u; cnt = 0u; mine = 0u;
#pragma unroll
        for (unsigned j = 0; j < 16; ++j) { const unsigned c = xb_ld(&bar[XB_XCNT(j)]); sum += c; cnt += (c > 0u) ? 1u : 0u; mine = (j == x) ? c : mine; }
        if (sum == G) break;
        __builtin_amdgcn_s_sleep(1);
        if ((++sp & 255u) == 0u) { if (xb_ld(&bar[XB_TMO])) break; if (sp > XB_SPIN_CAP) { atomicAdd(&bar[XB_TMO], 1u); break; } }
    }
    nloc = mine > 0u ? mine : 1u; nx = cnt > 0u ? cnt : 1u;
}
__device__ __forceinline__ void xcd_barrier(const XcdBarrier& b) {
    asm volatile("s_waitcnt vmcnt(0)" ::: "memory");
    __syncthreads();
    if (threadIdx.x == 0) {
        unsigned* bar = b.bar;
        __builtin_amdgcn_s_waitcnt(0);
        unsigned nloc = b.st[0], nx = b.st[1];
        if (nloc == 0u) { xcd_barrier_complete(bar, b.x, nloc, nx); b.st[0] = nloc; b.st[1] = nx; }
        const unsigned old = xb_add(&bar[XB_XSUB(b.x)], 1u);
        const unsigned gen = old / nloc;
        if (old + 1u == (gen + 1u) * nloc) {
            __builtin_amdgcn_fence(__ATOMIC_RELEASE, "agent");
            asm volatile("s_waitcnt vmcnt(0)" ::: "memory");
            const unsigned og = xb_add(&bar[XB_TOP], 1u);
            const unsigned tg = og / nx;
            if (og + 1u == (tg + 1u) * nx) xb_add(&bar[XB_TOPGEN], 1u);
            else XB_SPIN(xb_ld(&bar[XB_TOPGEN]) == tg, bar);
            __builtin_amdgcn_fence(__ATOMIC_ACQUIRE, "agent");
            xb_add(&bar[XB_XGEN(b.x)], 1u);
            asm volatile("s_waitcnt vmcnt(0)" ::: "memory");
        } else {
            XB_SPIN(xb_ld(&bar[XB_XGEN(b.x)]) == gen, bar);
            __builtin_amdgcn_fence(__ATOMIC_ACQUIRE, "agent");
            asm volatile("s_waitcnt vmcnt(0)" ::: "memory");
        }
    }
    __syncthreads();
}

__device__ __forceinline__ float wave_sum(float v) {
#pragma unroll
    for (int o = 1; o < 64; o <<= 1) v += __shfl_xor(v, o);
    return v;
}
__device__ __forceinline__ void transpose_item(const float* W, int ldw, int k0, int n0, bf16* WT, int Kd, int dst_row0, LAS float* scr, int lane) {
#pragma unroll 8
    for (int i = 0; i < 32; ++i) { const int kk = 2 * i + (lane >> 5); scr[kk * 33 + (lane & 31)] = W[(size_t)(k0 + kk) * ldw + n0 + (lane & 31)]; }
    LDS_WAIT(); asm volatile("" ::: "memory");
    const int c = lane & 7;
#pragma unroll
    for (int j = 0; j < 4; ++j) { const int n = (lane >> 3) + 8 * j; const LAS float* s = scr + (8 * c) * 33 + n;
        v4u o; o.x = pk2(s[0 * 33], s[1 * 33]); o.y = pk2(s[2 * 33], s[3 * 33]); o.z = pk2(s[4 * 33], s[5 * 33]); o.w = pk2(s[6 * 33], s[7 * 33]);
        *(GAS v4u*)(WT + (size_t)(dst_row0 + n) * Kd + k0 + 8 * c) = o; }
    LDS_WAIT(); asm volatile("" ::: "memory");
}
__device__ __forceinline__ float clamp448(float v) { return __builtin_fminf(__builtin_fmaxf(v, -448.f), 448.f); }
__device__ __forceinline__ unsigned pk4_fp8(float a, float b, float c, float d) {
    int w = __builtin_amdgcn_cvt_pk_fp8_f32(clamp448(a), clamp448(b), 0, false); w = __builtin_amdgcn_cvt_pk_fp8_f32(clamp448(c), clamp448(d), w, true); return (unsigned)w; }
__device__ __forceinline__ void transpose_item8(const float* W, int ldw, int k0, int n0, unsigned char* WT, int Kd, int dst_row0, float scl, LAS float* scr, int lane) {
#pragma unroll 8
    for (int i = 0; i < 32; ++i) { const int kk = 2 * i + (lane >> 5); scr[kk * 33 + (lane & 31)] = W[(size_t)(k0 + kk) * ldw + n0 + (lane & 31)]; }
    LDS_WAIT(); asm volatile("" ::: "memory");
    const int c = lane & 7;
#pragma unroll
    for (int j = 0; j < 4; ++j) { const int n = (lane >> 3) + 8 * j; const LAS float* s = scr + (8 * c) * 33 + n;
        typedef unsigned u2v __attribute__((ext_vector_type(2)));
        u2v o; o.x = pk4_fp8(s[0 * 33] * scl, s[1 * 33] * scl, s[2 * 33] * scl, s[3 * 33] * scl); o.y = pk4_fp8(s[4 * 33] * scl, s[5 * 33] * scl, s[6 * 33] * scl, s[7 * 33] * scl);
        *(GAS u2v*)(WT + (size_t)(dst_row0 + n) * Kd + k0 + 8 * c) = o; }
    LDS_WAIT(); asm volatile("" ::: "memory");
}
__device__ __forceinline__ unsigned pk4_i8(float a, float b, float c, float d) {
    const int ia = (int)__builtin_rintf(__builtin_fminf(__builtin_fmaxf(a, -127.f), 127.f)), ib = (int)__builtin_rintf(__builtin_fminf(__builtin_fmaxf(b, -127.f), 127.f));
    const int ic = (int)__builtin_rintf(__builtin_fminf(__builtin_fmaxf(c, -127.f), 127.f)), id = (int)__builtin_rintf(__builtin_fminf(__builtin_fmaxf(d, -127.f), 127.f));
    return (unsigned)(ia & 0xff) | ((unsigned)(ib & 0xff) << 8) | ((unsigned)(ic & 0xff) << 16) | ((unsigned)id << 24); }
__device__ __forceinline__ void transpose_item_i8(const float* W, int ldw, int k0, int n0, unsigned char* WT, int Kd, int dst_row0, float scl, LAS float* scr, int lane) {
#pragma unroll 8
    for (int i = 0; i < 32; ++i) { const int kk = 2 * i + (lane >> 5); scr[kk * 33 + (lane & 31)] = W[(size_t)(k0 + kk) * ldw + n0 + (lane & 31)]; }
    LDS_WAIT(); asm volatile("" ::: "memory");
    const int c = lane & 7;
#pragma unroll
    for (int j = 0; j < 4; ++j) { const int n = (lane >> 3) + 8 * j; const LAS float* s = scr + (8 * c) * 33 + n;
        typedef unsigned u2v __attribute__((ext_vector_type(2)));
        u2v o; o.x = pk4_i8(s[0 * 33] * scl, s[1 * 33] * scl, s[2 * 33] * scl, s[3 * 33] * scl); o.y = pk4_i8(s[4 * 33] * scl, s[5 * 33] * scl, s[6 * 33] * scl, s[7 * 33] * scl);
        *(GAS u2v*)(WT + (size_t)(dst_row0 + n) * Kd + k0 + 8 * c) = o; }
    LDS_WAIT(); asm volatile("" ::: "memory");
}
__device__ __forceinline__ float w_clip(const float* W, int lane) {
    float s2 = 0.f;
#pragma unroll
    for (int j = 0; j < 8; ++j) { const f32x4 v = ((const GAS f32x4*)W)[64 * j + lane]; s2 += (v.x * v.x + v.y * v.y) + (v.z * v.z + v.w * v.w); }
    return 4.5f * sqrtf(wave_sum(s2) * (1.0f / 2048.0f)) + 1e-30f;
}
__device__ __forceinline__ float silu_f(float x) { return x / (1.0f + __expf(-x)); }

struct Args { const float* in[18]; float* out; unsigned char* ws; int ph_lo, ph_hi, li, flags; };

__device__ __forceinline__ void modulate_row8(const float* xrow, unsigned char* orow, const LAS float* p0, const LAS float* p1, float scl, int lane) {
    const GAS f32x4* xr = (const GAS f32x4*)xrow + lane;
    GAS unsigned* o4 = (GAS unsigned*)orow + lane;
    f32x4 v[8];
#pragma unroll
    for (int j = 0; j < 8; ++j) v[j] = xr[64 * j];
#pragma unroll
    for (int j = 0; j < 8; ++j) { const f32x4 a = *(const LAS f32x4*)(p0 + 256 * j + 4 * lane), s = *(const LAS f32x4*)(p1 + 256 * j + 4 * lane); const f32x4 r = (v[j] * a + s) * scl;
        o4[64 * j] = pk4_fp8(r.x, r.y, r.z, r.w); }
}
__device__ __forceinline__ void modulate_row(const float* xrow, bf16* orow, const LAS float* p0, const LAS float* p1, int lane) {
    const GAS f32x4* xr = (const GAS f32x4*)xrow + lane;
    GAS unsigned long long* o8 = (GAS unsigned long long*)orow + lane;
    f32x4 v[8];
#pragma unroll
    for (int j = 0; j < 8; ++j) v[j] = xr[64 * j];
#pragma unroll
    for (int j = 0; j < 8; ++j) { const f32x4 a = *(const LAS f32x4*)(p0 + 256 * j + 4 * lane), s = *(const LAS f32x4*)(p1 + 256 * j + 4 * lane); const f32x4 r = v[j] * a + s;
        o8[64 * j] = (unsigned long long)pk2(r.x, r.y) | ((unsigned long long)pk2(r.z, r.w) << 32); }
}
typedef unsigned u32x2 __attribute__((ext_vector_type(2)));
__device__ __forceinline__ f32x4 bf4_to_f32(u32x2 w) { f32x4 r; r.x = __uint_as_float(w.x << 16); r.y = __uint_as_float(w.x & 0xffff0000u); r.z = __uint_as_float(w.y << 16); r.w = __uint_as_float(w.y & 0xffff0000u); return r; }
__device__ __forceinline__ void ln_regs(f32x4 (&v)[8], const LAS float* g, const LAS float* bb, int lane) {
    float s = 0.f;
#pragma unroll
    for (int j = 0; j < 8; ++j) s += (v[j].x + v[j].y) + (v[j].z + v[j].w);
    const float mean = wave_sum(s) * (1.f / DM); float s2 = 0.f;
#pragma unroll
    for (int j = 0; j < 8; ++j) { v[j] = v[j] - mean; s2 += (v[j].x * v[j].x + v[j].y * v[j].y) + (v[j].z * v[j].z + v[j].w * v[j].w); }
    const float rstd = __builtin_amdgcn_rsqf(wave_sum(s2) * (1.f / DM) + LN_EPS);
#pragma unroll
    for (int j = 0; j < 8; ++j) { const int c = 256 * j + 4 * lane; v[j] = v[j] * rstd * *(const LAS f32x4*)(g + c) + *(const LAS f32x4*)(bb + c); if (j & 1) asm volatile("" ::: "memory"); }
}
__device__ __forceinline__ f32x4 fp8x4_to_f32(unsigned w) { f32x4 r; r.x = __builtin_amdgcn_cvt_f32_fp8((int)w, 0); r.y = __builtin_amdgcn_cvt_f32_fp8((int)w, 1); r.z = __builtin_amdgcn_cvt_f32_fp8((int)w, 2); r.w = __builtin_amdgcn_cvt_f32_fp8((int)w, 3); return r; }
__device__ __forceinline__ void x1_row(f32x4 (&v)[8], const float* xrow, const unsigned char* arow, const LAS float* P, int lane) {
    const GAS f32x4* xr = (const GAS f32x4*)xrow + lane; const GAS unsigned* ar = (const GAS unsigned*)arow + lane;
    unsigned aw[8];
#pragma unroll
    for (int j = 0; j < 8; ++j) { v[j] = xr[64 * j]; aw[j] = ar[64 * j]; }
#pragma unroll
    for (int j = 0; j < 8; ++j) { v[j] = v[j] * DN_ALPHA + *(const LAS f32x4*)(P + 256 * j + 4 * lane) * (fp8x4_to_f32(aw[j]) * (1.0f / (float)(1 << S_AO))); if (j & 1) asm volatile("" ::: "memory"); }
    ln_regs(v, P + 2048, P + 4096, lane);
}

__global__ void __launch_bounds__(NWAVES * 64, 2) dit_fwd(Args args) {
    extern __shared__ __attribute__((aligned(16))) unsigned char lds[];
    LAS unsigned char* L = (LAS unsigned char*)lds;
    volatile LAS unsigned* MISC = (volatile LAS unsigned*)(L + MISC_OFF);
    const int tid = threadIdx.x, lane = tid & 63, wave = __builtin_amdgcn_readfirstlane(tid >> 6);
    const int G = gridDim.x, bx = blockIdx.x;
    unsigned char* ws = args.ws;
    gu32* ctl = (gu32*)(ws + WS_CTL);
    const float* x = args.in[0]; const float* cvec = args.in[1]; const float* ctx = args.in[2]; const float* c_ctx = args.in[3];
    const float* w_ada = args.in[4]; const float* b_ada = args.in[5]; const float* w_in = args.in[6]; const float* qng = args.in[7]; const float* kng = args.in[8];
    const float* sink = args.in[9]; const float* w_out = args.in[10]; const float* ln1g = args.in[11]; const float* ln1b = args.in[12];
    const float* w_gate = args.in[13]; const float* w_up = args.in[14]; const float* w_down = args.in[15]; const float* ln2g = args.in[16]; const float* ln2b = args.in[17];
    float* MODP = (float*)(ws + WS_MODP); float* MODS = (float*)(ws + WS_MODS); float* ROPEC = (float*)(ws + WS_ROPE); float* ROPES = ROPEC + 2048;
    bf16* WIN = (bf16*)(ws + WS_WIN); bf16* WOUT = (bf16*)(ws + WS_WOUT); bf16* WGU = (bf16*)(ws + WS_WGU); bf16* WDN = (bf16*)(ws + WS_WDN);
    bf16* U = (bf16*)(ws + WS_U); unsigned char* AB8 = ws + WS_Y; bf16* DB = (bf16*)(ws + WS_Y + 64 * MiB);
    unsigned char* U8i = ws + WS_U; unsigned char* WGU8 = ws + WS_WGU; float* RSC = (float*)(ws + WS_ROPE + 256 * 1024);
    unsigned char* U8 = ws + WS_U;
    unsigned char* WIN8 = ws + WS_WIN; unsigned char* WOUT8 = ws + WS_WOUT;
    unsigned char* OF8 = ws + WS_Y + 64 * MiB;
    unsigned char* VTA = ws + WS_KV + KV_BYTES; unsigned char* VTB = ws + WS_KV + 3 * KV_BYTES;
    unsigned char* QO8 = ws + WS_QO; unsigned char* KA8 = ws + WS_KV; unsigned char* KB8 = ws + WS_KV + 2 * KV_BYTES;
    bf16* KA = (bf16*)(ws + WS_KV); bf16* VA = (bf16*)(ws + WS_KV + KV_BYTES); bf16* KB = (bf16*)(ws + WS_KV + 2 * KV_BYTES); bf16* VB = (bf16*)(ws + WS_KV + 3 * KV_BYTES);
    bf16* HB = (bf16*)(ws + WS_H);

    for (int u = tid; u < (LDS_BYTES - LDSCTL_OFF) / 4; u += NWAVES * 64) ((LAS unsigned*)(L + LDSCTL_OFF))[u] = 0u;
    __syncthreads();
    XcdBarrier bar; bar.bar = (unsigned*)(ctl + CW_BAR); bar.x = 0; bar.st = nullptr;
    if (N_LAUNCHES == 1) bar = xcd_barrier_post((unsigned*)(ctl + CW_BAR), MISC + 8);
#define GRID_BAR() do { if (N_LAUNCHES == 1) xcd_barrier(bar); } while (0)
    const int lo = args.ph_lo, hi = args.ph_hi;
#ifndef PHMASK
#define PHMASK 0x3FF
#endif
#define IN(k) (((PHMASK >> (k)) & 1) && lo <= (k) && (k) < hi)
#define BOTH(k) (IN(k) && IN((k) + 1))

    if (IN(0)) {
        if (bx < 192) {
            const int cb = bx >> 2, kq = bx & 3, k0 = kq * 512 + wave * 64;
            float sv[5];
#pragma unroll
            for (int b = 0; b < 4; ++b) sv[b] = silu_f(cvec[b * DM + k0 + lane]);
            sv[4] = silu_f(c_ctx[k0 + lane]);
            f32x4 acc[5];
#pragma unroll
            for (int b = 0; b < 5; ++b) acc[b] = (f32x4){0.f, 0.f, 0.f, 0.f};
            const float* wp = w_ada + (size_t)k0 * NMOD + cb * 256 + lane * 4;
#pragma unroll 16
            for (int kk = 0; kk < 64; ++kk) { const f32x4 wv = *(const f32x4*)(wp + (size_t)kk * NMOD);
#pragma unroll
                for (int b = 0; b < 5; ++b) { const float s = __builtin_bit_cast(float, __builtin_amdgcn_readlane(__builtin_bit_cast(int, sv[b]), kk)); acc[b] += wv * s; } }
            LAS f32x4* red = (LAS f32x4*)(L + RING_OFF);
#pragma unroll
            for (int b = 0; b < 5; ++b) red[(wave * 5 + b) * 64 + lane] = acc[b];
            LDS_WAIT(); __syncthreads();
            if (tid < 320) { const int b = tid >> 6, l = tid & 63; f32x4 s = red[b * 64 + l];
#pragma unroll
                for (int w = 1; w < 8; ++w) s += red[(w * 5 + b) * 64 + l];
                *(f32x4*)(MODP + ((size_t)kq * 5 + b) * NMOD + cb * 256 + l * 4) = s; }
            __syncthreads();
        }
        if (bx == 255) {
            for (int e = tid; e < 2048; e += NWAVES * 64) { const int pos = e >> 5, f = e & 31;
                const float inv = exp2f(-(float)f * (13.287712379549449f / 32.0f)); const float ang = (float)pos * inv;
                float sn, cs; sincosf(ang, &sn, &cs); ROPEC[e] = cs; ROPES[e] = sn; }
        }
        {
            LAS float* scr = (LAS float*)(L + RING_OFF + wave * 16384);
            constexpr int I_IN = 32 * 96, I_OUT = 32 * 64, I_G = 32 * 176, NITEMS = I_IN + I_OUT + I_G, NSLOT = 192 * 8 * 2 + 64 * 8 * 5;
            const float qs_gate = 127.0f / w_clip(w_gate, lane);
            const int nsl = bx < 192 ? 2 : 5, sl0 = bx < 192 ? (bx * 8 + wave) * 2 : 3072 + ((bx - 192) * 8 + wave) * 5;
            for (int s = 0; s < nsl; ++s)
                for (int it = sl0 + s; it < NITEMS; it += NSLOT) {
                    int r = it;
                    if (r < I_IN) { const int kb = r / 96, nb = r % 96, pn = nb >> 3, q = nb & 7, hh = q >> 2, part = (q >> 1) & 1, bj = q & 1;
                        transpose_item8(w_in, INW, 64 * kb, 32 * nb, WIN8, DM, 256 * pn + 32 * (4 * bj + 2 * hh + part), (float)(1 << S_W), scr, lane); continue; } r -= I_IN;
                    if (r < I_OUT) { const int kb = r / 64, nb = r % 64; transpose_item8(w_out, DM, 64 * kb, 32 * nb, WOUT8, DM, 32 * nb, (float)(1 << S_W), scr, lane); continue; } r -= I_OUT;
                    { const int kb = r / 176, nb = r % 176; transpose_item_i8(w_gate, FFN, 64 * kb, 32 * nb, WGU8, DM, 256 * (nb >> 2) + 32 * (nb & 3), qs_gate, scr, lane); }
                }
        }
        if (BOTH(0)) GRID_BAR();
    }

    if (IN(1)) {
        { const int idx = bx * 512 + tid;
          if (idx < 5 * NMOD) { float s = b_ada[idx % NMOD];
#pragma unroll
              for (int q = 0; q < 4; ++q) s += MODP[(size_t)q * 5 * NMOD + idx];
              MODS[idx] = s; } }
        if (bx < 128) {
            LAS float* P0 = (LAS float*)(L + RING_OFF); LAS float* P1 = P0 + 2048;
            for (int i = tid; i < 2048; i += NWAVES * 64) { float sh = b_ada[i], sc = b_ada[2048 + i];
#pragma unroll
                for (int q = 0; q < 4; ++q) { sh += MODP[((size_t)q * 5 + 4) * NMOD + i]; sc += MODP[((size_t)q * 5 + 4) * NMOD + 2048 + i]; }
                P0[i] = 1.0f + sc; P1[i] = sh; }
            LDS_WAIT(); __syncthreads();
            const int r = bx * 8 + wave;
            modulate_row8(ctx + (size_t)r * DM, U8 + (size_t)(M + r) * DM, P0, P1, (float)(1 << S_U), lane);
            __syncthreads();
        }
        if (BOTH(1)) GRID_BAR();
    }

    if (IN(2)) {
        if (bx < 16) {
            const int pnl[4] = {4, 5, 10, 11};
            pg8::Gemm g{(const bf16*)U8, (const bf16*)WIN8, MU, INW, DM / 2}; pg8::OneUnit S{64 + (bx >> 2), (bx & 3) == 0 ? 4 : (bx & 3) == 1 ? 5 : (bx & 3) == 2 ? 10 : 11}; (void)pnl;
            pg8::EpiQKV E{QO8, KA8, VTA, KB8, VTB, qng, kng, ROPEC, ROPES, (LAS float*)(L + XCH_OFF)};
            pg8::gemm_phase<pg8::EpiQKV, pg8::OneUnit, true, true, E8(S_W), E8(S_U)>(L + RING_OFF, g, S, E);
        } else {
            LAS float* P0 = (LAS float*)(L + RING_OFF); LAS float* P1 = P0 + 2048;
            const int i = bx - 16, r0 = (int)(((long)i * M) / 240), r1 = (int)(((long)(i + 1) * M) / 240);
            int r = r0;
            while (r < r1) {
                const int b = r >> 12; int re = (b + 1) << 12; if (re > r1) re = r1;
                __syncthreads();
                for (int k = tid; k < 2048; k += NWAVES * 64) { P0[k] = 1.0f + MODS[b * NMOD + 2048 + k]; P1[k] = MODS[b * NMOD + k]; }
                LDS_WAIT(); __syncthreads();
                for (int rr = r + wave; rr < re; rr += NWAVES) modulate_row8(x + (size_t)rr * DM, U8 + (size_t)rr * DM, P0, P1, (float)(1 << S_U), lane);
                r = re;
            }
            __syncthreads();
            {
                LAS float* scr = (LAS float*)(L + RING_OFF + wave * 16384);
                constexpr int I_G = 32 * 176, I_D = 88 * 64, NITEMS2 = I_G + I_D;
                const float qs_up = 127.0f / w_clip(w_up, lane);
                for (int it = i * 8 + wave; it < NITEMS2; it += 240 * 8) {
                    if (it < I_G) { const int kb = it / 176, nb = it % 176; transpose_item_i8(w_up, FFN, 64 * kb, 32 * nb, WGU8, DM, 256 * (nb >> 2) + 128 + 32 * (nb & 3), qs_up, scr, lane); }
                    else { const int r2 = it - I_G, kb = r2 / 64, nb = r2 % 64; transpose_item(w_down, DM, 64 * kb, 32 * nb, WDN, FFN, 32 * nb, scr, lane); }
                }
            }
        }
        if (BOTH(2)) GRID_BAR();
    }

    if (IN(3)) {
        pg8::Gemm g{(const bf16*)U8, (const bf16*)WIN8, M, INW, DM / 2}; pg8::StaticOrder S; S.init(M, INW, G, bx);
        pg8::EpiQKV E{QO8, KA8, VTA, KB8, VTB, qng, kng, ROPEC, ROPES, (LAS float*)(L + XCH_OFF)};
        pg8::gemm_phase<pg8::EpiQKV, pg8::StaticOrder, true, true, E8(S_W), E8(S_U)>(L + RING_OFF, g, S, E);
        if (BOTH(3)) GRID_BAR();
    }

    if (IN(4)) {
        const int xg = bx & 7, y = bx >> 3, b = xg >> 1, kvh = xg & 1;
        const size_t kvoff = (size_t)(b * 2 + kvh) * SKV * 128;
        float kbnd; { float gm = fmaxf(fabsf(kng[lane]), fabsf(kng[64 + lane]));
#pragma unroll
            for (int o = 1; o < 64; o <<= 1) gm = fmaxf(gm, __shfl_xor(gm, o));
            kbnd = gm * 11.313708498984761f * 1.08f; }
#define MKUNIT(u, i_) do { const int i__ = (i_); const int uu = 2 * y + (i__ & 1), gq = uu >> 4, qb = uu & 15, q0 = qb * 256; const bool isA = i__ >= 2; const int head = kvh * 4 + gq; \
            unsigned char* Qp = QO8 + (size_t)(b * SEQ + q0) * DM + (isA ? 0 : 1024) + head * 128; \
            const int jlo = !isA ? 0 : ((q0 >> 6) - 2 < 0 ? 0 : (q0 >> 6) - 2), jhi = (q0 >> 6) + 6 > 64 ? 64 : (q0 >> 6) + 6; \
            (u).Q = Qp; (u).K = (isA ? KA8 : KB8) + kvoff; (u).V = (isA ? VTA : VTB) + kvoff; (u).O = ((args.flags & 1) ? ws + 384 * MiB : OF8) + (Qp - QO8); \
            (u).NT = isA ? 4 + (jhi - jlo) : SKV / 64; (u).nctx = isA ? 4 : 0; (u).jlo = jlo; (u).q0 = q0; (u).masked = isA; (u).sinkl2 = isA ? sink[head] * 1.4426950408889634f : -INFINITY; (u).kbound = -1.f; (void)kbnd; } while (0)
        att::v8i qr[2]; att::Stg stg[2];
        att::AUnit cur, nx; MKUNIT(cur, 0); att::attn_prime(cur, qr, stg);
        for (int i = 0; i < 4; ++i) {
            MKUNIT(nx, i < 3 ? i + 1 : 3);
            att::attn_unit(cur, i < 3, nx, qr, stg, (char*)lds + RING_OFF);
            cur = nx;
        }
#undef MKUNIT
        if (BOTH(4)) GRID_BAR();
    }

    if (IN(5)) {
        pg8::Gemm g{(const bf16*)OF8, (const bf16*)WOUT8, M, DM, DM / 2}; pg8::StaticOrder S; S.init(M, DM, G, bx);
        pg8::EpiFp8Plain E{AB8, DM, (float)(1 << S_AO)};
        pg8::gemm_phase<pg8::EpiFp8Plain, pg8::StaticOrder, true, true, E8(S_W), E8(S_O)>(L + RING_OFF, g, S, E);
        if (BOTH(5)) GRID_BAR();
    }

    if (IN(6)) {
        LAS float* P = (LAS float*)(L + RING_OFF);
        const int b = bx >> 6;
        for (int k = tid; k < 2048; k += NWAVES * 64) { P[k] = MODS[b * NMOD + 2 * 2048 + k]; P[2048 + k] = ln1g[k]; P[4096 + k] = ln1b[k]; P[6144 + k] = 1.0f + MODS[b * NMOD + 4 * 2048 + k]; P[8192 + k] = MODS[b * NMOD + 3 * 2048 + k]; }
        LDS_WAIT(); __syncthreads();
        for (int rr = bx * 64 + wave; rr < bx * 64 + 64; rr += NWAVES) {
            f32x4 v[8]; x1_row(v, x + (size_t)rr * DM, AB8 + (size_t)rr * DM, P, lane);
            float amax = 0.f;
#pragma unroll
            for (int j = 0; j < 8; ++j) { const int c = 256 * j + 4 * lane; v[j] = v[j] * *(const LAS f32x4*)(P + 6144 + c) + *(const LAS f32x4*)(P + 8192 + c);
                amax = __builtin_fmaxf(amax, __builtin_fmaxf(__builtin_fmaxf(__builtin_fabsf(v[j].x), __builtin_fabsf(v[j].y)), __builtin_fmaxf(__builtin_fabsf(v[j].z), __builtin_fabsf(v[j].w)))); }
#pragma unroll
            for (int o = 1; o < 64; o <<= 1) amax = __builtin_fmaxf(amax, __shfl_xor(amax, o));
            amax = __builtin_fmaxf(amax, 1e-20f);
            const float qs = 127.0f / amax;
            GAS unsigned* o4 = (GAS unsigned*)(U8i + (size_t)rr * DM) + lane;
#pragma unroll
            for (int j = 0; j < 8; ++j) o4[64 * j] = pk4_i8(v[j].x * qs, v[j].y * qs, v[j].z * qs, v[j].w * qs);
            if (lane == 0) RSC[rr] = amax * (1.0f / 127.0f);
        }
        __syncthreads();
        if (BOTH(6)) GRID_BAR();
    }

    if (IN(7)) {
        pg8::Gemm g{(const bf16*)U8i, (const bf16*)WGU8, M, 2 * FFN, DM / 2}; pg8::StaticOrder S; S.init(M, 2 * FFN, G, bx);
        pg8::EpiSwiglu8 E{HB, FFN, RSC, w_clip(w_gate, lane) * (1.0f / 127.0f), w_clip(w_up, lane) * (1.0f / 127.0f)};
        pg8::gemm_phase<pg8::EpiSwiglu8, pg8::StaticOrder, true, true, 0, 0, false, true>(L + RING_OFF, g, S, E);
        if (BOTH(7)) GRID_BAR();
    }

    if (IN(8)) {
        pg8::Gemm g{HB, WDN, M, DM, FFN}; pg8::StaticOrder S; S.init(M, DM, G, bx);
        pg8::EpiBf16Plain E{DB, DM};
        pg8::gemm_phase<pg8::EpiBf16Plain, pg8::StaticOrder, true, true>(L + RING_OFF, g, S, E);
        if (BOTH(8)) GRID_BAR();
    }

    if (IN(9)) {
        LAS float* P = (LAS float*)(L + RING_OFF);
        const int b = bx >> 6;
        for (int k = tid; k < 2048; k += NWAVES * 64) { P[k] = MODS[b * NMOD + 2 * 2048 + k]; P[2048 + k] = ln1g[k]; P[4096 + k] = ln1b[k]; P[6144 + k] = MODS[b * NMOD + 5 * 2048 + k]; P[8192 + k] = ln2g[k]; P[10240 + k] = ln2b[k]; }
        LDS_WAIT(); __syncthreads();
        for (int rr = bx * 64 + wave; rr < bx * 64 + 64; rr += NWAVES) {
            f32x4 v[8]; x1_row(v, x + (size_t)rr * DM, AB8 + (size_t)rr * DM, P, lane);
            const GAS u32x2* dr = (const GAS u32x2*)(DB + (size_t)rr * DM) + lane;
#pragma unroll
            for (int j = 0; j < 8; ++j) { v[j] = v[j] * DN_ALPHA + *(const LAS f32x4*)(P + 6144 + 256 * j + 4 * lane) * bf4_to_f32(dr[64 * j]); if ((j & 3) == 3) asm volatile("" ::: "memory"); }
            ln_regs(v, P + 8192, P + 10240, lane);
            GAS f32x4* orow = (GAS f32x4*)(args.out + (size_t)rr * DM) + lane;
#pragma unroll
            for (int j = 0; j < 8; ++j) orow[64 * j] = v[j];
        }
    }
#undef IN
#undef BOTH
#undef GRID_BAR
}

extern "C" void kernel_launch(void* const* d_in, const int* in_sizes, int n_in, void* d_out, int out_size, void* d_ws, size_t ws_size, hipStream_t stream) {
    static int grid = 0;
    if (grid == 0) {
        if (n_in != 18 || in_sizes[0] != M * DM || out_size != M * DM || ws_size < WS_END) {
            fprintf(stderr, "kernel_launch: shape mismatch (n_in %d, in0 %d, out %d, ws %zu; need ws >= %zu); nothing launched\n", n_in, n_in > 0 ? in_sizes[0] : -1, out_size, ws_size, (size_t)WS_END); grid = -1; return; }
        int dev = 0, cus = 0, per_cu = 0;
        if (hipGetDevice(&dev) != hipSuccess || hipDeviceGetAttribute(&cus, hipDeviceAttributeMultiprocessorCount, dev) != hipSuccess) { fprintf(stderr, "kernel_launch: device query failed\n"); grid = -1; return; }
        if (hipFuncSetAttribute((const void*)dit_fwd, hipFuncAttributeMaxDynamicSharedMemorySize, LDS_BYTES) != hipSuccess) { fprintf(stderr, "kernel_launch: hipFuncSetAttribute failed\n"); grid = -1; return; }
        if (hipOccupancyMaxActiveBlocksPerMultiprocessor(&per_cu, (const void*)dit_fwd, NWAVES * 64, LDS_BYTES) != hipSuccess || per_cu < 1)
            fprintf(stderr, "kernel_launch: note: occupancy query reports %d workgroups per CU\n", per_cu);
        (void)hipGetLastError();
        if (cus != 256) { fprintf(stderr, "kernel_launch: built for a 256-CU device, found %d CUs; nothing launched\n", cus); grid = -1; return; }
        grid = 256;
    }
    if (grid < 0) return;
    if (hipMemsetAsync((char*)d_ws + WS_CTL, 0, CTL_ZERO_BYTES, stream) != hipSuccess) { fprintf(stderr, "kernel_launch: hipMemsetAsync failed\n"); return; }
    Args a{};
    for (int i = 0; i < 18; ++i) a.in[i] = (const float*)d_in[i];
    a.out = (float*)d_out; a.ws = (unsigned char*)d_ws;
    if (N_LAUNCHES == 1) { a.ph_lo = 0; a.ph_hi = N_PHASES; a.li = 0; hipLaunchKernelGGL(dit_fwd, dim3(grid), dim3(NWAVES * 64), LDS_BYTES, stream, a); }
    else { const int plist[] = PHASE_LIST;
        for (unsigned i = 0; i < sizeof(plist) / sizeof(int); ++i) { const int p = plist[i] % 100; a.ph_lo = p; a.ph_hi = p + 1; a.li = 0; a.flags = plist[i] >= 100 ? 1 : 0;
            hipLaunchKernelGGL(dit_fwd, dim3(grid), dim3(NWAVES * 64), LDS_BYTES, stream, a); } }
    const hipError_t le = hipPeekAtLastError();
    if (le != hipSuccess) fprintf(stderr, "kernel_launch: launch failed: %s\n", hipGetErrorName(le));
}
```

```cpp
#include <hip/hip_runtime.h>
#include <hip/hip_bf16.h>
#include <cstdio>
#include <cstdint>

#ifndef PHASE_LIST
#define PHASE_LIST {0, 1, 2, 3, 4, 5, 6, 7, 8, 9}
#endif
#ifndef MK_N_LAUNCHES
#define MK_N_LAUNCHES 1
#endif

namespace pg8 {
#define PG8_LAS __attribute__((address_space(3)))
typedef unsigned short bf16_t;
typedef short bf16x8 __attribute__((ext_vector_type(8)));
typedef float f32x4 __attribute__((ext_vector_type(4)));
typedef unsigned u32x4 __attribute__((ext_vector_type(4)));
typedef int v8i_t __attribute__((ext_vector_type(8))); typedef int v4i_t __attribute__((ext_vector_type(4)));
constexpr int BM = 256, BK = 64, HALF = 128, HTB = HALF * BK * 2, STAGE_BYTES = 8 * HTB, NXCD = 8, WGM = 8;

__host__ __device__ __forceinline__ int lds_byte(int r, int c) { const int st = (r >> 4) * 2 + (c >> 5), rr = r & 15, cc = c & 31, ob = rr * 64 + cc * 2; return st * 1024 + (ob ^ (((ob >> 9) & 1) << 5)); }
__host__ __device__ __forceinline__ void stage_rc(int b, int& R, int& C) { const int st = b / 1024, sb = b % 1024, swz = sb ^ (((sb >> 9) & 1) << 5); R = (st >> 1) * 16 + swz / 64; C = (st & 1) * 32 + (swz % 64) / 2; }
__host__ __device__ __forceinline__ int perm32(int rho) { const int n = rho >> 4, i = rho & 15; return 8 * (i >> 2) + 4 * n + (i & 3); }

struct Unit { int pm, pn; };
struct Gemm { const bf16_t* A; const bf16_t* Bt; int M, N, K; };

struct StaticOrder {
    int nM, nN, nwg, G, c;
    __host__ __device__ void init(int M, int N, int G_, int c_) { nM = M / BM; nN = N / BM; nwg = nM * nN; G = G_; c = c_; }
    __host__ __device__ bool next(int i, Unit& u) const {
        const long L = (long)i * G + c; if (L >= nwg) return false;
        int wgid = (int)L; { const int q = nwg / NXCD, r = nwg % NXCD, xcd = wgid % NXCD, off = wgid / NXCD; wgid = (xcd < r ? xcd * (q + 1) : r * (q + 1) + (xcd - r) * q) + off; }
        const int nig = WGM * nN, gid = wgid / nig, fm = gid * WGM, gsz = (nM - fm) < WGM ? (nM - fm) : WGM;
        u.pm = fm + ((wgid % nig) % gsz); u.pn = (wgid % nig) / gsz; return true;
    }
    __device__ __forceinline__ void a_ready(const Unit&) const {}
    __device__ __forceinline__ void done(const Unit&) const {}
};
struct OneUnit {
    int pm, pn;
    __device__ bool next(int i, Unit& u) const { if (i > 0) return false; u.pm = pm; u.pn = pn; return true; }
    __device__ __forceinline__ void a_ready(const Unit&) const {}
    __device__ __forceinline__ void done(const Unit&) const {}
};

__device__ __forceinline__ unsigned cvt_pk_bf16(float lo, float hi) { unsigned r; asm volatile("v_cvt_pk_bf16_f32 %0, %1, %2" : "=v"(r) : "v"(lo), "v"(hi)); return r; }


struct EpiQKV {
    static constexpr bool PERM = true, AFTER_DRAIN = false;
    unsigned char* QO; unsigned char* KA; unsigned char* VA; unsigned char* KB; unsigned char* VB;
    const float* qg; const float* kg; const float* ropec; const float* ropes;
    PG8_LAS float* xch;
    __device__ __forceinline__ void operator()(const f32x4 (&acc)[2][2][4][2], const Unit& u, int wr, int wc, int fr, int fq) const {
        const int pn = u.pn; const bool is_ctx = u.pm >= 64;
        const int b = is_ctx ? (u.pm - 64) : (u.pm >> 4), t0 = is_ctx ? 4096 : ((u.pm & 15) << 8);
        const int hh = wc >> 1, part = wc & 1, wid = wr * 4 + wc;
        const bool isq = (pn < 4) || (pn >= 6 && pn < 10), donorm = (pn >= 6 && pn <= 10), dorope = (!is_ctx) && pn != 5 && pn != 11;
        const bool isv = (pn == 5 || pn == 11);
        bf16_t* base = nullptr; unsigned char* base8 = nullptr; size_t rstride;
        if (isq) { const int head = (pn < 4 ? 2 * pn : 8 + 2 * (pn - 6)) + hh; base8 = QO + (size_t)(b * 4096 + t0) * 2048 + head * 128; rstride = 2048; }
        else if (isv) {
            unsigned char* vt = (pn == 5 ? VA : VB) + (size_t)(b * 2 + hh) * 128 * 4352;
            int frl = fr, fql = fq; asm volatile("" : "+v"(frl), "+v"(fql));
            const unsigned p_ = (unsigned)(frl & 3);
            const unsigned sel2 = p_ | ((4u + p_) << 8);
#pragma unroll
            for (int bj = 0; bj < 2; ++bj)
#pragma unroll
                for (int n = 0; n < 2; ++n) {
                    unsigned char* dp = vt + (size_t)(64 * part + 32 * bj + 8 * fql + 4 * n + (frl & 3)) * 4352 + t0 + wr * 64 + 32 * ((frl >> 2) & 1) + 4 * (frl >> 3);
#pragma unroll
                    for (int ai = 0; ai < 2; ++ai)
#pragma unroll
                        for (int m = 0; m < 4; ++m) { const f32x4 v = acc[ai][bj][m][n] * 16.f;
                            int w_ = __builtin_amdgcn_cvt_pk_fp8_f32(__builtin_fminf(__builtin_fmaxf(v[0], -448.f), 448.f), __builtin_fminf(__builtin_fmaxf(v[1], -448.f), 448.f), 0, false);
                            w_ = __builtin_amdgcn_cvt_pk_fp8_f32(__builtin_fminf(__builtin_fmaxf(v[2], -448.f), 448.f), __builtin_fminf(__builtin_fmaxf(v[3], -448.f), 448.f), w_, true);
                            const unsigned W0 = (unsigned)__builtin_amdgcn_mov_dpp(w_, 0x00, 0xf, 0xf, true), W1 = (unsigned)__builtin_amdgcn_mov_dpp(w_, 0x55, 0xf, 0xf, true);
                            const unsigned W2 = (unsigned)__builtin_amdgcn_mov_dpp(w_, 0xaa, 0xf, 0xf, true), W3 = (unsigned)__builtin_amdgcn_mov_dpp(w_, 0xff, 0xf, 0xf, true);
                            const unsigned lo2 = __builtin_amdgcn_perm(W1, W0, sel2), hi2 = __builtin_amdgcn_perm(W3, W2, sel2);
                            *(unsigned*)(dp + ai * HALF + 8 * m) = __builtin_amdgcn_perm(hi2, lo2, 0x05040100u); }
                    asm volatile("" ::: "memory"); }
            return; }
        else { unsigned char* buf = pn == 4 ? KA : KB; base8 = buf + ((size_t)(b * 2 + hh) * 4352 + t0) * 128; rstride = 128; }
        const int d0 = 64 * part + 8 * fq;
        float rs[2][4];
        f32x4 gv[2][2];
#pragma unroll
        for (int bj = 0; bj < 2; ++bj)
#pragma unroll
            for (int n = 0; n < 2; ++n) gv[bj][n] = (f32x4){1.f, 1.f, 1.f, 1.f};
#pragma unroll
        for (int ai = 0; ai < 2; ++ai)
#pragma unroll
            for (int m = 0; m < 4; ++m) rs[ai][m] = 1.f;
        if (donorm) {
            const float* g = (pn == 10) ? kg : qg;
#pragma unroll
            for (int bj = 0; bj < 2; ++bj)
#pragma unroll
                for (int n = 0; n < 2; ++n) gv[bj][n] = *(const f32x4*)(g + d0 + 32 * bj + 4 * n);
#pragma unroll
            for (int ai = 0; ai < 2; ++ai)
#pragma unroll
                for (int m = 0; m < 4; ++m) {
                    float s = 0.f;
#pragma unroll
                    for (int bj = 0; bj < 2; ++bj)
#pragma unroll
                        for (int n = 0; n < 2; ++n) { const f32x4 x = acc[ai][bj][m][n]; s += (x[0] * x[0] + x[1] * x[1]) + (x[2] * x[2] + x[3] * x[3]); }
                    s += __shfl_xor(s, 16); s += __shfl_xor(s, 32);
                    if (fq == 0) xch[wid * 128 + ai * 64 + m * 16 + fr] = s;
                    rs[ai][m] = s;
                }
            asm volatile("s_waitcnt lgkmcnt(0)" ::: "memory"); __builtin_amdgcn_s_barrier(); asm volatile("" ::: "memory");
#pragma unroll
            for (int ai = 0; ai < 2; ++ai)
#pragma unroll
                for (int m = 0; m < 4; ++m) { const float o = xch[(wid ^ 1) * 128 + ai * 64 + m * 16 + fr]; rs[ai][m] = __builtin_amdgcn_rsqf((rs[ai][m] + o) * (1.0f / 128.0f) + 1e-6f); }
        }
#pragma unroll
        for (int ai = 0; ai < 2; ++ai)
#pragma unroll
            for (int m = 0; m < 4; ++m) {
                const int rt = ai * HALF + wr * 64 + m * 16 + fr;
                f32x4 lo[2], hi[2];
#pragma unroll
                for (int n = 0; n < 2; ++n) { lo[n] = acc[ai][0][m][n] * rs[ai][m] * gv[0][n]; hi[n] = acc[ai][1][m][n] * rs[ai][m] * gv[1][n]; }
                if (dorope) {
                    const int t = t0 + rt, pos = part ? (t & 63) : (t >> 6);
#pragma unroll
                    for (int n = 0; n < 2; ++n) {
                        const f32x4 c4 = *(const f32x4*)(ropec + pos * 32 + 8 * fq + 4 * n), s4 = *(const f32x4*)(ropes + pos * 32 + 8 * fq + 4 * n);
                        const f32x4 a = lo[n], bb = hi[n];
                        lo[n] = a * c4 - bb * s4; hi[n] = bb * c4 + a * s4;
                    }
                }
                if (false) {
                bf16_t* rowp = base + (size_t)rt * rstride + d0;
                u32x4 w0, w1;
                w0.x = cvt_pk_bf16(lo[0][0], lo[0][1]); w0.y = cvt_pk_bf16(lo[0][2], lo[0][3]); w0.z = cvt_pk_bf16(lo[1][0], lo[1][1]); w0.w = cvt_pk_bf16(lo[1][2], lo[1][3]);
                w1.x = cvt_pk_bf16(hi[0][0], hi[0][1]); w1.y = cvt_pk_bf16(hi[0][2], hi[0][3]); w1.z = cvt_pk_bf16(hi[1][0], hi[1][1]); w1.w = cvt_pk_bf16(hi[1][2], hi[1][3]);
                *(u32x4*)(rowp) = w0; *(u32x4*)(rowp + 32) = w1;
                } else {
                unsigned char* rowp = base8 + (size_t)rt * rstride + d0;
                typedef unsigned u2v __attribute__((ext_vector_type(2))); u2v w0, w1;
#define QK8(a, b, c, d) ({ int t_ = __builtin_amdgcn_cvt_pk_fp8_f32(__builtin_fminf(__builtin_fmaxf((a) * 16.f, -448.f), 448.f), __builtin_fminf(__builtin_fmaxf((b) * 16.f, -448.f), 448.f), 0, false); \
                        (unsigned)__builtin_amdgcn_cvt_pk_fp8_f32(__builtin_fminf(__builtin_fmaxf((c) * 16.f, -448.f), 448.f), __builtin_fminf(__builtin_fmaxf((d) * 16.f, -448.f), 448.f), t_, true); })
                w0.x = QK8(lo[0][0], lo[0][1], lo[0][2], lo[0][3]); w0.y = QK8(lo[1][0], lo[1][1], lo[1][2], lo[1][3]);
                w1.x = QK8(hi[0][0], hi[0][1], hi[0][2], hi[0][3]); w1.y = QK8(hi[1][0], hi[1][1], hi[1][2], hi[1][3]);
#undef QK8
                *(u2v*)(rowp) = w0; *(u2v*)(rowp + 32) = w1;
                }
            }
    }
};

struct EpiResid {
    static constexpr bool PERM = false, AFTER_DRAIN = false;
    const float* res; const float* gate; float* out; float alpha;
    __device__ __forceinline__ void operator()(const f32x4 (&acc)[2][2][4][2], const Unit& u, int wr, int wc, int fr, int fq) const {
        const int row0 = u.pm * BM + wr * 64 + fr, col0 = u.pn * BM + wc * 32 + 4 * fq, b = u.pm >> 4;
        f32x4 gv[2][2];
#pragma unroll
        for (int bj = 0; bj < 2; ++bj)
#pragma unroll
            for (int n = 0; n < 2; ++n) gv[bj][n] = *(const f32x4*)(gate + b * 12288 + col0 + bj * HALF + n * 16);
#pragma unroll
        for (int ai = 0; ai < 2; ++ai)
#pragma unroll
            for (int m = 0; m < 4; ++m) { const size_t off = (size_t)(row0 + ai * HALF + m * 16) * 2048 + col0;
#pragma unroll
                for (int bj = 0; bj < 2; ++bj)
#pragma unroll
                    for (int n = 0; n < 2; ++n) { const f32x4 xv = *(const f32x4*)(res + off + bj * HALF + n * 16);
                        *(f32x4*)(out + off + bj * HALF + n * 16) = xv * alpha + gv[bj][n] * acc[ai][bj][m][n]; } }
    }
};


struct EpiBf16Plain {
    static constexpr bool PERM = true, AFTER_DRAIN = false;
    bf16_t* O; int ldc;
    __device__ __forceinline__ void operator()(const f32x4 (&acc)[2][2][4][2], const Unit& u, int wr, int wc, int fr, int fq) const {
        const int row0 = u.pm * BM + wr * 64 + fr, col0 = u.pn * BM + wc * 32 + 8 * fq;
#pragma unroll
        for (int ai = 0; ai < 2; ++ai)
#pragma unroll
            for (int m = 0; m < 4; ++m) { bf16_t* rowp = O + (size_t)(row0 + ai * HALF + m * 16) * ldc + col0;
#pragma unroll
                for (int bj = 0; bj < 2; ++bj) { const f32x4 v0 = acc[ai][bj][m][0], v1 = acc[ai][bj][m][1];
                    u32x4 w; w.x = cvt_pk_bf16(v0[0], v0[1]); w.y = cvt_pk_bf16(v0[2], v0[3]); w.z = cvt_pk_bf16(v1[0], v1[1]); w.w = cvt_pk_bf16(v1[2], v1[3]);
                    *(u32x4*)(rowp + bj * HALF) = w; } }
    }
};


struct EpiFp8Plain {
    static constexpr bool PERM = true, AFTER_DRAIN = false;
    unsigned char* O; int ldc; float scl;
    __device__ __forceinline__ void operator()(const f32x4 (&acc)[2][2][4][2], const Unit& u, int wr, int wc, int fr, int fq) const {
        const int row0 = u.pm * BM + wr * 64 + fr, col0 = u.pn * BM + wc * 32 + 8 * fq;
        typedef unsigned u2v __attribute__((ext_vector_type(2)));
#pragma unroll
        for (int ai = 0; ai < 2; ++ai)
#pragma unroll
            for (int m = 0; m < 4; ++m) { unsigned char* rowp = O + (size_t)(row0 + ai * HALF + m * 16) * ldc + col0;
#pragma unroll
                for (int bj = 0; bj < 2; ++bj) { const f32x4 v0 = acc[ai][bj][m][0] * scl, v1 = acc[ai][bj][m][1] * scl; u2v w;
                    { int t = __builtin_amdgcn_cvt_pk_fp8_f32(__builtin_fminf(__builtin_fmaxf(v0[0], -448.f), 448.f), __builtin_fminf(__builtin_fmaxf(v0[1], -448.f), 448.f), 0, false);
                      w.x = (unsigned)__builtin_amdgcn_cvt_pk_fp8_f32(__builtin_fminf(__builtin_fmaxf(v0[2], -448.f), 448.f), __builtin_fminf(__builtin_fmaxf(v0[3], -448.f), 448.f), t, true); }
                    { int t = __builtin_amdgcn_cvt_pk_fp8_f32(__builtin_fminf(__builtin_fmaxf(v1[0], -448.f), 448.f), __builtin_fminf(__builtin_fmaxf(v1[1], -448.f), 448.f), 0, false);
                      w.y = (unsigned)__builtin_amdgcn_cvt_pk_fp8_f32(__builtin_fminf(__builtin_fmaxf(v1[2], -448.f), 448.f), __builtin_fminf(__builtin_fmaxf(v1[3], -448.f), 448.f), t, true); }
                    *(u2v*)(rowp + bj * HALF) = w; } }
    }
};

struct EpiSwiglu {
    static constexpr bool PERM = true, AFTER_DRAIN = false;
    bf16_t* H; int ldh;
    __device__ __forceinline__ void operator()(const f32x4 (&acc)[2][2][4][2], const Unit& u, int wr, int wc, int fr, int fq) const {
        const int row0 = u.pm * BM + wr * 64 + fr, col0 = u.pn * 128 + wc * 32 + 8 * fq;
#pragma unroll
        for (int ai = 0; ai < 2; ++ai)
#pragma unroll
            for (int m = 0; m < 4; ++m) { bf16_t* rowp = H + (size_t)(row0 + ai * HALF + m * 16) * ldh + col0;
                f32x4 o[2];
#pragma unroll
                for (int n = 0; n < 2; ++n) { const f32x4 g = acc[ai][0][m][n], up = acc[ai][1][m][n];
#pragma unroll
                    for (int e = 0; e < 4; ++e) { const float sg = __builtin_amdgcn_rcpf(1.0f + __builtin_amdgcn_exp2f(-1.4426950408889634f * g[e])); o[n][e] = g[e] * sg * up[e]; } }
                u32x4 w; w.x = cvt_pk_bf16(o[0][0], o[0][1]); w.y = cvt_pk_bf16(o[0][2], o[0][3]); w.z = cvt_pk_bf16(o[1][0], o[1][1]); w.w = cvt_pk_bf16(o[1][2], o[1][3]);
                *(u32x4*)rowp = w; }
    }
};


struct EpiSwiglu8 {
    static constexpr bool PERM = true, AFTER_DRAIN = false;
    bf16_t* H; int ldh; const float* rowscale; float dqg, dqu;
    __device__ __forceinline__ void operator()(const f32x4 (&acc)[2][2][4][2], const Unit& u, int wr, int wc, int fr, int fq) const {
        const int row0 = u.pm * BM + wr * 64 + fr, col0 = u.pn * 128 + wc * 32 + 8 * fq;
#pragma unroll
        for (int ai = 0; ai < 2; ++ai)
#pragma unroll
            for (int m = 0; m < 4; ++m) { const int row = row0 + ai * HALF + m * 16; bf16_t* rowp = H + (size_t)row * ldh + col0;
                const float rs = rowscale[row], sg_ = rs * dqg, su_ = rs * dqu;
                f32x4 o[2];
#pragma unroll
                for (int n = 0; n < 2; ++n) { const v4i_t gi = __builtin_bit_cast(v4i_t, acc[ai][0][m][n]), ui = __builtin_bit_cast(v4i_t, acc[ai][1][m][n]);
#pragma unroll
                    for (int e = 0; e < 4; ++e) { const float g = (float)gi[e] * sg_, up = (float)ui[e] * su_;
                        const float sg = __builtin_amdgcn_rcpf(1.0f + __builtin_amdgcn_exp2f(-1.4426950408889634f * g)); o[n][e] = g * sg * up; } }
                u32x4 w; w.x = cvt_pk_bf16(o[0][0], o[0][1]); w.y = cvt_pk_bf16(o[0][2], o[0][3]); w.z = cvt_pk_bf16(o[1][0], o[1][1]); w.w = cvt_pk_bf16(o[1][2], o[1][3]);
                *(u32x4*)rowp = w; }
    }
};

__device__ __forceinline__ v8i_t cat16(bf16x8 a, bf16x8 b) { return __builtin_shufflevector(__builtin_bit_cast(v4i_t, a), __builtin_bit_cast(v4i_t, b), 0, 1, 2, 3, 4, 5, 6, 7); }
template <class Epi, class Sched, bool ALIGN_EPI = false, bool SP2 = false, int SCW = 0, int SCA = 0, bool SWAPV = false, bool I8 = false>
__device__ __forceinline__ void gemm_phase(PG8_LAS unsigned char* lds, const Gemm g, const Sched& S, const Epi& E) {
    const int tid = threadIdx.x, wid = __builtin_amdgcn_readfirstlane(tid >> 6), lane = tid & 63, wr = wid >> 2, wc = wid & 3, fr = lane & 15, fq = lane >> 4;
    const int K = g.K, nt = K / BK;
    unsigned voffA[2], voffB[2];
#pragma unroll
    for (int i = 0; i < 2; ++i) { int R, C; stage_rc(tid * 16 + i * 8192, R, C); const int Rb = Epi::PERM ? ((R & ~31) + perm32(R & 31)) : R;
        voffA[i] = (unsigned)(R * K + C) * 2u; voffB[i] = (unsigned)(Rb * K + C) * 2u; }
    const size_t kstep = (size_t)(BK * 2);
    const size_t hstep = (size_t)HALF * K * 2;
    const size_t tstep = 2 * hstep;
    const unsigned ldsw = (unsigned)wid * 1024u;
    const int aoff = lds_byte(wr * 64 + fr, fq * 8), boff = lds_byte(wc * 32 + fr, fq * 8);
#define PG8_SA(b, h) (((b) * 2 + (h)) * HTB)
#define PG8_SB(b, h) ((4 + (b) * 2 + (h)) * HTB)
#define PG8_STAGE(bufoff, gbase, voff) do { _Pragma("unroll") for (int _i = 0; _i < 2; ++_i) \
        __builtin_amdgcn_global_load_lds((const unsigned*)((const char*)(gbase) + (voff)[_i]), (PG8_LAS unsigned*)(lds + (bufoff) + ldsw + _i * 8192), 16, 0, 0); } while (0)
#define PG8_LDA(dst, b, h) do { _Pragma("unroll") for (int m = 0; m < 4; ++m) { if constexpr (SCW != 0) dst##8[m] = cat16(*(const PG8_LAS bf16x8*)(lds + PG8_SA(b, h) + aoff + m * 2048), *(const PG8_LAS bf16x8*)(lds + PG8_SA(b, h) + aoff + m * 2048 + 1024)); \
        else { _Pragma("unroll") for (int k = 0; k < 2; ++k) dst[m][k] = *(const PG8_LAS bf16x8*)(lds + PG8_SA(b, h) + aoff + m * 2048 + k * 1024); } } } while (0)
#define PG8_LDB(dst, b, h) do { _Pragma("unroll") for (int n = 0; n < 2; ++n) { if constexpr (SCW != 0) dst##8[n] = cat16(*(const PG8_LAS bf16x8*)(lds + PG8_SB(b, h) + boff + n * 2048), *(const PG8_LAS bf16x8*)(lds + PG8_SB(b, h) + boff + n * 2048 + 1024)); \
        else { _Pragma("unroll") for (int k = 0; k < 2; ++k) dst[n][k] = *(const PG8_LAS bf16x8*)(lds + PG8_SB(b, h) + boff + n * 2048 + k * 1024); } } } while (0)
#define PG8_MMA(ai, bj, At, Bt) do { __builtin_amdgcn_s_setprio(1); _Pragma("unroll") for (int m = 0; m < 4; ++m) _Pragma("unroll") for (int n = 0; n < 2; ++n) { \
        if constexpr (SCW != 0) asm volatile("v_mfma_scale_f32_16x16x128_f8f6f4 %0, %1, %2, %0, %3, %4 op_sel_hi:[0,0,0]" : "+v"(acc[ai][bj][m][n]) : "v"(Bt##8[n]), "v"(At##8[m]), "v"(scw_), "v"(sca_));     \
        else if constexpr (I8) { _Pragma("unroll") for (int k = 0; k < 2; ++k) acc[ai][bj][m][n] = __builtin_bit_cast(f32x4, __builtin_amdgcn_mfma_i32_16x16x64_i8(__builtin_bit_cast(v4i_t, Bt[n][k]), __builtin_bit_cast(v4i_t, At[m][k]), __builtin_bit_cast(v4i_t, acc[ai][bj][m][n]), 0, 0, 0)); } \
        else { _Pragma("unroll") for (int k = 0; k < 2; ++k) acc[ai][bj][m][n] = __builtin_amdgcn_mfma_f32_16x16x32_bf16(Bt[n][k], At[m][k], acc[ai][bj][m][n], 0, 0, 0); } } \
        __builtin_amdgcn_s_setprio(0); } while (0)
#define PG8_WAIT_V(n) asm volatile("s_waitcnt vmcnt(" #n ")" ::: "memory")
#define PG8_WAIT_L(n) asm volatile("s_waitcnt lgkmcnt(" #n ")" ::: "memory")
#define PG8_BAR __builtin_amdgcn_s_barrier()
#define PG8_SCHED __builtin_amdgcn_sched_barrier(0)
    Unit cur, nxt; int ui = 0;
    if (!S.next(0, cur)) return;
    f32x4 acc[2][2][4][2];
#pragma unroll
    for (int a = 0; a < 2; ++a)
#pragma unroll
        for (int b = 0; b < 2; ++b)
#pragma unroll
            for (int m = 0; m < 4; ++m)
#pragma unroll
                for (int n = 0; n < 2; ++n) acc[a][b][m][n] = (f32x4){0.f, 0.f, 0.f, 0.f};
    int scw_ = SCW, sca_ = SCA; asm volatile("" : "+v"(scw_), "+v"(sca_));
    bf16x8 At[4][2], B0[2][2], B1[2][2]; v8i_t At8[4], B08[2], B18[2];
    const char* cA = (const char*)g.A + (size_t)cur.pm * tstep; const char* cB = (const char*)g.Bt + (size_t)cur.pn * tstep;
    S.a_ready(cur);
    if constexpr (SP2) {
        PG8_STAGE(PG8_SB(0, 0), cB, voffB); PG8_STAGE(PG8_SB(0, 1), cB + hstep, voffB); PG8_STAGE(PG8_SA(0, 0), cA, voffA); PG8_STAGE(PG8_SA(0, 1), cA + hstep, voffA);
        if (wr == 1) PG8_BAR;
        PG8_WAIT_V(2); PG8_BAR;
        PG8_STAGE(PG8_SB(1, 0), cB + kstep, voffB); PG8_STAGE(PG8_SA(1, 0), cA + kstep, voffA); PG8_STAGE(PG8_SB(1, 1), cB + hstep + kstep, voffB);
        PG8_WAIT_V(6); PG8_BAR;
    } else {
        PG8_STAGE(PG8_SB(0, 0), cB, voffB); PG8_STAGE(PG8_SA(0, 0), cA, voffA); PG8_STAGE(PG8_SB(0, 1), cB + hstep, voffB); PG8_STAGE(PG8_SA(0, 1), cA + hstep, voffA);
        if (wr == 1) PG8_BAR;
        PG8_WAIT_V(4); PG8_BAR;
        PG8_STAGE(PG8_SB(1, 0), cB + kstep, voffB); PG8_STAGE(PG8_SA(1, 0), cA + kstep, voffA); PG8_STAGE(PG8_SB(1, 1), cB + hstep + kstep, voffB);
        PG8_WAIT_V(6); PG8_BAR;
    }
    for (;;) {
        const bool has_next = S.next(ui + 1, nxt);
        const char* nA = has_next ? (const char*)g.A + (size_t)nxt.pm * tstep : cA; const char* nB = has_next ? (const char*)g.Bt + (size_t)nxt.pn * tstep : cB;
        for (int t = 0; t < nt; t += 2) {
            const bool last = (t == nt - 2);
            const char* a1 = cA + (size_t)(t + 1) * kstep;
            const char* a2 = last ? nA : cA + (size_t)(t + 2) * kstep; const char* b2 = last ? nB : cB + (size_t)(t + 2) * kstep;
            const char* a3 = a2 + kstep; const char* b3 = b2 + kstep;
            if (last && has_next) S.a_ready(nxt);
            if constexpr (SP2) {
            PG8_LDB(B0, 0, 0); PG8_LDB(B1, 0, 1); PG8_SCHED; PG8_LDA(At, 0, 0); PG8_STAGE(PG8_SA(1, 1), a1 + hstep, voffA);
            PG8_WAIT_V(8); PG8_WAIT_L(0); PG8_BAR; PG8_MMA(0, 0, At, B0); PG8_MMA(0, 1, At, B1); PG8_BAR; PG8_SCHED;
            PG8_LDA(At, 0, 1); PG8_STAGE(PG8_SB(0, 0), b2, voffB); PG8_STAGE(PG8_SB(0, 1), b2 + hstep, voffB); PG8_STAGE(PG8_SA(0, 0), a2, voffA);
            PG8_WAIT_V(8); PG8_WAIT_L(0); PG8_BAR; PG8_MMA(1, 0, At, B0); PG8_MMA(1, 1, At, B1); PG8_BAR; PG8_SCHED;
            PG8_LDB(B0, 1, 0); PG8_LDB(B1, 1, 1); PG8_SCHED; PG8_LDA(At, 1, 0); PG8_STAGE(PG8_SA(0, 1), a2 + hstep, voffA);
            PG8_WAIT_V(8); PG8_WAIT_L(0); PG8_BAR; PG8_MMA(0, 0, At, B0); PG8_MMA(0, 1, At, B1); PG8_BAR; PG8_SCHED;
            PG8_LDA(At, 1, 1); PG8_STAGE(PG8_SB(1, 0), b3, voffB); PG8_STAGE(PG8_SB(1, 1), b3 + hstep, voffB); PG8_STAGE(PG8_SA(1, 0), a3, voffA);
            PG8_WAIT_V(8); PG8_WAIT_L(0); PG8_BAR; PG8_MMA(1, 0, At, B0); PG8_MMA(1, 1, At, B1); PG8_BAR; PG8_SCHED;
            } else {
            PG8_LDB(B0, 0, 0); PG8_SCHED; PG8_LDA(At, 0, 0); PG8_STAGE(PG8_SA(1, 1), a1 + hstep, voffA);
            PG8_WAIT_L(8); PG8_BAR; PG8_WAIT_L(0); PG8_MMA(0, 0, At, B0); PG8_BAR; PG8_SCHED;
            PG8_LDB(B1, 0, 1); PG8_STAGE(PG8_SB(0, 0), b2, voffB);
            PG8_BAR; PG8_WAIT_L(0); PG8_MMA(0, 1, At, B1); PG8_BAR;
            PG8_LDA(At, 0, 1); PG8_STAGE(PG8_SA(0, 0), a2, voffA);
            PG8_BAR; PG8_WAIT_L(0); PG8_MMA(1, 0, At, B0); PG8_BAR; PG8_SCHED;
            PG8_STAGE(PG8_SB(0, 1), b2 + hstep, voffB);
            PG8_WAIT_V(6); PG8_BAR; PG8_MMA(1, 1, At, B1); PG8_BAR;
            PG8_LDB(B0, 1, 0); PG8_SCHED; PG8_LDA(At, 1, 0); PG8_STAGE(PG8_SA(0, 1), a2 + hstep, voffA);
            PG8_WAIT_L(8); PG8_BAR; PG8_WAIT_L(0); PG8_MMA(0, 0, At, B0); PG8_BAR; PG8_SCHED;
            PG8_LDB(B1, 1, 1); PG8_STAGE(PG8_SB(1, 0), b3, voffB);
            PG8_BAR; PG8_WAIT_L(0); PG8_MMA(0, 1, At, B1); PG8_BAR;
            PG8_LDA(At, 1, 1); PG8_STAGE(PG8_SA(1, 0), a3, voffA);
            PG8_BAR; PG8_WAIT_L(0); PG8_MMA(1, 0, At, B0); PG8_BAR; PG8_SCHED;
            PG8_STAGE(PG8_SB(1, 1), b3 + hstep, voffB);
            PG8_WAIT_V(6); PG8_BAR; PG8_MMA(1, 1, At, B1); PG8_BAR;
            }
        }
        if constexpr (ALIGN_EPI) { if (wr == 0) PG8_BAR; }
        if constexpr (SCW != 0) asm volatile("s_nop 15\n\ts_nop 15" ::: "memory");
        if constexpr (!Epi::AFTER_DRAIN) { E(acc, cur, wr, wc, fr, fq); S.done(cur); }
        if (!has_next) break;
#pragma unroll
        for (int a = 0; a < 2; ++a)
#pragma unroll
            for (int b = 0; b < 2; ++b)
#pragma unroll
                for (int m = 0; m < 4; ++m)
#pragma unroll
                    for (int n = 0; n < 2; ++n) acc[a][b][m][n] = (f32x4){0.f, 0.f, 0.f, 0.f};
        cur = nxt; cA = nA; cB = nB; ++ui;
        if constexpr (ALIGN_EPI) { if (wr == 1) PG8_BAR; }
    }
    PG8_WAIT_V(0);
    if constexpr (!ALIGN_EPI) { if (wr == 0) PG8_BAR; }
    PG8_BAR;
#undef PG8_SA
#undef PG8_SB
#undef PG8_STAGE
#undef PG8_LDA
#undef PG8_LDB
#undef PG8_MMA
#undef PG8_WAIT_V
#undef PG8_WAIT_L
#undef PG8_BAR
#undef PG8_SCHED
}
}

namespace att {
typedef unsigned short bf16;
using bf16x8 = __attribute__((ext_vector_type(8))) short;
using s16x4  = __attribute__((ext_vector_type(4))) short;
using f32x16 = __attribute__((ext_vector_type(16))) float;
using u32x4  = __attribute__((ext_vector_type(4))) unsigned;
typedef int v8i __attribute__((ext_vector_type(8))); typedef int v4i __attribute__((ext_vector_type(4)));
constexpr int D = 128, NW = 8, QBLK = 32, KVBLK = 64;
constexpr float SCALE = 0.088388347648318440f;
constexpr float THR = 1.5f;
constexpr float PSHIFT = 6.0f;
constexpr int LDQ = 2048, LDK = 128, LDO = 2048;
constexpr float OSCL = 16.f;
constexpr int SHM_V = KVBLK * D  , SHM_K = KVBLK * D  , SHM_ATTN = 2 * SHM_V + 2 * SHM_K + NW * 64 * 4;
#define KSWZ(row, colB) ((row) * 256 + ((colB) ^ (((row) & 7) << 4)))
#define SBAR() __builtin_amdgcn_sched_barrier(0)
__device__ __forceinline__ int crow(int r, int hi) { return (r & 3) + 8 * (r >> 2) + 4 * hi; }
__device__ __forceinline__ unsigned cvtpk(float lo, float hi) { unsigned r; asm volatile("v_cvt_pk_bf16_f32 %0, %1, %2" : "=v"(r) : "v"(lo), "v"(hi)); return r; }

__device__ __forceinline__ void partialSM(f32x16& p0, f32x16& p1, float& m_reg, float& mn, float& alpha, bool fixedm) {
  constexpr float C = SCALE * 1.4426950408889634f;
  if (fixedm) { mn = m_reg; alpha = 1.f; }
  else {
  float pmax = p0[0]; for (int r = 1; r < 16; ++r) pmax = fmaxf(pmax, p0[r]); for (int r = 0; r < 16; ++r) pmax = fmaxf(pmax, p1[r]);
  { auto rr = __builtin_amdgcn_permlane32_swap(__float_as_uint(pmax), __float_as_uint(pmax), false, false);
    pmax = fmaxf(__uint_as_float(rr[0]), __uint_as_float(rr[1])); }
  if (__builtin_expect(__all(pmax - m_reg <= THR / SCALE), 1)) { mn = m_reg; alpha = 1.f; }
  else { mn = fmaxf(m_reg, pmax); alpha = __builtin_amdgcn_exp2f((m_reg - mn) * C); m_reg = mn; }
  }
  float mnC = -mn * C + PSHIFT;
  for (int r = 0; r < 16; ++r) p0[r] = fmaf(p0[r], C, mnC); for (int r = 0; r < 16; ++r) p1[r] = fmaf(p1[r], C, mnC);
  for (int r = 0; r < 16; ++r) p0[r] = __builtin_amdgcn_exp2f(p0[r]);
}
__device__ __forceinline__ void finishSM8(f32x16& p0, f32x16& p1, float alpha, float& l_reg, v8i& pa) {
  for (int r = 0; r < 16; ++r) p1[r] = __builtin_amdgcn_exp2f(p1[r]);
  float ps = 0; for (int r = 0; r < 16; ++r) ps += p0[r]; for (int r = 0; r < 16; ++r) ps += p1[r];
  { auto rr = __builtin_amdgcn_permlane32_swap(__float_as_uint(ps), __float_as_uint(ps), false, false);
    ps = __uint_as_float(rr[0]) + __uint_as_float(rr[1]); }
  l_reg = l_reg * alpha + ps * (1.0f / 64.0f);
#pragma unroll
  for (int w = 0; w < 4; ++w) {
    int t0_ = __builtin_amdgcn_cvt_pk_fp8_f32(p0[4 * w], p0[4 * w + 1], 0, false); pa[w] = __builtin_amdgcn_cvt_pk_fp8_f32(p0[4 * w + 2], p0[4 * w + 3], t0_, true);
    int t1_ = __builtin_amdgcn_cvt_pk_fp8_f32(p1[4 * w], p1[4 * w + 1], 0, false); pa[4 + w] = __builtin_amdgcn_cvt_pk_fp8_f32(p1[4 * w + 2], p1[4 * w + 3], t1_, true); }
}
__device__ __forceinline__ void finishSM(f32x16& p0, f32x16& p1, float alpha, float& l_reg, bf16x8& pa0, bf16x8& pa1, bf16x8& pa2, bf16x8& pa3) {
  for (int r = 0; r < 16; ++r) p1[r] = __builtin_amdgcn_exp2f(p1[r]);
  float ps = 0; for (int r = 0; r < 16; ++r) ps += p0[r]; for (int r = 0; r < 16; ++r) ps += p1[r];
  { auto rr = __builtin_amdgcn_permlane32_swap(__float_as_uint(ps), __float_as_uint(ps), false, false);
    ps = __uint_as_float(rr[0]) + __uint_as_float(rr[1]); }
  l_reg = l_reg * alpha + ps;
#define PK4(P, BASE, OUT) do { unsigned a0 = cvtpk(P[BASE + 0], P[BASE + 1]), a1 = cvtpk(P[BASE + 2], P[BASE + 3]);   \
    unsigned b0 = cvtpk(P[BASE + 4], P[BASE + 5]), b1 = cvtpk(P[BASE + 6], P[BASE + 7]);                              \
    auto r0 = __builtin_amdgcn_permlane32_swap(a0, b0, false, false); auto r1 = __builtin_amdgcn_permlane32_swap(a1, b1, false, false); \
    u32x4 w = {r0[0], r1[0], r0[1], r1[1]}; OUT = *reinterpret_cast<bf16x8*>(&w); } while (0)
  PK4(p0, 0, pa0); PK4(p0, 8, pa1); PK4(p1, 0, pa2); PK4(p1, 8, pa3);
#undef PK4
}
__device__ __forceinline__ void qkt(f32x16& p0, f32x16& p1, const bf16* Ks, const bf16x8* qr, int r32, int hi) {
  p0 = f32x16{}; p1 = f32x16{};
  for (int d0 = 0; d0 < 8; ++d0) { int cb = (d0 * 16 + hi * 8) * 2;
    bf16x8 b0 = *reinterpret_cast<const bf16x8*>((const char*)Ks + KSWZ(r32, cb));
    bf16x8 b1 = *reinterpret_cast<const bf16x8*>((const char*)Ks + KSWZ(32 + r32, cb));
    p0 = __builtin_amdgcn_mfma_f32_32x32x16_bf16(b0, qr[d0], p0, 0, 0, 0);
    p1 = __builtin_amdgcn_mfma_f32_32x32x16_bf16(b1, qr[d0], p1, 0, 0, 0); }
}
__device__ __forceinline__ void wmask(f32x16& p0, f32x16& p1, int kb, int qpos) {
  const int dq = qpos - kb + 128;
#pragma unroll
  for (int r = 0; r < 16; ++r) { const int d = dq - ((r & 3) + 8 * (r >> 2));
    if ((unsigned)d > 256u) p0[r] = -INFINITY;
    if ((unsigned)(d - 32) > 256u) p1[r] = -INFINITY; }
}
__device__ __forceinline__ int v_st(int k, int c) { const int kk = (k & ~0xC) | ((k & 4) << 1) | ((k & 8) >> 1); return ((kk >> 3) * 4 + (c >> 5)) * 512 + ((kk & 7) * 32 + (c & 31)) * 2; }
__device__ __forceinline__ int v_rd_base(int lane) { return ((lane & 3) << 3) | (((lane >> 2) & 3) << 6) | (((lane >> 4) & 1) << 5) | (((lane >> 5) & 1) << 8); }
constexpr int v_rd_off(int d0, int ks, int half) { return d0 * 512 + ks * 4096 + half * 2048; }
template <int OFF> __device__ __forceinline__ s16x4 tr_read(int vb) {
  s16x4 r; asm volatile("ds_read_b64_tr_b16 %0, %1 offset:%2" : "=&v"(r) : "v"(vb), "i"(OFF) : "memory"); return r;
}
template <int D0> __device__ __forceinline__ void pv_one(f32x16& od, int vb, bf16x8 pa0, bf16x8 pa1, bf16x8 pa2, bf16x8 pa3) {
  const s16x4 l0 = tr_read<v_rd_off(D0, 0, 0)>(vb), h0 = tr_read<v_rd_off(D0, 0, 1)>(vb), l1 = tr_read<v_rd_off(D0, 1, 0)>(vb), h1 = tr_read<v_rd_off(D0, 1, 1)>(vb);
  const s16x4 l2 = tr_read<v_rd_off(D0, 2, 0)>(vb), h2 = tr_read<v_rd_off(D0, 2, 1)>(vb), l3 = tr_read<v_rd_off(D0, 3, 0)>(vb), h3 = tr_read<v_rd_off(D0, 3, 1)>(vb);
  asm volatile("s_waitcnt lgkmcnt(0)" ::: "memory"); SBAR();
#define PK(L, H) (bf16x8){L[0], L[1], L[2], L[3], H[0], H[1], H[2], H[3]}
  od = __builtin_amdgcn_mfma_f32_32x32x16_bf16(pa0, PK(l0, h0), od, 0, 0, 0);
  od = __builtin_amdgcn_mfma_f32_32x32x16_bf16(pa1, PK(l1, h1), od, 0, 0, 0);
  od = __builtin_amdgcn_mfma_f32_32x32x16_bf16(pa2, PK(l2, h2), od, 0, 0, 0);
  od = __builtin_amdgcn_mfma_f32_32x32x16_bf16(pa3, PK(l3, h3), od, 0, 0, 0);
#undef PK
}
__device__ __forceinline__ void pv_d0(f32x16* o, int vb, bf16x8 pa0, bf16x8 pa1, bf16x8 pa2, bf16x8 pa3) {
  pv_one<0>(o[0], vb, pa0, pa1, pa2, pa3); pv_one<1>(o[1], vb, pa0, pa1, pa2, pa3); pv_one<2>(o[2], vb, pa0, pa1, pa2, pa3); pv_one<3>(o[3], vb, pa0, pa1, pa2, pa3);
}

struct Stg { v4i v8; v4i k8; };
#define V8OFF(d, ch) ((d) * 64 + ((((ch) ^ (((d) >> 2) & 3))) << 4))
#define K8OFF(row, ch) ((row) * 128 + ((((ch) ^ (((row) >> 1) & 7))) << 4))
__device__ __forceinline__ v8i cat8(v4i a, v4i b) { return __builtin_shufflevector(a, b, 0, 1, 2, 3, 4, 5, 6, 7); }
__device__ __forceinline__ void qkt8(f32x16& p0, f32x16& p1, const char* Ks, const v8i (&q8)[2], int r32, int hi, int sc) {
  const v8i a00 = cat8(*(const v4i*)(Ks + K8OFF(r32, 2 * hi)), *(const v4i*)(Ks + K8OFF(r32, 2 * hi + 1)));
  const v8i a10 = cat8(*(const v4i*)(Ks + K8OFF(32 + r32, 2 * hi)), *(const v4i*)(Ks + K8OFF(32 + r32, 2 * hi + 1)));
  const v8i a01 = cat8(*(const v4i*)(Ks + K8OFF(r32, 4 + 2 * hi)), *(const v4i*)(Ks + K8OFF(r32, 4 + 2 * hi + 1)));
  const v8i a11 = cat8(*(const v4i*)(Ks + K8OFF(32 + r32, 4 + 2 * hi)), *(const v4i*)(Ks + K8OFF(32 + r32, 4 + 2 * hi + 1)));
  asm volatile("s_nop 1\n\tv_mfma_scale_f32_32x32x64_f8f6f4 %0, %1, %2, 0, %3, %3 op_sel_hi:[0,0,0]" : "=&v"(p0) : "v"(a00), "v"(q8[0]), "v"(sc));
  asm volatile("s_nop 1\n\tv_mfma_scale_f32_32x32x64_f8f6f4 %0, %1, %2, 0, %3, %3 op_sel_hi:[0,0,0]" : "=&v"(p1) : "v"(a10), "v"(q8[0]), "v"(sc));
  asm volatile("s_nop 1\n\tv_mfma_scale_f32_32x32x64_f8f6f4 %0, %1, %2, %0, %3, %3 op_sel_hi:[0,0,0]" : "+v"(p0) : "v"(a01), "v"(q8[1]), "v"(sc));
  asm volatile("s_nop 1\n\tv_mfma_scale_f32_32x32x64_f8f6f4 %0, %1, %2, %0, %3, %3 op_sel_hi:[0,0,0]" : "+v"(p1) : "v"(a11), "v"(q8[1]), "v"(sc));
}
__device__ __forceinline__ void pv8(f32x16* o, const char* Vs, const v8i& pa, int r32, int hi, int scp, int scv) {
#pragma unroll
  for (int d0 = 0; d0 < 4; ++d0) { const int d = 32 * d0 + r32;
    const v8i bfr = cat8(*(const v4i*)(Vs + V8OFF(d, 2 * hi)), *(const v4i*)(Vs + V8OFF(d, 2 * hi + 1)));
    asm volatile("s_nop 1\n\tv_mfma_scale_f32_32x32x64_f8f6f4 %0, %1, %2, %0, %3, %4 op_sel_hi:[0,0,0]" : "+v"(o[d0]) : "v"(pa), "v"(bfr), "v"(scp), "v"(scv)); }
}
#define O_SETTLE() asm volatile("s_nop 15\n\ts_nop 7" : "+v"(o[0]), "+v"(o[1]), "+v"(o[2]), "+v"(o[3]))
#define QKT_SETTLE(P0, P1) asm volatile("s_nop 15\n\ts_nop 7" : "+v"(P0), "+v"(P1))
struct AUnit { const unsigned char* Q; const unsigned char* K; const unsigned char* V; unsigned char* O; int NT, nctx, jlo, q0; bool masked; float sinkl2, kbound; };
#define KOFU(u, t) (((t) < (u).nctx) ? (4096 + 64 * (t)) : 64 * ((u).jlo + (t) - (u).nctx))
#define SLOADX(dst, Kp, Vp, k0) do { const int k0_ = (k0); (dst).v8 = *reinterpret_cast<const v4i*>(&(Vp)[(long)(tid >> 2) * 4352 + k0_ + (tid & 3) * 16]); \
    (dst).k8 = *reinterpret_cast<const v4i*>(&(Kp)[(long)(k0_ + (tid >> 3)) * 128 + (tid & 7) * 16]); } while (0)
__device__ __forceinline__ void attn_prime(const AUnit& u, v8i (&qr)[2], Stg (&sr_)[2]) {
  const int tid = threadIdx.x, wid = tid >> 6, lane = tid & 63, r32 = lane & 31, hi = lane >> 5;
  const unsigned char* Qw = u.Q + (long)(wid * QBLK + r32) * LDQ + hi * 32;
#pragma unroll
  for (int j = 0; j < 2; ++j) qr[j] = cat8(*reinterpret_cast<const v4i*>(Qw + 64 * j), *reinterpret_cast<const v4i*>(Qw + 64 * j + 16));
  SLOADX(sr_[0], u.K, u.V, KOFU(u, 0)); SLOADX(sr_[1], u.K, u.V, KOFU(u, 1));
}
__device__ __forceinline__ void attn_unit(const AUnit& u, bool has_next, const AUnit& nx, v8i (&qr)[2], Stg (&sr_)[2], char* lds) {
  const int tid = threadIdx.x, wid = tid >> 6, lane = tid & 63, r32 = lane & 31, hi = lane >> 5;
  const unsigned char* __restrict__ Kh = u.K; const unsigned char* __restrict__ Vh = u.V;
  int qksc = (127 - 4) * 0x01010101, pvsc = (127 - 6) * 0x01010101; asm volatile("" : "+v"(qksc), "+v"(pvsc));
  const int NT = u.NT, nctx = u.nctx, jlo = u.jlo; const bool masked = u.masked;
  bf16* V_lds = (bf16*)lds; bf16* K_lds = (bf16*)(lds + 2 * SHM_V);
  float* ws = (float*)(lds + 2 * SHM_V + 2 * SHM_K) + wid * 64; float* li_l = ws; float* al_l = ws + 32;
  float m_reg = -1e30f, l_reg = 0; f32x16 o[4] = {};
  const bool fixedm = u.kbound > 0.f;
  if (fixedm) { float ss = 0.f;
#pragma unroll
    for (int j = 0; j < 2; ++j)
#pragma unroll
      for (int e = 0; e < 8; ++e) { const int w = qr[j][e];
        const float q0_ = __builtin_amdgcn_cvt_f32_fp8(w, 0), q1_ = __builtin_amdgcn_cvt_f32_fp8(w, 1), q2_ = __builtin_amdgcn_cvt_f32_fp8(w, 2), q3_ = __builtin_amdgcn_cvt_f32_fp8(w, 3);
        ss += (q0_ * q0_ + q1_ * q1_) + (q2_ * q2_ + q3_ * q3_); }
    { auto rr = __builtin_amdgcn_permlane32_swap(__float_as_uint(ss), __float_as_uint(ss), false, false); ss = __uint_as_float(rr[0]) + __uint_as_float(rr[1]); }
    m_reg = sqrtf(ss) * (1.0f / 16.0f) * u.kbound; }

  const int qpos = u.q0 + wid * QBLK + r32;
#define KOF(t) (((t) < nctx) ? (4096 + 64 * (t)) : 64 * (jlo + (t) - nctx))
#define SLOAD(i, k0) SLOADX(sr_[i], Kh, Vh, k0)
#define SWRITE(b, i) do { *(v4i*)((char*)V_lds + (b) * SHM_V + V8OFF(tid >> 2, tid & 3)) = sr_[i].v8;          \
    *(v4i*)((char*)K_lds + (b) * SHM_K + K8OFF(tid >> 3, tid & 7)) = sr_[i].k8; } while (0)
#define SWAIT() asm volatile("s_waitcnt vmcnt(4)" ::: "memory")
#define RESC(a) do { if (__any((a) < 1.f)) { if (hi == 0) al_l[r32] = (a); asm volatile("s_waitcnt lgkmcnt(0)" ::: "memory"); O_SETTLE(); \
    for (int d = 0; d < 4; ++d) for (int r = 0; r < 16; ++r) o[d][r] *= al_l[crow(r, hi)]; } } while (0)
#define MASK(P0, P1, t) do { if (masked && (t) >= nctx) wmask(P0, P1, KOF(t) + 4 * hi, qpos); } while (0)
  f32x16 pA0, pA1, pB0, pB1; float mnA, mnB, alA, alB; v8i pa;
  constexpr int SE = 0, SO = 1;
  SWAIT(); SWRITE(0, SE); __syncthreads();
  if (2 < NT) SLOAD(SE, KOF(2));
  qkt8(pA0, pA1, (const char*)K_lds, qr, r32, hi, qksc); QKT_SETTLE(pA0, pA1); MASK(pA0, pA1, 0); partialSM(pA0, pA1, m_reg, mnA, alA, fixedm);
  SWAIT(); SWRITE(1, SO); __syncthreads();
  for (int j = 1; j + 1 < NT; j += 2) {
    SBAR(); qkt8(pB0, pB1, (const char*)K_lds + SHM_K, qr, r32, hi, qksc);
    finishSM8(pA0, pA1, alA, l_reg, pa); SBAR();
    SLOAD(SO, KOF(j + 2)); SBAR();
    pv8(o, (const char*)V_lds, pa, r32, hi, pvsc, qksc); QKT_SETTLE(pB0, pB1); MASK(pB0, pB1, j); partialSM(pB0, pB1, m_reg, mnB, alB, fixedm);
    __syncthreads(); SWAIT(); SWRITE(0, SE);
    RESC(alB); __syncthreads();
    SBAR(); qkt8(pA0, pA1, (const char*)K_lds, qr, r32, hi, qksc);
    finishSM8(pB0, pB1, alB, l_reg, pa); SBAR();
    if (j + 3 < NT) SLOAD(SE, KOF(j + 3)); SBAR();
    pv8(o, (const char*)V_lds + SHM_V, pa, r32, hi, pvsc, qksc); QKT_SETTLE(pA0, pA1); MASK(pA0, pA1, j + 1); partialSM(pA0, pA1, m_reg, mnA, alA, fixedm);
    __syncthreads(); SWAIT(); SWRITE(1, SO);
    RESC(alA); __syncthreads();
  }
  SBAR(); qkt8(pB0, pB1, (const char*)K_lds + SHM_K, qr, r32, hi, qksc);
  finishSM8(pA0, pA1, alA, l_reg, pa); SBAR();
  pv8(o, (const char*)V_lds, pa, r32, hi, pvsc, qksc); QKT_SETTLE(pB0, pB1); MASK(pB0, pB1, NT - 1); partialSM(pB0, pB1, m_reg, mnB, alB, fixedm);
  SBAR(); if (has_next) attn_prime(nx, qr, sr_); SBAR();
  __syncthreads(); RESC(alB);
  finishSM8(pB0, pB1, alB, l_reg, pa); SBAR();
  pv8(o, (const char*)V_lds + SHM_V, pa, r32, hi, pvsc, qksc);
  O_SETTLE();
  l_reg += __builtin_amdgcn_exp2f(u.sinkl2 - m_reg * (SCALE * 1.4426950408889634f));
  if (hi == 0) li_l[r32] = l_reg; asm volatile("s_waitcnt lgkmcnt(0)" ::: "memory");
  float rli[16];
#pragma unroll
  for (int r = 0; r < 16; ++r) rli[r] = __builtin_amdgcn_rcpf(li_l[crow(r, hi)]);
  __syncthreads();
  { char* stg = lds + wid * 8192 + (4 * hi * 128 + r32) * 2;
#pragma unroll
    for (int r = 0; r < 16; ++r) {
#pragma unroll
      for (int d0 = 0; d0 < 4; ++d0) { const float v = o[d0][r] * rli[r]; *(bf16*)(stg + ((r & 3) + 8 * (r >> 2)) * 256 + d0 * 64) = (bf16)(cvtpk(v, v) & 0xffffu); }
      asm volatile("" ::: "memory"); }
    asm volatile("s_waitcnt lgkmcnt(0)" ::: "memory");
    unsigned char* Ow = u.O + (long)(wid * QBLK + (lane >> 4)) * LDO + (lane & 15) * 8;
    const char* rd = lds + wid * 8192 + (lane >> 4) * 256 + (lane & 15) * 16;
#pragma unroll
    for (int i = 0; i < 8; ++i) { const u32x4 v = *(const u32x4*)(rd + i * 1024);
      typedef unsigned u2v __attribute__((ext_vector_type(2))); u2v w;
#define LO16(x) (__uint_as_float((x) << 16) * OSCL)
#define HI16(x) (__uint_as_float((x) & 0xffff0000u) * OSCL)
      { int t = __builtin_amdgcn_cvt_pk_fp8_f32(LO16(v.x), HI16(v.x), 0, false); t = __builtin_amdgcn_cvt_pk_fp8_f32(LO16(v.y), HI16(v.y), t, true); w.x = (unsigned)t; }
      { int t = __builtin_amdgcn_cvt_pk_fp8_f32(LO16(v.z), HI16(v.z), 0, false); t = __builtin_amdgcn_cvt_pk_fp8_f32(LO16(v.w), HI16(v.w), t, true); w.y = (unsigned)t; }
#undef LO16
#undef HI16
      *(u2v*)(Ow + (long)i * 4 * LDO) = w; } }
  __syncthreads();
#undef KOF
#undef SLOAD
#undef SWRITE
#undef SWAIT
#undef RESC
#undef MASK
}
#undef KOFU
#undef SLOADX
#undef K8OFF
#undef V8OFF
#undef QKT_SETTLE
#undef O_SETTLE
#undef KSWZ
#undef SBAR
}

constexpr int NWAVES = 8;
constexpr int N_LAUNCHES = MK_N_LAUNCHES;
constexpr int N_PHASES = 10;
constexpr int DM = 2048, NB = 4, SEQ = 4096, CTXL = 256, FFN = 5632, INW = 3072, NMOD = 12288;
constexpr int M = NB * SEQ, MC = NB * CTXL, MU = M + MC;
constexpr int SKV = SEQ + CTXL;
constexpr float LN_EPS = 1e-6f;
constexpr float DN_ALPHA = 1.189207115002721f;

constexpr size_t MiB = 1u << 20;
constexpr size_t WS_CTL = 0, CTL_ZERO_BYTES = 64 * 1024;
constexpr size_t WS_MODP = 1 * MiB;
constexpr size_t WS_MODS = 2 * MiB;
constexpr size_t WS_ROPE = 2 * MiB + 512 * 1024;
constexpr size_t WS_WIN = 3 * MiB, WS_WOUT = 15 * MiB, WS_WGU = 23 * MiB, WS_WDN = 67 * MiB;
constexpr size_t WS_U = 89 * MiB;
constexpr size_t WS_Y = 157 * MiB;
constexpr size_t WS_QO = 285 * MiB;
constexpr size_t WS_KV = 349 * MiB;
constexpr size_t KV_BYTES = (size_t)NB * 2 * SKV * 128 * 2;
constexpr size_t WS_H = 285 * MiB;
constexpr size_t WS_END = 461 * MiB;
static_assert(WS_WIN + (size_t)INW * DM * 2 <= WS_WOUT && WS_WOUT + (size_t)DM * DM * 2 <= WS_WGU && WS_WGU + (size_t)2 * FFN * DM * 2 <= WS_WDN && WS_WDN + (size_t)DM * FFN * 2 <= WS_U, "ws map (weights)");
static_assert(WS_U + (size_t)MU * DM * 2 <= WS_Y && WS_Y + (size_t)M * DM * 4 <= WS_QO && WS_QO + (size_t)M * DM * 2 <= WS_KV && WS_KV + 4 * KV_BYTES <= WS_END && WS_H + (size_t)M * FFN * 2 <= WS_END, "ws map");
constexpr int CW_BAR = 4096;
constexpr int S_U = 2, S_W = 6, S_O = 4, S_AO = 4;
constexpr int E8(int s) { return (127 - s) * 0x01010101; }

constexpr int RING_OFF = 0, RING_BYTES = 131072;
constexpr int LDSCTL_OFF = RING_BYTES, MISC_OFF = LDSCTL_OFF + 320;
constexpr int XCH_OFF = RING_BYTES + 1024;
constexpr int LDS_BYTES = 147456;
static_assert(XCH_OFF + 4096 <= LDS_BYTES, "LDS map");

#define GAS __attribute__((address_space(1)))
#define LAS __attribute__((address_space(3)))
typedef unsigned short bf16;
typedef unsigned v4u __attribute__((ext_vector_type(4)));
typedef float f32x4 __attribute__((ext_vector_type(4)));
typedef GAS unsigned gu32;
#define RLX_AGENT __ATOMIC_RELAXED, __HIP_MEMORY_SCOPE_AGENT
#define LDS_WAIT() asm volatile("s_waitcnt lgkmcnt(0)" ::: "memory")
#define VM_WAIT() asm volatile("s_waitcnt vmcnt(0)" ::: "memory")
__device__ __forceinline__ unsigned f2bf(float f) { unsigned u = __builtin_bit_cast(unsigned, f); return (u + 0x7fffu + ((u >> 16) & 1u)) >> 16; }
__device__ __forceinline__ unsigned pk2(float lo, float hi) { return f2bf(lo) | (f2bf(hi) << 16); }

#define XB_TMO      128
#define XB_XCNT(j)  (256  + 64 * (j))
#define XB_XSUB(j)  (1280 + 64 * (j))
#define XB_XGEN(j)  (2304 + 64 * (j))
#define XB_TOP      3328
#define XB_TOPGEN   3392
#define XCD_BAR_WORDS 3456
#define XB_SPIN_CAP (1u << 18)
__device__ __forceinline__ unsigned xb_ld(unsigned* p)              { return __hip_atomic_load(p, __ATOMIC_RELAXED, __HIP_MEMORY_SCOPE_AGENT); }
__device__ __forceinline__ unsigned xb_add(unsigned* p, unsigned v) { return __hip_atomic_fetch_add(p, v, __ATOMIC_RELAXED, __HIP_MEMORY_SCOPE_AGENT); }
__device__ __forceinline__ unsigned xb_xcc_id() { return (unsigned)__builtin_amdgcn_s_getreg((3 << 11) | 20) & 0xFu; }
#define XB_SPIN(cond, bar) do { unsigned _sp = 0; while (cond) { __builtin_amdgcn_s_sleep(1); \
    if ((++_sp & 255u) == 0u) { if (xb_ld(&(bar)[XB_TMO])) break; if (_sp > XB_SPIN_CAP) { atomicAdd(&(bar)[XB_TMO], 1u); break; } } } } while (0)
struct XcdBarrier { unsigned* bar; unsigned x; volatile LAS unsigned* st; };
__device__ __forceinline__ XcdBarrier xcd_barrier_post(unsigned* bar, volatile LAS unsigned* st) {
    XcdBarrier b; b.bar = bar; b.x = xb_xcc_id(); b.st = st;
    if (threadIdx.x == 0) (void)xb_add(&bar[XB_XCNT(b.x)], 1u);
    return b;
}
__device__ __forceinline__ void xcd_barrier_complete(unsigned* bar, unsigned x, unsigned& nloc, unsigned& nx) {
    const unsigned G = gridDim.x * gridDim.y * gridDim.z;
    unsigned sum, cnt, mine, sp = 0u;
    for (;;) {
        sum = 0u; cnt = 0u; mine = 0u;
#pragma unroll
        for (unsigned j = 0; j < 16; ++j) { const unsigned c = xb_ld(&bar[XB_XCNT(j)]); sum += c; cnt += (c > 0u) ? 1u : 0u; mine = (j == x) ? c : mine; }
        if (sum == G) break;
        __builtin_amdgcn_s_sleep(1);
        if ((++sp & 255u) == 0u) { if (xb_ld(&bar[XB_TMO])) break; if (sp > XB_SPIN_CAP) { atomicAdd(&bar[XB_TMO], 1u); break; } }
    }
    nloc = mine > 0u ? mine : 1u; nx = cnt > 0u ? cnt : 1u;
}
__device__ __forceinline__ void xcd_barrier(const XcdBarrier& b) {
    asm volatile("s_waitcnt vmcnt(0)" ::: "memory");
    __syncthreads();
    if (threadIdx.x == 0) {
        unsigned* bar = b.bar;
        __builtin_amdgcn_s_waitcnt(0);
        unsigned nloc = b.st[0], nx = b.st[1];
        if (nloc == 0u) { xcd_barrier_complete(bar, b.x, nloc, nx); b.st[0] = nloc; b.st[1] = nx; }
        const unsigned old = xb_add(&bar[XB_XSUB(b.x)], 1u);
        const unsigned gen = old / nloc;
        if (old + 1u == (gen + 1u) * nloc) {
            __builtin_amdgcn_fence(__ATOMIC_RELEASE, "agent");
            asm volatile("s_waitcnt vmcnt(0)" ::: "memory");
            const unsigned og = xb_add(&bar[XB_TOP], 1u);
            const unsigned tg = og / nx;
            if (og + 1u == (tg + 1u) * nx) xb_add(&bar[XB_TOPGEN], 1u);
            else XB_SPIN(xb_ld(&bar[XB_TOPGEN]) == tg, bar);
            __builtin_amdgcn_fence(__ATOMIC_ACQUIRE, "agent");
            xb_add(&bar[XB_XGEN(b.x)], 1u);
            asm volatile("s_waitcnt vmcnt(0)" ::: "memory");
        } else {
            XB_SPIN(xb_ld(&bar[XB_XGEN(b.x)]) == gen, bar);
            __builtin_amdgcn_fence(__ATOMIC_ACQUIRE, "agent");
            asm volatile("s_waitcnt vmcnt(0)" ::: "memory");
        }
    }
    __syncthreads();
}

__device__ __forceinline__ float wave_sum(float v) {
#pragma unroll
    for (int o = 1; o < 64; o <<= 1) v += __shfl_xor(v, o);
    return v;
}
__device__ __forceinline__ void transpose_item(const float* W, int ldw, int k0, int n0, bf16* WT, int Kd, int dst_row0, LAS float* scr, int lane) {
    float wv_[32];
#pragma unroll
    for (int i = 0; i < 32; ++i) wv_[i] = W[(size_t)(k0 + 2 * i + (lane >> 5)) * ldw + n0 + (lane & 31)];
#pragma unroll
    for (int i = 0; i < 32; ++i) scr[(2 * i + (lane >> 5)) * 33 + (lane & 31)] = wv_[i];
    LDS_WAIT(); asm volatile("" ::: "memory");
    const int c = lane & 7;
#pragma unroll
    for (int j = 0; j < 4; ++j) { const int n = (lane >> 3) + 8 * j; const LAS float* s = scr + (8 * c) * 33 + n;
        v4u o; o.x = pk2(s[0 * 33], s[1 * 33]); o.y = pk2(s[2 * 33], s[3 * 33]); o.z = pk2(s[4 * 33], s[5 * 33]); o.w = pk2(s[6 * 33], s[7 * 33]);
        *(GAS v4u*)(WT + (size_t)(dst_row0 + n) * Kd + k0 + 8 * c) = o; }
    LDS_WAIT(); asm volatile("" ::: "memory");
}
__device__ __forceinline__ float clamp448(float v) { return __builtin_fminf(__builtin_fmaxf(v, -448.f), 448.f); }
__device__ __forceinline__ unsigned pk4_fp8(float a, float b, float c, float d) {
    int w = __builtin_amdgcn_cvt_pk_fp8_f32(clamp448(a), clamp448(b), 0, false); w = __builtin_amdgcn_cvt_pk_fp8_f32(clamp448(c), clamp448(d), w, true); return (unsigned)w; }
__device__ __forceinline__ void transpose_item8(const float* W, int ldw, int k0, int n0, unsigned char* WT, int Kd, int dst_row0, float scl, LAS float* scr, int lane) {
    float wv_[32];
#pragma unroll
    for (int i = 0; i < 32; ++i) wv_[i] = W[(size_t)(k0 + 2 * i + (lane >> 5)) * ldw + n0 + (lane & 31)];
#pragma unroll
    for (int i = 0; i < 32; ++i) scr[(2 * i + (lane >> 5)) * 33 + (lane & 31)] = wv_[i];
    LDS_WAIT(); asm volatile("" ::: "memory");
    const int c = lane & 7;
#pragma unroll
    for (int j = 0; j < 4; ++j) { const int n = (lane >> 3) + 8 * j; const LAS float* s = scr + (8 * c) * 33 + n;
        typedef unsigned u2v __attribute__((ext_vector_type(2)));
        u2v o; o.x = pk4_fp8(s[0 * 33] * scl, s[1 * 33] * scl, s[2 * 33] * scl, s[3 * 33] * scl); o.y = pk4_fp8(s[4 * 33] * scl, s[5 * 33] * scl, s[6 * 33] * scl, s[7 * 33] * scl);
        *(GAS u2v*)(WT + (size_t)(dst_row0 + n) * Kd + k0 + 8 * c) = o; }
    LDS_WAIT(); asm volatile("" ::: "memory");
}
__device__ __forceinline__ unsigned pk4_i8(float a, float b, float c, float d) {
    const int ia = (int)__builtin_rintf(__builtin_fminf(__builtin_fmaxf(a, -127.f), 127.f)), ib = (int)__builtin_rintf(__builtin_fminf(__builtin_fmaxf(b, -127.f), 127.f));
    const int ic = (int)__builtin_rintf(__builtin_fminf(__builtin_fmaxf(c, -127.f), 127.f)), id = (int)__builtin_rintf(__builtin_fminf(__builtin_fmaxf(d, -127.f), 127.f));
    return (unsigned)(ia & 0xff) | ((unsigned)(ib & 0xff) << 8) | ((unsigned)(ic & 0xff) << 16) | ((unsigned)id << 24); }
__device__ __forceinline__ void transpose_item_i8(const float* W, int ldw, int k0, int n0, unsigned char* WT, int Kd, int dst_row0, float scl, LAS float* scr, int lane) {
    float wv_[32];
#pragma unroll
    for (int i = 0; i < 32; ++i) wv_[i] = W[(size_t)(k0 + 2 * i + (lane >> 5)) * ldw + n0 + (lane & 31)];
#pragma unroll
    for (int i = 0; i < 32; ++i) scr[(2 * i + (lane >> 5)) * 33 + (lane & 31)] = wv_[i];
    LDS_WAIT(); asm volatile("" ::: "memory");
    const int c = lane & 7;
#pragma unroll
    for (int j = 0; j < 4; ++j) { const int n = (lane >> 3) + 8 * j; const LAS float* s = scr + (8 * c) * 33 + n;
        typedef unsigned u2v __attribute__((ext_vector_type(2)));
        u2v o; o.x = pk4_i8(s[0 * 33] * scl, s[1 * 33] * scl, s[2 * 33] * scl, s[3 * 33] * scl); o.y = pk4_i8(s[4 * 33] * scl, s[5 * 33] * scl, s[6 * 33] * scl, s[7 * 33] * scl);
        *(GAS u2v*)(WT + (size_t)(dst_row0 + n) * Kd + k0 + 8 * c) = o; }
    LDS_WAIT(); asm volatile("" ::: "memory");
}
__device__ __forceinline__ float w_clip(const float* W, int lane) {
    float s2 = 0.f;
#pragma unroll
    for (int j = 0; j < 8; ++j) { const f32x4 v = ((const GAS f32x4*)W)[64 * j + lane]; s2 += (v.x * v.x + v.y * v.y) + (v.z * v.z + v.w * v.w); }
    return 4.5f * sqrtf(wave_sum(s2) * (1.0f / 2048.0f)) + 1e-30f;
}
__device__ __forceinline__ float silu_f(float x) { return x / (1.0f + __expf(-x)); }

struct Args { const float* in[18]; float* out; unsigned char* ws; int ph_lo, ph_hi, li, flags; };

__device__ __forceinline__ void modulate_row8(const float* xrow, unsigned char* orow, const LAS float* p0, const LAS float* p1, float scl, int lane) {
    const GAS f32x4* xr = (const GAS f32x4*)xrow + lane;
    GAS unsigned* o4 = (GAS unsigned*)orow + lane;
    f32x4 v[8];
#pragma unroll
    for (int j = 0; j < 8; ++j) v[j] = xr[64 * j];
#pragma unroll
    for (int j = 0; j < 8; ++j) { const f32x4 a = *(const LAS f32x4*)(p0 + 256 * j + 4 * lane), s = *(const LAS f32x4*)(p1 + 256 * j + 4 * lane); const f32x4 r = (v[j] * a + s) * scl;
        o4[64 * j] = pk4_fp8(r.x, r.y, r.z, r.w); }
}
__device__ __forceinline__ void modulate_row(const float* xrow, bf16* orow, const LAS float* p0, const LAS float* p1, int lane) {
    const GAS f32x4* xr = (const GAS f32x4*)xrow + lane;
    GAS unsigned long long* o8 = (GAS unsigned long long*)orow + lane;
    f32x4 v[8];
#pragma unroll
    for (int j = 0; j < 8; ++j) v[j] = xr[64 * j];
#pragma unroll
    for (int j = 0; j < 8; ++j) { const f32x4 a = *(const LAS f32x4*)(p0 + 256 * j + 4 * lane), s = *(const LAS f32x4*)(p1 + 256 * j + 4 * lane); const f32x4 r = v[j] * a + s;
        o8[64 * j] = (unsigned long long)pk2(r.x, r.y) | ((unsigned long long)pk2(r.z, r.w) << 32); }
}
typedef unsigned u32x2 __attribute__((ext_vector_type(2)));
__device__ __forceinline__ f32x4 bf4_to_f32(u32x2 w) { f32x4 r; r.x = __uint_as_float(w.x << 16); r.y = __uint_as_float(w.x & 0xffff0000u); r.z = __uint_as_float(w.y << 16); r.w = __uint_as_float(w.y & 0xffff0000u); return r; }
__device__ __forceinline__ void ln_regs(f32x4 (&v)[8], const LAS float* g, const LAS float* bb, int lane) {
    float s = 0.f;
#pragma unroll
    for (int j = 0; j < 8; ++j) s += (v[j].x + v[j].y) + (v[j].z + v[j].w);
    const float mean = wave_sum(s) * (1.f / DM); float s2 = 0.f;
#pragma unroll
    for (int j = 0; j < 8; ++j) { v[j] = v[j] - mean; s2 += (v[j].x * v[j].x + v[j].y * v[j].y) + (v[j].z * v[j].z + v[j].w * v[j].w); }
    const float rstd = __builtin_amdgcn_rsqf(wave_sum(s2) * (1.f / DM) + LN_EPS);
#pragma unroll
    for (int j = 0; j < 8; ++j) { const int c = 256 * j + 4 * lane; v[j] = v[j] * rstd * *(const LAS f32x4*)(g + c) + *(const LAS f32x4*)(bb + c); if (j & 1) asm volatile("" ::: "memory"); }
}
__device__ __forceinline__ f32x4 fp8x4_to_f32(unsigned w) { f32x4 r; r.x = __builtin_amdgcn_cvt_f32_fp8((int)w, 0); r.y = __builtin_amdgcn_cvt_f32_fp8((int)w, 1); r.z = __builtin_amdgcn_cvt_f32_fp8((int)w, 2); r.w = __builtin_amdgcn_cvt_f32_fp8((int)w, 3); return r; }
struct RowIn { f32x4 x[8]; unsigned a[8]; };
__device__ __forceinline__ void row_load(RowIn& r, const float* xrow, const unsigned char* arow, int lane) {
    const GAS f32x4* xr = (const GAS f32x4*)xrow + lane; const GAS unsigned* ar = (const GAS unsigned*)arow + lane;
#pragma unroll
    for (int j = 0; j < 8; ++j) { r.x[j] = __builtin_nontemporal_load(xr + 64 * j); r.a[j] = __builtin_nontemporal_load(ar + 64 * j); }
}
__device__ __forceinline__ void x1_from(f32x4 (&v)[8], const RowIn& r, const LAS float* P, int lane) {
#pragma unroll
    for (int j = 0; j < 8; ++j) { v[j] = r.x[j] * DN_ALPHA + *(const LAS f32x4*)(P + 256 * j + 4 * lane) * (fp8x4_to_f32(r.a[j]) * (1.0f / (float)(1 << S_AO))); if (j & 1) asm volatile("" ::: "memory"); }
    ln_regs(v, P + 2048, P + 4096, lane);
}

__device__ __forceinline__ void p6_rows(const float* __restrict__ x, const unsigned char* __restrict__ AB8, unsigned char* __restrict__ U8i, float* __restrict__ RSC, const LAS float* P, int bx, int wave, int lane) {
        {
            const int rbase = bx * 64 + wave * 8;
            RowIn in[2]; row_load(in[0], x + (size_t)rbase * DM, AB8 + (size_t)rbase * DM, lane);
#pragma unroll
            for (int i = 0; i < 8; ++i) { const int rr = rbase + i;
            if (i < 7) row_load(in[(i + 1) & 1], x + (size_t)(rr + 1) * DM, AB8 + (size_t)(rr + 1) * DM, lane);
            asm volatile("" ::: "memory");
            f32x4 v[8]; x1_from(v, in[i & 1], P, lane);
            float amax = 0.f;
#pragma unroll
            for (int j = 0; j < 8; ++j) { const int c = 256 * j + 4 * lane; v[j] = v[j] * *(const LAS f32x4*)(P + 6144 + c) + *(const LAS f32x4*)(P + 8192 + c);
                amax = __builtin_fmaxf(amax, __builtin_fmaxf(__builtin_fmaxf(__builtin_fabsf(v[j].x), __builtin_fabsf(v[j].y)), __builtin_fmaxf(__builtin_fabsf(v[j].z), __builtin_fabsf(v[j].w)))); }
#pragma unroll
            for (int o = 1; o < 64; o <<= 1) amax = __builtin_fmaxf(amax, __shfl_xor(amax, o));
            amax = __builtin_fmaxf(amax, 1e-20f);
            const float qs = 127.0f / amax;
            GAS unsigned* o4 = (GAS unsigned*)(U8i + (size_t)rr * DM) + lane;
#pragma unroll
            for (int j = 0; j < 8; ++j) o4[64 * j] = pk4_i8(v[j].x * qs, v[j].y * qs, v[j].z * qs, v[j].w * qs);
            if (lane == 0) RSC[rr] = amax * (1.0f / 127.0f);
            asm volatile("" ::: "memory");
            }
        }
}

__device__ __forceinline__ void p9_rows(const float* __restrict__ x, const unsigned char* __restrict__ AB8, const bf16* __restrict__ DB, float* __restrict__ outp, const LAS float* P, int bx, int wave, int lane) {
        {
            const int rbase = bx * 64 + wave * 8;
            RowIn in[2]; u32x2 dd[2][8];
            row_load(in[0], x + (size_t)rbase * DM, AB8 + (size_t)rbase * DM, lane);
            { const GAS u32x2* dr = (const GAS u32x2*)(DB + (size_t)rbase * DM) + lane;
#pragma unroll
              for (int j = 0; j < 8; ++j) dd[0][j] = __builtin_nontemporal_load(dr + 64 * j); }
#pragma unroll
            for (int i = 0; i < 8; ++i) { const int rr = rbase + i;
            if (i < 7) { row_load(in[(i + 1) & 1], x + (size_t)(rr + 1) * DM, AB8 + (size_t)(rr + 1) * DM, lane);
                const GAS u32x2* dr = (const GAS u32x2*)(DB + (size_t)(rr + 1) * DM) + lane;
#pragma unroll
                for (int j = 0; j < 8; ++j) dd[(i + 1) & 1][j] = __builtin_nontemporal_load(dr + 64 * j); }
            asm volatile("" ::: "memory");
            f32x4 v[8]; x1_from(v, in[i & 1], P, lane);
#pragma unroll
            for (int j = 0; j < 8; ++j) { v[j] = v[j] * DN_ALPHA + *(const LAS f32x4*)(P + 6144 + 256 * j + 4 * lane) * bf4_to_f32(dd[i & 1][j]); if ((j & 3) == 3) asm volatile("" ::: "memory"); }
            ln_regs(v, P + 8192, P + 10240, lane);
            GAS f32x4* orow = (GAS f32x4*)(outp + (size_t)rr * DM) + lane;
#pragma unroll
            for (int j = 0; j < 8; ++j) __builtin_nontemporal_store(v[j], orow + 64 * j);
            asm volatile("" ::: "memory");
            }
        }
}

__global__ void __launch_bounds__(NWAVES * 64, 2) dit_fwd(Args args) {
    extern __shared__ __attribute__((aligned(16))) unsigned char lds[];
    LAS unsigned char* L = (LAS unsigned char*)lds;
    volatile LAS unsigned* MISC = (volatile LAS unsigned*)(L + MISC_OFF);
    const int tid = threadIdx.x, lane = tid & 63, wave = __builtin_amdgcn_readfirstlane(tid >> 6);
    const int G = gridDim.x, bx = blockIdx.x;
    unsigned char* ws = args.ws;
    gu32* ctl = (gu32*)(ws + WS_CTL);
    const float* x = args.in[0]; const float* cvec = args.in[1]; const float* ctx = args.in[2]; const float* c_ctx = args.in[3];
    const float* w_ada = args.in[4]; const float* b_ada = args.in[5]; const float* w_in = args.in[6]; const float* qng = args.in[7]; const float* kng = args.in[8];
    const float* sink = args.in[9]; const float* w_out = args.in[10]; const float* ln1g = args.in[11]; const float* ln1b = args.in[12];
    const float* w_gate = args.in[13]; const float* w_up = args.in[14]; const float* w_down = args.in[15]; const float* ln2g = args.in[16]; const float* ln2b = args.in[17];
    float* MODP = (float*)(ws + WS_MODP); float* MODS = (float*)(ws + WS_MODS); float* ROPEC = (float*)(ws + WS_ROPE); float* ROPES = ROPEC + 2048;
    bf16* WIN = (bf16*)(ws + WS_WIN); bf16* WOUT = (bf16*)(ws + WS_WOUT); bf16* WGU = (bf16*)(ws + WS_WGU); bf16* WDN = (bf16*)(ws + WS_WDN);
    bf16* U = (bf16*)(ws + WS_U); unsigned char* AB8 = ws + WS_Y; bf16* DB = (bf16*)(ws + WS_Y + 64 * MiB);
    unsigned char* U8i = ws + WS_U; unsigned char* WGU8 = ws + WS_WGU; float* RSC = (float*)(ws + WS_ROPE + 256 * 1024);
    unsigned char* U8 = ws + WS_U;
    unsigned char* WIN8 = ws + WS_WIN; unsigned char* WOUT8 = ws + WS_WOUT;
    unsigned char* OF8 = ws + WS_Y + 64 * MiB;
    unsigned char* VTA = ws + WS_KV + KV_BYTES; unsigned char* VTB = ws + WS_KV + 3 * KV_BYTES;
    unsigned char* QO8 = ws + WS_QO; unsigned char* KA8 = ws + WS_KV; unsigned char* KB8 = ws + WS_KV + 2 * KV_BYTES;
    bf16* KA = (bf16*)(ws + WS_KV); bf16* VA = (bf16*)(ws + WS_KV + KV_BYTES); bf16* KB = (bf16*)(ws + WS_KV + 2 * KV_BYTES); bf16* VB = (bf16*)(ws + WS_KV + 3 * KV_BYTES);
    bf16* HB = (bf16*)(ws + WS_H);

    for (int u = tid; u < (LDS_BYTES - LDSCTL_OFF) / 4; u += NWAVES * 64) ((LAS unsigned*)(L + LDSCTL_OFF))[u] = 0u;
    __syncthreads();
    XcdBarrier bar; bar.bar = (unsigned*)(ctl + CW_BAR); bar.x = 0; bar.st = nullptr;
    if (N_LAUNCHES == 1) bar = xcd_barrier_post((unsigned*)(ctl + CW_BAR), MISC + 8);
#define GRID_BAR() do { if (N_LAUNCHES == 1) xcd_barrier(bar); } while (0)
    const int lo = args.ph_lo, hi = args.ph_hi;
#ifndef PHMASK
#define PHMASK 0x3FF
#endif
#define IN(k) (((PHMASK >> (k)) & 1) && lo <= (k) && (k) < hi)
#define BOTH(k) (IN(k) && IN((k) + 1))

    if (IN(0)) {
        if (bx < 192) {
            const int cb = bx >> 2, kq = bx & 3, k0 = kq * 512 + wave * 64;
            float sv[5];
#pragma unroll
            for (int b = 0; b < 4; ++b) sv[b] = silu_f(cvec[b * DM + k0 + lane]);
            sv[4] = silu_f(c_ctx[k0 + lane]);
            f32x4 acc[5];
#pragma unroll
            for (int b = 0; b < 5; ++b) acc[b] = (f32x4){0.f, 0.f, 0.f, 0.f};
            const float* wp = w_ada + (size_t)k0 * NMOD + cb * 256 + lane * 4;
#pragma unroll 16
            for (int kk = 0; kk < 64; ++kk) { const f32x4 wv = *(const f32x4*)(wp + (size_t)kk * NMOD);
#pragma unroll
                for (int b = 0; b < 5; ++b) { const float s = __builtin_bit_cast(float, __builtin_amdgcn_readlane(__builtin_bit_cast(int, sv[b]), kk)); acc[b] += wv * s; } }
            LAS f32x4* red = (LAS f32x4*)(L + RING_OFF);
#pragma unroll
            for (int b = 0; b < 5; ++b) red[(wave * 5 + b) * 64 + lane] = acc[b];
            LDS_WAIT(); __syncthreads();
            if (tid < 320) { const int b = tid >> 6, l = tid & 63; f32x4 s = red[b * 64 + l];
#pragma unroll
                for (int w = 1; w < 8; ++w) s += red[(w * 5 + b) * 64 + l];
                *(f32x4*)(MODP + ((size_t)kq * 5 + b) * NMOD + cb * 256 + l * 4) = s; }
            __syncthreads();
        }
        if (bx == 255) {
            for (int e = tid; e < 2048; e += NWAVES * 64) { const int pos = e >> 5, f = e & 31;
                const float inv = exp2f(-(float)f * (13.287712379549449f / 32.0f)); const float ang = (float)pos * inv;
                float sn, cs; sincosf(ang, &sn, &cs); ROPEC[e] = cs; ROPES[e] = sn; }
        }
        {
            LAS float* scr = (LAS float*)(L + RING_OFF + wave * 16384);
            constexpr int I_IN = 32 * 96, I_OUT = 32 * 64, I_G = 32 * 176, NITEMS = I_IN + I_OUT + I_G, NSLOT = 192 * 8 * 2 + 64 * 8 * 5;
            const float qs_gate = 127.0f / w_clip(w_gate, lane);
            const int nsl = bx < 192 ? 2 : 5, sl0 = bx < 192 ? (bx * 8 + wave) * 2 : 3072 + ((bx - 192) * 8 + wave) * 5;
            for (int s = 0; s < nsl; ++s)
                for (int it = sl0 + s; it < NITEMS; it += NSLOT) {
                    int r = it;
                    if (r < I_IN) { const int kb = r / 96, nb = r % 96, pn = nb >> 3, q = nb & 7, hh = q >> 2, part = (q >> 1) & 1, bj = q & 1;
                        transpose_item8(w_in, INW, 64 * kb, 32 * nb, WIN8, DM, 256 * pn + 32 * (4 * bj + 2 * hh + part), (float)(1 << S_W), scr, lane); continue; } r -= I_IN;
                    if (r < I_OUT) { const int kb = r / 64, nb = r % 64; transpose_item8(w_out, DM, 64 * kb, 32 * nb, WOUT8, DM, 32 * nb, (float)(1 << S_W), scr, lane); continue; } r -= I_OUT;
                    { const int kb = r / 176, nb = r % 176; transpose_item_i8(w_gate, FFN, 64 * kb, 32 * nb, WGU8, DM, 256 * (nb >> 2) + 32 * (nb & 3), qs_gate, scr, lane); }
                }
        }
        if (BOTH(0)) GRID_BAR();
    }

    if (IN(1)) {
        { const int idx = bx * 512 + tid;
          if (idx < 5 * NMOD) { float s = b_ada[idx % NMOD];
#pragma unroll
              for (int q = 0; q < 4; ++q) s += MODP[(size_t)q * 5 * NMOD + idx];
              MODS[idx] = s; } }
        if (bx < 128) {
            LAS float* P0 = (LAS float*)(L + RING_OFF); LAS float* P1 = P0 + 2048;
            for (int i = tid; i < 2048; i += NWAVES * 64) { float sh = b_ada[i], sc = b_ada[2048 + i];
#pragma unroll
                for (int q = 0; q < 4; ++q) { sh += MODP[((size_t)q * 5 + 4) * NMOD + i]; sc += MODP[((size_t)q * 5 + 4) * NMOD + 2048 + i]; }
                P0[i] = 1.0f + sc; P1[i] = sh; }
            LDS_WAIT(); __syncthreads();
            const int r = bx * 8 + wave;
            modulate_row8(ctx + (size_t)r * DM, U8 + (size_t)(M + r) * DM, P0, P1, (float)(1 << S_U), lane);
            __syncthreads();
        }
        if (BOTH(1)) GRID_BAR();
    }

    if (IN(2)) {
        if (bx < 16) {
            const int pnl[4] = {4, 5, 10, 11};
            pg8::Gemm g{(const bf16*)U8, (const bf16*)WIN8, MU, INW, DM / 2}; pg8::OneUnit S{64 + (bx >> 2), (bx & 3) == 0 ? 4 : (bx & 3) == 1 ? 5 : (bx & 3) == 2 ? 10 : 11}; (void)pnl;
            pg8::EpiQKV E{QO8, KA8, VTA, KB8, VTB, qng, kng, ROPEC, ROPES, (LAS float*)(L + XCH_OFF)};
            pg8::gemm_phase<pg8::EpiQKV, pg8::OneUnit, true, true, E8(S_W), E8(S_U)>(L + RING_OFF, g, S, E);
        } else {
            LAS float* P0 = (LAS float*)(L + RING_OFF); LAS float* P1 = P0 + 2048;
            const int i = bx - 16, r0 = (int)(((long)i * M) / 240), r1 = (int)(((long)(i + 1) * M) / 240);
            int r = r0;
            while (r < r1) {
                const int b = r >> 12; int re = (b + 1) << 12; if (re > r1) re = r1;
                __syncthreads();
                for (int k = tid; k < 2048; k += NWAVES * 64) { P0[k] = 1.0f + MODS[b * NMOD + 2048 + k]; P1[k] = MODS[b * NMOD + k]; }
                LDS_WAIT(); __syncthreads();
                for (int rr = r + wave; rr < re; rr += NWAVES) modulate_row8(x + (size_t)rr * DM, U8 + (size_t)rr * DM, P0, P1, (float)(1 << S_U), lane);
                r = re;
            }
            __syncthreads();
            {
                LAS float* scr = (LAS float*)(L + RING_OFF + wave * 16384);
                constexpr int I_G = 32 * 176, I_D = 88 * 64, NITEMS2 = I_G + I_D;
                const float qs_up = 127.0f / w_clip(w_up, lane);
                for (int it = i * 8 + wave; it < NITEMS2; it += 240 * 8) {
                    if (it < I_G) { const int kb = it / 176, nb = it % 176; transpose_item_i8(w_up, FFN, 64 * kb, 32 * nb, WGU8, DM, 256 * (nb >> 2) + 128 + 32 * (nb & 3), qs_up, scr, lane); }
                    else { const int r2 = it - I_G, kb = r2 / 64, nb = r2 % 64; transpose_item(w_down, DM, 64 * kb, 32 * nb, WDN, FFN, 32 * nb, scr, lane); }
                }
            }
        }
        if (BOTH(2)) GRID_BAR();
    }

    if (IN(3)) {
        pg8::Gemm g{(const bf16*)U8, (const bf16*)WIN8, M, INW, DM / 2}; pg8::StaticOrder S; S.init(M, INW, G, bx);
        pg8::EpiQKV E{QO8, KA8, VTA, KB8, VTB, qng, kng, ROPEC, ROPES, (LAS float*)(L + XCH_OFF)};
        pg8::gemm_phase<pg8::EpiQKV, pg8::StaticOrder, true, true, E8(S_W), E8(S_U)>(L + RING_OFF, g, S, E);
        if (BOTH(3)) GRID_BAR();
    }

    if (IN(4)) {
        const int xg = bx & 7, y = bx >> 3, b = xg >> 1, kvh = xg & 1;
        const size_t kvoff = (size_t)(b * 2 + kvh) * SKV * 128;
        float kbnd; { float gm = fmaxf(fabsf(kng[lane]), fabsf(kng[64 + lane]));
#pragma unroll
            for (int o = 1; o < 64; o <<= 1) gm = fmaxf(gm, __shfl_xor(gm, o));
            kbnd = gm * 11.313708498984761f * 1.08f; }
#define MKUNIT(u, i_) do { const int i__ = (i_); const int uu = 2 * y + (i__ & 1), gq = uu >> 4, qb = uu & 15, q0 = qb * 256; const bool isA = i__ >= 2; const int head = kvh * 4 + gq; \
            unsigned char* Qp = QO8 + (size_t)(b * SEQ + q0) * DM + (isA ? 0 : 1024) + head * 128; \
            const int jlo = !isA ? 0 : ((q0 >> 6) - 2 < 0 ? 0 : (q0 >> 6) - 2), jhi = (q0 >> 6) + 6 > 64 ? 64 : (q0 >> 6) + 6; \
            (u).Q = Qp; (u).K = (isA ? KA8 : KB8) + kvoff; (u).V = (isA ? VTA : VTB) + kvoff; (u).O = ((args.flags & 1) ? ws + 384 * MiB : OF8) + (Qp - QO8); \
            (u).NT = isA ? 4 + (jhi - jlo) : SKV / 64; (u).nctx = isA ? 4 : 0; (u).jlo = jlo; (u).q0 = q0; (u).masked = isA; (u).sinkl2 = isA ? sink[head] * 1.4426950408889634f : -INFINITY; (u).kbound = -1.f; (void)kbnd; } while (0)
        att::v8i qr[2]; att::Stg stg[2];
        att::AUnit cur, nx; MKUNIT(cur, 0); att::attn_prime(cur, qr, stg);
        for (int i = 0; i < 4; ++i) {
            MKUNIT(nx, i < 3 ? i + 1 : 3);
            att::attn_unit(cur, i < 3, nx, qr, stg, (char*)lds + RING_OFF);
            cur = nx;
        }
#undef MKUNIT
        if (BOTH(4)) GRID_BAR();
    }

    if (IN(5)) {
        pg8::Gemm g{(const bf16*)OF8, (const bf16*)WOUT8, M, DM, DM / 2}; pg8::StaticOrder S; S.init(M, DM, G, bx);
        pg8::EpiFp8Plain E{AB8, DM, (float)(1 << S_AO)};
        pg8::gemm_phase<pg8::EpiFp8Plain, pg8::StaticOrder, true, true, E8(S_W), E8(S_O)>(L + RING_OFF, g, S, E);
        if (BOTH(5)) GRID_BAR();
    }

    if (IN(6)) {
        LAS float* P = (LAS float*)(L + RING_OFF);
        const int b = bx >> 6;
        for (int k = tid; k < 2048; k += NWAVES * 64) { P[k] = MODS[b * NMOD + 2 * 2048 + k]; P[2048 + k] = ln1g[k]; P[4096 + k] = ln1b[k]; P[6144 + k] = 1.0f + MODS[b * NMOD + 4 * 2048 + k]; P[8192 + k] = MODS[b * NMOD + 3 * 2048 + k]; }
        LDS_WAIT(); __syncthreads();
        p6_rows(x, AB8, U8i, RSC, P, bx, wave, lane);
        __syncthreads();
        if (BOTH(6)) GRID_BAR();
    }

    if (IN(7)) {
        pg8::Gemm g{(const bf16*)U8i, (const bf16*)WGU8, M, 2 * FFN, DM / 2}; pg8::StaticOrder S; S.init(M, 2 * FFN, G, bx);
        pg8::EpiSwiglu8 E{HB, FFN, RSC, w_clip(w_gate, lane) * (1.0f / 127.0f), w_clip(w_up, lane) * (1.0f / 127.0f)};
        pg8::gemm_phase<pg8::EpiSwiglu8, pg8::StaticOrder, true, true, 0, 0, false, true>(L + RING_OFF, g, S, E);
        if (BOTH(7)) GRID_BAR();
    }

    if (IN(8)) {
        pg8::Gemm g{HB, WDN, M, DM, FFN}; pg8::StaticOrder S; S.init(M, DM, G, bx);
        pg8::EpiBf16Plain E{DB, DM};
        pg8::gemm_phase<pg8::EpiBf16Plain, pg8::StaticOrder, true, true>(L + RING_OFF, g, S, E);
        if (BOTH(8)) GRID_BAR();
    }

    if (IN(9)) {
        LAS float* P = (LAS float*)(L + RING_OFF);
        const int b = bx >> 6;
        for (int k = tid; k < 2048; k += NWAVES * 64) { P[k] = MODS[b * NMOD + 2 * 2048 + k]; P[2048 + k] = ln1g[k]; P[4096 + k] = ln1b[k]; P[6144 + k] = MODS[b * NMOD + 5 * 2048 + k]; P[8192 + k] = ln2g[k]; P[10240 + k] = ln2b[k]; }
        LDS_WAIT(); __syncthreads();
        p9_rows(x, AB8, DB, args.out, P, bx, wave, lane);
    }
#undef IN
#undef BOTH
#undef GRID_BAR
}

extern "C" void kernel_launch(void* const* d_in, const int* in_sizes, int n_in, void* d_out, int out_size, void* d_ws, size_t ws_size, hipStream_t stream) {
    static int grid = 0;
    if (grid == 0) {
        if (n_in != 18 || in_sizes[0] != M * DM || out_size != M * DM || ws_size < WS_END) {
            fprintf(stderr, "kernel_launch: shape mismatch (n_in %d, in0 %d, out %d, ws %zu; need ws >= %zu); nothing launched\n", n_in, n_in > 0 ? in_sizes[0] : -1, out_size, ws_size, (size_t)WS_END); grid = -1; return; }
        int dev = 0, cus = 0, per_cu = 0;
        if (hipGetDevice(&dev) != hipSuccess || hipDeviceGetAttribute(&cus, hipDeviceAttributeMultiprocessorCount, dev) != hipSuccess) { fprintf(stderr, "kernel_launch: device query failed\n"); grid = -1; return; }
        if (hipFuncSetAttribute((const void*)dit_fwd, hipFuncAttributeMaxDynamicSharedMemorySize, LDS_BYTES) != hipSuccess) { fprintf(stderr, "kernel_launch: hipFuncSetAttribute failed\n"); grid = -1; return; }
        if (hipOccupancyMaxActiveBlocksPerMultiprocessor(&per_cu, (const void*)dit_fwd, NWAVES * 64, LDS_BYTES) != hipSuccess || per_cu < 1)
            fprintf(stderr, "kernel_launch: note: occupancy query reports %d workgroups per CU\n", per_cu);
        (void)hipGetLastError();
        if (cus != 256) { fprintf(stderr, "kernel_launch: built for a 256-CU device, found %d CUs; nothing launched\n", cus); grid = -1; return; }
        grid = 256;
    }
    if (grid < 0) return;
    if (hipMemsetAsync((char*)d_ws + WS_CTL, 0, CTL_ZERO_BYTES, stream) != hipSuccess) { fprintf(stderr, "kernel_launch: hipMemsetAsync failed\n"); return; }
    Args a{};
    for (int i = 0; i < 18; ++i) a.in[i] = (const float*)d_in[i];
    a.out = (float*)d_out; a.ws = (unsigned char*)d_ws;
    if (N_LAUNCHES == 1) { a.ph_lo = 0; a.ph_hi = N_PHASES; a.li = 0; hipLaunchKernelGGL(dit_fwd, dim3(grid), dim3(NWAVES * 64), LDS_BYTES, stream, a); }
    else { const int plist[] = PHASE_LIST;
        for (unsigned i = 0; i < sizeof(plist) / sizeof(int); ++i) { const int p = plist[i] % 100; a.ph_lo = p; a.ph_hi = p + 1; a.li = 0; a.flags = plist[i] >= 100 ? 1 : 0;
            hipLaunchKernelGGL(dit_fwd, dim3(grid), dim3(NWAVES * 64), LDS_BYTES, stream, a); } }
    const hipError_t le = hipPeekAtLastError();
    if (le != hipSuccess) fprintf(stderr, "kernel_launch: launch failed: %s\n", hipGetErrorName(le));
}
```
